# Optimizing an MI355X kernel written in HIP

```python
import jax, jax.numpy as jnp
from jax import lax
import numpy as np

D_MODEL = 1024
BATCH = 2
SEQ = 16384
DEPTH = 2

GRID_W = 64
CTX_LEN = 256
HEAD_DIM = 64
ATTN_WIDTH = D_MODEL // 2
RET_WIDTH = D_MODEL // 4
POOL_WIDTH = D_MODEL // 4
ATTN_Q_HEADS = ATTN_WIDTH // HEAD_DIM
ATTN_KV_HEADS = 2
ATTN_GROUP = ATTN_Q_HEADS // ATTN_KV_HEADS
KV_WIDTH = ATTN_KV_HEADS * HEAD_DIM
RET_HEADS = RET_WIDTH // HEAD_DIM
POOL_WINDOWS = (2, 4, 8, 16)
POOL_GROUP = POOL_WIDTH // len(POOL_WINDOWS)
MIX_WIDTH = ATTN_WIDTH + RET_WIDTH + POOL_WIDTH
IN_WIDTH = ATTN_WIDTH + 2 * KV_WIDTH + 4 * RET_WIDTH + POOL_WIDTH
Q_BLOCK = 128
RET_CHUNK = 128
ROPE_THETA = 10000.0
D_FF = ((8 * D_MODEL // 3 + 127) // 128) * 128
N_EXPERTS = 8
TOP_K = 2
N_DENSE = (DEPTH + 1) // 2
N_MOE = DEPTH // 2
NORM_EPS = 1e-6

kernel_name = 'hybrid_attn_retention_pool_moe_dit'


def rms_norm(x, g):
    xf = x.astype(jnp.float32)
    y = xf * lax.rsqrt(jnp.mean(xf * xf, axis=-1, keepdims=True) + NORM_EPS)
    return (y * g.astype(jnp.float32)).astype(x.dtype)


def axial_rope_tables(n_tokens):
    rows = n_tokens // GRID_W
    row_pos = jnp.repeat(jnp.arange(rows, dtype=jnp.float32), GRID_W)
    col_pos = jnp.tile(jnp.arange(GRID_W, dtype=jnp.float32), rows)
    n_freq = HEAD_DIM // 4
    inv = ROPE_THETA ** (-jnp.arange(n_freq, dtype=jnp.float32) / n_freq)
    ang = jnp.stack([row_pos[:, None] * inv, col_pos[:, None] * inv], axis=1)
    return jnp.cos(ang), jnp.sin(ang)


def apply_axial_rope(x, cos, sin):
    xs = x.astype(jnp.float32).reshape(x.shape[:-1] + (2, 2, HEAD_DIM // 4))
    x1 = xs[..., :, 0, :]
    x2 = xs[..., :, 1, :]
    out = jnp.stack([x1 * cos - x2 * sin, x2 * cos + x1 * sin], axis=-2)
    return out.reshape(x.shape).astype(x.dtype)


def _split_projection(p):
    sizes = (ATTN_WIDTH, KV_WIDTH, KV_WIDTH, RET_WIDTH, RET_WIDTH, RET_WIDTH, RET_WIDTH, POOL_WIDTH)
    out, off = [], 0
    for s in sizes:
        out.append(p[..., off:off + s])
        off += s
    return out


def _attn_heads(q, k, v, q_gain, k_gain):
    B, T, _ = q.shape
    q = q.reshape(B, T, ATTN_KV_HEADS, ATTN_GROUP, HEAD_DIM).transpose(0, 2, 3, 1, 4)
    k = k.reshape(B, T, ATTN_KV_HEADS, HEAD_DIM).transpose(0, 2, 1, 3)
    v = v.reshape(B, T, ATTN_KV_HEADS, HEAD_DIM).transpose(0, 2, 1, 3)
    return rms_norm(q, q_gain), rms_norm(k, k_gain), v


def _sdpa(q, k, v):
    s = jnp.einsum('bkgqd,bknd->bkgqn', q, k).astype(jnp.float32) * (HEAD_DIM ** -0.5)
    p = jax.nn.softmax(s, axis=-1).astype(v.dtype)
    return jnp.einsum('bkgqn,bknd->bkgqd', p, v)


def _blocked_attention(q, k, v):
    B, KVH, G, T, d = q.shape
    nb = T // Q_BLOCK
    qb = q.reshape(B, KVH, G, nb, Q_BLOCK, d).transpose(3, 0, 1, 2, 4, 5)
    ob = lax.map(lambda qi: _sdpa(qi, k, v), qb)
    return ob.transpose(1, 2, 3, 0, 4, 5).reshape(B, KVH, G, T, d)


def _merge_attn(o):
    B, KVH, G, T, d = o.shape
    return o.transpose(0, 3, 1, 2, 4).reshape(B, T, ATTN_WIDTH)


def _ret_heads(t):
    B, T, _ = t.shape
    return t.reshape(B, T, RET_HEADS, HEAD_DIM).transpose(0, 2, 1, 3)


def retention_scan(q, k, v, log_gamma, state0):
    B, H, T, d = q.shape
    C = RET_CHUNK
    n = T // C
    qc = q.astype(jnp.float32).reshape(B, H, n, C, d)
    kc = k.astype(jnp.float32).reshape(B, H, n, C, d)
    vc = v.astype(jnp.float32).reshape(B, H, n, C, d)
    pos = jnp.arange(C, dtype=jnp.float32)
    lg = log_gamma.astype(jnp.float32)[:, None]
    diff = pos[:, None] - pos[None, :]
    dmat = jnp.where(diff >= 0, jnp.exp(lg[:, :, None] * jnp.maximum(diff, 0.0)), 0.0)
    scores = jnp.einsum('bhncd,bhnmd->bhncm', qc, kc) * dmat[:, None]
    intra = jnp.einsum('bhncm,bhnme->bhnce', scores, vc)
    zeta = jnp.exp(lg * (C - 1 - pos))
    upd = jnp.einsum('bhncd,hc,bhnce->nbhde', kc, zeta, vc)
    decay_chunk = jnp.exp(lg[:, 0] * C)[None, :, None, None]

    def step(state, u):
        return decay_chunk * state + u, state

    final, prev = lax.scan(step, state0, upd)
    xi = jnp.exp(lg * (pos + 1))
    cross = jnp.einsum('bhncd,hc,nbhde->bhnce', qc, xi, prev)
    return (intra + cross).reshape(B, H, T, d), final


def _bi_retention(q, k, v, lg_fwd, lg_bwd, init_fwd, init_bwd):
    of, sf = retention_scan(q, k, v, lg_fwd, init_fwd)
    fl = lambda t: jnp.flip(t, axis=2)
    ob, sb = retention_scan(fl(q), fl(k), fl(v), lg_bwd, init_bwd)
    return of + fl(ob), sf, sb


def _ret_output(o, g):
    mu = jnp.mean(o, axis=-1, keepdims=True)
    var = jnp.mean(jnp.square(o - mu), axis=-1, keepdims=True)
    y = (o - mu) * lax.rsqrt(var + NORM_EPS)
    B, H, T, d = o.shape
    y = y.transpose(0, 2, 1, 3).reshape(B, T, RET_WIDTH).astype(g.dtype)
    return jax.nn.silu(g) * y


def multiscale_pool(p, w_pool, pool_scale):
    B, T, _ = p.shape
    ng = len(POOL_WINDOWS)
    pg = p.astype(jnp.float32).reshape(B, T, ng, POOL_GROUP)
    cs = jnp.concatenate([jnp.zeros((B, 1, ng, POOL_GROUP), jnp.float32), jnp.cumsum(pg, axis=1)], axis=1)
    t = jnp.arange(T)
    outs = []
    for gi, w in enumerate(POOL_WINDOWS):
        lo = jnp.clip(t - w // 2, 0, T)
        hi = jnp.clip(t + w // 2, 0, T)
        csg = cs[:, :, gi]
        mean = (csg[:, hi] - csg[:, lo]) / (hi - lo).astype(jnp.float32)[None, :, None]
        outs.append(mean - pg[:, :, gi])
    mixed = jnp.stack(outs, axis=2)
    y = jnp.einsum('btgc,gcd->btgd', mixed, w_pool.astype(jnp.float32)).reshape(B, T, POOL_WIDTH)
    return (y * pool_scale.astype(jnp.float32)).astype(p.dtype)


def token_mixers(hx, hc, w_in, w_out, q_gain, k_gain, decay_logit, pool_w, pool_scale, cos, sin, need_ctx):
    B = hx.shape[0]
    aqx, akx, avx, rqx, rkx, rvx, rgx, ppx = _split_projection(hx @ w_in)
    aqc, akc, avc, rqc, rkc, rvc, rgc, ppc = _split_projection(hc @ w_in)

    qx, kx, vx = _attn_heads(aqx, akx, avx, q_gain, k_gain)
    qc, kc, vc = _attn_heads(aqc, akc, avc, q_gain, k_gain)
    qx = apply_axial_rope(qx, cos, sin)
    kx = apply_axial_rope(kx, cos, sin)
    k_all = jnp.concatenate([kc, kx], axis=2)
    v_all = jnp.concatenate([vc, vx], axis=2)
    attn_x = _merge_attn(_blocked_attention(qx, k_all, v_all))

    log_gamma = jax.nn.log_sigmoid(decay_logit.astype(jnp.float32))
    k_scale = HEAD_DIM ** -0.5
    zero = jnp.zeros((B, RET_HEADS, HEAD_DIM, HEAD_DIM), jnp.float32)
    ret_c, s_fwd, s_bwd = _bi_retention(_ret_heads(rqc), _ret_heads(rkc) * k_scale, _ret_heads(rvc),
                                        log_gamma[0], log_gamma[1], zero, zero)
    ret_x, _, _ = _bi_retention(_ret_heads(rqx), _ret_heads(rkx) * k_scale, _ret_heads(rvx),
                                log_gamma[0], log_gamma[1], s_fwd, s_bwd)
    ret_x = _ret_output(ret_x, rgx)

    pool_x = multiscale_pool(ppx, pool_w, pool_scale)

    mx = jnp.concatenate([attn_x.astype(hx.dtype), ret_x.astype(hx.dtype), pool_x], axis=-1) @ w_out
    if not need_ctx:
        return mx, None
    attn_c = _merge_attn(_sdpa(qc, kc, vc))
    ret_c = _ret_output(ret_c, rgc)
    pool_c = multiscale_pool(ppc, pool_w, pool_scale)
    mc = jnp.concatenate([attn_c.astype(hc.dtype), ret_c.astype(hc.dtype), pool_c], axis=-1) @ w_out
    return mx, mc


def swiglu(h, w1, w3, w2):
    return (jax.nn.silu(h @ w1) * (h @ w3)) @ w2


def moe_swiglu(h, router, w1, w3, w2):
    logits = (h @ router).astype(jnp.float32)
    top_vals, top_idx = lax.top_k(logits, TOP_K)
    top_w = jax.nn.softmax(top_vals, axis=-1)
    gates = jnp.sum(jax.nn.one_hot(top_idx, N_EXPERTS, dtype=jnp.float32) * top_w[..., None], axis=-2)
    out = jnp.zeros_like(h)
    for e in range(N_EXPERTS):
        out = out + gates[..., e:e + 1].astype(h.dtype) * swiglu(h, w1[e], w3[e], w2[e])
    return out


def setup_inputs(seed: int = 0) -> dict:
    key = jax.random.key(seed)
    ks = jax.random.split(key, 26)
    nrm = lambda k, shape, s: jax.random.normal(k, shape, jnp.float32) * s
    base_gamma = 1.0 - 2.0 ** (-5.0 - jnp.arange(RET_HEADS, dtype=jnp.float32))
    base_logit = jnp.log(base_gamma) - jnp.log1p(-base_gamma)
    return {
        'x': nrm(ks[0], (BATCH, SEQ, D_MODEL), 1.0),
        'c': nrm(ks[1], (BATCH, D_MODEL), 1.0),
        'ctx': nrm(ks[2], (BATCH, CTX_LEN, D_MODEL), 1.0),
        'c_ctx': nrm(ks[3], (D_MODEL,), 1.0),
        'w_mod': nrm(ks[4], (DEPTH, D_MODEL, 6 * D_MODEL), 0.5 * D_MODEL ** -0.5),
        'b_mod': nrm(ks[5], (DEPTH, 6 * D_MODEL), 0.02),
        'norm_pre_mix': 1.0 + nrm(ks[6], (DEPTH, D_MODEL), 0.05),
        'norm_post_mix': 1.0 + nrm(ks[7], (DEPTH, D_MODEL), 0.05),
        'norm_pre_ffn': 1.0 + nrm(ks[8], (DEPTH, D_MODEL), 0.05),
        'norm_post_ffn': 1.0 + nrm(ks[9], (DEPTH, D_MODEL), 0.05),
        'w_in': nrm(ks[10], (DEPTH, D_MODEL, IN_WIDTH), D_MODEL ** -0.5),
        'w_out': nrm(ks[11], (DEPTH, MIX_WIDTH, D_MODEL), MIX_WIDTH ** -0.5),
        'q_norm': 1.0 + nrm(ks[12], (DEPTH, HEAD_DIM), 0.05),
        'k_norm': 1.0 + nrm(ks[13], (DEPTH, HEAD_DIM), 0.05),
        'ret_decay_logit': jnp.broadcast_to(base_logit, (DEPTH, 2, RET_HEADS)) + nrm(ks[14], (DEPTH, 2, RET_HEADS), 0.1),
        'pool_w': nrm(ks[15], (DEPTH, len(POOL_WINDOWS), POOL_GROUP, POOL_GROUP), POOL_GROUP ** -0.5),
        'pool_scale': 1.0 + nrm(ks[16], (DEPTH, POOL_WIDTH), 0.05),
        'ffn_w1': nrm(ks[17], (N_DENSE, D_MODEL, D_FF), D_MODEL ** -0.5),
        'ffn_w3': nrm(ks[18], (N_DENSE, D_MODEL, D_FF), D_MODEL ** -0.5),
        'ffn_w2': nrm(ks[19], (N_DENSE, D_FF, D_MODEL), D_FF ** -0.5),
        'moe_router': nrm(ks[20], (N_MOE, D_MODEL, N_EXPERTS), D_MODEL ** -0.5),
        'moe_w1': nrm(ks[21], (N_MOE, N_EXPERTS, D_MODEL, D_FF), D_MODEL ** -0.5),
        'moe_w3': nrm(ks[22], (N_MOE, N_EXPERTS, D_MODEL, D_FF), D_MODEL ** -0.5),
        'moe_w2': nrm(ks[23], (N_MOE, N_EXPERTS, D_FF, D_MODEL), D_FF ** -0.5),
    }


def reference(x, c, ctx, c_ctx, w_mod, b_mod, norm_pre_mix, norm_post_mix, norm_pre_ffn, norm_post_ffn,
              w_in, w_out, q_norm, k_norm, ret_decay_logit, pool_w, pool_scale,
              ffn_w1, ffn_w3, ffn_w2, moe_router, moe_w1, moe_w3, moe_w2):
    n_tokens = x.shape[1]
    cos, sin = axial_rope_tables(n_tokens)
    xc = ctx
    silu_c = jax.nn.silu(c)
    silu_cc = jax.nn.silu(c_ctx)
    for i in range(DEPTH):
        need_ctx = i < DEPTH - 1
        mod_x = (silu_c @ w_mod[i] + b_mod[i])[:, None, :]
        mod_c = (silu_cc @ w_mod[i] + b_mod[i])[None, None, :]
        sh1, sc1, g1, sh2, sc2, g2 = jnp.split(mod_x, 6, axis=-1)
        csh1, csc1, cg1, csh2, csc2, cg2 = jnp.split(mod_c, 6, axis=-1)

        hx = rms_norm(x, norm_pre_mix[i]) * (1.0 + sc1) + sh1
        hc = rms_norm(xc, norm_pre_mix[i]) * (1.0 + csc1) + csh1
        mx, mc = token_mixers(hx, hc, w_in[i], w_out[i], q_norm[i], k_norm[i], ret_decay_logit[i],
                              pool_w[i], pool_scale[i], cos, sin, need_ctx)
        x = x + g1 * rms_norm(mx, norm_post_mix[i])
        if need_ctx:
            xc = xc + cg1 * rms_norm(mc, norm_post_mix[i])

        j = i // 2
        if i % 2 == 0:
            ffn = lambda h: swiglu(h, ffn_w1[j], ffn_w3[j], ffn_w2[j])
        else:
            ffn = lambda h: moe_swiglu(h, moe_router[j], moe_w1[j], moe_w3[j], moe_w2[j])
        hx = rms_norm(x, norm_pre_ffn[i]) * (1.0 + sc2) + sh2
        x = x + g2 * rms_norm(ffn(hx), norm_post_ffn[i])
        if need_ctx:
            hc = rms_norm(xc, norm_pre_ffn[i]) * (1.0 + csc2) + csh2
            xc = xc + cg2 * rms_norm(ffn(hc), norm_post_ffn[i])
    return x
```

```cpp
#include <hip/hip_runtime.h>
#include <hip/hip_bf16.h>
#include <cstdio>
#include <cstdint>
#include <cmath>
namespace pg8 {
#define PG8_LAS __attribute__((address_space(3)))
typedef unsigned short bf16_t;
typedef short bf16x8 __attribute__((ext_vector_type(8)));
typedef float f32x4 __attribute__((ext_vector_type(4)));
typedef unsigned u32x4 __attribute__((ext_vector_type(4)));
constexpr int BM = 256, BK = 64, HALF = 128, HTB = HALF * BK * 2  , STAGE_BYTES = 8 * HTB, NXCD = 8, WGM = 8;

__host__ __device__ __forceinline__ int lds_byte(int r, int c) { const int st = (r >> 4) * 2 + (c >> 5), rr = r & 15, cc = c & 31, ob = rr * 64 + cc * 2; return st * 1024 + (ob ^ (((ob >> 9) & 1) << 5)); }
__host__ __device__ __forceinline__ void stage_rc(int b, int& R, int& C) { const int st = b / 1024, sb = b % 1024, swz = sb ^ (((sb >> 9) & 1) << 5); R = (st >> 1) * 16 + swz / 64; C = (st & 1) * 32 + (swz % 64) / 2; }
__host__ __device__ __forceinline__ int perm32(int rho) { const int n = rho >> 4, i = rho & 15; return 8 * (i >> 2) + 4 * n + (i & 3); }

struct Unit { int pm, pn; const char* a; const char* b; int goff, gcnt; };

__device__ __forceinline__ void deal(int L, int nM, int nN, int& pm, int& pn) {
    const int nwg = nM * nN; int wgid = L;
    { const int q = nwg / NXCD, r = nwg % NXCD, xcd = wgid % NXCD, off = wgid / NXCD; wgid = (xcd < r ? xcd * (q + 1) : r * (q + 1) + (xcd - r) * q) + off; }
    const int nig = WGM * nN, gid = wgid / nig, fm = gid * WGM, gsz = (nM - fm) < WGM ? (nM - fm) : WGM;
    pm = fm + ((wgid % nig) % gsz); pn = (wgid % nig) / gsz;
}

__device__ __forceinline__ float zero_v() { float z; asm volatile("v_mov_b32 %0, 0" : "=v"(z)); return z; }
__device__ __forceinline__ unsigned cvt_pk_bf16(float lo, float hi) { unsigned r; asm volatile("v_cvt_pk_bf16_f32 %0, %1, %2" : "=v"(r) : "v"(lo), "v"(hi)); return r; }

struct EpiBf16 {
    static constexpr bool PERM = true;
    bf16_t* O; int ldc;
    __device__ __forceinline__ void operator()(const f32x4 (&acc)[2][2][4][2], const Unit& u, int wr, int wc, int fr, int fq) const {
        const int row0 = u.pm * BM + wr * 64 + fr; const int col0 = u.pn * BM + wc * 32 + 8 * fq;
#pragma unroll
        for (int ai = 0; ai < 2; ++ai)
#pragma unroll
            for (int m = 0; m < 4; ++m) { bf16_t* rowp = O + (size_t)(row0 + ai * HALF + m * 16) * ldc + col0;
#pragma unroll
                for (int bj = 0; bj < 2; ++bj) { const f32x4 v0 = acc[ai][bj][m][0], v1 = acc[ai][bj][m][1];
                    u32x4 w; w.x = cvt_pk_bf16(v0[0], v0[1]); w.y = cvt_pk_bf16(v0[2], v0[3]); w.z = cvt_pk_bf16(v1[0], v1[1]); w.w = cvt_pk_bf16(v1[2], v1[3]);
                    *(u32x4*)(rowp + bj * HALF) = w; } }
    }
};
__device__ __forceinline__ float silu_f(float x) { return x * __builtin_amdgcn_rcpf(1.0f + __builtin_amdgcn_exp2f(-1.4426950408889634f * x)); }
struct EpiSwiglu {
    static constexpr bool PERM = true;
    bf16_t* O; int ldc;
    __device__ __forceinline__ void operator()(const f32x4 (&acc)[2][2][4][2], const Unit& u, int wr, int wc, int fr, int fq) const {
        const int row0 = u.pm * BM + wr * 64 + fr; const int col0 = u.pn * HALF + wc * 32 + 8 * fq;
#pragma unroll
        for (int ai = 0; ai < 2; ++ai)
#pragma unroll
            for (int m = 0; m < 4; ++m) { bf16_t* rowp = O + (size_t)(row0 + ai * HALF + m * 16) * ldc + col0;
                const f32x4 a0 = acc[ai][0][m][0], a1 = acc[ai][0][m][1], g0 = acc[ai][1][m][0], g1 = acc[ai][1][m][1];
                u32x4 w; w.x = cvt_pk_bf16(silu_f(a0[0]) * g0[0], silu_f(a0[1]) * g0[1]); w.y = cvt_pk_bf16(silu_f(a0[2]) * g0[2], silu_f(a0[3]) * g0[3]);
                w.z = cvt_pk_bf16(silu_f(a1[0]) * g1[0], silu_f(a1[1]) * g1[1]); w.w = cvt_pk_bf16(silu_f(a1[2]) * g1[2], silu_f(a1[3]) * g1[3]);
                *(u32x4*)rowp = w; }
    }
};

template <class Epi, class Sched, bool ALIGN_EPI, bool GATHER>
__device__ __forceinline__ void gemm_phase(const int tid, PG8_LAS unsigned char* lds, PG8_LAS unsigned* gtab, const int* glist, const int K, const Sched& S, const Epi& E) {
    const int wid = __builtin_amdgcn_readfirstlane(tid >> 6), lane = tid & 63, wr = wid >> 2, wc = wid & 3, fr = lane & 15, fq = lane >> 4;
    const int nt = K / BK;
    unsigned voffA[2], voffB[2]; int RA[2], CA[2];
#pragma unroll
    for (int i = 0; i < 2; ++i) { int R, C; stage_rc(tid * 16 + i * 8192, R, C); const int Rb = Epi::PERM ? ((R & ~31) + perm32(R & 31)) : R;
        voffA[i] = (unsigned)(R * K + C) * 2u; voffB[i] = (unsigned)(Rb * K + C) * 2u; RA[i] = R; CA[i] = C; }
    const size_t kstep = (size_t)(BK * 2);
    const size_t hstep = (size_t)HALF * K * 2;
    const unsigned ldsw = (unsigned)wid * 1024u;
    const int aoff = lds_byte(wr * 64 + fr, fq * 8), boff = lds_byte(wc * 32 + fr, fq * 8);
    unsigned vc[2][2], vn[2][2], v2[2][2];
#define PG8_SA(b, h) (((b) * 2 + (h)) * HTB)
#define PG8_SB(b, h) ((4 + (b) * 2 + (h)) * HTB)
#define PG8_STAGE(bufoff, gbase, voff) do { _Pragma("unroll") for (int _i = 0; _i < 2; ++_i) \
        __builtin_amdgcn_global_load_lds((const unsigned*)((const char*)(gbase) + (voff)[_i]), (PG8_LAS unsigned*)(lds + (bufoff) + ldsw + _i * 8192), 16, 0, 0); } while (0)
#define PG8_STAGE_A(bufoff, gbase, h, VG) do { if constexpr (GATHER) { PG8_STAGE(bufoff, gbase, VG[h]); } else { PG8_STAGE(bufoff, (gbase) + (h) * hstep, voffA); } } while (0)
#define PG8_LDA(dst, b, h) do { _Pragma("unroll") for (int m = 0; m < 4; ++m) _Pragma("unroll") for (int k = 0; k < 2; ++k) dst[m][k] = *(const PG8_LAS bf16x8*)(lds + PG8_SA(b, h) + aoff + m * 2048 + k * 1024); } while (0)
#define PG8_LDB(dst, b, h) do { _Pragma("unroll") for (int n = 0; n < 2; ++n) _Pragma("unroll") for (int k = 0; k < 2; ++k) dst[n][k] = *(const PG8_LAS bf16x8*)(lds + PG8_SB(b, h) + boff + n * 2048 + k * 1024); } while (0)
#define PG8_MMA(ai, bj, At, Bt) do { __builtin_amdgcn_s_setprio(1); _Pragma("unroll") for (int m = 0; m < 4; ++m) _Pragma("unroll") for (int n = 0; n < 2; ++n) _Pragma("unroll") for (int k = 0; k < 2; ++k) \
        acc[ai][bj][m][n] = __builtin_amdgcn_mfma_f32_16x16x32_bf16(Bt[n][k], At[m][k], acc[ai][bj][m][n], 0, 0, 0); __builtin_amdgcn_s_setprio(0); } while (0)
#define PG8_WAIT_V(n) asm volatile("s_waitcnt vmcnt(" #n ")" ::: "memory")
#define PG8_WAIT_L(n) asm volatile("s_waitcnt lgkmcnt(" #n ")" ::: "memory")
#define PG8_BAR __builtin_amdgcn_s_barrier()
#define PG8_SCHED __builtin_amdgcn_sched_barrier(0)
#define PG8_GT_DMA(u) do { if (wid < 4) __builtin_amdgcn_global_load_lds((const unsigned*)(glist + (u).goff + wid * 64 + lane), (PG8_LAS unsigned*)(gtab + wid * 64), 4, 0, 0); } while (0)
#define PG8_GT_READ(V, u) do { _Pragma("unroll") for (int _h = 0; _h < 2; ++_h) _Pragma("unroll") for (int _i = 0; _i < 2; ++_i) { const int _p = _h * HALF + RA[_i]; int _r = (int)gtab[_p]; _r = (_p < (u).gcnt) ? _r : 0; \
        V[_h][_i] = ((unsigned)_r * (unsigned)K + (unsigned)CA[_i]) * 2u; } } while (0)
    Unit cur, nxt; int ui = 0;
    if (!S.next(0, cur)) return;
    f32x4 acc[2][2][4][2];
    { const float z = zero_v();
#pragma unroll
    for (int a = 0; a < 2; ++a)
#pragma unroll
        for (int b = 0; b < 2; ++b)
#pragma unroll
            for (int m = 0; m < 4; ++m)
#pragma unroll
                for (int n = 0; n < 2; ++n) acc[a][b][m][n] = (f32x4){z, z, z, z}; }
    bf16x8 At[4][2], B0[2][2], B1[2][2];
    const char* cA = cur.a; const char* cB = cur.b;
    if constexpr (GATHER) { PG8_GT_DMA(cur); PG8_WAIT_V(0); PG8_BAR; PG8_GT_READ(vc, cur); PG8_WAIT_L(0); PG8_BAR; }
    if constexpr (GATHER) {
#pragma unroll
        for (int _h = 0; _h < 2; ++_h) { vn[_h][0] = vc[_h][0]; vn[_h][1] = vc[_h][1]; } }
    PG8_STAGE(PG8_SB(0, 0), cB, voffB); PG8_STAGE(PG8_SB(0, 1), cB + hstep, voffB); PG8_STAGE_A(PG8_SA(0, 0), cA, 0, vc); PG8_STAGE_A(PG8_SA(0, 1), cA, 1, vc);
    if (wr == 1) PG8_BAR;
    PG8_WAIT_V(2); PG8_BAR;
    PG8_STAGE(PG8_SB(1, 0), cB + kstep, voffB); PG8_STAGE_A(PG8_SA(1, 0), cA + kstep, 0, vc); PG8_STAGE(PG8_SB(1, 1), cB + hstep + kstep, voffB);
    PG8_WAIT_V(6); PG8_BAR;
    for (;;) {
        const bool has_next = S.next(ui + 1, nxt);
        if constexpr (GATHER) { if (has_next) PG8_GT_DMA(nxt); }
        const char* nA = has_next ? nxt.a : cA; const char* nB = has_next ? nxt.b : cB;
        for (int t = 0; t < nt; t += 2) {
            const bool last = (t == nt - 2);
            const char* a1 = cA + (size_t)(t + 1) * kstep;
            const char* a2 = last ? nA : cA + (size_t)(t + 2) * kstep; const char* b2 = last ? nB : cB + (size_t)(t + 2) * kstep;
            const char* a3 = a2 + kstep; const char* b3 = b2 + kstep;
            if constexpr (GATHER) {
                if (last) { if (has_next) { PG8_GT_READ(vn, nxt); } else {
#pragma unroll
                        for (int _h = 0; _h < 2; ++_h) { vn[_h][0] = vc[_h][0]; vn[_h][1] = vc[_h][1]; } } }
#pragma unroll
                for (int _h = 0; _h < 2; ++_h) { v2[_h][0] = last ? vn[_h][0] : vc[_h][0]; v2[_h][1] = last ? vn[_h][1] : vc[_h][1]; }
            }
            PG8_LDB(B0, 0, 0); PG8_LDB(B1, 0, 1); PG8_SCHED; PG8_LDA(At, 0, 0); PG8_STAGE_A(PG8_SA(1, 1), a1, 1, vc);
            PG8_WAIT_V(8); PG8_WAIT_L(0); PG8_BAR; PG8_MMA(0, 0, At, B0); PG8_MMA(0, 1, At, B1); PG8_BAR; PG8_SCHED;
            PG8_LDA(At, 0, 1); PG8_STAGE(PG8_SB(0, 0), b2, voffB); PG8_STAGE(PG8_SB(0, 1), b2 + hstep, voffB); PG8_STAGE_A(PG8_SA(0, 0), a2, 0, v2);
            PG8_WAIT_V(8); PG8_WAIT_L(0); PG8_BAR; PG8_MMA(1, 0, At, B0); PG8_MMA(1, 1, At, B1); PG8_BAR; PG8_SCHED;
            PG8_LDB(B0, 1, 0); PG8_LDB(B1, 1, 1); PG8_SCHED; PG8_LDA(At, 1, 0); PG8_STAGE_A(PG8_SA(0, 1), a2, 1, v2);
            PG8_WAIT_V(8); PG8_WAIT_L(0); PG8_BAR; PG8_MMA(0, 0, At, B0); PG8_MMA(0, 1, At, B1); PG8_BAR; PG8_SCHED;
            PG8_LDA(At, 1, 1); PG8_STAGE(PG8_SB(1, 0), b3, voffB); PG8_STAGE(PG8_SB(1, 1), b3 + hstep, voffB); PG8_STAGE_A(PG8_SA(1, 0), a3, 0, v2);
            PG8_WAIT_V(8); PG8_WAIT_L(0); PG8_BAR; PG8_MMA(1, 0, At, B0); PG8_MMA(1, 1, At, B1); PG8_BAR; PG8_SCHED;
        }
        if constexpr (ALIGN_EPI) { if (wr == 0) PG8_BAR; }
        E(acc, cur, wr, wc, fr, fq);
        if (!has_next) break;
        { const float z = zero_v();
#pragma unroll
        for (int a = 0; a < 2; ++a)
#pragma unroll
            for (int b = 0; b < 2; ++b)
#pragma unroll
                for (int m = 0; m < 4; ++m)
#pragma unroll
                    for (int n = 0; n < 2; ++n) acc[a][b][m][n] = (f32x4){z, z, z, z}; }
        cur = nxt; cA = nA; cB = nB; ++ui;
        if constexpr (GATHER) {
#pragma unroll
            for (int _h = 0; _h < 2; ++_h) { vc[_h][0] = vn[_h][0]; vc[_h][1] = vn[_h][1]; } }
        if constexpr (ALIGN_EPI) { if (wr == 1) PG8_BAR; }
    }
    PG8_WAIT_V(0);
    if constexpr (!ALIGN_EPI) { if (wr == 0) PG8_BAR; }
    PG8_BAR;
#undef PG8_SA
#undef PG8_SB
#undef PG8_STAGE
#undef PG8_STAGE_A
#undef PG8_LDA
#undef PG8_LDB
#undef PG8_MMA
#undef PG8_WAIT_V
#undef PG8_WAIT_L
#undef PG8_BAR
#undef PG8_SCHED
#undef PG8_GT_DMA
#undef PG8_GT_READ
}
}
namespace attn_body {
using bf16=__hip_bfloat16;
using bf16x8=__attribute__((ext_vector_type(8)))short;
using s16x4=__attribute__((ext_vector_type(4)))short;
using f32x16=__attribute__((ext_vector_type(16)))float;
using u32x4=__attribute__((ext_vector_type(4)))unsigned;
constexpr int D=64,KP=64;
constexpr int NW=8,QBLK=32,QB=QBLK*NW,KVBLK=64;
__device__ __forceinline__ int crow(int r,int hi){return (r&3)+8*(r>>2)+4*hi;}
#define SBAR() __builtin_amdgcn_sched_barrier(0)
constexpr int NSLOT=3, SLOTB=8192;
constexpr int LDS_K=0, LDS_V=NSLOT*SLOTB, LDS_WS=2*NSLOT*SLOTB, LDS_OST=LDS_WS+NW*64*4, LDS_BYTES=LDS_OST+NW*4096;
constexpr float C2=0.125f*1.4426950408889634f;
__device__ __forceinline__ void glds16(const void*gsrc,unsigned lds_dst){unsigned keep;
  asm volatile("s_mov_b32 %0, m0\n\ts_mov_b32 m0, %2\n\ts_nop 0\n\tglobal_load_lds_dwordx4 %1, off\n\ts_mov_b32 m0, %0":"=&s"(keep):"v"(gsrc),"s"(lds_dst):"memory");}
__device__ __forceinline__ float max3f(float a,float b,float c){float r;asm("v_max3_f32 %0, %1, %2, %3":"=v"(r):"v"(a),"v"(b),"v"(c));return r;}
__device__ __forceinline__ float max2f(float a,float b){float r;asm("v_max_f32_e32 %0, %1, %2":"=v"(r):"v"(a),"v"(b));return r;}
__device__ __forceinline__ float fadd_s(float a,float b){float r;asm("v_add_f32_e32 %0, %1, %2":"=v"(r):"v"(a),"v"(b));return r;}
__device__ __forceinline__ float fsub_s(float a,float b){float r;asm("v_sub_f32_e32 %0, %1, %2":"=v"(r):"v"(a),"v"(b));return r;}
typedef float f32x2_t __attribute__((ext_vector_type(2))); typedef __bf16 bf16x2_t __attribute__((ext_vector_type(2)));
__device__ __forceinline__ unsigned cvtpk_s(float lo,float hi){f32x2_t v={lo,hi};bf16x2_t b=__builtin_convertvector(v,bf16x2_t);return __builtin_bit_cast(unsigned,b);}
#define WAIT_BAR(N) asm volatile("s_waitcnt vmcnt(" #N ") lgkmcnt(0)\n\ts_barrier":::"memory")

__device__ __forceinline__ void qkt(f32x16&p0,f32x16&p1,const char*Kslot,const bf16x8*qr,const f32x16&negm,int r32,int hi){
  const char*kb=Kslot+hi*1024+r32*16;
  #pragma unroll
  for(int d0=0;d0<4;++d0){
    const bf16x8 b0=*reinterpret_cast<const bf16x8*>(kb+d0*2048);
    const bf16x8 b1=*reinterpret_cast<const bf16x8*>(kb+d0*2048+512);
    if(d0==0){p0=__builtin_amdgcn_mfma_f32_32x32x16_bf16(b0,qr[0],negm,0,0,0);p1=__builtin_amdgcn_mfma_f32_32x32x16_bf16(b1,qr[0],negm,0,0,0);}
    else{p0=__builtin_amdgcn_mfma_f32_32x32x16_bf16(b0,qr[d0],p0,0,0,0);p1=__builtin_amdgcn_mfma_f32_32x32x16_bf16(b1,qr[d0],p1,0,0,0);}}
}
typedef __attribute__((address_space(3))) const char* lds_cptr;
typedef short v4i16_t __attribute__((ext_vector_type(4)));
__device__ __forceinline__ void kload8(bf16x8*kf,lds_cptr kp){
  kf[0]=*(const __attribute__((address_space(3))) bf16x8*)(kp);      kf[1]=*(const __attribute__((address_space(3))) bf16x8*)(kp+512);
  kf[2]=*(const __attribute__((address_space(3))) bf16x8*)(kp+2048); kf[3]=*(const __attribute__((address_space(3))) bf16x8*)(kp+2560);
  kf[4]=*(const __attribute__((address_space(3))) bf16x8*)(kp+4096); kf[5]=*(const __attribute__((address_space(3))) bf16x8*)(kp+4608);
  kf[6]=*(const __attribute__((address_space(3))) bf16x8*)(kp+6144); kf[7]=*(const __attribute__((address_space(3))) bf16x8*)(kp+6656);
}
__device__ __forceinline__ void kload2(bf16x8*kf,lds_cptr kp,int j){ kf[2*j]=*(const __attribute__((address_space(3))) bf16x8*)(kp+j*2048); kf[2*j+1]=*(const __attribute__((address_space(3))) bf16x8*)(kp+j*2048+512); }
__device__ __forceinline__ s16x4 vtr(lds_cptr p){ return __builtin_bit_cast(s16x4,__builtin_amdgcn_ds_read_tr16_b64_v4i16((__attribute__((address_space(3))) v4i16_t*)p)); }
__device__ __forceinline__ float rowmax(const f32x16&p0,const f32x16&p1){
  float a=max3f(p0[0],p0[1],p1[0]),b=max3f(p0[2],p0[3],p1[1]);a=max3f(a,p1[2],p1[3]);
  #pragma unroll
  for(int r=4;r<16;r+=4){a=max3f(a,p0[r],p0[r+1]);b=max3f(b,p0[r+2],p0[r+3]);a=max3f(a,p1[r],p1[r+1]);b=max3f(b,p1[r+2],p1[r+3]);}
  const float m=max2f(a,b);
  auto rr=__builtin_amdgcn_permlane32_swap(__float_as_uint(m),__float_as_uint(m),false,false);
  return max2f(__uint_as_float(rr[0]),__uint_as_float(rr[1]));
}
__device__ __forceinline__ void pv(f32x16*o,int vb,bf16x8 pa0,bf16x8 pa1,bf16x8 pa2,bf16x8 pa3){
  #pragma unroll
  for(int d0=0;d0<2;++d0){s16x4 lo[4],hi[4];
    #pragma unroll
    for(int ks=0;ks<4;++ks){
      asm volatile("ds_read_b64_tr_b16 %0,%1 offset:%c2":"=&v"(lo[ks]):"v"(vb),"i"(d0*4096+ks*1024):"memory");
      asm volatile("ds_read_b64_tr_b16 %0,%1 offset:%c2":"=&v"(hi[ks]):"v"(vb),"i"(d0*4096+ks*1024+512):"memory");}
    asm volatile("s_waitcnt lgkmcnt(0)":::"memory");SBAR();
    #define PK(k) (bf16x8){lo[k][0],lo[k][1],lo[k][2],lo[k][3],hi[k][0],hi[k][1],hi[k][2],hi[k][3]}
    o[d0]=__builtin_amdgcn_mfma_f32_32x32x16_bf16(pa0,PK(0),o[d0],0,0,0);
    o[d0]=__builtin_amdgcn_mfma_f32_32x32x16_bf16(pa1,PK(1),o[d0],0,0,0);
    o[d0]=__builtin_amdgcn_mfma_f32_32x32x16_bf16(pa2,PK(2),o[d0],0,0,0);
    o[d0]=__builtin_amdgcn_mfma_f32_32x32x16_bf16(pa3,PK(3),o[d0],0,0,0);
    #undef PK
  }
}

template<int THRL> __device__ __forceinline__ void attn_unit(const int tid,const bf16*Qu,int QP,const bf16*__restrict__ Kh,const bf16*__restrict__ Vh,int NT,bf16*Ou,int OP,char*shm){
  const int lane=tid&63,r32=lane&31,hi=lane>>5; const int wid=__builtin_amdgcn_readfirstlane(tid>>6);
  const bf16*Qw=Qu+(long)(wid*QBLK)*QP;
  const unsigned lds0=(unsigned)(uintptr_t)shm;
  float*wsf=(float*)(shm+LDS_WS)+wid*64;
  const bf16*ksrc=Kh+(long)lane*KP+wid*8;
  const bf16*vsrc=Vh+(long)(16*(wid&3)+(lane>>2))*KP+(wid>>2)*32+(lane&3)*8;
  const unsigned kdst=lds0+LDS_K+wid*1024, vdst=lds0+LDS_V+wid*1024;
  #define DMA_K(t,slot) glds16(ksrc+(long)(t)*KVBLK*KP,(unsigned)__builtin_amdgcn_readfirstlane(kdst+(slot)))
  #define DMA_V(t,slot) glds16(vsrc+(long)(t)*KVBLK*KP,(unsigned)__builtin_amdgcn_readfirstlane(vdst+(slot)))
  const int vb0=(int)(lds0+LDS_V)+((lane>>4)&1)*32+(lane&3)*8+(4*hi+((lane&15)>>2))*64;
  const char*Kbase=shm+LDS_K; bf16x8 kf[8];
  const lds_cptr shm3=(lds_cptr)shm; const lds_cptr kp0=shm3+LDS_K+hi*1024+r32*16; const lds_cptr vp0=shm3+LDS_V+((lane>>4)&1)*32+(lane&3)*8+(4*hi+((lane&15)>>2))*64;
  DMA_K(0,0);DMA_V(0,0);DMA_K(1,SLOTB);
  bf16x8 qr[4];
  #pragma unroll
  for(int d0=0;d0<4;++d0)qr[d0]=*reinterpret_cast<const bf16x8*>(&Qw[(long)r32*QP+d0*16+hi*8]);
  float mhat=0.f,l_reg=0.f;f32x16 o[2],negm; { const float z=pg8::zero_v(); _Pragma("unroll") for(int r=0;r<16;++r){o[0][r]=z;o[1][r]=z;negm[r]=z;} } asm volatile("":"+v"(negm));
  bool resc=false;
  #define START(P0,P1) do{ const float rm=rowmax(P0,P1); resc=false; \
    { const float dl=rm; mhat=fadd_s(mhat,dl); \
      _Pragma("unroll") for(int r=0;r<16;++r){P0[r]=fsub_s(P0[r],dl);P1[r]=fsub_s(P1[r],dl);} \
      _Pragma("unroll") for(int r=0;r<16;++r)negm[r]=-mhat; asm volatile("":"+v"(negm)); } \
    _Pragma("unroll") for(int r=0;r<16;++r)P0[r]=__builtin_amdgcn_exp2f(P0[r]); }while(0)
  #define RESC() do{ if(resc){ asm volatile("s_waitcnt lgkmcnt(0)":::"memory"); \
      _Pragma("unroll") for(int d_=0;d_<2;++d_) _Pragma("unroll") for(int r=0;r<16;++r)o[d_][r]*=wsf[crow(r,hi)]; } }while(0)
  f32x16 pA0,pA1,pB0,pB1;
  int sl_prev=0,sl_cur=0,sl_next=SLOTB;
  #define ROT() do{sl_prev=sl_cur;sl_cur=sl_next;sl_next=(sl_next==(NSLOT-1)*SLOTB)?0:sl_next+SLOTB;}while(0)
  DMA_K(2,2*SLOTB);
  WAIT_BAR(3);
  qkt(pA0,pA1,Kbase,qr,negm,r32,hi);asm volatile("s_nop 15\n\ts_nop 7":"+v"(pA0),"+v"(pA1));
  START(pA0,pA1);
  _Pragma("unroll") for(int r=0;r<16;++r)pA1[r]=__builtin_amdgcn_exp2f(pA1[r]);
  WAIT_BAR(0);
  DMA_K(3,0);DMA_V(1,SLOTB);
  ROT();
  kload8(kf,kp0+sl_cur);
  WAIT_BAR(2);
  s16x4 vlo[8],vhi[8]; u32x4 pw0,pw1,pw2,pw3;
  #define PKW(P,B) cvtpk_s(P[B],P[B+1])
  #define PAF(k) __builtin_bit_cast(bf16x8,pw##k)
  #define VFR(i) (bf16x8){vlo[i][0],vlo[i][1],vlo[i][2],vlo[i][3],vhi[i][0],vhi[i][1],vhi[i][2],vhi[i][3]}
  #define PIN(x) asm volatile("":"+v"(x))
  #define MX3(a,b,c) __builtin_fmaxf(__builtin_fmaxf((a),(b)),(c))
  #define GAPA(MF,A0,A1,A2,A3,W0,W1,PW) do{ MF; sacc+=A0; sacc+=A1; sacc+=A2; sacc+=A3; PIN(sacc); W0; W1; PIN(PW); SBAR(); }while(0)
  #define EX(v) __builtin_amdgcn_exp2f(v)
  #define GAPB(MF,X,B) do{ MF; X[B]=EX(X[B]); X[B+1]=EX(X[B+1]); X[B+2]=EX(X[B+2]); X[B+3]=EX(X[B+3]); PIN(X); SBAR(); }while(0)
  #define VRD(i) do{ vlo[i]=vtr(vp_+(((i)>>2)*4096+((i)&3)*1024)); vhi[i]=vtr(vp_+(((i)>>2)*4096+((i)&3)*1024+512)); }while(0)
  #define KRD(G,j) do{ if(G){ kload2(kf,kp0+sl_next,j); SBAR(); } }while(0)
  #define STEP(C0,C1,P0,P1,t,GK,GV,GL) do{ SBAR(); \
    const lds_cptr vp_=vp0+sl_prev; \
    VRD(0); SBAR(); float sacc=(P0[0]+P0[1]); \
    GAPA(C0=__builtin_amdgcn_mfma_f32_32x32x16_bf16(kf[0],qr[0],negm,0,0,0), P0[2],P0[3],P0[4],P0[5],     pw0[0]=PKW(P0,0), pw0[1]=PKW(P0,2), pw0); \
    VRD(4); SBAR(); GAPA(C1=__builtin_amdgcn_mfma_f32_32x32x16_bf16(kf[1],qr[0],negm,0,0,0), P0[6],P0[7],P0[8],P0[9],     pw0[2]=PKW(P0,4), pw0[3]=PKW(P0,6), pw0); \
    VRD(1); SBAR(); GAPA(C0=__builtin_amdgcn_mfma_f32_32x32x16_bf16(kf[2],qr[1],C0,0,0,0),   P0[10],P0[11],P0[12],P0[13], pw1[0]=PKW(P0,8), pw1[1]=PKW(P0,10), pw1); \
    VRD(5); SBAR(); GAPA(C1=__builtin_amdgcn_mfma_f32_32x32x16_bf16(kf[3],qr[1],C1,0,0,0),   P0[14],P0[15],P1[0],P1[1],   pw1[2]=PKW(P0,12),pw1[3]=PKW(P0,14), pw1); \
    VRD(2); SBAR(); GAPA(C0=__builtin_amdgcn_mfma_f32_32x32x16_bf16(kf[4],qr[2],C0,0,0,0),   P1[2],P1[3],P1[4],P1[5],     pw2[0]=PKW(P1,0), pw2[1]=PKW(P1,2), pw2); \
    VRD(6); SBAR(); GAPA(C1=__builtin_amdgcn_mfma_f32_32x32x16_bf16(kf[5],qr[2],C1,0,0,0),   P1[6],P1[7],P1[8],P1[9],     pw2[2]=PKW(P1,4), pw2[3]=PKW(P1,6), pw2); \
    VRD(3); SBAR(); GAPA(C0=__builtin_amdgcn_mfma_f32_32x32x16_bf16(kf[6],qr[3],C0,0,0,0),   P1[10],P1[11],P1[12],P1[13], pw3[0]=PKW(P1,8), pw3[1]=PKW(P1,10), pw3); \
    VRD(7); SBAR(); GAPA(C1=__builtin_amdgcn_mfma_f32_32x32x16_bf16(kf[7],qr[3],C1,0,0,0),   P1[14],P1[15],0.f,0.f,       pw3[2]=PKW(P1,12),pw3[3]=PKW(P1,14), pw3); \
    l_reg+=sacc; \
    if(GK){DMA_K((t)+3,sl_cur);} if(GV){DMA_V((t)+1,sl_next);} \
    { float a=MX3(C0[0],C0[1],C1[0]),b=MX3(C0[2],C0[3],C1[1]); a=MX3(a,C1[2],C1[3]); \
      _Pragma("unroll") for(int r=4;r<16;r+=4){a=MX3(a,C0[r],C0[r+1]);b=MX3(b,C0[r+2],C0[r+3]);a=MX3(a,C1[r],C1[r+1]);b=MX3(b,C1[r+2],C1[r+3]);} \
      float rm=__builtin_fmaxf(a,b); { auto rr=__builtin_amdgcn_permlane32_swap(__float_as_uint(rm),__float_as_uint(rm),false,false); rm=__builtin_fmaxf(__uint_as_float(rr[0]),__uint_as_float(rr[1])); } \
      resc=false; \
      if(__builtin_expect(__any(rm>(float)THRL),0)){ const float dl=__builtin_fmaxf(rm,0.f); mhat+=dl; \
        _Pragma("unroll") for(int r=0;r<16;++r){C0[r]-=dl;C1[r]-=dl;} \
        _Pragma("unroll") for(int r=0;r<16;++r)negm[r]=-mhat; asm volatile("":"+v"(negm)); \
        const float f=__builtin_amdgcn_exp2f(-dl); l_reg*=f; if(hi==0)wsf[r32]=f; resc=true; } } \
    SBAR(); \
    GAPB(o[0]=__builtin_amdgcn_mfma_f32_32x32x16_bf16(PAF(0),VFR(0),o[0],0,0,0), C0,0); \
    GAPB(o[1]=__builtin_amdgcn_mfma_f32_32x32x16_bf16(PAF(0),VFR(4),o[1],0,0,0), C0,4); \
    KRD(GL,0); GAPB(o[0]=__builtin_amdgcn_mfma_f32_32x32x16_bf16(PAF(1),VFR(1),o[0],0,0,0), C0,8); \
    KRD(GL,1); GAPB(o[1]=__builtin_amdgcn_mfma_f32_32x32x16_bf16(PAF(1),VFR(5),o[1],0,0,0), C0,12); \
    KRD(GL,2); GAPB(o[0]=__builtin_amdgcn_mfma_f32_32x32x16_bf16(PAF(2),VFR(2),o[0],0,0,0), C1,0); \
    KRD(GL,3); GAPB(o[1]=__builtin_amdgcn_mfma_f32_32x32x16_bf16(PAF(2),VFR(6),o[1],0,0,0), C1,4); \
    GAPB(o[0]=__builtin_amdgcn_mfma_f32_32x32x16_bf16(PAF(3),VFR(3),o[0],0,0,0), C1,8); \
    GAPB(o[1]=__builtin_amdgcn_mfma_f32_32x32x16_bf16(PAF(3),VFR(7),o[1],0,0,0), C1,12); \
    }while(0)
  int t=1;
  for(;t+5<NT;t+=2){
    STEP(pB0,pB1,pA0,pA1,t,true,true,true);     WAIT_BAR(2); RESC(); ROT();
    STEP(pA0,pA1,pB0,pB1,t+1,true,true,true);   WAIT_BAR(2); RESC(); ROT();
  }
  #define ENDW(tt) do{ if((tt)+3<NT){WAIT_BAR(2);} else if((tt)+2<NT){WAIT_BAR(1);} else {WAIT_BAR(0);} }while(0)
  for(;t+1<NT;t+=2){
    STEP(pB0,pB1,pA0,pA1,t,(t+3<NT),(t+1<NT),(t+1<NT));       ENDW(t);   RESC(); ROT();
    STEP(pA0,pA1,pB0,pB1,t+1,(t+4<NT),(t+2<NT),(t+2<NT));     ENDW(t+1); RESC(); ROT();
  }
  STEP(pB0,pB1,pA0,pA1,NT-1,false,false,false); RESC();
  { float sacc=pB0[0]+pB0[1]; _Pragma("unroll") for(int r=2;r<16;++r)sacc+=pB0[r]; _Pragma("unroll") for(int r=0;r<16;++r)sacc+=pB1[r]; l_reg+=sacc;
    pw0=(u32x4){PKW(pB0,0),PKW(pB0,2),PKW(pB0,4),PKW(pB0,6)};pw1=(u32x4){PKW(pB0,8),PKW(pB0,10),PKW(pB0,12),PKW(pB0,14)};pw2=(u32x4){PKW(pB1,0),PKW(pB1,2),PKW(pB1,4),PKW(pB1,6)};pw3=(u32x4){PKW(pB1,8),PKW(pB1,10),PKW(pB1,12),PKW(pB1,14)};
    SBAR(); pv(o,vb0+sl_cur,PAF(0),PAF(1),PAF(2),PAF(3)); }
  #undef PKW
  #undef PAF
  #undef VFR
  #undef PIN
  #undef MX3
  #undef GAPA
  #undef GAPB
  #undef EX
  #undef VRD
  #undef KRD
  #undef STEP
  #undef ENDW
  {auto rr=__builtin_amdgcn_permlane32_swap(__float_as_uint(l_reg),__float_as_uint(l_reg),false,false);l_reg=__uint_as_float(rr[0])+__uint_as_float(rr[1]);}
  if(hi==0)wsf[32+r32]=l_reg;asm volatile("s_waitcnt lgkmcnt(0)":::"memory");
  float rli[16];
  #pragma unroll
  for(int r=0;r<16;++r)rli[r]=__builtin_amdgcn_rcpf(wsf[32+crow(r,hi)]);
  bf16*Ow=Ou+(long)(wid*QBLK)*OP;
  { bf16*stg=(bf16*)(shm+LDS_OST)+wid*2048;
    #pragma unroll
    for(int r=0;r<16;++r){const int orow=crow(r,hi);
      #pragma unroll
      for(int d0=0;d0<2;++d0)stg[orow*64+d0*32+r32]=__float2bfloat16(o[d0][r]*rli[r]);}
    asm volatile("s_waitcnt lgkmcnt(0)":::"memory");
    #pragma unroll
    for(int i=0;i<4;++i){const int row=i*8+(lane>>3),ch=lane&7; const u32x4 v=*(const u32x4*)(stg+row*64+ch*8); *(u32x4*)(Ow+(long)row*OP+ch*8)=v;} }
  asm volatile("s_waitcnt lgkmcnt(0)\n\ts_barrier":::"memory");
  #undef DMA_K
  #undef DMA_V
  #undef START
  #undef RESC
  #undef ROT
}
#undef SBAR
#undef WAIT_BAR
}
#define GAS __attribute__((address_space(1)))
#define LAS __attribute__((address_space(3)))
typedef unsigned short bf16;
typedef unsigned v4u __attribute__((ext_vector_type(4)));
typedef float f32x4 __attribute__((ext_vector_type(4)));
typedef short bf16x8 __attribute__((ext_vector_type(8)));
typedef GAS unsigned gu32;
typedef GAS unsigned long long gu64;
#define RLX_AGENT __ATOMIC_RELAXED, __HIP_MEMORY_SCOPE_AGENT
#define LDS_WAIT() asm volatile("s_waitcnt lgkmcnt(0)" ::: "memory")
#define VM_WAIT() asm volatile("s_waitcnt vmcnt(0)" ::: "memory")
__device__ __forceinline__ unsigned long long rt() { return __builtin_amdgcn_s_memrealtime(); }
__device__ __forceinline__ unsigned f2bf(float f) { unsigned u = __builtin_bit_cast(unsigned, f); return (u + 0x7fffu + ((u >> 16) & 1u)) >> 16; }
__device__ __forceinline__ unsigned pk2(float lo, float hi) { return f2bf(lo) | (f2bf(hi) << 16); }

#define XB_TMO      128
#define XB_XCNT(j)  (256  + 64 * (j))
#define XB_XSUB(j)  (1280 + 64 * (j))
#define XB_XGEN(j)  (2304 + 64 * (j))
#define XB_TOP      3328
#define XB_TOPGEN   3392
#define XCD_BAR_WORDS 3456
#define XB_SPIN_CAP (1u << 18)

__device__ __forceinline__ unsigned xb_ld(unsigned* p)              { return __hip_atomic_load(p, __ATOMIC_RELAXED, __HIP_MEMORY_SCOPE_AGENT); }
__device__ __forceinline__ unsigned xb_add(unsigned* p, unsigned v) { return __hip_atomic_fetch_add(p, v, __ATOMIC_RELAXED, __HIP_MEMORY_SCOPE_AGENT); }
__device__ __forceinline__ unsigned xb_xcc_id() { return (unsigned)__builtin_amdgcn_s_getreg((3 << 11) | 20) & 0xFu; }
#define XB_SPIN(cond, bar) do { unsigned _sp = 0; while (cond) { __builtin_amdgcn_s_sleep(1); \
    if ((++_sp & 255u) == 0u) { if (xb_ld(&(bar)[XB_TMO])) break; if (_sp > XB_SPIN_CAP) { atomicAdd(&(bar)[XB_TMO], 1u); break; } } } } while (0)

struct XcdBarrier {
    unsigned* bar; unsigned x;
    volatile LAS unsigned* st;
};

__device__ __forceinline__ XcdBarrier xcd_barrier_post(unsigned* bar, volatile LAS unsigned* st) {
    XcdBarrier b; b.bar = bar; b.x = xb_xcc_id(); b.st = st;
    if (threadIdx.x == 0) (void)xb_add(&bar[XB_XCNT(b.x)], 1u);
    return b;
}
__device__ __forceinline__ void xcd_barrier_complete(unsigned* bar, unsigned x, unsigned& nloc, unsigned& nx) {
    const unsigned G = gridDim.x * gridDim.y * gridDim.z;
    unsigned sum, cnt, mine, sp = 0u;
    for (;;) {
        sum = 0u; cnt = 0u; mine = 0u;
#pragma unroll
        for (unsigned j = 0; j < 16; ++j) { const unsigned c = xb_ld(&bar[XB_XCNT(j)]); sum += c; cnt += (c > 0u) ? 1u : 0u; mine = (j == x) ? c : mine; }
        if (sum == G) break;
        __builtin_amdgcn_s_sleep(1);
        if ((++sp & 255u) == 0u) { if (xb_ld(&bar[XB_TMO])) break; if (sp > XB_SPIN_CAP) { atomicAdd(&bar[XB_TMO], 1u); break; } }
    }
    nloc = mine > 0u ? mine : 1u; nx = cnt > 0u ? cnt : 1u;
}

__device__ __forceinline__ void xcd_barrier(const XcdBarrier& b) {
    asm volatile("s_waitcnt vmcnt(0)" ::: "memory");
    __syncthreads();
    if (threadIdx.x == 0) {
        unsigned* bar = b.bar;
        __builtin_amdgcn_s_waitcnt(0);
        unsigned nloc = b.st[0], nx = b.st[1];
        if (nloc == 0u) { xcd_barrier_complete(bar, b.x, nloc, nx); b.st[0] = nloc; b.st[1] = nx; }
        const unsigned old = xb_add(&bar[XB_XSUB(b.x)], 1u);
        const unsigned gen = old / nloc;
        if (old + 1u == (gen + 1u) * nloc) {
            __builtin_amdgcn_fence(__ATOMIC_RELEASE, "agent");
            asm volatile("s_waitcnt vmcnt(0)" ::: "memory");
            const unsigned og = xb_add(&bar[XB_TOP], 1u);
            const unsigned tg = og / nx;
            if (og + 1u == (tg + 1u) * nx) xb_add(&bar[XB_TOPGEN], 1u);
            else XB_SPIN(xb_ld(&bar[XB_TOPGEN]) == tg, bar);
            __builtin_amdgcn_fence(__ATOMIC_ACQUIRE, "agent");
            xb_add(&bar[XB_XGEN(b.x)], 1u);
            asm volatile("s_waitcnt vmcnt(0)" ::: "memory");
        } else {
            XB_SPIN(xb_ld(&bar[XB_XGEN(b.x)]) == gen, bar);
            __builtin_amdgcn_fence(__ATOMIC_ACQUIRE, "agent");
            asm volatile("s_waitcnt vmcnt(0)" ::: "memory");
        }
    }
    __syncthreads();
}
constexpr int NWAVES = 8;
constexpr int DM = 1024, NB = 2, SEQ = 16384, CTX = 256, RB = SEQ + CTX  , NR = NB * RB  ;
constexpr int INW = 2048, FF = 2816, NE = 8, NCH = RB / 128  , NLAT = NB * SEQ;
constexpr float EPS = 1e-6f;
constexpr int PC_K = 512, PC_V = 640, PC_RQ = 768, PC_RK = 1024, PC_RV = 1280, PC_RG = 1536, PC_PP = 1792;
constexpr int MOE_TP = 88, MOE_PASSES = 3, LISTCAP = 32768;

constexpr size_t MiB = 1u << 20, U128K = 131072;
constexpr size_t WS_CTL = 0, CTL_ZERO_BYTES = 1 * MiB;
constexpr size_t WS_MODV = 1 * MiB;
constexpr size_t WS_ROPE = 1 * MiB + 256 * 1024;
constexpr size_t WS_TOK = 3 * MiB / 2;
constexpr size_t WS_LIST = 5 * MiB / 2;
constexpr size_t WS_XC = 7 * MiB / 2;
constexpr size_t WS_WIN = 6 * MiB, WS_WOUT = 14 * MiB, WS_W13D = 18 * MiB, WS_W2D = 29 * MiB, WS_W13M = 35 * MiB, WS_W2M = 123 * MiB;
constexpr size_t SZ_WIN = (size_t)INW * DM * 2, SZ_WOUT = (size_t)DM * DM * 2, SZ_W13 = (size_t)2 * FF * DM * 2, SZ_W2 = (size_t)DM * FF * 2;
constexpr size_t WS_AR = 168 * MiB;
constexpr size_t AR_P = 0, AR_QB = 1040 * U128K, AR_KC = 1300 * U128K, AR_VC = 1365 * U128K, AR_US = 1430 * U128K, AR_MIX = 1690 * U128K, AR_MX = 2210 * U128K;
constexpr size_t AR_HX2 = 0, AR_ACT = 520 * U128K, AR_YD = 2210 * U128K, AR_YM = 1488 * U128K;
constexpr size_t WS_END = 512 * MiB;
static_assert(WS_W2M + 8 * SZ_W2 <= WS_AR && WS_W13M + 8 * SZ_W13 <= WS_W2M && WS_W13D + SZ_W13 <= WS_W2D && WS_W2D + SZ_W2 <= WS_W13M, "weights map");
static_assert(AR_MX + (size_t)NR * DM * 2 <= WS_END - WS_AR && AR_ACT + (size_t)NR * FF * 2 <= AR_YD && AR_YM + (size_t)264 * 256 * DM * 2 <= WS_END - WS_AR && AR_ACT + (size_t)MOE_TP * 256 * FF * 2 <= AR_YM, "arena map");
static_assert(AR_QB == (size_t)NR * INW * 2 && AR_KC == AR_QB + (size_t)NR * 512 * 2 && AR_US == AR_VC + (size_t)NR * 128 * 2 && AR_MIX == AR_US + (size_t)16 * NCH * 16384 && AR_MX == AR_MIX + (size_t)NR * DM * 2, "arena map 2");
constexpr int CW_TMO = 0, CW_CODE = 1, CW_CNT = 64  , CW_BAR = 4096;
constexpr int RING_BYTES = 131072, MISC_OFF = RING_BYTES + 320, GTAB_OFF = RING_BYTES + 1024, MOE_OFF = RING_BYTES + 2048, LDS_BYTES = 147456;

typedef unsigned v2u __attribute__((ext_vector_type(2)));
typedef float f32x16 __attribute__((ext_vector_type(16)));

struct Args { const float* in[24]; float* out; unsigned char* ws; int ph_lo, ph_hi, li, pad; };
enum { I_X = 0, I_C, I_CTX, I_CCTX, I_WMOD, I_BMOD, I_NPREMIX, I_NPOSTMIX, I_NPREFFN, I_NPOSTFFN, I_WIN, I_WOUT, I_QN, I_KN, I_DECAY, I_POOLW, I_POOLS, I_FW1, I_FW3, I_FW2, I_ROUTER, I_MW1, I_MW3, I_MW2 };

typedef const __attribute__((address_space(4))) Args* ArgP;
__device__ __forceinline__ ArgP args_here() { ArgP p = (ArgP)__builtin_amdgcn_kernarg_segment_ptr(); asm volatile("" : "+s"(p)); return p; }
struct Frame { LAS unsigned char* lds; int tid, lane, wave, G, gw, NGW, bx; };
__device__ __forceinline__ void relaunder(Frame& F) { int t = threadIdx.x; asm volatile("" : "+v"(t)); F.tid = t; F.lane = t & 63; F.wave = __builtin_amdgcn_readfirstlane(t >> 6);
    int g = gridDim.x; asm volatile("" : "+s"(g)); F.G = g; int bx = blockIdx.x; asm volatile("" : "+s"(bx)); F.bx = bx; F.gw = bx * NWAVES + F.wave; F.NGW = F.G * NWAVES; }

__device__ __forceinline__ float bf_lo(unsigned u) { return __uint_as_float(u << 16); }
__device__ __forceinline__ float bf_hi(unsigned u) { return __uint_as_float(u & 0xffff0000u); }
__device__ __forceinline__ unsigned pkbf(float lo, float hi) { return attn_body::cvtpk_s(lo, hi); }
__device__ __forceinline__ float wave_sum(float v) {
#pragma unroll
    for (int o = 1; o < 64; o <<= 1) v += __shfl_xor(v, o);
    return v;
}
__device__ __forceinline__ float siluf(float x) { return x / (1.0f + __expf(-x)); }
__device__ __forceinline__ float logsig(float x) { return -log1pf(expf(-x)); }
__device__ __forceinline__ void ld16(f32x4 (&v)[4], const float* p, int lane) {
#pragma unroll
    for (int j = 0; j < 4; ++j) v[j] = *(const f32x4*)(p + 256 * j + 4 * lane);
}
__device__ __forceinline__ void ld16b(f32x4 (&v)[4], const bf16* p, int lane) {
#pragma unroll
    for (int j = 0; j < 4; ++j) { const v2u u = *(const v2u*)(p + 256 * j + 4 * lane); v[j] = (f32x4){bf_lo(u.x), bf_hi(u.x), bf_lo(u.y), bf_hi(u.y)}; }
}
__device__ __forceinline__ void st16(float* p, const f32x4 (&v)[4], int lane) {
#pragma unroll
    for (int j = 0; j < 4; ++j) *(f32x4*)(p + 256 * j + 4 * lane) = v[j];
}
__device__ __forceinline__ void st16b(bf16* p, const f32x4 (&v)[4], int lane) {
#pragma unroll
    for (int j = 0; j < 4; ++j) { v2u u; u.x = pkbf(v[j][0], v[j][1]); u.y = pkbf(v[j][2], v[j][3]); *(v2u*)(p + 256 * j + 4 * lane) = u; }
}
__device__ __forceinline__ float sumsq16(const f32x4 (&v)[4]) {
    float s = 0.f;
#pragma unroll
    for (int j = 0; j < 4; ++j) s += (v[j][0] * v[j][0] + v[j][1] * v[j][1]) + (v[j][2] * v[j][2] + v[j][3] * v[j][3]);
    return s;
}
__device__ __forceinline__ const float* modv(const unsigned char* ws, int l, int cls, int chunk) { return (const float*)(ws + WS_MODV) + ((size_t)(l * 3 + cls) * 6 + chunk) * DM; }

__device__ __forceinline__ void p0_transpose_item(const float* W, int K, int N, bf16* WT, int k0, int n0, int drow0, LAS float* scr, int lane) {
#pragma unroll 8
    for (int i = 0; i < 32; ++i) { const int kk = 2 * i + (lane >> 5); scr[kk * 33 + (lane & 31)] = W[(size_t)(k0 + kk) * N + n0 + (lane & 31)]; }
    LDS_WAIT(); asm volatile("" ::: "memory");
    const int c = lane & 7;
#pragma unroll
    for (int j = 0; j < 4; ++j) { const int n = (lane >> 3) + 8 * j; const LAS float* s = scr + (8 * c) * 33 + n;
        v4u o; o.x = pkbf(s[0 * 33], s[1 * 33]); o.y = pkbf(s[2 * 33], s[3 * 33]); o.z = pkbf(s[4 * 33], s[5 * 33]); o.w = pkbf(s[6 * 33], s[7 * 33]);
        *(v4u*)(WT + (size_t)(drow0 + n) * K + k0 + 8 * c) = o; }
    LDS_WAIT(); asm volatile("" ::: "memory");
}
__device__ __forceinline__ void phase_p0a(ArgP a, Frame& F) {
    LAS float* sv = (LAS float*)F.lds;
    LAS float* red = (LAS float*)(F.lds + 12288);
    for (int i = F.tid; i < 3072; i += 512) { const int v = i >> 10, k = i & 1023; const float x = (v < 2) ? a->in[I_C][v * 1024 + k] : a->in[I_CCTX][k]; sv[i] = siluf(x); }
    __syncthreads();
    for (int it = F.bx; it < 256; it += F.G) {
        const int l = it >> 7, cg = it & 127; const int r5 = F.lane / 12, c12 = F.lane % 12; const bool act = F.lane < 60;
        f32x4 acc[3]; acc[0] = acc[1] = acc[2] = (f32x4){0.f, 0.f, 0.f, 0.f};
        const float* Wl = a->in[I_WMOD] + (size_t)l * DM * 6144 + 48 * cg + 4 * c12;
#pragma unroll 2
        for (int itk = 0; itk < 26; ++itk) { const int kk = r5 + 5 * itk;
            if (act && kk < 128) { const int k = 128 * F.wave + kk; const f32x4 w4 = *(const f32x4*)(Wl + (size_t)k * 6144);
                acc[0] += sv[k] * w4; acc[1] += sv[1024 + k] * w4; acc[2] += sv[2048 + k] * w4; } }
        if (act) {
#pragma unroll
            for (int v = 0; v < 3; ++v)
#pragma unroll
                for (int e = 0; e < 4; ++e) red[(F.wave * 60 + F.lane) * 12 + v * 4 + e] = acc[v][e]; }
        __syncthreads();
        if (F.tid < 144) { const int v = F.tid / 48, col = F.tid % 48, c12b = col >> 2, e = col & 3; float s = 0.f;
            for (int w = 0; w < 8; ++w)
                for (int r = 0; r < 5; ++r) s += red[(w * 60 + r * 12 + c12b) * 12 + v * 4 + e];
            ((float*)(a->ws + WS_MODV))[((size_t)(l * 3 + v)) * 6144 + 48 * cg + col] = s + a->in[I_BMOD][l * 6144 + 48 * cg + col]; }
        __syncthreads();
    }
    if (F.bx == F.G - 1) {
        for (int i = F.tid; i < 4096; i += 512) { const int pos = i >> 4, fi = i & 15; const double inv = pow(10000.0, -(double)fi / 16.0); const double ang = (double)pos * inv;
            ((float*)(a->ws + WS_ROPE))[i] = (float)cos(ang); ((float*)(a->ws + WS_ROPE))[4096 + i] = (float)sin(ang); }
    }
    __syncthreads();
    LAS float* scr = (LAS float*)(F.lds + F.wave * 16384);
    constexpr int IT_IN = 16 * 64, IT_OUT = 16 * 32, IT_F = 1408;
    constexpr int NITEMS = 2 * IT_IN + 2 * IT_OUT + 27 * IT_F;
    for (int it = F.gw; it < NITEMS; it += F.NGW) {
        int r = it;
        if (r < 2 * IT_IN) { const int l = r / IT_IN, q = r % IT_IN, kb = q / 64, nb = q % 64;
            p0_transpose_item(a->in[I_WIN] + (size_t)l * DM * INW, DM, INW, (bf16*)(a->ws + WS_WIN + l * SZ_WIN), 64 * kb, 32 * nb, 32 * nb, scr, F.lane); continue; }
        r -= 2 * IT_IN;
        if (r < 2 * IT_OUT) { const int l = r / IT_OUT, q = r % IT_OUT, kb = q / 32, nb = q % 32;
            p0_transpose_item(a->in[I_WOUT] + (size_t)l * DM * DM, DM, DM, (bf16*)(a->ws + WS_WOUT + l * SZ_WOUT), 64 * kb, 32 * nb, 32 * nb, scr, F.lane); continue; }
        r -= 2 * IT_OUT;
        const int mat = r / IT_F, q = r % IT_F;
        int which, e; bool moe;
        if (mat < 3) { which = mat; e = 0; moe = false; } else { which = (mat - 3) % 3; e = (mat - 3) / 3; moe = true; }
        if (which < 2) {
            const float* W = (moe ? a->in[which == 0 ? I_MW1 : I_MW3] + (size_t)e * DM * FF : a->in[which == 0 ? I_FW1 : I_FW3]);
            bf16* WT = (bf16*)(a->ws + (moe ? WS_W13M + e * SZ_W13 : WS_W13D));
            const int kb = q / 88, nb = q % 88, n0 = 32 * nb; const int drow0 = (n0 >> 7) * 256 + which * 128 + (n0 & 127);
            p0_transpose_item(W, DM, FF, WT, 64 * kb, n0, drow0, scr, F.lane);
        } else {
            const float* W = (moe ? a->in[I_MW2] + (size_t)e * FF * DM : a->in[I_FW2]);
            bf16* WT = (bf16*)(a->ws + (moe ? WS_W2M + e * SZ_W2 : WS_W2D));
            const int kb = q / 32, nb = q % 32;
            p0_transpose_item(W, FF, DM, WT, 64 * kb, 32 * nb, 32 * nb, scr, F.lane);
        }
    }
}

struct RowLoc { int b, jj, cls; size_t xoff; bool isctx; };
__device__ __forceinline__ RowLoc rowloc(int r) { RowLoc L; L.b = r / RB; L.jj = r - L.b * RB; L.isctx = L.jj < CTX; L.cls = L.isctx ? 2 : L.b;
    L.xoff = L.isctx ? (size_t)(L.b * CTX + L.jj) * DM : (size_t)(L.b * SEQ + (L.jj - CTX)) * DM; return L; }

__device__ __forceinline__ void phase_premix0(ArgP a, Frame& F) {
    bf16* HX = (bf16*)(a->ws + WS_AR + AR_MIX);
    for (int it = F.gw; it < NR / 16; it += F.NGW) {
        const RowLoc L0 = rowloc(it * 16);
        f32x4 A[4], B[4], t0[4];
        ld16(A, a->in[I_NPREMIX], F.lane); ld16(t0, modv(a->ws, 0, L0.cls, 1), F.lane); ld16(B, modv(a->ws, 0, L0.cls, 0), F.lane);
#pragma unroll
        for (int j = 0; j < 4; ++j) A[j] = A[j] * (1.0f + t0[j]);
        const float* xb = (L0.isctx ? a->in[I_CTX] : a->in[I_X]) + L0.xoff;
#pragma unroll 2
        for (int rr = 0; rr < 16; ++rr) {
            f32x4 v[4]; ld16(v, xb + (size_t)rr * DM, F.lane);
            const float rstd = 1.0f / sqrtf(wave_sum(sumsq16(v)) * (1.0f / DM) + EPS);
#pragma unroll
            for (int j = 0; j < 4; ++j) v[j] = v[j] * rstd * A[j] + B[j];
            st16b(HX + (size_t)(it * 16 + rr) * DM, v, F.lane);
        }
    }
}

__device__ __forceinline__ void moe_prefix(const unsigned char* ws, int (&tstart)[9], int (&cnt)[8]) {
    const unsigned* cw = (const unsigned*)(ws + WS_CTL) + CW_CNT; int s = 0;
#pragma unroll
    for (int e = 0; e < 8; ++e) { cnt[e] = (int)__builtin_amdgcn_readfirstlane(cw[64 * e]); tstart[e] = s; s += (cnt[e] + 255) >> 8; }
    tstart[8] = s;
}

template <int MODE> __device__ __forceinline__ void phase_resid(ArgP a, Frame& F) {
    constexpr int l = MODE >> 1; constexpr bool post_ffn = MODE & 1; constexpr bool latent_only = MODE >= 2;
    const int nitems = latent_only ? NLAT / 16 : NR / 16;
    const bf16* SRC = (const bf16*)(a->ws + WS_AR + (MODE == 1 ? AR_YD : (MODE == 3 ? AR_YM : AR_MX)));
    bf16* H = (bf16*)(a->ws + WS_AR + (MODE == 1 ? AR_MIX : AR_HX2));
    const float* gpost = a->in[post_ffn ? I_NPOSTFFN : I_NPOSTMIX] + l * DM;
    const float* gnext = (MODE == 1) ? a->in[I_NPREMIX] + DM : a->in[I_NPREFFN] + l * DM;
    constexpr int gate_chunk = post_ffn ? 5 : 2, sc_chunk = (MODE == 1) ? 1 : 4, sh_chunk = (MODE == 1) ? 0 : 3, lnext = (MODE == 1) ? 1 : l;
    float* XC = (float*)(a->ws + WS_XC);
    int tstart[9], ecnt[8];
    if constexpr (MODE == 3) moe_prefix(a->ws, tstart, ecnt);
    LAS float* rts = (LAS float*)F.lds;
    LAS int* wcnt = (LAS int*)(F.lds + 32768);
    LAS int* bbase = (LAS int*)(F.lds + 32768 + 256);
    if constexpr (MODE == 2) { for (int i = F.tid; i < 8192; i += 512) { const int k = i >> 3, e = i & 7; rts[e * 1024 + k] = a->in[I_ROUTER][i]; } __syncthreads(); }
    const int rounds = (nitems + F.NGW - 1) / F.NGW;
    for (int rd = 0; rd < rounds; ++rd) {
        const int it = F.gw + rd * F.NGW; const bool active = it < nitems;
        int myE0 = -1, myE1 = -1; float myW0 = 0.f, myW1 = 0.f;
        if (active) {
            RowLoc L0; int row0;
            if constexpr (latent_only) { row0 = it * 16; L0.b = row0 / SEQ; L0.jj = 0; L0.isctx = false; L0.cls = L0.b; L0.xoff = (size_t)row0 * DM; }
            else { row0 = it * 16; L0 = rowloc(row0); }
            f32x4 G1[4], A2[4], B2[4], t0[4];
            ld16(G1, gpost, F.lane); ld16(t0, modv(a->ws, l, L0.cls, gate_chunk), F.lane);
#pragma unroll
            for (int j = 0; j < 4; ++j) G1[j] = G1[j] * t0[j];
            if constexpr (MODE != 3) { ld16(A2, gnext, F.lane); ld16(t0, modv(a->ws, lnext, L0.cls, sc_chunk), F.lane); ld16(B2, modv(a->ws, lnext, L0.cls, sh_chunk), F.lane);
#pragma unroll
                for (int j = 0; j < 4; ++j) A2[j] = A2[j] * (1.0f + t0[j]); }
            const float* xin = (MODE == 0) ? ((L0.isctx ? a->in[I_CTX] : a->in[I_X]) + L0.xoff) : ((L0.isctx ? XC : a->out) + L0.xoff);
            float* xout = (L0.isctx ? XC : a->out) + L0.xoff;
#pragma unroll 1
            for (int rr = 0; rr < 16; ++rr) {
                f32x4 s[4], x[4];
                if constexpr (MODE == 3) {
                    const int tk = row0 + rr; const v4u ti = *(const v4u*)(a->ws + WS_TOK + (size_t)tk * 32); const float w0 = *(const float*)(a->ws + WS_TOK + (size_t)tk * 32 + 16), w1 = *(const float*)(a->ws + WS_TOK + (size_t)tk * 32 + 20);
                    const int e0 = __builtin_amdgcn_readfirstlane((int)ti.x), p0l = __builtin_amdgcn_readfirstlane((int)ti.y), e1 = __builtin_amdgcn_readfirstlane((int)ti.z), p1l = __builtin_amdgcn_readfirstlane((int)ti.w);
                    int ts0 = 0, ts1 = 0;
#pragma unroll
                    for (int e = 0; e < 8; ++e) { ts0 = (e0 == e) ? tstart[e] : ts0; ts1 = (e1 == e) ? tstart[e] : ts1; }
                    f32x4 y0[4], y1[4]; ld16b(y0, SRC + ((size_t)ts0 * 256 + p0l) * DM, F.lane); ld16b(y1, SRC + ((size_t)ts1 * 256 + p1l) * DM, F.lane);
#pragma unroll
                    for (int j = 0; j < 4; ++j) s[j] = w0 * y0[j] + w1 * y1[j];
                } else if constexpr (MODE == 2) {
                    const int tk = row0 + rr; const int ur = tk + CTX * (L0.b + 1);
                    ld16b(s, SRC + (size_t)ur * DM, F.lane);
                } else ld16b(s, SRC + (size_t)(row0 + rr) * DM, F.lane);
                ld16(x, xin + (size_t)rr * DM, F.lane);
                const float rstd = 1.0f / sqrtf(wave_sum(sumsq16(s)) * (1.0f / DM) + EPS);
#pragma unroll
                for (int j = 0; j < 4; ++j) x[j] = x[j] + G1[j] * (s[j] * rstd);
                st16(xout + (size_t)rr * DM, x, F.lane);
                if constexpr (MODE != 3) {
                    const float rstd2 = 1.0f / sqrtf(wave_sum(sumsq16(x)) * (1.0f / DM) + EPS);
#pragma unroll
                    for (int j = 0; j < 4; ++j) x[j] = x[j] * rstd2 * A2[j] + B2[j];
                    st16b(H + (size_t)(row0 + rr) * DM, x, F.lane);
                    if constexpr (MODE == 2) {
                        float lg[8];
#pragma unroll
                        for (int e = 0; e < 8; ++e) { float p = 0.f;
#pragma unroll
                            for (int j = 0; j < 4; ++j) { const f32x4 rv = *(const LAS f32x4*)(rts + e * 1024 + 256 * j + 4 * F.lane); p += (x[j][0] * rv[0] + x[j][1] * rv[1]) + (x[j][2] * rv[2] + x[j][3] * rv[3]); }
                            lg[e] = wave_sum(p); }
                        int i0 = 0; float v0 = lg[0];
#pragma unroll
                        for (int e = 1; e < 8; ++e) if (lg[e] > v0) { v0 = lg[e]; i0 = e; }
                        int i1 = -1; float v1 = -INFINITY;
#pragma unroll
                        for (int e = 0; e < 8; ++e) if (e != i0 && lg[e] > v1) { v1 = lg[e]; i1 = e; }
                        const float w0 = 1.0f / (1.0f + __expf(v1 - v0));
                        if (F.lane == rr) { myE0 = i0; myE1 = i1; myW0 = w0; myW1 = 1.0f - w0; }
                    }
                }
            }
        }
        if constexpr (MODE == 2) {
            if (F.lane < 8) wcnt[F.wave * 8 + F.lane] = 0;
            LDS_WAIT();
            int r0 = 0, r1 = 0;
            if (active && F.lane < 16) { r0 = __hip_atomic_fetch_add(wcnt + F.wave * 8 + myE0, 1, __ATOMIC_RELAXED, __HIP_MEMORY_SCOPE_WORKGROUP); r1 = __hip_atomic_fetch_add(wcnt + F.wave * 8 + myE1, 1, __ATOMIC_RELAXED, __HIP_MEMORY_SCOPE_WORKGROUP); }
            __syncthreads();
            if (F.tid < 8) { int tot = 0; for (int w = 0; w < 8; ++w) tot += wcnt[w * 8 + F.tid];
                int base = 0; if (tot > 0) base = (int)__hip_atomic_fetch_add((unsigned*)(a->ws + WS_CTL) + CW_CNT + 64 * F.tid, (unsigned)tot, RLX_AGENT);
                bbase[F.tid] = base; }
            __syncthreads();
            if (active && F.lane < 16) {
                int wb0 = bbase[myE0], wb1 = bbase[myE1];
                for (int w = 0; w < F.wave; ++w) { wb0 += wcnt[w * 8 + myE0]; wb1 += wcnt[w * 8 + myE1]; }
                const int lp0 = wb0 + r0, lp1 = wb1 + r1;
                const int tk = it * 16 + F.lane; int* lists = (int*)(a->ws + WS_LIST);
                lists[myE0 * LISTCAP + lp0] = tk; lists[myE1 * LISTCAP + lp1] = tk;
                v4u ti; ti.x = (unsigned)myE0; ti.y = (unsigned)lp0; ti.z = (unsigned)myE1; ti.w = (unsigned)lp1;
                *(v4u*)(a->ws + WS_TOK + (size_t)tk * 32) = ti; *(float*)(a->ws + WS_TOK + (size_t)tk * 32 + 16) = myW0; *(float*)(a->ws + WS_TOK + (size_t)tk * 32 + 20) = myW1;
            }
            __syncthreads();
        }
    }
}
typedef float f32x16v __attribute__((ext_vector_type(16)));
__device__ __forceinline__ int crow32(int r, int hi) { return (r & 3) + 8 * (r >> 2) + 4 * hi; }
__device__ __forceinline__ int chain_id(int b, int h, int dir) { return (b * 4 + h) * 2 + dir; }

__device__ __forceinline__ void phase_prep(ArgP a, Frame& F, int l) {
    const bf16* P = (const bf16*)(a->ws + WS_AR + AR_P);
    bf16* QB = (bf16*)(a->ws + WS_AR + AR_QB); bf16* KC = (bf16*)(a->ws + WS_AR + AR_KC); bf16* VC = (bf16*)(a->ws + WS_AR + AR_VC);
    const float* ropec = (const float*)(a->ws + WS_ROPE); const float* ropes = ropec + 4096;
    {
        const int rr = F.lane >> 3, c = F.lane & 7;
        float gq[8], gk[8];
#pragma unroll
        for (int j = 0; j < 8; ++j) { gq[j] = a->in[I_QN][l * 64 + 8 * c + j]; gk[j] = a->in[I_KN][l * 64 + 8 * c + j]; }
        for (int it = F.gw; it < NR / 8; it += F.NGW) {
            const int row = it * 8 + rr; const int b = row / RB, jj = row - b * RB; const bool lat = jj >= CTX; const int t = jj - CTX;
            float cs[8], sn[8];
            if (lat) { const int pos = (c < 4) ? (t >> 6) : (t & 63); const int fi = 8 * (c & 1);
#pragma unroll
                for (int j = 0; j < 8; ++j) { cs[j] = ropec[pos * 16 + fi + j]; sn[j] = ropes[pos * 16 + fi + j]; } }
            else {
#pragma unroll
                for (int j = 0; j < 8; ++j) { cs[j] = 1.f; sn[j] = 0.f; } }
            const float sgn = (c & 2) ? 1.f : -1.f;
            const bf16* prow = P + (size_t)row * INW;
#pragma unroll 2
            for (int hs = 0; hs < 10; ++hs) {
                const v4u u = *(const v4u*)(prow + hs * 64 + 8 * c);
                float x[8] = {bf_lo(u.x), bf_hi(u.x), bf_lo(u.y), bf_hi(u.y), bf_lo(u.z), bf_hi(u.z), bf_lo(u.w), bf_hi(u.w)};
                float ss = 0.f;
#pragma unroll
                for (int j = 0; j < 8; ++j) ss += x[j] * x[j];
                ss += __shfl_xor(ss, 1); ss += __shfl_xor(ss, 2); ss += __shfl_xor(ss, 4);
                const float rstd = 1.0f / sqrtf(ss * (1.0f / 64.0f) + EPS);
                float y[8];
#pragma unroll
                for (int j = 0; j < 8; ++j) { y[j] = x[j] * rstd * (hs < 8 ? gq[j] : gk[j]); }
#pragma unroll
                for (int j = 0; j < 8; ++j) { const float p = __shfl_xor(y[j], 2); x[j] = y[j] * cs[j] + sgn * p * sn[j]; }
                const float sc = (hs < 8) ? attn_body::C2 : 1.0f;
                v4u o; o.x = pkbf(x[0] * sc, x[1] * sc); o.y = pkbf(x[2] * sc, x[3] * sc); o.z = pkbf(x[4] * sc, x[5] * sc); o.w = pkbf(x[6] * sc, x[7] * sc);
                if (hs < 8) *(v4u*)(QB + (size_t)row * 512 + hs * 64 + 8 * c) = o;
                else *(v4u*)(KC + ((size_t)(b * 2 + (hs - 8)) * RB + jj) * 64 + 8 * c) = o;
            }
#pragma unroll
            for (int kv = 0; kv < 2; ++kv) *(v4u*)(VC + ((size_t)(b * 2 + kv) * RB + jj) * 64 + 8 * c) = *(const v4u*)(prow + PC_V + kv * 64 + 8 * c);
        }
    }
    __syncthreads();
    LAS float* ks = (LAS float*)F.lds; LAS float* vs = (LAS float*)(F.lds + 32768); LAS float* zt = (LAS float*)(F.lds + 65536);
    float* US = (float*)(a->ws + WS_AR + AR_US);
    for (int it = F.bx; it < NB * 4 * NCH; it += F.G) {
        const int c = it % NCH, bh = it / NCH, b = bh >> 2, h = bh & 3;
        const float lgf = logsig(a->in[I_DECAY][l * 8 + h]), lgb = logsig(a->in[I_DECAY][l * 8 + 4 + h]);
        { const int p = F.tid >> 2, sg = F.tid & 3; const bf16* prow = P + (size_t)(b * RB + c * 128 + p) * INW;
#pragma unroll
            for (int q = 0; q < 2; ++q) { const v4u uk = *(const v4u*)(prow + PC_RK + h * 64 + sg * 16 + q * 8), uv = *(const v4u*)(prow + PC_RV + h * 64 + sg * 16 + q * 8);
                LAS float* kd = ks + p * 64 + sg * 16 + q * 8; LAS float* vd = vs + p * 64 + sg * 16 + q * 8;
                *(LAS f32x4*)kd = (f32x4){bf_lo(uk.x), bf_hi(uk.x), bf_lo(uk.y), bf_hi(uk.y)} * 0.125f; *(LAS f32x4*)(kd + 4) = (f32x4){bf_lo(uk.z), bf_hi(uk.z), bf_lo(uk.w), bf_hi(uk.w)} * 0.125f;
                *(LAS f32x4*)vd = (f32x4){bf_lo(uv.x), bf_hi(uv.x), bf_lo(uv.y), bf_hi(uv.y)}; *(LAS f32x4*)(vd + 4) = (f32x4){bf_lo(uv.z), bf_hi(uv.z), bf_lo(uv.w), bf_hi(uv.w)}; }
            if (F.tid < 128) { zt[F.tid] = __expf(lgf * (float)(127 - F.tid)); zt[128 + F.tid] = __expf(lgb * (float)F.tid); } }
        __syncthreads();
        { const int dir = F.wave >> 2, di = (F.wave >> 1) & 1, ei = F.wave & 1, i = F.lane & 31, kk = F.lane >> 5;
            f32x16v acc; { const float z = pg8::zero_v(); _Pragma("unroll") for (int r = 0; r < 16; ++r) acc[r] = z; }
#pragma unroll 8
            for (int s = 0; s < 64; ++s) { const int pos = 2 * s + kk; const float av = ks[pos * 64 + 32 * di + i] * zt[dir * 128 + pos]; const float bv = vs[pos * 64 + 32 * ei + i];
                acc = __builtin_amdgcn_mfma_f32_32x32x2f32(av, bv, acc, 0, 0, 0); }
            float* dst = US + ((size_t)(chain_id(b, h, dir) * NCH + c)) * 4096;
#pragma unroll
            for (int r = 0; r < 16; ++r) dst[(32 * di + crow32(r, kk)) * 64 + 32 * ei + i] = acc[r]; }
        __syncthreads();
    }
}

__device__ __forceinline__ void phase_scan(ArgP a, Frame& F, int l) {
    float* US = (float*)(a->ws + WS_AR + AR_US);
    if (F.tid < 256) {
        for (int id = F.bx * 256 + F.tid; id < 16 * 4096; id += F.G * 256) {
            const int chain = id >> 12, e = id & 4095, dir = chain & 1, h = (chain >> 1) & 3;
            const float dec = expf(128.0f * logsig(a->in[I_DECAY][l * 8 + dir * 4 + h]));
            float* base = US + (size_t)chain * NCH * 4096 + e; float st = 0.f;
            for (int s0 = 0; s0 < NCH; s0 += 10) { float u[10]; int ci[10];
#pragma unroll
                for (int q = 0; q < 10; ++q) { const int s = s0 + q; ci[q] = dir == 0 ? s : (s < 2 ? 1 - s : NCH + 1 - s); u[q] = base[(size_t)ci[q] * 4096]; }
#pragma unroll
                for (int q = 0; q < 10; ++q) { base[(size_t)ci[q] * 4096] = st; st = dec * st + u[q]; } }
        }
    }
}

__device__ __forceinline__ void ret_out_item(ArgP a, Frame& F, int l, int b, int h, int c) {
    const bf16* P = (const bf16*)(a->ws + WS_AR + AR_P); const float* US = (const float*)(a->ws + WS_AR + AR_US); bf16* MIX = (bf16*)(a->ws + WS_AR + AR_MIX);
    LAS bf16* qs = (LAS bf16*)F.lds; LAS bf16* ks = (LAS bf16*)(F.lds + 16896); LAS bf16* vs = (LAS bf16*)(F.lds + 33792);
    LAS float* Ss = (LAS float*)(F.lds + 50176);
    LAS float* efb = (LAS float*)(F.lds + 116224);
    const float lgf = logsig(a->in[I_DECAY][l * 8 + h]), lgb = logsig(a->in[I_DECAY][l * 8 + 4 + h]);
    const int row0 = b * RB + c * 128;
    { const int p = F.tid >> 2, sg = F.tid & 3; const bf16* prow = P + (size_t)(row0 + p) * INW + h * 64 + sg * 16;
#pragma unroll
        for (int q = 0; q < 2; ++q) { const v4u uq = *(const v4u*)(prow + PC_RQ + q * 8), uk = *(const v4u*)(prow + PC_RK + q * 8), uv = *(const v4u*)(prow + PC_RV + q * 8);
            LAS unsigned* qd = (LAS unsigned*)(qs + p * 66 + sg * 16 + q * 8); qd[0] = uq.x; qd[1] = uq.y; qd[2] = uq.z; qd[3] = uq.w;
            LAS unsigned* kd = (LAS unsigned*)(ks + p * 66 + sg * 16 + q * 8); kd[0] = uk.x; kd[1] = uk.y; kd[2] = uk.z; kd[3] = uk.w;
            *(LAS v4u*)(vs + p * 64 + sg * 16 + q * 8) = uv; }
        if (F.tid < 128) { efb[F.tid] = __expf(lgf * (float)(F.tid + 1)); efb[128 + F.tid] = __expf(lgb * (float)(128 - F.tid)); } }
    __syncthreads();
    const int pi = F.wave >> 1, hf = F.wave & 1, i = F.lane & 31, kk = F.lane >> 5;
#define BFL(ptr) __uint_as_float(((unsigned)*(ptr)) << 16)
#pragma unroll 1
    for (int mm = 0; mm < 2; ++mm) { const int mj = 2 * hf + mm; f32x16v acc; { const float z = pg8::zero_v(); _Pragma("unroll") for (int r = 0; r < 16; ++r) acc[r] = z; }
#pragma unroll 8
        for (int s = 0; s < 32; ++s) { const int d = 2 * s + kk; acc = __builtin_amdgcn_mfma_f32_32x32x2f32(BFL(qs + (32 * pi + i) * 66 + d), BFL(ks + (32 * mj + i) * 66 + d), acc, 0, 0, 0); }
#pragma unroll
        for (int r = 0; r < 16; ++r) { const int p = 32 * pi + crow32(r, kk), m = 32 * mj + i; const int df = p - m;
            const float dc = df > 0 ? __expf(lgf * (float)df) : (df < 0 ? __expf(lgb * (float)(-df)) : 2.0f);
            Ss[p * 129 + m] = acc[r] * 0.125f * dc; } }
    __syncthreads();
    f32x16v o; { const float z = pg8::zero_v(); _Pragma("unroll") for (int r = 0; r < 16; ++r) o[r] = z; }
    { const int ei = hf;
#pragma unroll 8
        for (int s = 0; s < 64; ++s) { const int m = 2 * s + kk; o = __builtin_amdgcn_mfma_f32_32x32x2f32(Ss[(32 * pi + i) * 129 + m], BFL(vs + m * 64 + 32 * ei + i), o, 0, 0, 0); }
        const float* Sf = US + ((size_t)(chain_id(b, h, 0) * NCH + c)) * 4096; const float* Sb = US + ((size_t)(chain_id(b, h, 1) * NCH + c)) * 4096;
        const float ef1 = efb[32 * pi + i], eb1 = efb[128 + 32 * pi + i];
#pragma unroll 8
        for (int s = 0; s < 32; ++s) { const int d = 2 * s + kk; const float qv = BFL(qs + (32 * pi + i) * 66 + d);
            o = __builtin_amdgcn_mfma_f32_32x32x2f32(qv * ef1, Sf[d * 64 + 32 * ei + i], o, 0, 0, 0);
            o = __builtin_amdgcn_mfma_f32_32x32x2f32(qv * eb1, Sb[d * 64 + 32 * ei + i], o, 0, 0, 0); }
    }
    __syncthreads();
#pragma unroll
    for (int r = 0; r < 16; ++r) Ss[(32 * pi + crow32(r, kk)) * 65 + 32 * hf + i] = o[r];
    __syncthreads();
    { const int p = F.tid >> 2, qd = F.tid & 3; float v[16]; float s = 0.f;
#pragma unroll
        for (int e = 0; e < 16; ++e) { v[e] = Ss[p * 65 + 16 * qd + e]; s += v[e]; }
        s += __shfl_xor(s, 1); s += __shfl_xor(s, 2); const float mu = s * (1.0f / 64.0f); float q2 = 0.f;
#pragma unroll
        for (int e = 0; e < 16; ++e) { v[e] -= mu; q2 += v[e] * v[e]; }
        q2 += __shfl_xor(q2, 1); q2 += __shfl_xor(q2, 2); const float rstd = 1.0f / sqrtf(q2 * (1.0f / 64.0f) + EPS);
        const bf16* grow = P + (size_t)(row0 + p) * INW + PC_RG + h * 64 + 16 * qd; const v4u g0 = *(const v4u*)grow, g1 = *(const v4u*)(grow + 8);
        const float g[16] = {bf_lo(g0.x), bf_hi(g0.x), bf_lo(g0.y), bf_hi(g0.y), bf_lo(g0.z), bf_hi(g0.z), bf_lo(g0.w), bf_hi(g0.w), bf_lo(g1.x), bf_hi(g1.x), bf_lo(g1.y), bf_hi(g1.y), bf_lo(g1.z), bf_hi(g1.z), bf_lo(g1.w), bf_hi(g1.w)};
        unsigned w[8];
#pragma unroll
        for (int e = 0; e < 8; ++e) w[e] = pkbf(siluf(g[2 * e]) * (v[2 * e] * rstd), siluf(g[2 * e + 1]) * (v[2 * e + 1] * rstd));
        bf16* orow = MIX + (size_t)(row0 + p) * DM + 512 + h * 64 + 16 * qd;
        *(v4u*)orow = (v4u){w[0], w[1], w[2], w[3]}; *(v4u*)(orow + 8) = (v4u){w[4], w[5], w[6], w[7]}; }
    __syncthreads();
}
__device__ __forceinline__ void pool_item(ArgP a, Frame& F, int l, int b, int tl, int g) {
    const bf16* P = (const bf16*)(a->ws + WS_AR + AR_P); bf16* MIX = (bf16*)(a->ws + WS_AR + AR_MIX);
    LAS float* ms = (LAS float*)F.lds;
    const int sb = (tl < 2) ? 0 : CTX, T = (tl < 2) ? CTX : SEQ, hw = 1 << g  ;
    { const int p = F.tid >> 2, qd = F.tid & 3; const int t = tl * 128 - sb + p; const int lo = max(t - hw, 0), hi = min(t + hw, T);
        float acc[16];
#pragma unroll
        for (int e = 0; e < 16; ++e) acc[e] = 0.f;
        const bf16* colp = P + (size_t)(b * RB + sb) * INW + PC_PP + g * 64 + 16 * qd;
        for (int tt = lo; tt < hi; ++tt) { const v4u u0 = *(const v4u*)(colp + (size_t)tt * INW), u1 = *(const v4u*)(colp + (size_t)tt * INW + 8);
            acc[0] += bf_lo(u0.x); acc[1] += bf_hi(u0.x); acc[2] += bf_lo(u0.y); acc[3] += bf_hi(u0.y); acc[4] += bf_lo(u0.z); acc[5] += bf_hi(u0.z); acc[6] += bf_lo(u0.w); acc[7] += bf_hi(u0.w);
            acc[8] += bf_lo(u1.x); acc[9] += bf_hi(u1.x); acc[10] += bf_lo(u1.y); acc[11] += bf_hi(u1.y); acc[12] += bf_lo(u1.z); acc[13] += bf_hi(u1.z); acc[14] += bf_lo(u1.w); acc[15] += bf_hi(u1.w); }
        const v4u s0 = *(const v4u*)(colp + (size_t)t * INW), s1 = *(const v4u*)(colp + (size_t)t * INW + 8);
        const float sf[16] = {bf_lo(s0.x), bf_hi(s0.x), bf_lo(s0.y), bf_hi(s0.y), bf_lo(s0.z), bf_hi(s0.z), bf_lo(s0.w), bf_hi(s0.w), bf_lo(s1.x), bf_hi(s1.x), bf_lo(s1.y), bf_hi(s1.y), bf_lo(s1.z), bf_hi(s1.z), bf_lo(s1.w), bf_hi(s1.w)};
        const float inv = 1.0f / (float)(hi - lo);
#pragma unroll
        for (int e = 0; e < 16; ++e) ms[p * 65 + 16 * qd + e] = acc[e] * inv - sf[e]; }
    __syncthreads();
    { const int pi = F.wave >> 1, di = F.wave & 1, i = F.lane & 31, kk = F.lane >> 5; f32x16v o; { const float z = pg8::zero_v(); _Pragma("unroll") for (int r = 0; r < 16; ++r) o[r] = z; }
        const float* W = a->in[I_POOLW] + ((size_t)(l * 4 + g)) * 4096;
#pragma unroll 8
        for (int s = 0; s < 32; ++s) { const int cc = 2 * s + kk; o = __builtin_amdgcn_mfma_f32_32x32x2f32(ms[(32 * pi + i) * 65 + cc], W[cc * 64 + 32 * di + i], o, 0, 0, 0); }
        const float scl = a->in[I_POOLS][l * 256 + g * 64 + 32 * di + i];
        bf16* ocol = MIX + (size_t)(b * RB + tl * 128 + 32 * pi) * DM + 768 + g * 64 + 32 * di + i;
#pragma unroll
        for (int r = 0; r < 16; ++r) ocol[(size_t)crow32(r, kk) * DM] = (bf16)(pkbf(o[r] * scl, 0.f) & 0xffffu); }
    __syncthreads();
}
__device__ __forceinline__ void phase_mix(ArgP a, Frame& F, int l, int vcu) {
    for (int it = F.bx; it < 2 * NB * 4 * NCH; it += F.G) {
        const int kind = it / (NB * 4 * NCH), r = it % (NB * 4 * NCH); const int c = r % NCH, bh = r / NCH, b = bh >> 2, hg = bh & 3;
        if (l == 1 && c < 2) continue;
        if (kind == 0) ret_out_item(a, F, l, b, hg, c); else pool_item(a, F, l, b, c, hg);
    }
    const bf16* QBp = (const bf16*)(a->ws + WS_AR + AR_QB); const bf16* KC = (const bf16*)(a->ws + WS_AR + AR_KC); const bf16* VC = (const bf16*)(a->ws + WS_AR + AR_VC); bf16* MIX = (bf16*)(a->ws + WS_AR + AR_MIX);
    const int NU = NB * 8 * (SEQ / 256);
    for (int i = 0; ; ++i) {
        int u;
        if (F.G == 256) { if (i >= 4) break; const int x = vcu >> 5, cu = vcu & 31; const int grp = x >> 1; u = grp * 256 + (x & 1) * 128 + cu * 4 + i; }
        else { u = F.bx + i * F.G; if (u >= NU) break; }
        const int grp = u >> 8, w = u & 255, b = grp >> 1, kvh = grp & 1, hd = kvh * 4 + (w >> 6), qb = w & 63;
        const size_t qrow = (size_t)b * RB + CTX + qb * 256;
        attn_body::attn_unit<8>(F.tid, (const attn_body::bf16*)(QBp + qrow * 512 + hd * 64), 512, (const attn_body::bf16*)(KC + (size_t)(b * 2 + kvh) * RB * 64), (const attn_body::bf16*)(VC + (size_t)(b * 2 + kvh) * RB * 64), RB / 64,
                                (attn_body::bf16*)(MIX + qrow * DM + hd * 64), DM, (char*)F.lds);
    }
    if (l == 0) {
        for (int u = F.bx; u < NB * 8; u += F.G) { const int b = u >> 3, hd = u & 7, kvh = hd >> 2; const size_t qrow = (size_t)b * RB;
            attn_body::attn_unit<8>(F.tid, (const attn_body::bf16*)(QBp + qrow * 512 + hd * 64), 512, (const attn_body::bf16*)(KC + (size_t)(b * 2 + kvh) * RB * 64), (const attn_body::bf16*)(VC + (size_t)(b * 2 + kvh) * RB * 64), CTX / 64,
                                    (attn_body::bf16*)(MIX + qrow * DM + hd * 64), DM, (char*)F.lds); }
    }
}
struct PlainSched {
    int nM, nN, G, c, skipctx; const char* A; const char* B; size_t tA, tB;
    __device__ __forceinline__ bool next(int i, pg8::Unit& u) const {
        const long L = (long)i * G + c; if (L >= (long)nM * nN) return false;
        int pm, pn; pg8::deal((int)L, nM, nN, pm, pn); if (skipctx) pm = pm + 1 + (pm >= 64 ? 1 : 0);
        u.pm = pm; u.pn = pn; u.a = A + (size_t)pm * tA; u.b = B + (size_t)pn * tB; u.goff = 0; u.gcnt = 0; return true; }
};
struct MoeSched {
    int nM, nN, G, c, t0, up; const char* A; const char* W; size_t tA, tB, wsz; int ts[9], cnt[8];
    __device__ __forceinline__ bool next(int i, pg8::Unit& u) const {
        const long L = (long)i * G + c; if (L >= (long)nM * nN) return false;
        int pml, pn; pg8::deal((int)L, nM, nN, pml, pn); const int rt = t0 + pml;
        int e = 0, tse = 0, ce = cnt[0];
#pragma unroll
        for (int k = 1; k < 8; ++k) { const bool sel = (rt >= ts[k]) && (ts[k + 1] > ts[k]); e = sel ? k : e; tse = sel ? ts[k] : tse; ce = sel ? cnt[k] : ce; }
        const int lt = rt - tse;
        u.pn = pn; u.b = W + (size_t)e * wsz + (size_t)pn * tB;
        if (up) { u.pm = pml; u.a = A; u.goff = e * LISTCAP + lt * 256; const int rem = ce - lt * 256; u.gcnt = rem < 256 ? rem : 256; }
        else { u.pm = rt; u.a = A + (size_t)pml * tA; u.goff = 0; u.gcnt = 0; }
        return true; }
};

__global__ void __launch_bounds__(NWAVES * 64, 2) mk_fwd(Args a_unused) {
    extern __shared__ __attribute__((aligned(16))) unsigned char lds[];
    Frame F; ArgP a = args_here();
    F.lds = (LAS unsigned char*)lds;
    relaunder(F);
        unsigned* ctl = (unsigned*)(a->ws + WS_CTL);
    for (int u = F.tid; u < (LDS_BYTES - RING_BYTES) / 4; u += NWAVES * 64) ((LAS unsigned*)(F.lds + RING_BYTES))[u] = 0u;
    __syncthreads();
    volatile LAS unsigned* MISC = (volatile LAS unsigned*)(F.lds + MISC_OFF);
    XcdBarrier bar = xcd_barrier_post(ctl + CW_BAR + a->li * XCD_BAR_WORDS, MISC + 8);
    LAS unsigned* gtab = (LAS unsigned*)(F.lds + GTAB_OFF);
    const int lo = a->ph_lo, hi = a->ph_hi; int ph = 0;
#ifndef PHMASK
#define PHMASK 0x7fff
#endif
#define HAS(k) (((PHMASK) >> (k)) & 1)
#define RUN (a = args_here(), relaunder(F), (ph >= lo && ph < hi))
#define SEAM() do { if (ph >= lo && ph + 1 < hi) xcd_barrier(bar); ++ph; } while (0)
    unsigned char* AR = a->ws + WS_AR;

    if (HAS(0) && RUN) phase_p0a(a, F);
    SEAM();
    if (HAS(1) && RUN) phase_premix0(a, F);
    SEAM();
#pragma unroll 1
    for (int l = 0; l < 2; ++l) {
        if (HAS(2) && RUN) {
            PlainSched S{NR / 256, INW / 256, F.G, F.bx, 0, (const char*)(AR + AR_MIX), (const char*)(a->ws + WS_WIN + l * SZ_WIN), (size_t)256 * DM * 2, (size_t)256 * DM * 2};
            pg8::EpiBf16 E{(bf16*)(AR + AR_P), INW};
            pg8::gemm_phase<pg8::EpiBf16, PlainSched, true, false>(F.tid, F.lds, gtab, nullptr, DM, S, E);
        }
        SEAM();
        if (HAS(3) && RUN) phase_prep(a, F, l);
        SEAM();
        if (HAS(4) && RUN) phase_scan(a, F, l);
        SEAM();
        if (HAS(5) && RUN) phase_mix(a, F, l, (F.G % 8 == 0) ? (F.bx % 8) * (F.G / 8) + (F.bx / 8) : F.bx);
        SEAM();
        if (HAS(6) && RUN) {
            PlainSched S{l == 0 ? NR / 256 : NLAT / 256, DM / 256, F.G, F.bx, l, (const char*)(AR + AR_MIX), (const char*)(a->ws + WS_WOUT + l * SZ_WOUT), (size_t)256 * DM * 2, (size_t)256 * DM * 2};
            pg8::EpiBf16 E{(bf16*)(AR + AR_MX), DM};
            pg8::gemm_phase<pg8::EpiBf16, PlainSched, true, false>(F.tid, F.lds, gtab, nullptr, DM, S, E);
        }
        SEAM();
        if (l == 0) {
            if (HAS(7) && RUN) phase_resid<0>(a, F);
            SEAM();
            if (HAS(8) && RUN) {
                PlainSched S{NR / 256, 2 * FF / 256, F.G, F.bx, 0, (const char*)(AR + AR_HX2), (const char*)(a->ws + WS_W13D), (size_t)256 * DM * 2, (size_t)256 * DM * 2};
                pg8::EpiSwiglu E{(bf16*)(AR + AR_ACT), FF};
                pg8::gemm_phase<pg8::EpiSwiglu, PlainSched, true, false>(F.tid, F.lds, gtab, nullptr, DM, S, E);
            }
            SEAM();
            if (HAS(9) && RUN) {
                PlainSched S{NR / 256, DM / 256, F.G, F.bx, 0, (const char*)(AR + AR_ACT), (const char*)(a->ws + WS_W2D), (size_t)256 * FF * 2, (size_t)256 * FF * 2};
                pg8::EpiBf16 E{(bf16*)(AR + AR_YD), DM};
                pg8::gemm_phase<pg8::EpiBf16, PlainSched, true, false>(F.tid, F.lds, gtab, nullptr, FF, S, E);
            }
            SEAM();
            if (HAS(10) && RUN) phase_resid<1>(a, F);
            SEAM();
        } else {
            if (HAS(11) && RUN) phase_resid<2>(a, F);
            SEAM();
#pragma unroll 1
            for (int p = 0; p < MOE_PASSES; ++p) {
                if (HAS(12) && RUN) {
                    MoeSched S; moe_prefix(a->ws, S.ts, S.cnt);
                    const int tot = S.ts[8]; int n = tot - p * MOE_TP; n = n < 0 ? 0 : (n > MOE_TP ? MOE_TP : n);
                    S.nM = n; S.nN = 2 * FF / 256; S.G = F.G; S.c = F.bx; S.t0 = p * MOE_TP; S.up = 1; S.A = (const char*)(AR + AR_HX2); S.W = (const char*)(a->ws + WS_W13M); S.tA = 0; S.tB = (size_t)256 * DM * 2; S.wsz = SZ_W13;
                    pg8::EpiSwiglu E{(bf16*)(AR + AR_ACT), FF};
                    pg8::gemm_phase<pg8::EpiSwiglu, MoeSched, true, true>(F.tid, F.lds, gtab, (const int*)(a->ws + WS_LIST), DM, S, E);
                }
                SEAM();
                if (HAS(13) && RUN) {
                    MoeSched S; moe_prefix(a->ws, S.ts, S.cnt);
                    const int tot = S.ts[8]; int n = tot - p * MOE_TP; n = n < 0 ? 0 : (n > MOE_TP ? MOE_TP : n);
                    S.nM = n; S.nN = DM / 256; S.G = F.G; S.c = F.bx; S.t0 = p * MOE_TP; S.up = 0; S.A = (const char*)(AR + AR_ACT); S.W = (const char*)(a->ws + WS_W2M); S.tA = (size_t)256 * FF * 2; S.tB = (size_t)256 * FF * 2; S.wsz = SZ_W2;
                    pg8::EpiBf16 E{(bf16*)(AR + AR_YM), DM};
                    pg8::gemm_phase<pg8::EpiBf16, MoeSched, true, false>(F.tid, F.lds, gtab, nullptr, FF, S, E);
                }
                SEAM();
            }
            if (HAS(14) && RUN) phase_resid<3>(a, F);
            ++ph;
        }
    }
#undef RUN
#undef SEAM
}
constexpr int N_PHASES = 24;

#ifndef MK_N_LAUNCHES
#define MK_N_LAUNCHES 1
#endif
extern "C" void kernel_launch(void* const* d_in, const int* in_sizes, int n_in, void* d_out, int out_size, void* d_ws, size_t ws_size, hipStream_t stream) {
    static int grid = 0;
    if (grid == 0) {
        if (n_in != 24 || out_size != NLAT * DM || ws_size < WS_END) { fprintf(stderr, "kernel_launch: unexpected shapes (n_in %d out %d ws %zu)\n", n_in, out_size, ws_size); grid = -1; return; }
        int dev = 0, cus = 0, per_cu = 0;
        if (hipGetDevice(&dev) != hipSuccess || hipDeviceGetAttribute(&cus, hipDeviceAttributeMultiprocessorCount, dev) != hipSuccess) { grid = -1; return; }
        if (hipFuncSetAttribute((const void*)mk_fwd, hipFuncAttributeMaxDynamicSharedMemorySize, LDS_BYTES) != hipSuccess) { fprintf(stderr, "kernel_launch: hipFuncSetAttribute failed\n"); grid = -1; return; }
        if (hipOccupancyMaxActiveBlocksPerMultiprocessor(&per_cu, (const void*)mk_fwd, NWAVES * 64, LDS_BYTES) != hipSuccess || per_cu < 1) fprintf(stderr, "kernel_launch: occupancy query says %d\n", per_cu);
        (void)hipGetLastError();
        grid = cus;
    }
    if (grid < 0) return;
    if (hipMemsetAsync((char*)d_ws + WS_CTL, 0, CTL_ZERO_BYTES, stream) != hipSuccess) return;
    Args a{};
    for (int i = 0; i < 24; ++i) a.in[i] = (const float*)d_in[i];
    a.out = (float*)d_out; a.ws = (unsigned char*)d_ws; a.pad = 0;
    if (MK_N_LAUNCHES == 1) { a.ph_lo = 0; a.ph_hi = N_PHASES; a.li = 0; hipLaunchKernelGGL(mk_fwd, dim3(grid), dim3(NWAVES * 64), LDS_BYTES, stream, a); }
    else { for (int p = 0; p < N_PHASES; ++p) { a.ph_lo = p; a.ph_hi = p + 1; a.li = p; hipLaunchKernelGGL(mk_fwd, dim3(grid), dim3(NWAVES * 64), LDS_BYTES, stream, a); } }
}
```

```cpp
#include <hip/hip_runtime.h>
#include <hip/hip_bf16.h>
#include <cstdio>
#include <cstdint>
#include <cmath>
namespace pg8 {
#define PG8_LAS __attribute__((address_space(3)))
typedef unsigned short bf16_t;
typedef short bf16x8 __attribute__((ext_vector_type(8)));
typedef float f32x4 __attribute__((ext_vector_type(4)));
typedef unsigned u32x4 __attribute__((ext_vector_type(4)));
typedef int i32x4_t __attribute__((ext_vector_type(4)));
typedef int i32x8_t __attribute__((ext_vector_type(8)));
typedef int i32x8_t __attribute__((ext_vector_type(8)));
constexpr int BM = 256, BK = 64, HALF = 128, HTB = HALF * BK * 2  , STAGE_BYTES = 8 * HTB, NXCD = 8, WGM = 8;

__host__ __device__ __forceinline__ int lds_byte(int r, int c) { const int st = (r >> 4) * 2 + (c >> 5), rr = r & 15, cc = c & 31, ob = rr * 64 + cc * 2; return st * 1024 + (ob ^ (((ob >> 9) & 1) << 5)); }
__host__ __device__ __forceinline__ void stage_rc(int b, int& R, int& C) { const int st = b / 1024, sb = b % 1024, swz = sb ^ (((sb >> 9) & 1) << 5); R = (st >> 1) * 16 + swz / 64; C = (st & 1) * 32 + (swz % 64) / 2; }
__host__ __device__ __forceinline__ int perm32(int rho) { const int n = rho >> 4, i = rho & 15; return 8 * (i >> 2) + 4 * n + (i & 3); }

struct Unit { int pm, pn; const char* a; const char* b; int goff, gcnt; };

__device__ __forceinline__ void deal(int L, int nM, int nN, int& pm, int& pn) {
    const int nwg = nM * nN; int wgid = L;
    { const int q = nwg / NXCD, r = nwg % NXCD, xcd = wgid % NXCD, off = wgid / NXCD; wgid = (xcd < r ? xcd * (q + 1) : r * (q + 1) + (xcd - r) * q) + off; }
    const int nig = WGM * nN, gid = wgid / nig, fm = gid * WGM, gsz = (nM - fm) < WGM ? (nM - fm) : WGM;
    pm = fm + ((wgid % nig) % gsz); pn = (wgid % nig) / gsz;
}

__device__ __forceinline__ float zero_v() { float z; asm volatile("v_mov_b32 %0, 0" : "=v"(z)); return z; }
__device__ __forceinline__ unsigned cvt_pk_bf16(float lo, float hi) { unsigned r; asm volatile("v_cvt_pk_bf16_f32 %0, %1, %2" : "=v"(r) : "v"(lo), "v"(hi)); return r; }

struct EpiBf16 {
    static constexpr bool PERM = true;
    bf16_t* O; int ldc;
    __device__ __forceinline__ void operator()(const f32x4 (&acc)[2][2][4][2], const Unit& u, int wr, int wc, int fr, int fq) const {
        const int row0 = u.pm * BM + wr * 64 + fr; const int col0 = u.pn * BM + wc * 32 + 8 * fq;
#pragma unroll
        for (int ai = 0; ai < 2; ++ai)
#pragma unroll
            for (int m = 0; m < 4; ++m) { bf16_t* rowp = O + (size_t)(row0 + ai * HALF + m * 16) * ldc + col0;
#pragma unroll
                for (int bj = 0; bj < 2; ++bj) { const f32x4 v0 = acc[ai][bj][m][0], v1 = acc[ai][bj][m][1];
                    u32x4 w; w.x = cvt_pk_bf16(v0[0], v0[1]); w.y = cvt_pk_bf16(v0[2], v0[3]); w.z = cvt_pk_bf16(v1[0], v1[1]); w.w = cvt_pk_bf16(v1[2], v1[3]);
                    *(u32x4*)(rowp + bj * HALF) = w; } }
    }
};
struct EpiF32 {
    static constexpr bool PERM = false;
    float* O; int ldc;
    __device__ __forceinline__ void operator()(const f32x4 (&acc)[2][2][4][2], const Unit& u, int wr, int wc, int fr, int fq) const {
        const int row0 = u.pm * BM + wr * 64 + fr; const int col0 = u.pn * BM + wc * 32 + 4 * fq;
#pragma unroll
        for (int ai = 0; ai < 2; ++ai)
#pragma unroll
            for (int m = 0; m < 4; ++m) { float* rowp = O + (size_t)(row0 + ai * HALF + m * 16) * ldc + col0;
#pragma unroll
                for (int bj = 0; bj < 2; ++bj)
#pragma unroll
                    for (int n = 0; n < 2; ++n) *(f32x4*)(rowp + bj * HALF + n * 16) = acc[ai][bj][m][n]; }
    }
};
__device__ __forceinline__ float silu_f(float x) { return x * __builtin_amdgcn_rcpf(1.0f + __builtin_amdgcn_exp2f(-1.4426950408889634f * x)); }
struct EpiSwiglu {
    static constexpr bool PERM = true;
    bf16_t* O; int ldc;
    __device__ __forceinline__ void operator()(const f32x4 (&acc)[2][2][4][2], const Unit& u, int wr, int wc, int fr, int fq) const {
        const int row0 = u.pm * BM + wr * 64 + fr; const int col0 = u.pn * HALF + wc * 32 + 8 * fq;
#pragma unroll
        for (int ai = 0; ai < 2; ++ai)
#pragma unroll
            for (int m = 0; m < 4; ++m) { bf16_t* rowp = O + (size_t)(row0 + ai * HALF + m * 16) * ldc + col0;
                const f32x4 a0 = acc[ai][0][m][0], a1 = acc[ai][0][m][1], g0 = acc[ai][1][m][0], g1 = acc[ai][1][m][1];
                u32x4 w; w.x = cvt_pk_bf16(silu_f(a0[0]) * g0[0], silu_f(a0[1]) * g0[1]); w.y = cvt_pk_bf16(silu_f(a0[2]) * g0[2], silu_f(a0[3]) * g0[3]);
                w.z = cvt_pk_bf16(silu_f(a1[0]) * g1[0], silu_f(a1[1]) * g1[1]); w.w = cvt_pk_bf16(silu_f(a1[2]) * g1[2], silu_f(a1[3]) * g1[3]);
                *(u32x4*)rowp = w; }
    }
};

struct EpiBf16S {
    static constexpr bool PERM = true;
    bf16_t* O; int ldc; float scl; const float* rs = nullptr;
    __device__ __forceinline__ void operator()(const f32x4 (&acc)[2][2][4][2], const Unit& u, int wr, int wc, int fr, int fq) const {
        const int row0 = u.pm * BM + wr * 64 + fr; const int col0 = u.pn * BM + wc * 32 + 8 * fq;
#pragma unroll
        for (int ai = 0; ai < 2; ++ai)
#pragma unroll
            for (int m = 0; m < 4; ++m) { bf16_t* rowp = O + (size_t)(row0 + ai * HALF + m * 16) * ldc + col0;
                const float scl = rs ? this->scl * rs[row0 + ai * HALF + m * 16] : this->scl;
#pragma unroll
                for (int bj = 0; bj < 2; ++bj) { const f32x4 v0 = acc[ai][bj][m][0] * scl, v1 = acc[ai][bj][m][1] * scl;
                    u32x4 w; w.x = cvt_pk_bf16(v0[0], v0[1]); w.y = cvt_pk_bf16(v0[2], v0[3]); w.z = cvt_pk_bf16(v1[0], v1[1]); w.w = cvt_pk_bf16(v1[2], v1[3]);
                    *(u32x4*)(rowp + bj * HALF) = w; } }
    }
};
struct EpiF32S {
    static constexpr bool PERM = false;
    float* O; int ldc; float scl;
    __device__ __forceinline__ void operator()(const f32x4 (&acc)[2][2][4][2], const Unit& u, int wr, int wc, int fr, int fq) const {
        const int row0 = u.pm * BM + wr * 64 + fr; const int col0 = u.pn * BM + wc * 32 + 4 * fq;
#pragma unroll
        for (int ai = 0; ai < 2; ++ai)
#pragma unroll
            for (int m = 0; m < 4; ++m) { float* rowp = O + (size_t)(row0 + ai * HALF + m * 16) * ldc + col0;
#pragma unroll
                for (int bj = 0; bj < 2; ++bj)
#pragma unroll
                    for (int n = 0; n < 2; ++n) *(f32x4*)(rowp + bj * HALF + n * 16) = acc[ai][bj][m][n] * scl; }
    }
};
__device__ __forceinline__ unsigned cvt_fp8x4(float a, float b, float c, float d) { int w = 0; w = __builtin_amdgcn_cvt_pk_fp8_f32(a, b, w, false); w = __builtin_amdgcn_cvt_pk_fp8_f32(c, d, w, true); return (unsigned)w; }
struct EpiSwigluS {
    static constexpr bool PERM = true;
    bf16_t* O; int ldc; float si;
    __device__ __forceinline__ void operator()(const f32x4 (&acc)[2][2][4][2], const Unit& u, int wr, int wc, int fr, int fq) const {
        const int row0 = u.pm * BM + wr * 64 + fr; const int col0 = u.pn * HALF + wc * 32 + 8 * fq;
#pragma unroll
        for (int ai = 0; ai < 2; ++ai)
#pragma unroll
            for (int m = 0; m < 4; ++m) { bf16_t* rowp = O + (size_t)(row0 + ai * HALF + m * 16) * ldc + col0;
                const f32x4 a0 = acc[ai][0][m][0] * si, a1 = acc[ai][0][m][1] * si, g0 = acc[ai][1][m][0] * si, g1 = acc[ai][1][m][1] * si;
                u32x4 w; w.x = cvt_pk_bf16(silu_f(a0[0]) * g0[0], silu_f(a0[1]) * g0[1]); w.y = cvt_pk_bf16(silu_f(a0[2]) * g0[2], silu_f(a0[3]) * g0[3]);
                w.z = cvt_pk_bf16(silu_f(a1[0]) * g1[0], silu_f(a1[1]) * g1[1]); w.w = cvt_pk_bf16(silu_f(a1[2]) * g1[2], silu_f(a1[3]) * g1[3]);
                *(u32x4*)rowp = w; }
    }
};
struct EpiSwiglu8 {
    static constexpr bool PERM = true;
    unsigned char* O; int ldc; float si, so; const float* rs = nullptr;
    __device__ __forceinline__ f32x4 sw4(const f32x4 a, const f32x4 g, const float c1, const float k2) const {
        const f32x4 t = a * c1; f32x4 e; e[0] = __builtin_amdgcn_exp2f(t[0]); e[1] = __builtin_amdgcn_exp2f(t[1]); e[2] = __builtin_amdgcn_exp2f(t[2]); e[3] = __builtin_amdgcn_exp2f(t[3]);
        const f32x4 d = e + 1.0f; f32x4 r; r[0] = __builtin_amdgcn_rcpf(d[0]); r[1] = __builtin_amdgcn_rcpf(d[1]); r[2] = __builtin_amdgcn_rcpf(d[2]); r[3] = __builtin_amdgcn_rcpf(d[3]);
        return ((a * g) * k2) * r; }
    __device__ __forceinline__ void operator()(const f32x4 (&acc)[2][2][4][2], const Unit& u, int wr, int wc, int fr, int fq) const {
        const int row0 = u.pm * BM + wr * 64 + fr; const int col0 = u.pn * HALF + wc * 32 + 8 * fq;
#pragma unroll
        for (int ai = 0; ai < 2; ++ai)
#pragma unroll
            for (int m = 0; m < 4; ++m) { unsigned char* rowp = O + (size_t)(row0 + ai * HALF + m * 16) * ldc + col0;
                const float sr = rs ? si * rs[row0 + ai * HALF + m * 16] : si; const float c1 = -1.4426950408889634f * sr, k2 = sr * sr * so;
                const f32x4 o0 = sw4(acc[ai][0][m][0], acc[ai][1][m][0], c1, k2), o1 = sw4(acc[ai][0][m][1], acc[ai][1][m][1], c1, k2);
                const unsigned w0 = cvt_fp8x4(o0[0], o0[1], o0[2], o0[3]), w1 = cvt_fp8x4(o1[0], o1[1], o1[2], o1[3]);
                typedef unsigned u32x2_t __attribute__((ext_vector_type(2)));
                *(u32x2_t*)rowp = (u32x2_t){w0, w1}; }
    }
};

template <class Epi, class Sched, bool ALIGN_EPI, bool GATHER, int F8 = 0  >
__device__ __forceinline__ void gemm_phase(const int tid, PG8_LAS unsigned char* lds, PG8_LAS unsigned* gtab, const int* glist, const int K  , const int KL  , const Sched& S, const Epi& E) {
    const int wid = __builtin_amdgcn_readfirstlane(tid >> 6), lane = tid & 63, wr = wid >> 2, wc = wid & 3, fr = lane & 15, fq = lane >> 4;
    const int nt = KL / BK;
    unsigned voffA[2], voffB[2]; int RA[2], CA[2];
#pragma unroll
    for (int i = 0; i < 2; ++i) { int R, C; stage_rc(tid * 16 + i * 8192, R, C); const int Rb = Epi::PERM ? ((R & ~31) + perm32(R & 31)) : R;
        voffA[i] = (unsigned)(R * K + C) * 2u; voffB[i] = (unsigned)(Rb * K + C) * 2u; RA[i] = R; CA[i] = C; }
    const size_t kstep = (size_t)(BK * 2);
    const size_t hstep = (size_t)HALF * K * 2;
    const unsigned ldsw = (unsigned)wid * 1024u;
    const int aoff = lds_byte(wr * 64 + fr, fq * 8), boff = lds_byte(wc * 32 + fr, fq * 8);
    unsigned vc[2][2], vn[2][2], v2[2][2];
#define PG8_SA(b, h) (((b) * 2 + (h)) * HTB)
#define PG8_SB(b, h) ((4 + (b) * 2 + (h)) * HTB)
#define PG8_STAGE(bufoff, gbase, voff) do { _Pragma("unroll") for (int _i = 0; _i < 2; ++_i) \
        __builtin_amdgcn_global_load_lds((const unsigned*)((const char*)(gbase) + (voff)[_i]), (PG8_LAS unsigned*)(lds + (bufoff) + ldsw + _i * 8192), 16, 0, 0); } while (0)
#define PG8_STAGE_A(bufoff, gbase, h, VG) do { if constexpr (GATHER) { PG8_STAGE(bufoff, gbase, VG[h]); } else { PG8_STAGE(bufoff, (gbase) + (h) * hstep, voffA); } } while (0)
#define PG8_LDA(dst, b, h) do { _Pragma("unroll") for (int m = 0; m < 4; ++m) _Pragma("unroll") for (int k = 0; k < 2; ++k) dst[m][k] = *(const PG8_LAS bf16x8*)(lds + PG8_SA(b, h) + aoff + m * 2048 + k * 1024); } while (0)
#define PG8_LDB(dst, b, h) do { _Pragma("unroll") for (int n = 0; n < 2; ++n) _Pragma("unroll") for (int k = 0; k < 2; ++k) dst[n][k] = *(const PG8_LAS bf16x8*)(lds + PG8_SB(b, h) + boff + n * 2048 + k * 1024); } while (0)
#define PG8_CAT(x) __builtin_shufflevector(__builtin_bit_cast(i32x4_t, x[0]), __builtin_bit_cast(i32x4_t, x[1]), 0, 1, 2, 3, 4, 5, 6, 7)
#define PG8_MMA(ai, bj, At, Bt) do { __builtin_amdgcn_s_setprio(1); \
        if constexpr (F8 == 2) { _Pragma("unroll") for (int m = 0; m < 4; ++m) _Pragma("unroll") for (int n = 0; n < 2; ++n) _Pragma("unroll") for (int k = 0; k < 2; ++k) \
            asm volatile("v_mfma_i32_16x16x64_i8 %0, %1, %2, %0" : "+v"(acc[ai][bj][m][n]) : "v"(Bt[n][k]), "v"(At[m][k])); } \
        else if constexpr (F8 == 1) { _Pragma("unroll") for (int m = 0; m < 4; ++m) _Pragma("unroll") for (int n = 0; n < 2; ++n) \
            { const i32x8_t b8_ = PG8_CAT(Bt[n]), a8_ = PG8_CAT(At[m]); asm volatile("v_mfma_f32_16x16x128_f8f6f4 %0, %1, %2, %0" : "+v"(acc[ai][bj][m][n]) : "v"(b8_), "v"(a8_)); } } \
        else { _Pragma("unroll") for (int m = 0; m < 4; ++m) _Pragma("unroll") for (int n = 0; n < 2; ++n) _Pragma("unroll") for (int k = 0; k < 2; ++k) \
            acc[ai][bj][m][n] = __builtin_amdgcn_mfma_f32_16x16x32_bf16(Bt[n][k], At[m][k], acc[ai][bj][m][n], 0, 0, 0); } __builtin_amdgcn_s_setprio(0); } while (0)
#define PG8_WAIT_V(n) asm volatile("s_waitcnt vmcnt(" #n ")" ::: "memory")
#define PG8_WAIT_L(n) asm volatile("s_waitcnt lgkmcnt(" #n ")" ::: "memory")
#define PG8_BAR __builtin_amdgcn_s_barrier()
#define PG8_SCHED __builtin_amdgcn_sched_barrier(0)
#define PG8_GT_DMA(u) do { if (wid < 4) __builtin_amdgcn_global_load_lds((const unsigned*)(glist + (u).goff + wid * 64 + lane), (PG8_LAS unsigned*)(gtab + wid * 64), 4, 0, 0); } while (0)
#define PG8_GT_READ(V, u) do { _Pragma("unroll") for (int _h = 0; _h < 2; ++_h) _Pragma("unroll") for (int _i = 0; _i < 2; ++_i) { const int _p = _h * HALF + RA[_i]; int _r = (int)gtab[_p]; _r = (_p < (u).gcnt) ? _r : 0; \
        V[_h][_i] = ((unsigned)_r * (unsigned)K + (unsigned)CA[_i]) * 2u; } } while (0)
    Unit cur, nxt; int ui = 0;
    if (!S.next(0, cur)) return;
    f32x4 acc[2][2][4][2];
    { const float z = zero_v();
#pragma unroll
    for (int a = 0; a < 2; ++a)
#pragma unroll
        for (int b = 0; b < 2; ++b)
#pragma unroll
            for (int m = 0; m < 4; ++m)
#pragma unroll
                for (int n = 0; n < 2; ++n) acc[a][b][m][n] = (f32x4){z, z, z, z}; }
    bf16x8 At[4][2], B0[2][2], B1[2][2];
    const char* cA = cur.a; const char* cB = cur.b;
    if constexpr (GATHER) { PG8_GT_DMA(cur); PG8_WAIT_V(0); PG8_BAR; PG8_GT_READ(vc, cur); PG8_WAIT_L(0); PG8_BAR; }
    if constexpr (GATHER) {
#pragma unroll
        for (int _h = 0; _h < 2; ++_h) { vn[_h][0] = vc[_h][0]; vn[_h][1] = vc[_h][1]; } }
    PG8_STAGE(PG8_SB(0, 0), cB, voffB); PG8_STAGE(PG8_SB(0, 1), cB + hstep, voffB); PG8_STAGE_A(PG8_SA(0, 0), cA, 0, vc); PG8_STAGE_A(PG8_SA(0, 1), cA, 1, vc);
    if (wr == 1) PG8_BAR;
    PG8_WAIT_V(2); PG8_BAR;
    PG8_STAGE(PG8_SB(1, 0), cB + kstep, voffB); PG8_STAGE_A(PG8_SA(1, 0), cA + kstep, 0, vc); PG8_STAGE(PG8_SB(1, 1), cB + hstep + kstep, voffB);
    PG8_WAIT_V(6); PG8_BAR;
    for (;;) {
        const bool has_next = S.next(ui + 1, nxt);
        if constexpr (GATHER) { if (has_next) PG8_GT_DMA(nxt); }
        const char* nA = has_next ? nxt.a : cA; const char* nB = has_next ? nxt.b : cB;
        for (int t = 0; t < nt; t += 2) {
            const bool last = (t == nt - 2);
            const char* a1 = cA + (size_t)(t + 1) * kstep;
            const char* a2 = last ? nA : cA + (size_t)(t + 2) * kstep; const char* b2 = last ? nB : cB + (size_t)(t + 2) * kstep;
            const char* a3 = a2 + kstep; const char* b3 = b2 + kstep;
            if constexpr (GATHER) {
                if (last) { if (has_next) { PG8_GT_READ(vn, nxt); } else {
#pragma unroll
                        for (int _h = 0; _h < 2; ++_h) { vn[_h][0] = vc[_h][0]; vn[_h][1] = vc[_h][1]; } } }
#pragma unroll
                for (int _h = 0; _h < 2; ++_h) { v2[_h][0] = last ? vn[_h][0] : vc[_h][0]; v2[_h][1] = last ? vn[_h][1] : vc[_h][1]; }
            }
            PG8_LDB(B0, 0, 0); PG8_LDB(B1, 0, 1); PG8_SCHED; PG8_LDA(At, 0, 0); PG8_STAGE_A(PG8_SA(1, 1), a1, 1, vc);
            PG8_WAIT_V(8); PG8_WAIT_L(0); PG8_BAR; PG8_MMA(0, 0, At, B0); PG8_MMA(0, 1, At, B1); PG8_BAR; PG8_SCHED;
            PG8_LDA(At, 0, 1); PG8_STAGE(PG8_SB(0, 0), b2, voffB); PG8_STAGE(PG8_SB(0, 1), b2 + hstep, voffB); PG8_STAGE_A(PG8_SA(0, 0), a2, 0, v2);
            PG8_WAIT_V(8); PG8_WAIT_L(0); PG8_BAR; PG8_MMA(1, 0, At, B0); PG8_MMA(1, 1, At, B1); PG8_BAR; PG8_SCHED;
            PG8_LDB(B0, 1, 0); PG8_LDB(B1, 1, 1); PG8_SCHED; PG8_LDA(At, 1, 0); PG8_STAGE_A(PG8_SA(0, 1), a2, 1, v2);
            PG8_WAIT_V(8); PG8_WAIT_L(0); PG8_BAR; PG8_MMA(0, 0, At, B0); PG8_MMA(0, 1, At, B1); PG8_BAR; PG8_SCHED;
            PG8_LDA(At, 1, 1); PG8_STAGE(PG8_SB(1, 0), b3, voffB); PG8_STAGE(PG8_SB(1, 1), b3 + hstep, voffB); PG8_STAGE_A(PG8_SA(1, 0), a3, 0, v2);
            PG8_WAIT_V(8); PG8_WAIT_L(0); PG8_BAR; PG8_MMA(1, 0, At, B0); PG8_MMA(1, 1, At, B1); PG8_BAR; PG8_SCHED;
        }
        if constexpr (ALIGN_EPI) { if (wr == 0) PG8_BAR; }
        if constexpr (F8 != 0) {
            asm volatile("s_nop 15\n\ts_nop 15" : "+v"(acc[1][0][0][0]), "+v"(acc[1][0][0][1]), "+v"(acc[1][0][1][0]), "+v"(acc[1][0][1][1]), "+v"(acc[1][0][2][0]), "+v"(acc[1][0][2][1]), "+v"(acc[1][0][3][0]), "+v"(acc[1][0][3][1]) :: "memory");
            asm volatile("" : "+v"(acc[1][1][0][0]), "+v"(acc[1][1][0][1]), "+v"(acc[1][1][1][0]), "+v"(acc[1][1][1][1]), "+v"(acc[1][1][2][0]), "+v"(acc[1][1][2][1]), "+v"(acc[1][1][3][0]), "+v"(acc[1][1][3][1]) :: "memory"); }
        if constexpr (F8 == 2) {
#pragma unroll
            for (int a_ = 0; a_ < 2; ++a_)
#pragma unroll
                for (int b_ = 0; b_ < 2; ++b_)
#pragma unroll
                    for (int m = 0; m < 4; ++m)
#pragma unroll
                        for (int n = 0; n < 2; ++n) { const i32x4_t iv = __builtin_bit_cast(i32x4_t, acc[a_][b_][m][n]); acc[a_][b_][m][n] = (f32x4){(float)iv[0], (float)iv[1], (float)iv[2], (float)iv[3]}; } }
        E(acc, cur, wr, wc, fr, fq);
        if (!has_next) break;
        { const float z = zero_v();
#pragma unroll
        for (int a = 0; a < 2; ++a)
#pragma unroll
            for (int b = 0; b < 2; ++b)
#pragma unroll
                for (int m = 0; m < 4; ++m)
#pragma unroll
                    for (int n = 0; n < 2; ++n) acc[a][b][m][n] = (f32x4){z, z, z, z}; }
        cur = nxt; cA = nA; cB = nB; ++ui;
        if constexpr (GATHER) {
#pragma unroll
            for (int _h = 0; _h < 2; ++_h) { vc[_h][0] = vn[_h][0]; vc[_h][1] = vn[_h][1]; } }
        if constexpr (ALIGN_EPI) { if (wr == 1) PG8_BAR; }
    }
    PG8_WAIT_V(0);
    if constexpr (!ALIGN_EPI) { if (wr == 0) PG8_BAR; }
    PG8_BAR;
#undef PG8_SA
#undef PG8_SB
#undef PG8_STAGE
#undef PG8_STAGE_A
#undef PG8_LDA
#undef PG8_LDB
#undef PG8_CAT
#undef PG8_MMA
#undef PG8_WAIT_V
#undef PG8_WAIT_L
#undef PG8_BAR
#undef PG8_SCHED
#undef PG8_GT_DMA
#undef PG8_GT_READ
}
}
namespace attn_body {
using bf16=__hip_bfloat16;
using bf16x8=__attribute__((ext_vector_type(8)))short;
using s16x4=__attribute__((ext_vector_type(4)))short;
using f32x16=__attribute__((ext_vector_type(16)))float;
using u32x4=__attribute__((ext_vector_type(4)))unsigned;
constexpr int D=64,KP=64;
constexpr int NW=8,QBLK=32,QB=QBLK*NW,KVBLK=64;
__device__ __forceinline__ int crow(int r,int hi){return (r&3)+8*(r>>2)+4*hi;}
#define SBAR() __builtin_amdgcn_sched_barrier(0)
constexpr int NSLOT=3, SLOTB=8192;
constexpr int LDS_K=0, LDS_V=NSLOT*SLOTB, LDS_WS=2*NSLOT*SLOTB, LDS_OST=LDS_WS+NW*64*4, LDS_BYTES=LDS_OST+NW*4096;
constexpr float C2=0.125f*1.4426950408889634f;
__device__ __forceinline__ void glds16(const void*gsrc,unsigned lds_dst){unsigned keep;
  asm volatile("s_mov_b32 %0, m0\n\ts_mov_b32 m0, %2\n\ts_nop 0\n\tglobal_load_lds_dwordx4 %1, off\n\ts_mov_b32 m0, %0":"=&s"(keep):"v"(gsrc),"s"(lds_dst):"memory");}
__device__ __forceinline__ float max3f(float a,float b,float c){float r;asm("v_max3_f32 %0, %1, %2, %3":"=v"(r):"v"(a),"v"(b),"v"(c));return r;}
__device__ __forceinline__ float max2f(float a,float b){float r;asm("v_max_f32_e32 %0, %1, %2":"=v"(r):"v"(a),"v"(b));return r;}
__device__ __forceinline__ float fadd_s(float a,float b){float r;asm("v_add_f32_e32 %0, %1, %2":"=v"(r):"v"(a),"v"(b));return r;}
__device__ __forceinline__ float fsub_s(float a,float b){float r;asm("v_sub_f32_e32 %0, %1, %2":"=v"(r):"v"(a),"v"(b));return r;}
typedef float f32x2_t __attribute__((ext_vector_type(2))); typedef __bf16 bf16x2_t __attribute__((ext_vector_type(2)));
__device__ __forceinline__ unsigned cvtpk_s(float lo,float hi){f32x2_t v={lo,hi};bf16x2_t b=__builtin_convertvector(v,bf16x2_t);return __builtin_bit_cast(unsigned,b);}
#define WAIT_BAR(N) asm volatile("s_waitcnt vmcnt(" #N ") lgkmcnt(0)\n\ts_barrier":::"memory")

__device__ __forceinline__ void qkt(f32x16&p0,f32x16&p1,const char*Kslot,const bf16x8*qr,const f32x16&negm,int r32,int hi){
  const char*kb=Kslot+hi*1024+r32*16;
  #pragma unroll
  for(int d0=0;d0<4;++d0){
    const bf16x8 b0=*reinterpret_cast<const bf16x8*>(kb+d0*2048);
    const bf16x8 b1=*reinterpret_cast<const bf16x8*>(kb+d0*2048+512);
    if(d0==0){p0=__builtin_amdgcn_mfma_f32_32x32x16_bf16(b0,qr[0],negm,0,0,0);p1=__builtin_amdgcn_mfma_f32_32x32x16_bf16(b1,qr[0],negm,0,0,0);}
    else{p0=__builtin_amdgcn_mfma_f32_32x32x16_bf16(b0,qr[d0],p0,0,0,0);p1=__builtin_amdgcn_mfma_f32_32x32x16_bf16(b1,qr[d0],p1,0,0,0);}}
}
typedef __attribute__((address_space(3))) const char* lds_cptr;
typedef short v4i16_t __attribute__((ext_vector_type(4)));
__device__ __forceinline__ void kload8(bf16x8*kf,lds_cptr kp){
  kf[0]=*(const __attribute__((address_space(3))) bf16x8*)(kp);      kf[1]=*(const __attribute__((address_space(3))) bf16x8*)(kp+512);
  kf[2]=*(const __attribute__((address_space(3))) bf16x8*)(kp+2048); kf[3]=*(const __attribute__((address_space(3))) bf16x8*)(kp+2560);
  kf[4]=*(const __attribute__((address_space(3))) bf16x8*)(kp+4096); kf[5]=*(const __attribute__((address_space(3))) bf16x8*)(kp+4608);
  kf[6]=*(const __attribute__((address_space(3))) bf16x8*)(kp+6144); kf[7]=*(const __attribute__((address_space(3))) bf16x8*)(kp+6656);
}
__device__ __forceinline__ void kload2(bf16x8*kf,lds_cptr kp,int j){ kf[2*j]=*(const __attribute__((address_space(3))) bf16x8*)(kp+j*2048); kf[2*j+1]=*(const __attribute__((address_space(3))) bf16x8*)(kp+j*2048+512); }
__device__ __forceinline__ s16x4 vtr(lds_cptr p){ return __builtin_bit_cast(s16x4,__builtin_amdgcn_ds_read_tr16_b64_v4i16((__attribute__((address_space(3))) v4i16_t*)p)); }
__device__ __forceinline__ float rowmax(const f32x16&p0,const f32x16&p1){
  float a=max3f(p0[0],p0[1],p1[0]),b=max3f(p0[2],p0[3],p1[1]);a=max3f(a,p1[2],p1[3]);
  #pragma unroll
  for(int r=4;r<16;r+=4){a=max3f(a,p0[r],p0[r+1]);b=max3f(b,p0[r+2],p0[r+3]);a=max3f(a,p1[r],p1[r+1]);b=max3f(b,p1[r+2],p1[r+3]);}
  const float m=max2f(a,b);
  auto rr=__builtin_amdgcn_permlane32_swap(__float_as_uint(m),__float_as_uint(m),false,false);
  return max2f(__uint_as_float(rr[0]),__uint_as_float(rr[1]));
}
__device__ __forceinline__ void pv(f32x16*o,int vb,bf16x8 pa0,bf16x8 pa1,bf16x8 pa2,bf16x8 pa3){
  #pragma unroll
  for(int d0=0;d0<2;++d0){s16x4 lo[4],hi[4];
    #pragma unroll
    for(int ks=0;ks<4;++ks){
      asm volatile("ds_read_b64_tr_b16 %0,%1 offset:%c2":"=&v"(lo[ks]):"v"(vb),"i"(d0*4096+ks*1024):"memory");
      asm volatile("ds_read_b64_tr_b16 %0,%1 offset:%c2":"=&v"(hi[ks]):"v"(vb),"i"(d0*4096+ks*1024+512):"memory");}
    asm volatile("s_waitcnt lgkmcnt(0)":::"memory");SBAR();
    #define PK(k) (bf16x8){lo[k][0],lo[k][1],lo[k][2],lo[k][3],hi[k][0],hi[k][1],hi[k][2],hi[k][3]}
    o[d0]=__builtin_amdgcn_mfma_f32_32x32x16_bf16(pa0,PK(0),o[d0],0,0,0);
    o[d0]=__builtin_amdgcn_mfma_f32_32x32x16_bf16(pa1,PK(1),o[d0],0,0,0);
    o[d0]=__builtin_amdgcn_mfma_f32_32x32x16_bf16(pa2,PK(2),o[d0],0,0,0);
    o[d0]=__builtin_amdgcn_mfma_f32_32x32x16_bf16(pa3,PK(3),o[d0],0,0,0);
    #undef PK
  }
}

__device__ __forceinline__ void attn_unit(const int tid,const float mref,const bf16*Qu,int QP,const bf16*__restrict__ Kh,const bf16*__restrict__ Vh,int NT,bf16*Ou,int OP,char*shm){
  const int lane=tid&63,r32=lane&31,hi=lane>>5; const int wid=__builtin_amdgcn_readfirstlane(tid>>6);
  const bf16*Qw=Qu+(long)(wid*QBLK)*QP;
  const unsigned lds0=(unsigned)(uintptr_t)shm;
  float*wsf=(float*)(shm+LDS_WS)+wid*64;
  const bf16*ksrc=Kh+(long)lane*KP+wid*8;
  const bf16*vsrc=Vh+(long)(16*(wid&3)+(lane>>2))*KP+(wid>>2)*32+(lane&3)*8;
  const unsigned kdst=lds0+LDS_K+wid*1024, vdst=lds0+LDS_V+wid*1024;
  #define DMA_K(t,slot) glds16(ksrc+(long)(t)*KVBLK*KP,(unsigned)__builtin_amdgcn_readfirstlane(kdst+(slot)))
  #define DMA_V(t,slot) glds16(vsrc+(long)(t)*KVBLK*KP,(unsigned)__builtin_amdgcn_readfirstlane(vdst+(slot)))
  const int vb0=(int)(lds0+LDS_V)+((lane>>4)&1)*32+(lane&3)*8+(4*hi+((lane&15)>>2))*64;
  const char*Kbase=shm+LDS_K; bf16x8 kf[8];
  const lds_cptr shm3=(lds_cptr)shm; const lds_cptr kp0=shm3+LDS_K+hi*1024+r32*16; const lds_cptr vp0=shm3+LDS_V+((lane>>4)&1)*32+(lane&3)*8+(4*hi+((lane&15)>>2))*64;
  DMA_K(0,0);DMA_V(0,0);DMA_K(1,SLOTB);
  bf16x8 qr[4];
  #pragma unroll
  for(int d0=0;d0<4;++d0)qr[d0]=*reinterpret_cast<const bf16x8*>(&Qw[(long)r32*QP+d0*16+hi*8]);
  float l_reg=0.f;f32x16 o[2],negm; { const float z=pg8::zero_v(); _Pragma("unroll") for(int r=0;r<16;++r){o[0][r]=z;o[1][r]=z;negm[r]=z-mref;} } asm volatile("":"+v"(negm));
  f32x16 pA0,pA1,pB0,pB1;
  int sl_prev=0,sl_cur=0,sl_next=SLOTB;
  #define ROT() do{sl_prev=sl_cur;sl_cur=sl_next;sl_next=(sl_next==(NSLOT-1)*SLOTB)?0:sl_next+SLOTB;}while(0)
  DMA_K(2,2*SLOTB);
  WAIT_BAR(3);
  qkt(pA0,pA1,Kbase,qr,negm,r32,hi);asm volatile("s_nop 15\n\ts_nop 7":"+v"(pA0),"+v"(pA1));
  _Pragma("unroll") for(int r=0;r<16;++r){pA0[r]=__builtin_amdgcn_exp2f(pA0[r]);pA1[r]=__builtin_amdgcn_exp2f(pA1[r]);}
  WAIT_BAR(0);
  DMA_K(3,0);DMA_V(1,SLOTB);
  ROT();
  kload8(kf,kp0+sl_cur);
  WAIT_BAR(2);
  s16x4 vlo[8],vhi[8]; u32x4 pw0,pw1,pw2,pw3;
  #define MFX(a_,b_,c_) __builtin_amdgcn_mfma_f32_32x32x16_bf16(a_,b_,c_,0,0,0)
  #define PKW(P,B) cvtpk_s(P[B],P[B+1])
  #define PAF(k) __builtin_bit_cast(bf16x8,pw##k)
  #define VFR(i) (bf16x8){vlo[i][0],vlo[i][1],vlo[i][2],vlo[i][3],vhi[i][0],vhi[i][1],vhi[i][2],vhi[i][3]}
  #define PIN(x) asm volatile("":"+v"(x))
  #define GAPA(MF,A0,A1,A2,A3,W0,W1,PW) do{ MF; sacc+=A0; sacc+=A1; sacc+=A2; sacc+=A3; PIN(sacc); W0; W1; PIN(PW); SBAR(); }while(0)
  #define EX(v) __builtin_amdgcn_exp2f(v)
  #define GAPB(MF,X,B) do{ MF; X[B]=EX(X[B]); X[B+1]=EX(X[B+1]); X[B+2]=EX(X[B+2]); X[B+3]=EX(X[B+3]); PIN(X); SBAR(); }while(0)
  #define VRD(i) do{ vlo[i]=vtr(vp_+(((i)>>2)*4096+((i)&3)*1024)); vhi[i]=vtr(vp_+(((i)>>2)*4096+((i)&3)*1024+512)); }while(0)
  #define KRD(G,j) do{ if(G){ kload2(kf,kp0+sl_next,j); SBAR(); } }while(0)
  #define STEP(C0,C1,P0,P1,t,GK,GV,GL) do{ SBAR(); \
    const lds_cptr vp_=vp0+sl_prev; \
    VRD(0); SBAR(); float sacc=(P0[0]+P0[1]); \
    GAPA(C0=MFX(kf[0],qr[0],negm), P0[2],P0[3],P0[4],P0[5],     pw0[0]=PKW(P0,0), pw0[1]=PKW(P0,2), pw0); \
    VRD(4); SBAR(); GAPA(C1=MFX(kf[1],qr[0],negm), P0[6],P0[7],P0[8],P0[9],     pw0[2]=PKW(P0,4), pw0[3]=PKW(P0,6), pw0); \
    VRD(1); SBAR(); GAPA(C0=MFX(kf[2],qr[1],C0),   P0[10],P0[11],P0[12],P0[13], pw1[0]=PKW(P0,8), pw1[1]=PKW(P0,10), pw1); \
    VRD(5); SBAR(); GAPA(C1=MFX(kf[3],qr[1],C1),   P0[14],P0[15],P1[0],P1[1],   pw1[2]=PKW(P0,12),pw1[3]=PKW(P0,14), pw1); \
    VRD(2); SBAR(); GAPA(C0=MFX(kf[4],qr[2],C0),   P1[2],P1[3],P1[4],P1[5],     pw2[0]=PKW(P1,0), pw2[1]=PKW(P1,2), pw2); \
    VRD(6); SBAR(); GAPA(C1=MFX(kf[5],qr[2],C1),   P1[6],P1[7],P1[8],P1[9],     pw2[2]=PKW(P1,4), pw2[3]=PKW(P1,6), pw2); \
    VRD(3); SBAR(); GAPA(C0=MFX(kf[6],qr[3],C0),   P1[10],P1[11],P1[12],P1[13], pw3[0]=PKW(P1,8), pw3[1]=PKW(P1,10), pw3); \
    VRD(7); SBAR(); GAPA(C1=MFX(kf[7],qr[3],C1),   P1[14],P1[15],0.f,0.f,       pw3[2]=PKW(P1,12),pw3[3]=PKW(P1,14), pw3); \
    l_reg+=sacc; \
    if(GK){DMA_K((t)+3,sl_cur);} if(GV){DMA_V((t)+1,sl_next);} \
    SBAR(); \
    GAPB(o[0]=MFX(PAF(0),VFR(0),o[0]), C0,0); \
    GAPB(o[1]=MFX(PAF(0),VFR(4),o[1]), C0,4); \
    KRD(GL,0); GAPB(o[0]=MFX(PAF(1),VFR(1),o[0]), C0,8); \
    KRD(GL,1); GAPB(o[1]=MFX(PAF(1),VFR(5),o[1]), C0,12); \
    KRD(GL,2); GAPB(o[0]=MFX(PAF(2),VFR(2),o[0]), C1,0); \
    KRD(GL,3); GAPB(o[1]=MFX(PAF(2),VFR(6),o[1]), C1,4); \
    GAPB(o[0]=MFX(PAF(3),VFR(3),o[0]), C1,8); \
    GAPB(o[1]=MFX(PAF(3),VFR(7),o[1]), C1,12); \
    }while(0)
  int t=1;
  for(;t+5<NT;t+=2){
    STEP(pB0,pB1,pA0,pA1,t,true,true,true);     WAIT_BAR(2); ROT();
    STEP(pA0,pA1,pB0,pB1,t+1,true,true,true);   WAIT_BAR(2); ROT();
  }
  #define ENDW(tt) do{ if((tt)+3<NT){WAIT_BAR(2);} else if((tt)+2<NT){WAIT_BAR(1);} else {WAIT_BAR(0);} }while(0)
  for(;t+1<NT;t+=2){
    STEP(pB0,pB1,pA0,pA1,t,(t+3<NT),(t+1<NT),(t+1<NT));       ENDW(t);   ROT();
    STEP(pA0,pA1,pB0,pB1,t+1,(t+4<NT),(t+2<NT),(t+2<NT));     ENDW(t+1); ROT();
  }
  STEP(pB0,pB1,pA0,pA1,NT-1,false,false,false);
  { float sacc=pB0[0]+pB0[1]; _Pragma("unroll") for(int r=2;r<16;++r)sacc+=pB0[r]; _Pragma("unroll") for(int r=0;r<16;++r)sacc+=pB1[r]; l_reg+=sacc;
    pw0=(u32x4){PKW(pB0,0),PKW(pB0,2),PKW(pB0,4),PKW(pB0,6)};pw1=(u32x4){PKW(pB0,8),PKW(pB0,10),PKW(pB0,12),PKW(pB0,14)};pw2=(u32x4){PKW(pB1,0),PKW(pB1,2),PKW(pB1,4),PKW(pB1,6)};pw3=(u32x4){PKW(pB1,8),PKW(pB1,10),PKW(pB1,12),PKW(pB1,14)};
    SBAR(); pv(o,vb0+sl_cur,PAF(0),PAF(1),PAF(2),PAF(3)); }
  #undef PKW
  #undef PAF
  #undef VFR
  #undef PIN
  #undef GAPA
  #undef GAPB
  #undef EX
  #undef VRD
  #undef KRD
  #undef STEP
  #undef MFX
  #undef ENDW
  {auto rr=__builtin_amdgcn_permlane32_swap(__float_as_uint(l_reg),__float_as_uint(l_reg),false,false);l_reg=__uint_as_float(rr[0])+__uint_as_float(rr[1]);}
  if(hi==0)wsf[32+r32]=l_reg;asm volatile("s_waitcnt lgkmcnt(0)":::"memory");
  float rli[16];
  #pragma unroll
  for(int r=0;r<16;++r)rli[r]=__builtin_amdgcn_rcpf(wsf[32+crow(r,hi)]);
  bf16*Ow=Ou+(long)(wid*QBLK)*OP;
  { bf16*stg=(bf16*)(shm+LDS_OST)+wid*2048;
    #pragma unroll
    for(int r=0;r<16;++r){const int orow=crow(r,hi);
      #pragma unroll
      for(int d0=0;d0<2;++d0)stg[orow*64+d0*32+r32]=__float2bfloat16(o[d0][r]*rli[r]);}
    asm volatile("s_waitcnt lgkmcnt(0)":::"memory");
    #pragma unroll
    for(int i=0;i<4;++i){const int row=i*8+(lane>>3),ch=lane&7; const u32x4 v=*(const u32x4*)(stg+row*64+ch*8); *(u32x4*)(Ow+(long)row*OP+ch*8)=v;} }
  asm volatile("s_waitcnt lgkmcnt(0)\n\ts_barrier":::"memory");
  #undef DMA_K
  #undef DMA_V
  #undef ROT
}

typedef int v8i __attribute__((ext_vector_type(8)));
typedef int v4i __attribute__((ext_vector_type(4)));
typedef unsigned v2u_t __attribute__((ext_vector_type(2)));
constexpr int F8_SLOTB=4096, F8_LDS_K=0, F8_LDS_V=3*F8_SLOTB, F8_LDS_WS=6*F8_SLOTB, F8_OSTP=144, F8_LDS_OST=F8_LDS_WS+2048, F8_LDS_BYTES=F8_LDS_OST+NW*32*F8_OSTP;
constexpr float F8_SH=13.0f;
#define MF8(a_,b_,c_,BF) __builtin_amdgcn_mfma_scale_f32_32x32x64_f8f6f4(a_,b_,c_,0,BF,0,0,0,0)
typedef __attribute__((address_space(3))) const v4i* lds_v4p;
__device__ __forceinline__ v8i ld256(lds_cptr p){ const v4i a=*(lds_v4p)(p), b=*(lds_v4p)(p+1024); return __builtin_shufflevector(a,b,0,1,2,3,4,5,6,7); }
__device__ __forceinline__ void attn_unit8(const int tid,const float mref,const unsigned char*Qu,int QP,const unsigned char*__restrict__ Kh,const unsigned char*__restrict__ Vh,int NT,bf16*Ou,int OP,char*shm){
  const int lane=tid&63,r32=lane&31,hi=lane>>5; const int wid=__builtin_amdgcn_readfirstlane(tid>>6);
  const unsigned lds0=(unsigned)(uintptr_t)shm;
  const bool isK=wid<4;
  const unsigned char*dsrc=(isK?Kh:Vh)+(wid&3)*1024+lane*16;
  const unsigned ddst=lds0+(isK?F8_LDS_K:F8_LDS_V)+(wid&3)*1024;
  #define DMA8(tk,sk,tv,sv) glds16(dsrc+(long)(isK?(tk):(tv))*4096,(unsigned)__builtin_amdgcn_readfirstlane(ddst+(isK?(sk):(sv))))
  const lds_cptr shm3=(lds_cptr)shm; const lds_cptr kp0=shm3+F8_LDS_K+hi*2048+r32*16; const lds_cptr vp0=shm3+F8_LDS_V+hi*2048+r32*16;
  DMA8(0,0,0,0); if(isK){DMA8(1,F8_SLOTB,0,0);}
  v8i qf; { const unsigned char*qp=Qu+(long)(wid*QBLK+r32)*QP+32*hi; const v4i a=*(const v4i*)qp, b=*(const v4i*)(qp+16); qf=__builtin_shufflevector(a,b,0,1,2,3,4,5,6,7); }
  f32x16 o[2],lacc,negm; { const float z=pg8::zero_v(); _Pragma("unroll") for(int r=0;r<16;++r){o[0][r]=z;o[1][r]=z;lacc[r]=z;negm[r]=z-mref+F8_SH;} } asm volatile("":"+v"(negm));
  v8i ones,pw; { int o1; asm volatile("v_mov_b32 %0, 0x38383838":"=v"(o1)); _Pragma("unroll") for(int j=0;j<8;++j){ones[j]=o1;pw[j]=o1;} } asm volatile("":"+v"(ones));
  f32x16 pA0,pA1,pB0,pB1; v8i kf[2],vf[2];
  int sl_prev=0,sl_cur=0,sl_next=F8_SLOTB;
  #define ROT() do{sl_prev=sl_cur;sl_cur=sl_next;sl_next=(sl_next==2*F8_SLOTB)?0:sl_next+F8_SLOTB;}while(0)
  if(isK){DMA8(2,2*F8_SLOTB,0,0);}
  WAIT_BAR(3);
  kf[0]=ld256(kp0); kf[1]=ld256(kp0+512);
  pA0=MF8(kf[0],qf,negm,0); pA1=MF8(kf[1],qf,negm,0);
  _Pragma("unroll") for(int r=0;r<16;++r){pA0[r]=__builtin_amdgcn_exp2f(pA0[r]);pA1[r]=__builtin_amdgcn_exp2f(pA1[r]);}
  WAIT_BAR(0);
  DMA8(3,0,1,F8_SLOTB);
  ROT();
  kf[0]=ld256(kp0+sl_cur); kf[1]=ld256(kp0+sl_cur+512);
  WAIT_BAR(1);
  #define PIN(x) asm volatile("":"+v"(x))
  #define EX(v) __builtin_amdgcn_exp2f(v)
  #define CV4(W,P,B) do{ W=__builtin_amdgcn_cvt_pk_bf8_f32(P[B],P[(B)+1],W,false); W=__builtin_amdgcn_cvt_pk_bf8_f32(P[(B)+2],P[(B)+3],W,true); }while(0)
  #define STEP8(C0,C1,P0,P1,t,GK,GV,GL) do{ SBAR(); \
    const lds_cptr vp_=vp0+sl_prev; \
    vf[0]=ld256(vp_); SBAR(); \
    C0=MF8(kf[0],qf,negm,0); CV4(pw[0],P0,0); CV4(pw[1],P0,4); CV4(pw[2],P0,8); CV4(pw[3],P0,12); PIN(pw); SBAR(); \
    vf[1]=ld256(vp_+512); SBAR(); \
    C1=MF8(kf[1],qf,negm,0); CV4(pw[4],P1,0); CV4(pw[5],P1,4); CV4(pw[6],P1,8); CV4(pw[7],P1,12); PIN(pw); SBAR(); \
    if(isK?(GK):(GV)){DMA8((t)+3,sl_cur,(t)+1,sl_next);} \
    SBAR(); \
    o[0]=MF8(vf[0],pw,o[0],1); \
    C0[0]=EX(C0[0]);C0[1]=EX(C0[1]);C0[2]=EX(C0[2]);C0[3]=EX(C0[3]);C0[4]=EX(C0[4]);C0[5]=EX(C0[5]);C0[6]=EX(C0[6]);C0[7]=EX(C0[7]);C0[8]=EX(C0[8]);C0[9]=EX(C0[9]);C0[10]=EX(C0[10]); PIN(C0); SBAR(); \
    if(GL){ kf[0]=ld256(kp0+sl_next); SBAR(); } \
    o[1]=MF8(vf[1],pw,o[1],1); \
    C0[11]=EX(C0[11]);C0[12]=EX(C0[12]);C0[13]=EX(C0[13]);C0[14]=EX(C0[14]);C0[15]=EX(C0[15]);C1[0]=EX(C1[0]);C1[1]=EX(C1[1]);C1[2]=EX(C1[2]);C1[3]=EX(C1[3]);C1[4]=EX(C1[4]);C1[5]=EX(C1[5]); PIN(C0); PIN(C1); SBAR(); \
    if(GL){ kf[1]=ld256(kp0+sl_next+512); SBAR(); } \
    lacc=MF8(ones,pw,lacc,1); \
    C1[6]=EX(C1[6]);C1[7]=EX(C1[7]);C1[8]=EX(C1[8]);C1[9]=EX(C1[9]);C1[10]=EX(C1[10]);C1[11]=EX(C1[11]);C1[12]=EX(C1[12]);C1[13]=EX(C1[13]);C1[14]=EX(C1[14]);C1[15]=EX(C1[15]); PIN(C1); SBAR(); \
    }while(0)
  int t=1;
  for(;t+5<NT;t+=2){
    STEP8(pB0,pB1,pA0,pA1,t,true,true,true);     WAIT_BAR(1); ROT();
    STEP8(pA0,pA1,pB0,pB1,t+1,true,true,true);   WAIT_BAR(1); ROT();
  }
  #define ENDW8(tt) do{ if((tt)+3<NT){WAIT_BAR(1);} else {WAIT_BAR(0);} }while(0)
  for(;t+1<NT;t+=2){
    STEP8(pB0,pB1,pA0,pA1,t,(t+3<NT),(t+1<NT),(t+1<NT));       ENDW8(t);   ROT();
    STEP8(pA0,pA1,pB0,pB1,t+1,(t+4<NT),(t+2<NT),(t+2<NT));     ENDW8(t+1); ROT();
  }
  STEP8(pB0,pB1,pA0,pA1,NT-1,false,false,false);
  { CV4(pw[0],pB0,0); CV4(pw[1],pB0,4); CV4(pw[2],pB0,8); CV4(pw[3],pB0,12); CV4(pw[4],pB1,0); CV4(pw[5],pB1,4); CV4(pw[6],pB1,8); CV4(pw[7],pB1,12);
    const lds_cptr vp_=vp0+sl_cur; vf[0]=ld256(vp_); vf[1]=ld256(vp_+512);
    o[0]=MF8(vf[0],pw,o[0],1); o[1]=MF8(vf[1],pw,o[1],1); lacc=MF8(ones,pw,lacc,1); }
  #undef PIN
  #undef EX
  #undef CV4
  #undef STEP8
  #undef ENDW8
  { const float rl=__builtin_amdgcn_rcpf(lacc[0]);
    typedef __attribute__((address_space(3))) char* lds_wptr;
    const lds_wptr stg=(lds_wptr)shm+F8_LDS_OST+wid*(32*F8_OSTP);
    #pragma unroll
    for(int m=0;m<2;++m)
      #pragma unroll
      for(int g=0;g<4;++g){ v2u_t w; w.x=cvtpk_s(o[m][4*g]*rl,o[m][4*g+1]*rl); w.y=cvtpk_s(o[m][4*g+2]*rl,o[m][4*g+3]*rl);
        *(__attribute__((address_space(3))) v2u_t*)(stg+r32*F8_OSTP+(32*m+8*g+4*hi)*2)=w; }
    asm volatile("s_waitcnt lgkmcnt(0)":::"memory");
    bf16*Ow=Ou+(long)(wid*QBLK)*OP;
    #pragma unroll
    for(int i=0;i<4;++i){const int row=i*8+(lane>>3),ch=lane&7; const u32x4 v=*(const __attribute__((address_space(3))) u32x4*)(stg+row*F8_OSTP+ch*16); *(u32x4*)(Ow+(long)row*OP+ch*8)=v;} }
  asm volatile("s_waitcnt lgkmcnt(0)\n\ts_barrier":::"memory");
  #undef DMA8
  #undef ROT
}
constexpr int F8P_NS=5, F8P_LDS_V=F8P_NS*F8_SLOTB, F8P_LDS_OST=2*F8P_NS*F8_SLOTB, F8P_LDS_BYTES=F8P_LDS_OST+NW*32*F8_OSTP;
__device__ __forceinline__ void attn_unit8p(const int tid,const float mref,const unsigned char*Qu,int QP,const unsigned char*__restrict__ Kh,const unsigned char*__restrict__ Vh,int NT,bf16*Ou,int OP,char*shm){
  const int lane=tid&63,r32=lane&31,hi=lane>>5; const int wid=__builtin_amdgcn_readfirstlane(tid>>6);
  const unsigned lds0=(unsigned)(uintptr_t)shm;
  const bool isK=wid<4;
  const unsigned char*dsrc=(isK?Kh:Vh)+(wid&3)*1024+lane*16;
  const unsigned ddst=lds0+(isK?0:F8P_LDS_V)+(wid&3)*1024;
  #define DMA8(tk,sk,tv,sv) glds16(dsrc+(long)(isK?(tk):(tv))*4096,(unsigned)__builtin_amdgcn_readfirstlane(ddst+(isK?(sk):(sv))))
  #define WR(x) (((x)>=F8P_NS*F8_SLOTB)?((x)-F8P_NS*F8_SLOTB):(x))
  const lds_cptr shm3=(lds_cptr)shm; const lds_cptr kp0=shm3+hi*2048+r32*16; const lds_cptr vp0=shm3+F8P_LDS_V+hi*2048+r32*16;
  DMA8(0,0,0,0); DMA8(1,F8_SLOTB,1,F8_SLOTB); DMA8(2,2*F8_SLOTB,2,2*F8_SLOTB); if(isK){DMA8(3,3*F8_SLOTB,0,0); DMA8(4,4*F8_SLOTB,0,0);}
  v8i qf; { const unsigned char*qp=Qu+(long)(wid*QBLK+r32)*QP+32*hi; const v4i a=*(const v4i*)qp, b=*(const v4i*)(qp+16); qf=__builtin_shufflevector(a,b,0,1,2,3,4,5,6,7); }
  f32x16 o[2],lacc,negm; { const float z=pg8::zero_v(); _Pragma("unroll") for(int r=0;r<16;++r){o[0][r]=z;o[1][r]=z;lacc[r]=z;negm[r]=z-mref+F8_SH;} } asm volatile("":"+v"(negm));
  v8i ones,pw; { int o1; asm volatile("v_mov_b32 %0, 0x38383838":"=v"(o1)); _Pragma("unroll") for(int j=0;j<8;++j){ones[j]=o1;pw[j]=o1;} } asm volatile("":"+v"(ones));
  f32x16 pA0,pA1,pB0,pB1; v8i kf[2],vf[2];
  WAIT_BAR(0);
  kf[0]=ld256(kp0); kf[1]=ld256(kp0+512);
  pA0=MF8(kf[0],qf,negm,0); pA1=MF8(kf[1],qf,negm,0);
  _Pragma("unroll") for(int r=0;r<16;++r){pA0[r]=__builtin_amdgcn_exp2f(pA0[r]);pA1[r]=__builtin_amdgcn_exp2f(pA1[r]);}
  kf[0]=ld256(kp0+F8_SLOTB); kf[1]=ld256(kp0+F8_SLOTB+512);
  WAIT_BAR(0);
  int sl=F8_SLOTB;
  #define PIN(x) asm volatile("":"+v"(x))
  #define EX(v) __builtin_amdgcn_exp2f(v)
  #define CV4(W,P,B) do{ W=__builtin_amdgcn_cvt_pk_bf8_f32(P[B],P[(B)+1],W,false); W=__builtin_amdgcn_cvt_pk_bf8_f32(P[(B)+2],P[(B)+3],W,true); }while(0)
  #define STEP8(C0,C1,P0,P1,t,GK,GV,GL) do{ SBAR(); \
    const int sl_p1=(sl==0)?(F8P_NS-1)*F8_SLOTB:sl-F8_SLOTB, sl_n1=WR(sl+F8_SLOTB), sl_n2=WR(sl+2*F8_SLOTB); \
    const lds_cptr vp_=vp0+sl_p1; \
    vf[0]=ld256(vp_); SBAR(); \
    C0=MF8(kf[0],qf,negm,0); CV4(pw[0],P0,0); CV4(pw[1],P0,4); CV4(pw[2],P0,8); CV4(pw[3],P0,12); PIN(pw); SBAR(); \
    vf[1]=ld256(vp_+512); SBAR(); \
    C1=MF8(kf[1],qf,negm,0); CV4(pw[4],P1,0); CV4(pw[5],P1,4); CV4(pw[6],P1,8); CV4(pw[7],P1,12); PIN(pw); SBAR(); \
    if(isK?(GK):(GV)){DMA8((t)+4,sl_p1,(t)+2,sl_n2);} \
    SBAR(); \
    o[0]=MF8(vf[0],pw,o[0],1); \
    C0[0]=EX(C0[0]);C0[1]=EX(C0[1]);C0[2]=EX(C0[2]);C0[3]=EX(C0[3]);C0[4]=EX(C0[4]);C0[5]=EX(C0[5]);C0[6]=EX(C0[6]);C0[7]=EX(C0[7]);C0[8]=EX(C0[8]);C0[9]=EX(C0[9]);C0[10]=EX(C0[10]); PIN(C0); SBAR(); \
    if(GL){ kf[0]=ld256(kp0+sl_n1); SBAR(); } \
    o[1]=MF8(vf[1],pw,o[1],1); \
    C0[11]=EX(C0[11]);C0[12]=EX(C0[12]);C0[13]=EX(C0[13]);C0[14]=EX(C0[14]);C0[15]=EX(C0[15]);C1[0]=EX(C1[0]);C1[1]=EX(C1[1]);C1[2]=EX(C1[2]);C1[3]=EX(C1[3]);C1[4]=EX(C1[4]);C1[5]=EX(C1[5]); PIN(C0); PIN(C1); SBAR(); \
    if(GL){ kf[1]=ld256(kp0+sl_n1+512); SBAR(); } \
    lacc=MF8(ones,pw,lacc,1); \
    C1[6]=EX(C1[6]);C1[7]=EX(C1[7]);C1[8]=EX(C1[8]);C1[9]=EX(C1[9]);C1[10]=EX(C1[10]);C1[11]=EX(C1[11]);C1[12]=EX(C1[12]);C1[13]=EX(C1[13]);C1[14]=EX(C1[14]);C1[15]=EX(C1[15]); PIN(C1); SBAR(); \
    sl=sl_n1; \
    }while(0)
  int t=1;
  for(;t+6<NT;t+=2){
    STEP8(pB0,pB1,pA0,pA1,t,true,true,true);
    STEP8(pA0,pA1,pB0,pB1,t+1,true,true,true);   WAIT_BAR(1);
  }
  for(;t+1<NT;t+=2){
    STEP8(pB0,pB1,pA0,pA1,t,(t+4<NT),(t+2<NT),true);
    STEP8(pA0,pA1,pB0,pB1,t+1,(t+5<NT),(t+3<NT),(t+2<NT));
    if(t+5<NT){WAIT_BAR(1);} else {WAIT_BAR(0);}
  }
  STEP8(pB0,pB1,pA0,pA1,NT-1,false,false,false);
  { CV4(pw[0],pB0,0); CV4(pw[1],pB0,4); CV4(pw[2],pB0,8); CV4(pw[3],pB0,12); CV4(pw[4],pB1,0); CV4(pw[5],pB1,4); CV4(pw[6],pB1,8); CV4(pw[7],pB1,12);
    const int sl_last=(sl==0)?(F8P_NS-1)*F8_SLOTB:sl-F8_SLOTB;
    const lds_cptr vp_=vp0+sl_last; vf[0]=ld256(vp_); vf[1]=ld256(vp_+512);
    o[0]=MF8(vf[0],pw,o[0],1); o[1]=MF8(vf[1],pw,o[1],1); lacc=MF8(ones,pw,lacc,1); }
  #undef PIN
  #undef EX
  #undef CV4
  #undef STEP8
  #undef WR
  { const float rl=__builtin_amdgcn_rcpf(lacc[0]);
    typedef __attribute__((address_space(3))) char* lds_wptr;
    const lds_wptr stg=(lds_wptr)shm+F8P_LDS_OST+wid*(32*F8_OSTP);
    #pragma unroll
    for(int m=0;m<2;++m)
      #pragma unroll
      for(int g=0;g<4;++g){ v2u_t w; w.x=cvtpk_s(o[m][4*g]*rl,o[m][4*g+1]*rl); w.y=cvtpk_s(o[m][4*g+2]*rl,o[m][4*g+3]*rl);
        *(__attribute__((address_space(3))) v2u_t*)(stg+r32*F8_OSTP+(32*m+8*g+4*hi)*2)=w; }
    asm volatile("s_waitcnt lgkmcnt(0)":::"memory");
    bf16*Ow=Ou+(long)(wid*QBLK)*OP;
    #pragma unroll
    for(int i=0;i<4;++i){const int row=i*8+(lane>>3),ch=lane&7; const u32x4 v=*(const __attribute__((address_space(3))) u32x4*)(stg+row*F8_OSTP+ch*16); *(u32x4*)(Ow+(long)row*OP+ch*8)=v;} }
  asm volatile("s_waitcnt lgkmcnt(0)\n\ts_barrier":::"memory");
  #undef DMA8
}
#undef MF8
#undef SBAR
#undef WAIT_BAR
}
#define GAS __attribute__((address_space(1)))
#define LAS __attribute__((address_space(3)))
typedef unsigned short bf16;
typedef unsigned v4u __attribute__((ext_vector_type(4)));
typedef float f32x4 __attribute__((ext_vector_type(4)));
typedef short bf16x8 __attribute__((ext_vector_type(8)));
typedef GAS unsigned gu32;
typedef GAS unsigned long long gu64;
#define RLX_AGENT __ATOMIC_RELAXED, __HIP_MEMORY_SCOPE_AGENT
#define LDS_WAIT() asm volatile("s_waitcnt lgkmcnt(0)" ::: "memory")
#define VM_WAIT() asm volatile("s_waitcnt vmcnt(0)" ::: "memory")
__device__ __forceinline__ unsigned long long rt() { return __builtin_amdgcn_s_memrealtime(); }
__device__ __forceinline__ unsigned f2bf(float f) { unsigned u = __builtin_bit_cast(unsigned, f); return (u + 0x7fffu + ((u >> 16) & 1u)) >> 16; }
__device__ __forceinline__ unsigned pk2(float lo, float hi) { return f2bf(lo) | (f2bf(hi) << 16); }

#define XB_TMO      128
#define XB_XCNT(j)  (256  + 64 * (j))
#define XB_XSUB(j)  (1280 + 64 * (j))
#define XB_XGEN(j)  (2304 + 64 * (j))
#define XB_TOP      3328
#define XB_TOPGEN   3392
#define XCD_BAR_WORDS 3456
#define XB_SPIN_CAP (1u << 18)

__device__ __forceinline__ unsigned xb_ld(unsigned* p)              { return __hip_atomic_load(p, __ATOMIC_RELAXED, __HIP_MEMORY_SCOPE_AGENT); }
__device__ __forceinline__ unsigned xb_add(unsigned* p, unsigned v) { return __hip_atomic_fetch_add(p, v, __ATOMIC_RELAXED, __HIP_MEMORY_SCOPE_AGENT); }
__device__ __forceinline__ unsigned xb_xcc_id() { return (unsigned)__builtin_amdgcn_s_getreg((3 << 11) | 20) & 0xFu; }
#define XB_SPIN(cond, bar) do { unsigned _sp = 0; while (cond) { __builtin_amdgcn_s_sleep(1); \
    if ((++_sp & 255u) == 0u) { if (xb_ld(&(bar)[XB_TMO])) break; if (_sp > XB_SPIN_CAP) { atomicAdd(&(bar)[XB_TMO], 1u); break; } } } } while (0)

struct XcdBarrier {
    unsigned* bar; unsigned x;
    volatile LAS unsigned* st;
};

__device__ __forceinline__ XcdBarrier xcd_barrier_post(unsigned* bar, volatile LAS unsigned* st) {
    XcdBarrier b; b.bar = bar; b.x = xb_xcc_id(); b.st = st;
    if (threadIdx.x == 0) (void)xb_add(&bar[XB_XCNT(b.x)], 1u);
    return b;
}
__device__ __forceinline__ void xcd_barrier_complete(unsigned* bar, unsigned x, unsigned& nloc, unsigned& nx) {
    const unsigned G = gridDim.x * gridDim.y * gridDim.z;
    unsigned sum, cnt, mine, sp = 0u;
    for (;;) {
        sum = 0u; cnt = 0u; mine = 0u;
#pragma unroll
        for (unsigned j = 0; j < 16; ++j) { const unsigned c = xb_ld(&bar[XB_XCNT(j)]); sum += c; cnt += (c > 0u) ? 1u : 0u; mine = (j == x) ? c : mine; }
        if (sum == G) break;
        __builtin_amdgcn_s_sleep(1);
        if ((++sp & 255u) == 0u) { if (xb_ld(&bar[XB_TMO])) break; if (sp > XB_SPIN_CAP) { atomicAdd(&bar[XB_TMO], 1u); break; } }
    }
    nloc = mine > 0u ? mine : 1u; nx = cnt > 0u ? cnt : 1u;
}

__device__ __forceinline__ void xcd_barrier(const XcdBarrier& b) {
    asm volatile("s_waitcnt vmcnt(0)" ::: "memory");
    __syncthreads();
    if (threadIdx.x == 0) {
        unsigned* bar = b.bar;
        __builtin_amdgcn_s_waitcnt(0);
        unsigned nloc = b.st[0], nx = b.st[1];
        if (nloc == 0u) { xcd_barrier_complete(bar, b.x, nloc, nx); b.st[0] = nloc; b.st[1] = nx; }
        const unsigned old = xb_add(&bar[XB_XSUB(b.x)], 1u);
        const unsigned gen = old / nloc;
        if (old + 1u == (gen + 1u) * nloc) {
            __builtin_amdgcn_fence(__ATOMIC_RELEASE, "agent");
            asm volatile("s_waitcnt vmcnt(0)" ::: "memory");
            const unsigned og = xb_add(&bar[XB_TOP], 1u);
            const unsigned tg = og / nx;
            if (og + 1u == (tg + 1u) * nx) xb_add(&bar[XB_TOPGEN], 1u);
            else XB_SPIN(xb_ld(&bar[XB_TOPGEN]) == tg, bar);
            __builtin_amdgcn_fence(__ATOMIC_ACQUIRE, "agent");
            xb_add(&bar[XB_XGEN(b.x)], 1u);
            asm volatile("s_waitcnt vmcnt(0)" ::: "memory");
        } else {
            XB_SPIN(xb_ld(&bar[XB_XGEN(b.x)]) == gen, bar);
            __builtin_amdgcn_fence(__ATOMIC_ACQUIRE, "agent");
            asm volatile("s_waitcnt vmcnt(0)" ::: "memory");
        }
    }
    __syncthreads();
}
constexpr int NWAVES = 8;
constexpr int DM = 1024, NB = 2, SEQ = 16384, CTX = 256, RB = SEQ + CTX  , NR = NB * RB  ;
constexpr int INW = 2048, FF = 2816, NE = 8, NCH = RB / 128  , NLAT = NB * SEQ;
constexpr float EPS = 1e-6f;
constexpr int PC_K = 512, PC_V = 640, PC_RQ = 768, PC_RK = 1024, PC_RV = 1280, PC_RG = 1536, PC_PP = 1792;
constexpr int MOE_TP = 104, MOE_PASSES = 3, LISTCAP = 32768;

constexpr size_t MiB = 1u << 20, U128K = 131072;
constexpr size_t WS_CTL = 0, CTL_ZERO_BYTES = 1 * MiB;
constexpr size_t WS_MODV = 1 * MiB;
constexpr size_t WS_ROPE = 1 * MiB + 256 * 1024;
constexpr size_t WS_DEC = WS_ROPE + 32768;
constexpr size_t WS_TOK = 3 * MiB / 2;
constexpr size_t WS_LIST = 5 * MiB / 2;
constexpr size_t WS_XC = 7 * MiB / 2;
constexpr size_t WS_WIN = 6 * MiB, WS_WOUT = 14 * MiB, WS_W13D = 18 * MiB, WS_W2D = 29 * MiB, WS_W13M = 35 * MiB, WS_W2M = 80 * MiB  , WS_XB = 103 * MiB  ;
constexpr size_t SZ_WIN = (size_t)INW * DM * 2, SZ_WOUT = (size_t)DM * DM * 2, SZ_W13 = (size_t)2 * FF * DM * 2, SZ_W2 = (size_t)DM * FF * 2;
constexpr size_t SZ8_W13 = SZ_W13 / 2, SZ8_W2 = SZ_W2 / 2;
constexpr size_t WS_AR = 168 * MiB;
constexpr size_t AR_P = 0, AR_QB = 1040 * U128K, AR_KC = 1300 * U128K, AR_VC = 1365 * U128K, AR_US = 1430 * U128K, AR_MIX = 1690 * U128K, AR_MX = 2210 * U128K;
constexpr size_t AR_HX2 = 0, AR_ACT = 520 * U128K, AR_YD = 2210 * U128K, AR_YM = 1664 * U128K;
constexpr size_t AR_PART0 = 1040 * U128K  , AR_PART1 = 0  ;
constexpr size_t AR_Q8 = AR_QB, AR_K8 = AR_QB + 136 * U128K, AR_V8 = AR_QB + 176 * U128K;
constexpr size_t DO_Q8 = AR_MX + 20 * MiB, DO_K8 = AR_MX + 40 * MiB, DO_V8 = AR_MX + 46 * MiB, DO_O8 = AR_US;
constexpr size_t WS_END = 512 * MiB;
static_assert(WS_XB + (size_t)NLAT * DM * 2 <= WS_AR && WS_W2M + 8 * SZ8_W2 <= WS_XB && WS_W13M + 8 * SZ8_W13 <= WS_W2M && WS_W13D + SZ_W13 <= WS_W2D && WS_W2D + SZ_W2 <= WS_W13M, "weights map");
static_assert(AR_MX + (size_t)NR * DM * 2 <= WS_END - WS_AR && AR_ACT + (size_t)NR * FF * 2 <= AR_YD && AR_YM + (size_t)264 * 256 * DM * 2 <= WS_END - WS_AR && AR_ACT + (size_t)MOE_TP * 256 * FF * 2 <= AR_YM, "arena map");
static_assert(AR_QB == (size_t)NR * INW * 2 && AR_KC == AR_QB + (size_t)NR * 512 * 2 && AR_US == AR_VC + (size_t)NR * 128 * 2 && AR_MIX == AR_US + (size_t)16 * NCH * 16384 && AR_MX == AR_MIX + (size_t)NR * DM * 2, "arena map 2");
constexpr int CW_TMO = 0, CW_CODE = 1, CW_CNT = 64  , CW_BAR = 4096;
constexpr int RING_BYTES = 131072, MISC_OFF = RING_BYTES + 320, GTAB_OFF = RING_BYTES + 1024, MOE_OFF = RING_BYTES + 2048, LDS_BYTES = 147456;

typedef unsigned v2u __attribute__((ext_vector_type(2)));
typedef float f32x16 __attribute__((ext_vector_type(16)));

struct Args { const float* in[24]; float* out; unsigned char* ws; int ph_lo, ph_hi, li, pad; };
enum { I_X = 0, I_C, I_CTX, I_CCTX, I_WMOD, I_BMOD, I_NPREMIX, I_NPOSTMIX, I_NPREFFN, I_NPOSTFFN, I_WIN, I_WOUT, I_QN, I_KN, I_DECAY, I_POOLW, I_POOLS, I_FW1, I_FW3, I_FW2, I_ROUTER, I_MW1, I_MW3, I_MW2 };

typedef const __attribute__((address_space(4))) Args* ArgP;
__device__ __forceinline__ ArgP args_here() { ArgP p = (ArgP)__builtin_amdgcn_kernarg_segment_ptr(); asm volatile("" : "+s"(p)); return p; }
struct Frame { LAS unsigned char* lds; int tid, lane, wave, G, gw, NGW, bx; };
__device__ __forceinline__ void relaunder(Frame& F) { int t = threadIdx.x; asm volatile("" : "+v"(t)); F.tid = t; F.lane = t & 63; F.wave = __builtin_amdgcn_readfirstlane(t >> 6);
    int g = gridDim.x; asm volatile("" : "+s"(g)); F.G = g; int bx = blockIdx.x; asm volatile("" : "+s"(bx)); F.bx = bx; F.gw = bx * NWAVES + F.wave; F.NGW = F.G * NWAVES; }

#ifndef ATT8_DEBUG
#define ATT8_DEBUG 0
#endif
#ifndef DENSE_F8
#define DENSE_F8 0
#endif
#ifndef MOE_F8
#define MOE_F8 1
#endif
#ifndef DENSE_I8UP
#define DENSE_I8UP 1
#endif
#ifndef MOE_I8UP
#define MOE_I8UP 1
#endif
#ifndef DENSE_DOWN_F8
#define DENSE_DOWN_F8 1
#endif
#ifndef IN_I8
#define IN_I8 3
#endif
constexpr float I8_XS = 20.0f, I8_XI = 20.0f, I8_WS = 1024.0f;
#ifndef IN1_F8
#define IN1_F8 0
#endif
__device__ __forceinline__ unsigned char* q8_ptr(ArgP a) { return ATT8_DEBUG ? a->ws + WS_AR + DO_Q8 : a->ws + WS_AR + AR_Q8; }
__device__ __forceinline__ unsigned char* k8_ptr(ArgP a) { return ATT8_DEBUG ? a->ws + WS_AR + DO_K8 : a->ws + WS_AR + AR_K8; }
__device__ __forceinline__ unsigned char* v8_ptr(ArgP a) { return ATT8_DEBUG ? a->ws + WS_AR + DO_V8 : a->ws + WS_AR + AR_V8; }
__device__ __forceinline__ unsigned fp8x4(float a, float b, float c, float d) { int w = 0; w = __builtin_amdgcn_cvt_pk_fp8_f32(a, b, w, false); w = __builtin_amdgcn_cvt_pk_fp8_f32(c, d, w, true); return (unsigned)w; }
__device__ __forceinline__ unsigned i8x4(float a, float b, float c, float d, float s) {
    unsigned w = 0;
    w = __builtin_amdgcn_cvt_pk_u8_f32(__builtin_amdgcn_fmed3f(__builtin_rintf(__builtin_fmaf(a, s, 128.0f)), 1.0f, 255.0f), 0, w);
    w = __builtin_amdgcn_cvt_pk_u8_f32(__builtin_amdgcn_fmed3f(__builtin_rintf(__builtin_fmaf(b, s, 128.0f)), 1.0f, 255.0f), 1, w);
    w = __builtin_amdgcn_cvt_pk_u8_f32(__builtin_amdgcn_fmed3f(__builtin_rintf(__builtin_fmaf(c, s, 128.0f)), 1.0f, 255.0f), 2, w);
    w = __builtin_amdgcn_cvt_pk_u8_f32(__builtin_amdgcn_fmed3f(__builtin_rintf(__builtin_fmaf(d, s, 128.0f)), 1.0f, 255.0f), 3, w);
    return w ^ 0x80808080u; }
__device__ __forceinline__ float bf_lo(unsigned u) { return __uint_as_float(u << 16); }
__device__ __forceinline__ float bf_hi(unsigned u) { return __uint_as_float(u & 0xffff0000u); }
__device__ __forceinline__ unsigned pkbf(float lo, float hi) { return attn_body::cvtpk_s(lo, hi); }
template <int M> __device__ __forceinline__ float shx(float v) { return __builtin_bit_cast(float, __builtin_amdgcn_ds_swizzle(__builtin_bit_cast(int, v), 0x1F | (M << 10))); }
__device__ __forceinline__ float half_sum(float v) { auto rr = __builtin_amdgcn_permlane32_swap(__float_as_uint(v), __float_as_uint(v), false, false); return __uint_as_float(rr[0]) + __uint_as_float(rr[1]); }
__device__ __forceinline__ float half_max(float v) { auto rr = __builtin_amdgcn_permlane32_swap(__float_as_uint(v), __float_as_uint(v), false, false); return fmaxf(__uint_as_float(rr[0]), __uint_as_float(rr[1])); }
__device__ __forceinline__ float wave_sum(float v) { v += shx<1>(v); v += shx<2>(v); v += shx<4>(v); v += shx<8>(v); v += shx<16>(v); return half_sum(v); }
__device__ __forceinline__ float siluf(float x) { return x / (1.0f + __expf(-x)); }
__device__ __forceinline__ float logsig(float x) { return -log1pf(expf(-x)); }
#define ROWCOL(j) (512 * ((j) >> 1) + 4 * ((j) & 1))
__device__ __forceinline__ void ld16(f32x4 (&v)[4], const float* p, int lane) {
#pragma unroll
    for (int j = 0; j < 4; ++j) v[j] = *(const f32x4*)(p + ROWCOL(j) + 8 * lane);
}
__device__ __forceinline__ void ld16b(f32x4 (&v)[4], const bf16* p, int lane) {
#pragma unroll
    for (int h = 0; h < 2; ++h) { const v4u u = *(const v4u*)(p + 512 * h + 8 * lane); v[2 * h] = (f32x4){bf_lo(u.x), bf_hi(u.x), bf_lo(u.y), bf_hi(u.y)}; v[2 * h + 1] = (f32x4){bf_lo(u.z), bf_hi(u.z), bf_lo(u.w), bf_hi(u.w)}; }
}
__device__ __forceinline__ void st16(float* p, const f32x4 (&v)[4], int lane) {
#pragma unroll
    for (int j = 0; j < 4; ++j) *(f32x4*)(p + ROWCOL(j) + 8 * lane) = v[j];
}
__device__ __forceinline__ void st16b(bf16* p, const f32x4 (&v)[4], int lane) {
#pragma unroll
    for (int h = 0; h < 2; ++h) { v4u u; u.x = pkbf(v[2 * h][0], v[2 * h][1]); u.y = pkbf(v[2 * h][2], v[2 * h][3]); u.z = pkbf(v[2 * h + 1][0], v[2 * h + 1][1]); u.w = pkbf(v[2 * h + 1][2], v[2 * h + 1][3]); *(v4u*)(p + 512 * h + 8 * lane) = u; }
}
__device__ __forceinline__ void st16f8(unsigned char* p, const f32x4 (&v)[4], int lane) {
#pragma unroll
    for (int h = 0; h < 2; ++h) { v2u u; u.x = fp8x4(v[2 * h][0], v[2 * h][1], v[2 * h][2], v[2 * h][3]); u.y = fp8x4(v[2 * h + 1][0], v[2 * h + 1][1], v[2 * h + 1][2], v[2 * h + 1][3]); *(v2u*)(p + 512 * h + 8 * lane) = u; }
}
__device__ __forceinline__ void st16i8(unsigned char* p, const f32x4 (&v)[4], int lane, const float I8_XS = ::I8_XS) {
#pragma unroll
    for (int h = 0; h < 2; ++h) { v2u u; u.x = i8x4(v[2 * h][0], v[2 * h][1], v[2 * h][2], v[2 * h][3], I8_XS); u.y = i8x4(v[2 * h + 1][0], v[2 * h + 1][1], v[2 * h + 1][2], v[2 * h + 1][3], I8_XS); *(v2u*)(p + 512 * h + 8 * lane) = u; }
}
constexpr size_t WS_RSIN = 256 * 1024, WS_RSFF = 512 * 1024;
__device__ __forceinline__ float absmax16(const f32x4 (&v)[4]) {
    float m = 0.f;
#pragma unroll
    for (int j = 0; j < 4; ++j) m = fmaxf(fmaxf(m, fmaxf(fabsf(v[j][0]), fabsf(v[j][1]))), fmaxf(fabsf(v[j][2]), fabsf(v[j][3])));
    return m;
}
__device__ __forceinline__ void wave_max2(float& a, float& b) {
    a = fmaxf(a, shx<1>(a)); b = fmaxf(b, shx<1>(b)); a = fmaxf(a, shx<2>(a)); b = fmaxf(b, shx<2>(b)); a = fmaxf(a, shx<4>(a)); b = fmaxf(b, shx<4>(b));
    a = fmaxf(a, shx<8>(a)); b = fmaxf(b, shx<8>(b)); a = fmaxf(a, shx<16>(a)); b = fmaxf(b, shx<16>(b)); a = half_max(a); b = half_max(b);
}
__device__ __forceinline__ void st16i8_rows(unsigned char* pa, unsigned char* pb, const f32x4 (&va)[4], const f32x4 (&vb)[4], float* rsa, float* rsb, int lane) {
    float ma = absmax16(va), mb = absmax16(vb); wave_max2(ma, mb); ma = fmaxf(ma, 1e-20f); mb = fmaxf(mb, 1e-20f);
    st16i8(pa, va, lane, 127.0f / ma); st16i8(pb, vb, lane, 127.0f / mb);
    if (lane == 0) { *rsa = ma * (1.0f / 127.0f); *rsb = mb * (1.0f / 127.0f); }
}
__device__ __forceinline__ float sumsq16(const f32x4 (&v)[4]) {
    float s = 0.f;
#pragma unroll
    for (int j = 0; j < 4; ++j) s += (v[j][0] * v[j][0] + v[j][1] * v[j][1]) + (v[j][2] * v[j][2] + v[j][3] * v[j][3]);
    return s;
}
__device__ __forceinline__ const float* modv(const unsigned char* ws, int l, int cls, int chunk) { return (const float*)(ws + WS_MODV) + ((size_t)(l * 3 + cls) * 6 + chunk) * DM; }

template <int F8 = 0  > __device__ __forceinline__ void p0_transpose_item(const float* W, int K, int N, bf16* WT, int k0, int n0, int drow0, LAS float* scr, int lane) {
    { const int c4 = (lane & 7) * 4, r8 = lane >> 3;
#pragma unroll
        for (int i = 0; i < 8; ++i) { const int kk = 8 * i + r8; const f32x4 v = *(const f32x4*)(W + (size_t)(k0 + kk) * N + n0 + c4);
            LAS float* d = scr + kk * 33 + c4; d[0] = v[0]; d[1] = v[1]; d[2] = v[2]; d[3] = v[3]; } }
    LDS_WAIT(); asm volatile("" ::: "memory");
    const int c = lane & 7;
#pragma unroll
    for (int j = 0; j < 4; ++j) { const int n = (lane >> 3) + 8 * j; const LAS float* s = scr + (8 * c) * 33 + n;
        if constexpr (F8 == 2) { v2u o; o.x = i8x4(s[0 * 33], s[1 * 33], s[2 * 33], s[3 * 33], I8_WS); o.y = i8x4(s[4 * 33], s[5 * 33], s[6 * 33], s[7 * 33], I8_WS);
            *(v2u*)((unsigned char*)WT + (size_t)(drow0 + n) * K + k0 + 8 * c) = o; }
        else if constexpr (F8 == 1) { v2u o; o.x = fp8x4(s[0 * 33] * 64.0f, s[1 * 33] * 64.0f, s[2 * 33] * 64.0f, s[3 * 33] * 64.0f); o.y = fp8x4(s[4 * 33] * 64.0f, s[5 * 33] * 64.0f, s[6 * 33] * 64.0f, s[7 * 33] * 64.0f);
            *(v2u*)((unsigned char*)WT + (size_t)(drow0 + n) * K + k0 + 8 * c) = o; }
        else { v4u o; o.x = pkbf(s[0 * 33], s[1 * 33]); o.y = pkbf(s[2 * 33], s[3 * 33]); o.z = pkbf(s[4 * 33], s[5 * 33]); o.w = pkbf(s[6 * 33], s[7 * 33]);
        *(v4u*)(WT + (size_t)(drow0 + n) * K + k0 + 8 * c) = o; } }
    LDS_WAIT(); asm volatile("" ::: "memory");
}
constexpr int WC_IN = 16 * 64, WC_OUT = 16 * 32, WC_F = 1408, WCOPY_ITEMS = 2 * WC_IN + 2 * WC_OUT + 27 * WC_F;
constexpr int WCOPY_SPLIT1 = WCOPY_ITEMS - 21120, WCOPY_SPLIT2 = WCOPY_ITEMS - 12800;
struct WItem { const float* src; unsigned char* dst; int N, K, mode; };
__device__ __forceinline__ WItem wc_decode(ArgP a, int it) {
    WItem w; int r = it;
    if (r < 2 * WC_IN) { const int l = r / WC_IN, q = r % WC_IN, kb = q / 64, nb = q % 64;
        w.mode = ((IN_I8 >> l) & 1) ? 2 : ((IN1_F8 && l == 1) ? 1 : 0); w.N = INW; w.K = DM; w.src = a->in[I_WIN] + (size_t)l * DM * INW + (size_t)(64 * kb) * INW + 32 * nb;
        w.dst = a->ws + WS_WIN + l * SZ_WIN + ((size_t)(32 * nb) * DM + 64 * kb) * (w.mode ? 1 : 2); return w; }
    r -= 2 * WC_IN;
    if (r < 2 * WC_OUT) { const int l = r / WC_OUT, q = r % WC_OUT, kb = q / 32, nb = q % 32;
        w.mode = 0; w.N = DM; w.K = DM; w.src = a->in[I_WOUT] + (size_t)l * DM * DM + (size_t)(64 * kb) * DM + 32 * nb; w.dst = a->ws + WS_WOUT + l * SZ_WOUT + ((size_t)(32 * nb) * DM + 64 * kb) * 2; return w; }
    r -= 2 * WC_OUT;
    const int mat = r / WC_F, q = r % WC_F;
    int which, e; bool moe;
    if (mat < 3) { which = mat; e = 0; moe = false; } else { which = (mat - 3) % 3; e = (mat - 3) / 3; moe = true; }
    if (which < 2) {
        const float* W = (moe ? a->in[which == 0 ? I_MW1 : I_MW3] + (size_t)e * DM * FF : a->in[which == 0 ? I_FW1 : I_FW3]);
        unsigned char* WT = a->ws + (moe ? WS_W13M + e * (MOE_F8 ? SZ8_W13 : SZ_W13) : WS_W13D);
        const int kb = q / 88, nb = q % 88, n0 = 32 * nb; const int drow0 = (n0 >> 7) * 256 + which * 128 + (n0 & 127);
        w.mode = moe ? ((MOE_F8 && !MOE_I8UP) ? 1 : (MOE_I8UP ? 2 : 0)) : (DENSE_F8 ? 1 : (DENSE_I8UP ? 2 : 0));
        w.N = FF; w.K = DM; w.src = W + (size_t)(64 * kb) * FF + n0; w.dst = WT + ((size_t)drow0 * DM + 64 * kb) * (w.mode ? 1 : 2);
    } else {
        const float* W = (moe ? a->in[I_MW2] + (size_t)e * FF * DM : a->in[I_FW2]);
        unsigned char* WT = a->ws + (moe ? WS_W2M + e * (MOE_F8 ? SZ8_W2 : SZ_W2) : WS_W2D);
        const int kb = q / 32, nb = q % 32;
        w.mode = moe ? (MOE_F8 ? 1 : 0) : ((DENSE_F8 || DENSE_DOWN_F8) ? 1 : 0);
        w.N = DM; w.K = FF; w.src = W + (size_t)(64 * kb) * DM + 32 * nb; w.dst = WT + ((size_t)(32 * nb) * FF + 64 * kb) * (w.mode ? 1 : 2);
    }
    return w;
}
__device__ __forceinline__ void wc_load(const WItem& w, f32x4 (&v)[8], int lane) {
    const int c4 = (lane & 7) * 4, r8 = lane >> 3;
#pragma unroll
    for (int i = 0; i < 8; ++i) v[i] = *(const f32x4*)(w.src + (size_t)(8 * i + r8) * w.N + c4);
}
__device__ __forceinline__ void wc_process(const WItem& w, const f32x4 (&v)[8], LAS float* scr, int lane) {
    { const int c4 = (lane & 7) * 4, r8 = lane >> 3;
#pragma unroll
        for (int i = 0; i < 8; ++i) { LAS float* d = scr + (8 * i + r8) * 33 + c4; d[0] = v[i][0]; d[1] = v[i][1]; d[2] = v[i][2]; d[3] = v[i][3]; } }
    LDS_WAIT(); asm volatile("" ::: "memory");
    const int c = lane & 7;
#pragma unroll
    for (int j = 0; j < 4; ++j) { const int n = (lane >> 3) + 8 * j; const LAS float* s = scr + (8 * c) * 33 + n;
        const float s0 = s[0 * 33], s1 = s[1 * 33], s2 = s[2 * 33], s3 = s[3 * 33], s4 = s[4 * 33], s5 = s[5 * 33], s6 = s[6 * 33], s7 = s[7 * 33];
        if (w.mode == 2) { v2u o; o.x = i8x4(s0, s1, s2, s3, I8_WS); o.y = i8x4(s4, s5, s6, s7, I8_WS); *(v2u*)(w.dst + (size_t)n * w.K + 8 * c) = o; }
        else if (w.mode == 1) { v2u o; o.x = fp8x4(s0 * 64.0f, s1 * 64.0f, s2 * 64.0f, s3 * 64.0f); o.y = fp8x4(s4 * 64.0f, s5 * 64.0f, s6 * 64.0f, s7 * 64.0f); *(v2u*)(w.dst + (size_t)n * w.K + 8 * c) = o; }
        else { v4u o; o.x = pkbf(s0, s1); o.y = pkbf(s2, s3); o.z = pkbf(s4, s5); o.w = pkbf(s6, s7); *(v4u*)(w.dst + ((size_t)n * w.K + 8 * c) * 2) = o; } }
    LDS_WAIT(); asm volatile("" ::: "memory");
}
__device__ __forceinline__ void weight_copy_items(ArgP a, Frame& F, const int lo_, const int hi_, const int rk, const int nrk) {
    LAS float* scr = (LAS float*)(F.lds + F.wave * 16384);
    int it = lo_ + rk; if (it >= hi_) return;
    WItem cur = wc_decode(a, it); f32x4 vc[8]; wc_load(cur, vc, F.lane);
    for (;;) {
        const int itn = it + nrk; const bool more = itn < hi_;
        const WItem nx = wc_decode(a, more ? itn : it); f32x4 vn[8]; wc_load(nx, vn, F.lane);
        wc_process(cur, vc, scr, F.lane);
        if (!more) break;
        cur = nx; it = itn;
#pragma unroll
        for (int i = 0; i < 8; ++i) vc[i] = vn[i];
    }
}
__device__ __forceinline__ void phase_p0a(ArgP a, Frame& F) {
    LAS float* sv = (LAS float*)F.lds;
    LAS float* red = (LAS float*)(F.lds + 12288);
    for (int i = F.tid; i < 3072; i += 512) { const int v = i >> 10, k = i & 1023; const float x = (v < 2) ? a->in[I_C][v * 1024 + k] : a->in[I_CCTX][k]; sv[i] = siluf(x); }
    __syncthreads();
    for (int it = F.bx; it < 256; it += F.G) {
        const int l = it >> 7, cg = it & 127; const int r5 = F.lane / 12, c12 = F.lane % 12; const bool act = F.lane < 60;
        f32x4 acc[3]; acc[0] = acc[1] = acc[2] = (f32x4){0.f, 0.f, 0.f, 0.f};
        const float* Wl = a->in[I_WMOD] + (size_t)l * DM * 6144 + 48 * cg + 4 * c12;
#pragma unroll
        for (int hb = 0; hb < 2; ++hb) { f32x4 w4[13];
#pragma unroll
            for (int j = 0; j < 13; ++j) { const int kk = r5 + 5 * (13 * hb + j); const int kc = (act && kk < 128) ? 128 * F.wave + kk : 128 * F.wave; w4[j] = *(const f32x4*)(Wl + (size_t)kc * 6144); }
#pragma unroll
            for (int j = 0; j < 13; ++j) { const int kk = r5 + 5 * (13 * hb + j); const int k = 128 * F.wave + kk;
                if (act && kk < 128) { acc[0] += sv[k] * w4[j]; acc[1] += sv[1024 + k] * w4[j]; acc[2] += sv[2048 + k] * w4[j]; } } }
        if (act) {
#pragma unroll
            for (int v = 0; v < 3; ++v)
#pragma unroll
                for (int e = 0; e < 4; ++e) red[(F.wave * 60 + F.lane) * 12 + v * 4 + e] = acc[v][e]; }
        __syncthreads();
        if (F.tid < 144) { const int v = F.tid / 48, col = F.tid % 48, c12b = col >> 2, e = col & 3; float s = 0.f;
            for (int w = 0; w < 8; ++w)
                for (int r = 0; r < 5; ++r) s += red[(w * 60 + r * 12 + c12b) * 12 + v * 4 + e];
            ((float*)(a->ws + WS_MODV))[((size_t)(l * 3 + v)) * 6144 + 48 * cg + col] = s + a->in[I_BMOD][l * 6144 + 48 * cg + col]; }
        __syncthreads();
    }
    if (F.bx == F.G - 1 && F.tid >= 64 && F.tid < 80) { const int t = F.tid - 64; const float lg = logsig(a->in[I_DECAY][t]); ((float*)(a->ws + WS_DEC))[t] = lg; ((float*)(a->ws + WS_DEC))[16 + t] = expf(128.0f * lg); }
    if (F.tid < 16)
        for (int i = F.bx * 16 + F.tid; i < 4096; i += F.G * 16) { const int pos = i >> 4, fi = i & 15; const double inv = pow(10000.0, -(double)fi / 16.0); const double ang = (double)pos * inv;
            ((float*)(a->ws + WS_ROPE))[i] = (float)cos(ang); ((float*)(a->ws + WS_ROPE))[4096 + i] = (float)sin(ang); }
    weight_copy_items(a, F, 0, WCOPY_ITEMS, F.gw, F.NGW);
}

struct RowLoc { int b, jj, cls; size_t xoff; bool isctx; };
__device__ __forceinline__ RowLoc rowloc(int r) { RowLoc L; L.b = r / RB; L.jj = r - L.b * RB; L.isctx = L.jj < CTX; L.cls = L.isctx ? 2 : L.b;
    L.xoff = L.isctx ? (size_t)(L.b * CTX + L.jj) * DM : (size_t)(L.b * SEQ + (L.jj - CTX)) * DM; return L; }

__device__ __forceinline__ void wave_sum2(float& a, float& b) {
    for (int o = 0; o < 1; ++o) { float ta, tb; ta = shx<1>(a); tb = shx<1>(b); a += ta; b += tb; ta = shx<2>(a); tb = shx<2>(b); a += ta; b += tb; ta = shx<4>(a); tb = shx<4>(b); a += ta; b += tb;
        ta = shx<8>(a); tb = shx<8>(b); a += ta; b += tb; ta = shx<16>(a); tb = shx<16>(b); a += ta; b += tb; a = half_sum(a); b = half_sum(b); }
}
__device__ __forceinline__ void premix_rows(ArgP a, Frame& F, const int r0  , const int stride, const int nrows  , const bool isctx) {
    bf16* HX = (bf16*)(a->ws + WS_AR + AR_MIX);
    const float* xsrc = isctx ? a->in[I_CTX] : a->in[I_X];
    f32x4 A[4], B[4], t0[4]; int curcls = -1;
    f32x4 v0[4], v1[4], n0[4], n1[4]; ld16(v0, xsrc + (size_t)r0 * DM, F.lane); ld16(v1, xsrc + (size_t)(r0 + stride) * DM, F.lane);
#pragma unroll 1
    for (int rr = 0; rr < nrows; rr += 2) {
        const int ra = r0 + rr * stride, rb = ra + stride;
        if (rr + 2 < nrows) { ld16(n0, xsrc + (size_t)(ra + 2 * stride) * DM, F.lane); ld16(n1, xsrc + (size_t)(rb + 2 * stride) * DM, F.lane); }
        const int ba = isctx ? ra / CTX : ra / SEQ, bb = isctx ? rb / CTX : rb / SEQ; const int cls = isctx ? 2 : ba;
        if (cls != curcls) { curcls = cls; ld16(A, a->in[I_NPREMIX], F.lane); ld16(t0, modv(a->ws, 0, cls, 1), F.lane); ld16(B, modv(a->ws, 0, cls, 0), F.lane);
#pragma unroll
            for (int j = 0; j < 4; ++j) A[j] = A[j] * (1.0f + t0[j]); }
        const int ua = isctx ? ba * RB + (ra - ba * CTX) : ra + CTX * (ba + 1), ub = isctx ? bb * RB + (rb - bb * CTX) : rb + CTX * (bb + 1);
        float q0 = sumsq16(v0), q1 = sumsq16(v1); wave_sum2(q0, q1);
        const float r0s = 1.0f / sqrtf(q0 * (1.0f / DM) + EPS), r1s = 1.0f / sqrtf(q1 * (1.0f / DM) + EPS);
#pragma unroll
        for (int j = 0; j < 4; ++j) { v0[j] = v0[j] * r0s * A[j] + B[j]; v1[j] = v1[j] * r1s * A[j] + B[j]; }
        if (IN_I8 & 1) { float* rs = (float*)(a->ws + WS_RSIN); st16i8_rows((unsigned char*)HX + (size_t)ua * DM, (unsigned char*)HX + (size_t)ub * DM, v0, v1, rs + ua, rs + ub, F.lane); }
        else { st16b(HX + (size_t)ua * DM, v0, F.lane); st16b(HX + (size_t)ub * DM, v1, F.lane); }
#pragma unroll
        for (int j = 0; j < 4; ++j) { v0[j] = n0[j]; v1[j] = n1[j]; }
    }
}
__device__ __forceinline__ void phase_premix0(ArgP a, Frame& F) {
    const int per = NLAT / F.NGW;
    if (F.gw < NLAT) premix_rows(a, F, F.gw, F.NGW, per, false);
    for (int j = F.gw; j < 8 * NB * CTX / 2; j += F.NGW) if ((j & 7) == 0) premix_rows(a, F, (j >> 3) * 2, 1, 2, true);
}

__device__ __forceinline__ void moe_prefix(const unsigned char* ws, int (&tstart)[9], int (&cnt)[8]) {
    const unsigned* cw = (const unsigned*)(ws + WS_CTL) + CW_CNT; int s = 0;
#pragma unroll
    for (int e = 0; e < 8; ++e) { cnt[e] = (int)__builtin_amdgcn_readfirstlane(cw[64 * e]); tstart[e] = s; s += (cnt[e] + 255) >> 8; }
    tstart[8] = s;
}

template <int MODE> __device__ __forceinline__ void resid_rows(ArgP a, Frame& F, const int r0, const int stride, const int nrows, const bool isctx,
                                                               const int (&tstart)[9], int& myE0, int& myE1, float& myW0, float& myW1) {
    constexpr int l = MODE >> 1; constexpr bool post_ffn = MODE & 1;
    const bf16* SRC = (const bf16*)(a->ws + WS_AR + (MODE == 1 ? AR_YD : (MODE == 3 ? AR_YM : AR_MX)));
    bf16* H = (bf16*)(a->ws + WS_AR + (MODE == 1 ? AR_MIX : AR_HX2));
    const float* gpost = a->in[post_ffn ? I_NPOSTFFN : I_NPOSTMIX] + l * DM;
    const float* gnext = (MODE == 1) ? a->in[I_NPREMIX] + DM : a->in[I_NPREFFN] + l * DM;
    constexpr int gate_chunk = post_ffn ? 5 : 2, sc_chunk = (MODE == 1) ? 1 : 4, sh_chunk = (MODE == 1) ? 0 : 3, lnext = (MODE == 1) ? 1 : l;
    const LAS float* rts = (const LAS float*)F.lds;
    float* XC = (float*)(a->ws + WS_XC);
    const float* xin = isctx ? (MODE == 0 ? a->in[I_CTX] : (const float*)XC) : a->in[I_X];
    float* xout = isctx ? XC : a->out;
    bf16* XB = (bf16*)(a->ws + WS_XB);
    f32x4 G1[4], A2[4], B2[4], t0[4]; int curcls = -1;
#define UROW(r_) (isctx ? ((r_) / CTX) * RB + ((r_) % CTX) : (r_) + CTX * ((r_) / SEQ + 1))
    v4u tiv = (v4u){0u, 0u, 0u, 0u}; float tw0 = 0.f, tw1 = 0.f;
    if constexpr (MODE == 3) { if (F.lane < nrows) { const unsigned char* tp = a->ws + WS_TOK + (size_t)(r0 + F.lane * stride) * 32; tiv = *(const v4u*)tp; tw0 = *(const float*)(tp + 16); tw1 = *(const float*)(tp + 20); } }
    f32x4 s0[4], x0[4], s1[4], x1[4], sn0[4], xn0[4], sn1[4], xn1[4], y1[4];
#define RESID_LOAD(S_, X_, rr_) do { \
        if constexpr (MODE == 3) { const int e0 = __builtin_amdgcn_readlane((int)tiv.x, rr_), p0l = __builtin_amdgcn_readlane((int)tiv.y, rr_), e1 = __builtin_amdgcn_readlane((int)tiv.z, rr_), p1l = __builtin_amdgcn_readlane((int)tiv.w, rr_); \
            const float w0 = __builtin_bit_cast(float, __builtin_amdgcn_readlane(__builtin_bit_cast(int, tw0), rr_)), w1 = __builtin_bit_cast(float, __builtin_amdgcn_readlane(__builtin_bit_cast(int, tw1), rr_)); \
            int ts0 = 0, ts1 = 0; _Pragma("unroll") for (int e = 0; e < 8; ++e) { ts0 = (e0 == e) ? tstart[e] : ts0; ts1 = (e1 == e) ? tstart[e] : ts1; } \
            ld16b(S_, SRC + ((size_t)ts0 * 256 + p0l) * DM, F.lane); ld16b(y1, SRC + ((size_t)ts1 * 256 + p1l) * DM, F.lane); \
            _Pragma("unroll") for (int j = 0; j < 4; ++j) S_[j] = w0 * S_[j] + w1 * y1[j]; } \
        else if (isctx && (MODE == 0 || (MODE == 1 && !DENSE_DOWN_F8))) { const int cr_ = r0 + (rr_) * stride; const float* pp_ = (const float*)(a->ws + WS_AR + (MODE == 0 ? AR_PART0 : AR_PART1)) + (size_t)((cr_ >> 8) * 256 + (cr_ & 255)) * DM; \
            ld16(S_, pp_, F.lane); for (int ks_ = 1; ks_ < (MODE == 0 ? 4 : 11); ++ks_) { ld16(y1, pp_ + (size_t)ks_ * 512 * DM, F.lane); _Pragma("unroll") for (int j = 0; j < 4; ++j) S_[j] += y1[j]; } } \
        else ld16b(S_, SRC + (size_t)UROW(r0 + (rr_) * stride) * DM, F.lane); \
        if (!isctx && MODE != 0) ld16b(X_, XB + (size_t)(r0 + (rr_) * stride) * DM, F.lane); else ld16(X_, xin + (size_t)(r0 + (rr_) * stride) * DM, F.lane); } while (0)
    RESID_LOAD(s0, x0, 0); RESID_LOAD(s1, x1, 1);
#pragma unroll 1
    for (int rr = 0; rr < nrows; rr += 2) {
        if (rr + 2 < nrows) { RESID_LOAD(sn0, xn0, rr + 2); RESID_LOAD(sn1, xn1, rr + 3); }
        const int ra = r0 + rr * stride, rb = ra + stride; const int cls = isctx ? 2 : ra / SEQ;
        if (cls != curcls) { curcls = cls; ld16(G1, gpost, F.lane); ld16(t0, modv(a->ws, l, cls, gate_chunk), F.lane);
#pragma unroll
            for (int j = 0; j < 4; ++j) G1[j] = G1[j] * t0[j];
            if constexpr (MODE != 3) { ld16(A2, gnext, F.lane); ld16(t0, modv(a->ws, lnext, cls, sc_chunk), F.lane); ld16(B2, modv(a->ws, lnext, cls, sh_chunk), F.lane);
#pragma unroll
                for (int j = 0; j < 4; ++j) A2[j] = A2[j] * (1.0f + t0[j]); } }
        float q0 = sumsq16(s0), q1 = sumsq16(s1); wave_sum2(q0, q1);
        const float rs0 = 1.0f / sqrtf(q0 * (1.0f / DM) + EPS), rs1 = 1.0f / sqrtf(q1 * (1.0f / DM) + EPS);
#pragma unroll
        for (int j = 0; j < 4; ++j) { x0[j] = x0[j] + G1[j] * (s0[j] * rs0); x1[j] = x1[j] + G1[j] * (s1[j] * rs1); }
        if (!isctx && MODE != 3) { st16b(XB + (size_t)ra * DM, x0, F.lane); st16b(XB + (size_t)rb * DM, x1, F.lane); } else { st16(xout + (size_t)ra * DM, x0, F.lane); st16(xout + (size_t)rb * DM, x1, F.lane); }
        if constexpr (MODE != 3) {
            float u0 = sumsq16(x0), u1 = sumsq16(x1); wave_sum2(u0, u1);
            const float t0r = 1.0f / sqrtf(u0 * (1.0f / DM) + EPS), t1r = 1.0f / sqrtf(u1 * (1.0f / DM) + EPS);
#pragma unroll
            for (int j = 0; j < 4; ++j) { x0[j] = x0[j] * t0r * A2[j] + B2[j]; x1[j] = x1[j] * t1r * A2[j] + B2[j]; }
            if constexpr (MODE == 1 && (IN_I8 & 2)) { float* rs = (float*)(a->ws + WS_RSIN); st16i8_rows((unsigned char*)H + (size_t)UROW(ra) * DM, (unsigned char*)H + (size_t)UROW(rb) * DM, x0, x1, rs + UROW(ra), rs + UROW(rb), F.lane); }
            else if constexpr (MODE == 2 && MOE_F8 && MOE_I8UP) { st16i8((unsigned char*)H + (size_t)ra * DM, x0, F.lane); st16i8((unsigned char*)H + (size_t)rb * DM, x1, F.lane); }
            else if constexpr (MODE == 0 && DENSE_I8UP && !DENSE_F8) { float* rs = (float*)(a->ws + WS_RSFF); st16i8_rows((unsigned char*)H + (size_t)UROW(ra) * DM, (unsigned char*)H + (size_t)UROW(rb) * DM, x0, x1, rs + UROW(ra), rs + UROW(rb), F.lane); }
            else if constexpr ((MODE == 1 && !IN1_F8) || (MODE == 0 && !DENSE_F8) || (MODE == 2 && !MOE_F8)) { st16b(H + (size_t)(MODE == 2 ? ra : UROW(ra)) * DM, x0, F.lane); st16b(H + (size_t)(MODE == 2 ? rb : UROW(rb)) * DM, x1, F.lane); }
            else { st16f8((unsigned char*)H + (size_t)(MODE == 2 ? ra : UROW(ra)) * DM, x0, F.lane); st16f8((unsigned char*)H + (size_t)(MODE == 2 ? rb : UROW(rb)) * DM, x1, F.lane); }
            if constexpr (MODE == 2) {
                asm volatile("" ::: "memory");
                float lgA[8], lgB[8];
#pragma unroll
                for (int e = 0; e < 8; ++e) { float pA = 0.f, pB = 0.f;
#pragma unroll
                    for (int j = 0; j < 4; ++j) { const f32x4 rv = *(const LAS f32x4*)(rts + e * 1024 + ROWCOL(j) + 8 * F.lane);
                        pA += (x0[j][0] * rv[0] + x0[j][1] * rv[1]) + (x0[j][2] * rv[2] + x0[j][3] * rv[3]); pB += (x1[j][0] * rv[0] + x1[j][1] * rv[1]) + (x1[j][2] * rv[2] + x1[j][3] * rv[3]); }
                    wave_sum2(pA, pB); lgA[e] = pA; lgB[e] = pB; }
#define TOP2(lg, rrow) do { int i0 = 0; float v0 = lg[0]; _Pragma("unroll") for (int e = 1; e < 8; ++e) if (lg[e] > v0) { v0 = lg[e]; i0 = e; } \
                    int i1 = -1; float v1 = -INFINITY; _Pragma("unroll") for (int e = 0; e < 8; ++e) if (e != i0 && lg[e] > v1) { v1 = lg[e]; i1 = e; } \
                    const float w0 = 1.0f / (1.0f + __expf(v1 - v0)); if (F.lane == (rrow)) { myE0 = i0; myE1 = i1; myW0 = w0; myW1 = 1.0f - w0; } } while (0)
                TOP2(lgA, rr); TOP2(lgB, rr + 1);
#undef TOP2
            }
        }
#pragma unroll
        for (int j = 0; j < 4; ++j) { s0[j] = sn0[j]; x0[j] = xn0[j]; s1[j] = sn1[j]; x1[j] = xn1[j]; }
    }
#undef RESID_LOAD
#undef UROW
}
template <int MODE> __device__ __forceinline__ void phase_resid(ArgP a, Frame& F) {
    float* XC = (float*)(a->ws + WS_XC);
    int tstart[9], ecnt[8];
    if constexpr (MODE == 3) moe_prefix(a->ws, tstart, ecnt); else {
#pragma unroll
        for (int e = 0; e < 9; ++e) tstart[e] = 0; }
    int myE0 = -1, myE1 = -1; float myW0 = 0.f, myW1 = 0.f;
    if constexpr (MODE < 2) {
        if (F.gw < NLAT) resid_rows<MODE>(a, F, F.gw, F.NGW, NLAT / F.NGW, false, tstart, myE0, myE1, myW0, myW1);
        for (int j = F.gw; j < 8 * NB * CTX / 2; j += F.NGW) if ((j & 7) == 0) resid_rows<MODE>(a, F, (j >> 3) * 2, 1, 2, true, tstart, myE0, myE1, myW0, myW1);
    } else {
        LAS float* rts = (LAS float*)F.lds;
        LAS int* wcnt = (LAS int*)(F.lds + 32768);
        LAS int* bbase = (LAS int*)(F.lds + 32768 + 256);
        if constexpr (MODE == 2) { for (int i = F.tid; i < 8192; i += 512) { const int k = i >> 3, e = i & 7; rts[e * 1024 + k] = a->in[I_ROUTER][i]; } __syncthreads(); }
        const int per = NLAT / F.NGW;
        for (int rd = 0; rd < 1; ++rd) {
            const bool active = F.gw < NLAT;
            myE0 = -1; myE1 = -1;
            if (active) resid_rows<MODE>(a, F, F.gw, F.NGW, per, false, tstart, myE0, myE1, myW0, myW1);
            if constexpr (MODE == 2) {
                int tid2 = F.tid; asm volatile("" : "+v"(tid2)); const int lane2 = tid2 & 63;
                if (lane2 < 8) wcnt[F.wave * 8 + lane2] = 0;
                LDS_WAIT();
                int r0 = 0, r1 = 0;
                if (active && lane2 < per) { r0 = __hip_atomic_fetch_add(wcnt + F.wave * 8 + myE0, 1, __ATOMIC_RELAXED, __HIP_MEMORY_SCOPE_WORKGROUP); r1 = __hip_atomic_fetch_add(wcnt + F.wave * 8 + myE1, 1, __ATOMIC_RELAXED, __HIP_MEMORY_SCOPE_WORKGROUP); }
                __syncthreads();
                if (tid2 < 8) { int tot = 0; for (int w = 0; w < 8; ++w) tot += wcnt[w * 8 + tid2];
                    int base = 0; if (tot > 0) base = (int)__hip_atomic_fetch_add((unsigned*)(a->ws + WS_CTL) + CW_CNT + 64 * tid2, (unsigned)tot, RLX_AGENT);
                    bbase[tid2] = base; }
                __syncthreads();
                if (active && lane2 < per) {
                    int wb0 = bbase[myE0], wb1 = bbase[myE1];
                    for (int w = 0; w < F.wave; ++w) { wb0 += wcnt[w * 8 + myE0]; wb1 += wcnt[w * 8 + myE1]; }
                    const int lp0 = wb0 + r0, lp1 = wb1 + r1;
                    const int tk = F.gw + lane2 * F.NGW; int* lists = (int*)(a->ws + WS_LIST);
                    lists[myE0 * LISTCAP + lp0] = tk; lists[myE1 * LISTCAP + lp1] = tk;
                    v4u ti; ti.x = (unsigned)myE0; ti.y = (unsigned)lp0; ti.z = (unsigned)myE1; ti.w = (unsigned)lp1;
                    *(v4u*)(a->ws + WS_TOK + (size_t)tk * 32) = ti; *(float*)(a->ws + WS_TOK + (size_t)tk * 32 + 16) = myW0; *(float*)(a->ws + WS_TOK + (size_t)tk * 32 + 20) = myW1;
                }
                __syncthreads();
            }
        }
    }
}
typedef float f32x16v __attribute__((ext_vector_type(16)));
__device__ __forceinline__ int crow32(int r, int hi) { return (r & 3) + 8 * (r >> 2) + 4 * hi; }
__device__ __forceinline__ int chain_id(int b, int h, int dir) { return (b * 4 + h) * 2 + dir; }

__device__ __forceinline__ void phase_prep(ArgP a, Frame& F, int l) {
    const bf16* P = (const bf16*)(a->ws + WS_AR + AR_P);
    bf16* QB = (bf16*)(a->ws + WS_AR + AR_QB); bf16* KC = (bf16*)(a->ws + WS_AR + AR_KC); bf16* VC = (bf16*)(a->ws + WS_AR + AR_VC);
    unsigned char* Q8 = q8_ptr(a); unsigned char* K8 = k8_ptr(a); unsigned char* V8 = v8_ptr(a);
    const float* ropec = (const float*)(a->ws + WS_ROPE); const float* ropes = ropec + 4096;
    {
        const int rr = F.lane >> 3, c = F.lane & 7;
        float gq[8], gk[8];
#pragma unroll
        for (int j = 0; j < 8; ++j) { gq[j] = a->in[I_QN][l * 64 + 8 * c + j]; gk[j] = a->in[I_KN][l * 64 + 8 * c + j]; }
        for (int it = F.gw; it < NR / 8; it += F.NGW) {
            const int row = it * 8 + rr; const int b = row / RB, jj = row - b * RB; const bool lat = jj >= CTX; const int t = jj - CTX;
            float cs[8], sn[8];
            if (lat) { const int pos = (c < 4) ? (t >> 6) : (t & 63); const int fi = 8 * (c & 1);
#pragma unroll
                for (int j = 0; j < 8; ++j) { cs[j] = ropec[pos * 16 + fi + j]; sn[j] = ropes[pos * 16 + fi + j]; } }
            else {
#pragma unroll
                for (int j = 0; j < 8; ++j) { cs[j] = 1.f; sn[j] = 0.f; } }
            const float sgn = (c & 2) ? 1.f : -1.f;
            const bf16* prow = P + (size_t)row * INW;
#pragma unroll 2
            for (int hs = 0; hs < 10; ++hs) {
                const v4u u = *(const v4u*)(prow + hs * 64 + 8 * c);
                float x[8] = {bf_lo(u.x), bf_hi(u.x), bf_lo(u.y), bf_hi(u.y), bf_lo(u.z), bf_hi(u.z), bf_lo(u.w), bf_hi(u.w)};
                float ss = 0.f;
#pragma unroll
                for (int j = 0; j < 8; ++j) ss += x[j] * x[j];
                ss += shx<1>(ss); ss += shx<2>(ss); ss += shx<4>(ss);
                const float rstd = 1.0f / sqrtf(ss * (1.0f / 64.0f) + EPS);
                float y[8];
#pragma unroll
                for (int j = 0; j < 8; ++j) { y[j] = x[j] * rstd * (hs < 8 ? gq[j] : gk[j]); }
#pragma unroll
                for (int j = 0; j < 8; ++j) { const float p = shx<2>(y[j]); x[j] = y[j] * cs[j] + sgn * p * sn[j]; }
                const float sc = (hs < 8) ? attn_body::C2 : 1.0f;
#if ATT8_DEBUG
                { v4u o; o.x = pkbf(x[0] * sc, x[1] * sc); o.y = pkbf(x[2] * sc, x[3] * sc); o.z = pkbf(x[4] * sc, x[5] * sc); o.w = pkbf(x[6] * sc, x[7] * sc);
                if (hs < 8) *(v4u*)(QB + (size_t)row * 512 + hs * 64 + 8 * c) = o;
                else *(v4u*)(KC + ((size_t)(b * 2 + (hs - 8)) * RB + jj) * 64 + 8 * c) = o; }
#endif
                { v2u o8; o8.x = fp8x4(x[0] * sc, x[1] * sc, x[2] * sc, x[3] * sc); o8.y = fp8x4(x[4] * sc, x[5] * sc, x[6] * sc, x[7] * sc);
                if (hs < 8) *(v2u*)(Q8 + (size_t)row * 512 + hs * 64 + 8 * c) = o8;
                else *(v2u*)(K8 + ((size_t)((b * 2 + (hs - 8)) * (RB / 64) + (jj >> 6))) * 4096 + (c >> 1) * 1024 + (jj & 63) * 16 + 8 * (c & 1)) = o8; }
            }
#if ATT8_DEBUG
#pragma unroll
            for (int kv = 0; kv < 2; ++kv) *(v4u*)(VC + ((size_t)(b * 2 + kv) * RB + jj) * 64 + 8 * c) = *(const v4u*)(prow + PC_V + kv * 64 + 8 * c);
#endif
        }
    }
    for (int it = F.gw; it < NR / 32; it += F.NGW) {
        const int b = it / (RB / 32), g = it - b * (RB / 32), tile = g >> 1, c2 = g & 1, kv = F.lane >> 5, kg = (F.lane >> 4) & 1, d4 = F.lane & 15;
        const bf16* src = P + (size_t)(b * RB + 32 * g + 4 * kg) * INW + PC_V + kv * 64 + 4 * d4;
        v2u u[16];
#pragma unroll
        for (int j = 0; j < 16; ++j) u[j] = *(const v2u*)(src + (size_t)((j & 3) + 8 * (j >> 2)) * INW);
        unsigned char* dst = V8 + ((size_t)((b * 2 + kv) * (RB / 64) + tile)) * 4096 + ((kg * 2 + c2) * 64 + 4 * d4) * 16;
        v4u o0, o1, o2, o3;
        o0.x = fp8x4(bf_lo(u[0].x), bf_lo(u[1].x), bf_lo(u[2].x), bf_lo(u[3].x)); o0.y = fp8x4(bf_lo(u[4].x), bf_lo(u[5].x), bf_lo(u[6].x), bf_lo(u[7].x)); o0.z = fp8x4(bf_lo(u[8].x), bf_lo(u[9].x), bf_lo(u[10].x), bf_lo(u[11].x)); o0.w = fp8x4(bf_lo(u[12].x), bf_lo(u[13].x), bf_lo(u[14].x), bf_lo(u[15].x));
        o1.x = fp8x4(bf_hi(u[0].x), bf_hi(u[1].x), bf_hi(u[2].x), bf_hi(u[3].x)); o1.y = fp8x4(bf_hi(u[4].x), bf_hi(u[5].x), bf_hi(u[6].x), bf_hi(u[7].x)); o1.z = fp8x4(bf_hi(u[8].x), bf_hi(u[9].x), bf_hi(u[10].x), bf_hi(u[11].x)); o1.w = fp8x4(bf_hi(u[12].x), bf_hi(u[13].x), bf_hi(u[14].x), bf_hi(u[15].x));
        o2.x = fp8x4(bf_lo(u[0].y), bf_lo(u[1].y), bf_lo(u[2].y), bf_lo(u[3].y)); o2.y = fp8x4(bf_lo(u[4].y), bf_lo(u[5].y), bf_lo(u[6].y), bf_lo(u[7].y)); o2.z = fp8x4(bf_lo(u[8].y), bf_lo(u[9].y), bf_lo(u[10].y), bf_lo(u[11].y)); o2.w = fp8x4(bf_lo(u[12].y), bf_lo(u[13].y), bf_lo(u[14].y), bf_lo(u[15].y));
        o3.x = fp8x4(bf_hi(u[0].y), bf_hi(u[1].y), bf_hi(u[2].y), bf_hi(u[3].y)); o3.y = fp8x4(bf_hi(u[4].y), bf_hi(u[5].y), bf_hi(u[6].y), bf_hi(u[7].y)); o3.z = fp8x4(bf_hi(u[8].y), bf_hi(u[9].y), bf_hi(u[10].y), bf_hi(u[11].y)); o3.w = fp8x4(bf_hi(u[12].y), bf_hi(u[13].y), bf_hi(u[14].y), bf_hi(u[15].y));
        *(v4u*)(dst) = o0; *(v4u*)(dst + 16) = o1; *(v4u*)(dst + 32) = o2; *(v4u*)(dst + 48) = o3;
    }
    __syncthreads();
    typedef short bf16x8_t __attribute__((ext_vector_type(8)));
    LAS unsigned char* VT = F.lds; LAS unsigned char* KTf = F.lds + 17536; LAS unsigned char* KTb = F.lds + 2 * 17536;
    float* US = (float*)(a->ws + WS_AR + AR_US);
    for (int it = F.bx; it < NB * 4 * NCH; it += F.G) {
        const int c = it % NCH, bh = it / NCH, b = bh >> 2, h = bh & 3;
        const float lgf = ((const float*)(a->ws + WS_DEC))[l * 8 + h], lgb = ((const float*)(a->ws + WS_DEC))[l * 8 + 4 + h];
        { const int p = F.tid >> 2, sg = F.tid & 3; const bf16* prow = P + (size_t)(b * RB + c * 128 + p) * INW;
            const float zf = __expf(lgf * (float)(127 - p)) * 0.125f, zb = __expf(lgb * (float)p) * 0.125f;
#pragma unroll
            for (int q = 0; q < 2; ++q) { const v4u uk = *(const v4u*)(prow + PC_RK + h * 64 + sg * 16 + q * 8), uv = *(const v4u*)(prow + PC_RV + h * 64 + sg * 16 + q * 8);
                const unsigned kw[4] = {uk.x, uk.y, uk.z, uk.w}, vw[4] = {uv.x, uv.y, uv.z, uv.w};
#pragma unroll
                for (int i = 0; i < 8; ++i) { const int ch = sg * 16 + q * 8 + i; const int off = ch * 272 + sg * 32 + 2 * p;
                    const unsigned kwv = kw[i >> 1], vwv = vw[i >> 1]; const float kf = (i & 1) ? bf_hi(kwv) : bf_lo(kwv);
                    *(LAS bf16*)(VT + off) = (bf16)((i & 1) ? (vwv >> 16) : (vwv & 0xffffu));
                    *(LAS bf16*)(KTf + off) = (bf16)(pkbf(kf * zf, 0.f) & 0xffffu); *(LAS bf16*)(KTb + off) = (bf16)(pkbf(kf * zb, 0.f) & 0xffffu); } } }
        __syncthreads();
        { const int dir = F.wave >> 2, di = (F.wave >> 1) & 1, ei = F.wave & 1, r32 = F.lane & 31, hh = F.lane >> 5;
            f32x16v acc; { const float z = pg8::zero_v(); _Pragma("unroll") for (int r = 0; r < 16; ++r) acc[r] = z; }
            const int erow = 32 * ei + r32, drow = 32 * di + r32;
            const LAS unsigned char* ap = VT + erow * 272 + (erow >> 4) * 32 + 16 * hh; const LAS unsigned char* bp = (dir ? KTb : KTf) + drow * 272 + (drow >> 4) * 32 + 16 * hh;
#pragma unroll
            for (int s8 = 0; s8 < 8; ++s8) { const bf16x8_t av = *(const LAS bf16x8_t*)(ap + 32 * s8), bv = *(const LAS bf16x8_t*)(bp + 32 * s8);
                acc = __builtin_amdgcn_mfma_f32_32x32x16_bf16(av, bv, acc, 0, 0, 0); }
            float* dst = US + ((size_t)(chain_id(b, h, dir) * NCH + c)) * 4096;
#pragma unroll
            for (int r = 0; r < 16; ++r) dst[(32 * ei + crow32(r, hh)) * 64 + 32 * di + r32] = acc[r]; }
        __syncthreads();
    }
}

__device__ __forceinline__ void phase_scan(ArgP a, Frame& F, int l) {
    float* US = (float*)(a->ws + WS_AR + AR_US);
    if (F.tid < 256) {
        for (int id = F.bx * 256 + F.tid; id < 16 * 4096; id += F.G * 256) {
            const int chain = id >> 12, e = id & 4095, dir = chain & 1, h = (chain >> 1) & 3;
            const float dec = ((const float*)(a->ws + WS_DEC))[16 + l * 8 + dir * 4 + h];
            float* base = US + (size_t)chain * NCH * 4096 + e; float st = 0.f;
            bf16* sb = (bf16*)(a->ws + WS_AR + AR_MX) + (size_t)chain * NCH * 4096 + e;
            for (int s0 = 0; s0 < NCH; s0 += 10) { float u[10]; int ci[10];
#pragma unroll
                for (int q = 0; q < 10; ++q) { const int s = s0 + q; ci[q] = dir == 0 ? s : (s < 2 ? 1 - s : NCH + 1 - s); u[q] = base[(size_t)ci[q] * 4096]; }
#pragma unroll
                for (int q = 0; q < 10; ++q) { base[(size_t)ci[q] * 4096] = st; sb[(size_t)ci[q] * 4096] = (bf16)(pkbf(st, 0.f) & 0xffffu); st = dec * st + u[q]; } }
        }
    }
}

__device__ __forceinline__ void ret_out_item(ArgP a, Frame& F, int l, int b, int c, int hp, int buf) {
    typedef short bf16x8_t __attribute__((ext_vector_type(8)));
    const bf16* P = (const bf16*)(a->ws + WS_AR + AR_P); bf16* MIX = (bf16*)(a->ws + WS_AR + AR_MIX);
    LAS bf16* VT = (LAS bf16*)(F.lds + buf * 34816);
    const int hl = F.wave >> 2, head = 2 * hp + hl, pi = F.wave & 3, r32 = F.lane & 31, hh = F.lane >> 5;
    const int row0 = b * RB + c * 128;
    { const int m = F.tid >> 2, qd = F.tid & 3; const bf16* src = P + (size_t)(row0 + m) * INW + PC_RV + (2 * hp) * 64 + 32 * qd;
        LAS bf16* dst = VT + (size_t)((qd >> 1) * 64 + 32 * (qd & 1)) * 132 + m;
#pragma unroll
        for (int q = 0; q < 4; ++q) { const v4u u = *(const v4u*)(src + 8 * q);
            dst[(8 * q + 0) * 132] = (bf16)(u.x & 0xffffu); dst[(8 * q + 1) * 132] = (bf16)(u.x >> 16); dst[(8 * q + 2) * 132] = (bf16)(u.y & 0xffffu); dst[(8 * q + 3) * 132] = (bf16)(u.y >> 16);
            dst[(8 * q + 4) * 132] = (bf16)(u.z & 0xffffu); dst[(8 * q + 5) * 132] = (bf16)(u.z >> 16); dst[(8 * q + 6) * 132] = (bf16)(u.w & 0xffffu); dst[(8 * q + 7) * 132] = (bf16)(u.w >> 16); } }
    bf16x8_t qf[4], kf[4][4];
    { const bf16* qrow = P + (size_t)(row0 + 32 * pi + r32) * INW + PC_RQ + head * 64 + 8 * hh;
#pragma unroll
        for (int d0 = 0; d0 < 4; ++d0) qf[d0] = *(const bf16x8_t*)(qrow + 16 * d0);
#pragma unroll
        for (int mb = 0; mb < 4; ++mb) { const bf16* krow = P + (size_t)(row0 + 32 * mb + r32) * INW + PC_RK + head * 64 + 8 * hh;
#pragma unroll
            for (int d0 = 0; d0 < 4; ++d0) kf[mb][d0] = *(const bf16x8_t*)(krow + 16 * d0); } }
    const float L2E = 1.4426950408889634f;
    const float lgf2 = ((const float*)(a->ws + WS_DEC))[l * 8 + head] * L2E, lgb2 = ((const float*)(a->ws + WS_DEC))[l * 8 + 4 + head] * L2E;
    int p = 32 * pi + r32; asm volatile("" : "+v"(p));
    bf16x8_t pk[8];
#pragma unroll
    for (int mb = 0; mb < 4; ++mb) {
        f32x16v st; { const float z = pg8::zero_v(); _Pragma("unroll") for (int r = 0; r < 16; ++r) st[r] = z; }
#pragma unroll
        for (int d0 = 0; d0 < 4; ++d0) st = __builtin_amdgcn_mfma_f32_32x32x16_bf16(kf[mb][d0], qf[d0], st, 0, 0, 0);
#pragma unroll
        for (int r = 0; r < 16; ++r) { const float fd = (float)(p - (32 * mb + crow32(r, hh)));
            const float arg = lgf2 * fmaxf(fd, 0.f) + lgb2 * fmaxf(-fd, 0.f) + fmaxf(1.0f - fabsf(fd), 0.f) - 3.0f;
            st[r] = st[r] * __builtin_amdgcn_exp2f(arg); }
        v4u w0, w1; w0.x = pkbf(st[0], st[1]); w0.y = pkbf(st[2], st[3]); w0.z = pkbf(st[4], st[5]); w0.w = pkbf(st[6], st[7]);
        w1.x = pkbf(st[8], st[9]); w1.y = pkbf(st[10], st[11]); w1.z = pkbf(st[12], st[13]); w1.w = pkbf(st[14], st[15]);
        pk[2 * mb] = __builtin_bit_cast(bf16x8_t, w0); pk[2 * mb + 1] = __builtin_bit_cast(bf16x8_t, w1);
    }
    __builtin_amdgcn_sched_barrier(0);
    const float ef = __builtin_amdgcn_exp2f(lgf2 * (float)(p + 1)), ebk = __builtin_amdgcn_exp2f(lgb2 * (float)(128 - p));
    f32x16v ot[2];
    { const float z = pg8::zero_v(); _Pragma("unroll") for (int r = 0; r < 16; ++r) { ot[0][r] = z; ot[1][r] = z; } }
    { const bf16* SB = (const bf16*)(a->ws + WS_AR + AR_MX);
      const bf16* Sf = SB + ((size_t)(chain_id(b, head, 0) * NCH + c)) * 4096; const bf16* Sb = SB + ((size_t)(chain_id(b, head, 1) * NCH + c)) * 4096;
#pragma unroll
        for (int s4 = 0; s4 < 4; ++s4) {
            const v4u qu = __builtin_bit_cast(v4u, qf[s4]); v4u qa, qb;
            qa.x = pkbf(bf_lo(qu.x) * ef, bf_hi(qu.x) * ef); qa.y = pkbf(bf_lo(qu.y) * ef, bf_hi(qu.y) * ef); qa.z = pkbf(bf_lo(qu.z) * ef, bf_hi(qu.z) * ef); qa.w = pkbf(bf_lo(qu.w) * ef, bf_hi(qu.w) * ef);
            qb.x = pkbf(bf_lo(qu.x) * ebk, bf_hi(qu.x) * ebk); qb.y = pkbf(bf_lo(qu.y) * ebk, bf_hi(qu.y) * ebk); qb.z = pkbf(bf_lo(qu.z) * ebk, bf_hi(qu.z) * ebk); qb.w = pkbf(bf_lo(qu.w) * ebk, bf_hi(qu.w) * ebk);
#pragma unroll
            for (int eb = 0; eb < 2; ++eb) { const int off = (32 * eb + r32) * 64 + 16 * s4 + 8 * hh;
                const bf16x8_t wf = *(const bf16x8_t*)(Sf + off), wb = *(const bf16x8_t*)(Sb + off);
                ot[eb] = __builtin_amdgcn_mfma_f32_32x32x16_bf16(wf, __builtin_bit_cast(bf16x8_t, qa), ot[eb], 0, 0, 0);
                ot[eb] = __builtin_amdgcn_mfma_f32_32x32x16_bf16(wb, __builtin_bit_cast(bf16x8_t, qb), ot[eb], 0, 0, 0); } } }
    __builtin_amdgcn_sched_barrier(0);
    __syncthreads();
    { const LAS bf16* vrow = VT + (size_t)(hl * 64 + r32) * 132 + 4 * hh;
#pragma unroll
        for (int eb = 0; eb < 2; ++eb)
#pragma unroll
            for (int sg = 0; sg < 8; ++sg) { const LAS bf16* vp = vrow + (size_t)(32 * eb) * 132 + 16 * sg;
                const v2u lo = *(const LAS v2u*)vp, hi = *(const LAS v2u*)(vp + 8);
                const v4u av = (v4u){lo.x, lo.y, hi.x, hi.y};
                ot[eb] = __builtin_amdgcn_mfma_f32_32x32x16_bf16(__builtin_bit_cast(bf16x8_t, av), pk[sg], ot[eb], 0, 0, 0); } }
    __builtin_amdgcn_sched_barrier(0);
    float s1 = 0.f, s2 = 0.f;
#pragma unroll
    for (int eb = 0; eb < 2; ++eb)
#pragma unroll
        for (int r = 0; r < 16; ++r) { const float v = ot[eb][r]; s1 += v; s2 += v * v; }
    { auto rr = __builtin_amdgcn_permlane32_swap(__float_as_uint(s1), __float_as_uint(s1), false, false); s1 = __uint_as_float(rr[0]) + __uint_as_float(rr[1]); }
    { auto rr = __builtin_amdgcn_permlane32_swap(__float_as_uint(s2), __float_as_uint(s2), false, false); s2 = __uint_as_float(rr[0]) + __uint_as_float(rr[1]); }
    const float mu = s1 * (1.0f / 64.0f); const float var = fmaxf(s2 * (1.0f / 64.0f) - mu * mu, 0.f); const float rstd = 1.0f / sqrtf(var + EPS);
    const size_t orow = (size_t)(row0 + p);
#pragma unroll
    for (int eb = 0; eb < 2; ++eb)
#pragma unroll
        for (int g = 0; g < 4; ++g) { const int e0 = 32 * eb + 8 * g + 4 * hh;
            const v2u gu = *(const v2u*)(P + orow * INW + PC_RG + head * 64 + e0);
            const float g0 = bf_lo(gu.x), g1 = bf_hi(gu.x), g2 = bf_lo(gu.y), g3 = bf_hi(gu.y);
            v2u w; w.x = pkbf(siluf(g0) * ((ot[eb][4 * g] - mu) * rstd), siluf(g1) * ((ot[eb][4 * g + 1] - mu) * rstd)); w.y = pkbf(siluf(g2) * ((ot[eb][4 * g + 2] - mu) * rstd), siluf(g3) * ((ot[eb][4 * g + 3] - mu) * rstd));
            *(v2u*)(MIX + orow * DM + 512 + head * 64 + e0) = w; }
}
__device__ __forceinline__ void pool_item(ArgP a, Frame& F, int l, int b, int tl, int g) {
    typedef short bf16x8_t __attribute__((ext_vector_type(8)));
    const bf16* P = (const bf16*)(a->ws + WS_AR + AR_P); bf16* MIX = (bf16*)(a->ws + WS_AR + AR_MIX);
    LAS bf16* msb = (LAS bf16*)F.lds;
    LAS bf16* wt = (LAS bf16*)(F.lds + 18432);
    LAS bf16* ost = (LAS bf16*)(F.lds + 18432 + 9216);
    const int sb = (tl < 2) ? 0 : CTX, T = (tl < 2) ? CTX : SEQ, hw = 1 << g  ;
    { const int d = F.tid & 63, cq = F.tid >> 6; const float* W = a->in[I_POOLW] + ((size_t)(l * 4 + g)) * 4096 + d;
        v4u o; o.x = pkbf(W[(8 * cq + 0) * 64], W[(8 * cq + 1) * 64]); o.y = pkbf(W[(8 * cq + 2) * 64], W[(8 * cq + 3) * 64]); o.z = pkbf(W[(8 * cq + 4) * 64], W[(8 * cq + 5) * 64]); o.w = pkbf(W[(8 * cq + 6) * 64], W[(8 * cq + 7) * 64]);
        *(LAS v4u*)(wt + d * 72 + 8 * cq) = o; }
    { const int p = F.tid >> 2, qd = F.tid & 3; const int t = tl * 128 - sb + p; const int lo = max(t - hw, 0), hi = min(t + hw, T);
        float acc[16];
#pragma unroll
        for (int e = 0; e < 16; ++e) acc[e] = 0.f;
        const bf16* colp = P + (size_t)(b * RB + sb) * INW + PC_PP + g * 64 + 16 * qd;
        for (int tt = lo; tt < hi; ++tt) { const v4u u0 = *(const v4u*)(colp + (size_t)tt * INW), u1 = *(const v4u*)(colp + (size_t)tt * INW + 8);
            acc[0] += bf_lo(u0.x); acc[1] += bf_hi(u0.x); acc[2] += bf_lo(u0.y); acc[3] += bf_hi(u0.y); acc[4] += bf_lo(u0.z); acc[5] += bf_hi(u0.z); acc[6] += bf_lo(u0.w); acc[7] += bf_hi(u0.w);
            acc[8] += bf_lo(u1.x); acc[9] += bf_hi(u1.x); acc[10] += bf_lo(u1.y); acc[11] += bf_hi(u1.y); acc[12] += bf_lo(u1.z); acc[13] += bf_hi(u1.z); acc[14] += bf_lo(u1.w); acc[15] += bf_hi(u1.w); }
        const v4u s0 = *(const v4u*)(colp + (size_t)t * INW), s1 = *(const v4u*)(colp + (size_t)t * INW + 8);
        const float sf[16] = {bf_lo(s0.x), bf_hi(s0.x), bf_lo(s0.y), bf_hi(s0.y), bf_lo(s0.z), bf_hi(s0.z), bf_lo(s0.w), bf_hi(s0.w), bf_lo(s1.x), bf_hi(s1.x), bf_lo(s1.y), bf_hi(s1.y), bf_lo(s1.z), bf_hi(s1.z), bf_lo(s1.w), bf_hi(s1.w)};
        const float inv = 1.0f / (float)(hi - lo);
        float m[16];
#pragma unroll
        for (int e = 0; e < 16; ++e) m[e] = acc[e] * inv - sf[e];
        v4u o0, o1; o0.x = pkbf(m[0], m[1]); o0.y = pkbf(m[2], m[3]); o0.z = pkbf(m[4], m[5]); o0.w = pkbf(m[6], m[7]); o1.x = pkbf(m[8], m[9]); o1.y = pkbf(m[10], m[11]); o1.z = pkbf(m[12], m[13]); o1.w = pkbf(m[14], m[15]);
        *(LAS v4u*)(msb + p * 72 + 16 * qd) = o0; *(LAS v4u*)(msb + p * 72 + 16 * qd + 8) = o1; }
    __syncthreads();
    { const int pi = F.wave >> 1, di = F.wave & 1, i = F.lane & 31, kk = F.lane >> 5; f32x16v o; { const float z = pg8::zero_v(); _Pragma("unroll") for (int r = 0; r < 16; ++r) o[r] = z; }
        const LAS bf16* ap = msb + (32 * pi + i) * 72 + 8 * kk; const LAS bf16* bp = wt + (32 * di + i) * 72 + 8 * kk;
#pragma unroll
        for (int s4 = 0; s4 < 4; ++s4) o = __builtin_amdgcn_mfma_f32_32x32x16_bf16(*(const LAS bf16x8_t*)(ap + 16 * s4), *(const LAS bf16x8_t*)(bp + 16 * s4), o, 0, 0, 0);
        const float scl = a->in[I_POOLS][l * 256 + g * 64 + 32 * di + i];
#pragma unroll
        for (int r = 0; r < 16; ++r) ost[(32 * pi + crow32(r, kk)) * 72 + 32 * di + i] = (bf16)(pkbf(o[r] * scl, 0.f) & 0xffffu); }
    __syncthreads();
    { bf16* obase = MIX + (size_t)(b * RB + tl * 128) * DM + 768 + g * 64;
#pragma unroll
        for (int k = 0; k < 2; ++k) { const int idx = F.tid + 512 * k, row = idx >> 3, ch = idx & 7; *(v4u*)(obase + (size_t)row * DM + 8 * ch) = *(const LAS v4u*)(ost + row * 72 + 8 * ch); } }
    __syncthreads();
}
__device__ __forceinline__ void phase_mix(ArgP a, Frame& F, int l, int vcu) {
    { int nb = 0;
      for (int it = F.bx; it < NB * NCH * 2; it += F.G) { const int hp = it & 1, r = it >> 1, c = r % NCH, b = r / NCH;
          if (l == 1 && c < 2) continue;
          ret_out_item(a, F, l, b, c, hp, nb & 1); ++nb; }
      __syncthreads(); }
    for (int it = (F.bx + F.G - 16) % F.G; it < NB * 4 * NCH; it += F.G) { const int c = it % NCH, bh = it / NCH, b = bh >> 2, hg = bh & 3;
        if (l == 1 && c < 2) continue;
        pool_item(a, F, l, b, c, hg); }
    const bf16* QBp = (const bf16*)(a->ws + WS_AR + AR_QB); const bf16* KC = (const bf16*)(a->ws + WS_AR + AR_KC); const bf16* VC = (const bf16*)(a->ws + WS_AR + AR_VC); bf16* MIX = (bf16*)(a->ws + WS_AR + AR_MIX);
    const unsigned char* Q8 = q8_ptr(a); const unsigned char* K8 = k8_ptr(a); const unsigned char* V8 = v8_ptr(a);
    const int NU = NB * 8 * (SEQ / 256);
    float mref;
    { float gq = fabsf(a->in[I_QN][l * 64 + F.lane]), gk = fabsf(a->in[I_KN][l * 64 + F.lane]);
#pragma unroll
      for (int o = 0; o < 1; ++o) { gq = fmaxf(gq, shx<1>(gq)); gk = fmaxf(gk, shx<1>(gk)); gq = fmaxf(gq, shx<2>(gq)); gk = fmaxf(gk, shx<2>(gk)); gq = fmaxf(gq, shx<4>(gq)); gk = fmaxf(gk, shx<4>(gk));
          gq = fmaxf(gq, shx<8>(gq)); gk = fmaxf(gk, shx<8>(gk)); gq = fmaxf(gq, shx<16>(gq)); gk = fmaxf(gk, shx<16>(gk)); gq = half_max(gq); gk = half_max(gk); }
      mref = fminf(64.0f * gq * gk * attn_body::C2 * 1.01f + 0.125f, 64.0f); mref = __builtin_amdgcn_readfirstlane(mref); }
    for (int i = 0; ; ++i) {
        int u;
        if (F.G == 256) { if (i >= 4) break; const int x = vcu >> 5, cu = vcu & 31; const int grp = x >> 1; u = grp * 256 + (x & 1) * 128 + cu * 4 + i; }
        else { u = F.bx + i * F.G; if (u >= NU) break; }
        const int grp = u >> 8, w = u & 255, b = grp >> 1, kvh = grp & 1, hd = kvh * 4 + (w >> 6), qb = w & 63;
        const size_t qrow = (size_t)b * RB + CTX + qb * 256;
#if ATT8_DEBUG
        attn_body::attn_unit(F.tid, mref, (const attn_body::bf16*)(QBp + qrow * 512 + hd * 64), 512, (const attn_body::bf16*)(KC + (size_t)(b * 2 + kvh) * RB * 64), (const attn_body::bf16*)(VC + (size_t)(b * 2 + kvh) * RB * 64), RB / 64,
                                (attn_body::bf16*)(MIX + qrow * DM + hd * 64), DM, (char*)F.lds);
        attn_body::attn_unit8(F.tid, mref, Q8 + qrow * 512 + hd * 64, 512, K8 + (size_t)(b * 2 + kvh) * (RB / 64) * 4096, V8 + (size_t)(b * 2 + kvh) * (RB / 64) * 4096, RB / 64,
                                (attn_body::bf16*)((bf16*)(a->ws + WS_AR + DO_O8) + qrow * 512 + hd * 64), 512, (char*)F.lds);
#else
        attn_body::attn_unit8(F.tid, mref, Q8 + qrow * 512 + hd * 64, 512, K8 + (size_t)(b * 2 + kvh) * (RB / 64) * 4096, V8 + (size_t)(b * 2 + kvh) * (RB / 64) * 4096, RB / 64,
                                (attn_body::bf16*)(MIX + qrow * DM + hd * 64), DM, (char*)F.lds);
#endif
    }
    if (l == 0) {
        for (int u = (F.bx + F.G - 32) % F.G; u < NB * 8; u += F.G) { const int b = u >> 3, hd = u & 7, kvh = hd >> 2; const size_t qrow = (size_t)b * RB;
#if ATT8_DEBUG
            attn_body::attn_unit(F.tid, mref, (const attn_body::bf16*)(QBp + qrow * 512 + hd * 64), 512, (const attn_body::bf16*)(KC + (size_t)(b * 2 + kvh) * RB * 64), (const attn_body::bf16*)(VC + (size_t)(b * 2 + kvh) * RB * 64), CTX / 64,
                                    (attn_body::bf16*)(MIX + qrow * DM + hd * 64), DM, (char*)F.lds);
            attn_body::attn_unit8(F.tid, mref, Q8 + qrow * 512 + hd * 64, 512, K8 + (size_t)(b * 2 + kvh) * (RB / 64) * 4096, V8 + (size_t)(b * 2 + kvh) * (RB / 64) * 4096, CTX / 64,
                                    (attn_body::bf16*)((bf16*)(a->ws + WS_AR + DO_O8) + qrow * 512 + hd * 64), 512, (char*)F.lds);
#else
            attn_body::attn_unit8(F.tid, mref, Q8 + qrow * 512 + hd * 64, 512, K8 + (size_t)(b * 2 + kvh) * (RB / 64) * 4096, V8 + (size_t)(b * 2 + kvh) * (RB / 64) * 4096, CTX / 64,
                                    (attn_body::bf16*)(MIX + qrow * DM + hd * 64), DM, (char*)F.lds);
#endif
        }
    }
}
struct PlainSched {
    int nM, nN, G, c, skipctx; const char* A; const char* B; size_t tA, tB;
    __device__ __forceinline__ bool next(int i, pg8::Unit& u) const {
        const long L = (long)i * G + c; if (L >= (long)nM * nN) return false;
        int pm, pn; pg8::deal((int)L, nM, nN, pm, pn); if (skipctx) pm = pm + 1 + (pm >= 64 ? 1 : 0);
        u.pm = pm; u.pn = pn; u.a = A + (size_t)pm * tA; u.b = B + (size_t)pn * tB; u.goff = 0; u.gcnt = 0; return true; }
};
struct CtxSplitSched {
    int nN, nsp, G, c, KL; const char* A; const char* B; size_t tA, tB;
    __device__ __forceinline__ bool next(int i, pg8::Unit& u) const {
        const long L = (long)i * G + c; if (L >= (long)2 * nN * nsp) return false;
        const int ct = (int)L & 1, r = (int)L >> 1, pn = r % nN, ks = r / nN;
        u.pm = 2 * ks + ct; u.pn = pn; u.a = A + (size_t)(ct * 65) * tA + (size_t)ks * KL * 2; u.b = B + (size_t)pn * tB + (size_t)ks * KL * 2; u.goff = 0; u.gcnt = 0; return true; }
};
struct CtxFullSched {
    int nN, G, c; const char* A; const char* B; size_t tA, tB;
    __device__ __forceinline__ bool next(int i, pg8::Unit& u) const {
        const long L = (long)i * G + c; if (L >= (long)2 * nN) return false;
        const int ct = (int)L & 1, pn = (int)L >> 1;
        u.pm = ct * 65; u.pn = pn; u.a = A + (size_t)(ct * 65) * tA; u.b = B + (size_t)pn * tB; u.goff = 0; u.gcnt = 0; return true; }
};
struct MoeSched {
    int nM, nN, G, c, t0, up, c0; const char* A; const char* W; size_t tA, tB, wsz; int ts[9], cnt[8];
    __device__ __forceinline__ bool next(int i, pg8::Unit& u) const {
        long L = (long)i * G + c;
        if (c0 > 0) { const int w = G - c0; const long E = 3L * w; L = (c >= c0) ? ((i < 3) ? (long)i * w + (c - c0) : E + (long)(i - 3) * G + c) : E + (long)i * G + c; }
        if (L >= (long)nM * nN) return false;
        int pml, pn; pg8::deal((int)L, nM, nN, pml, pn); const int rt = t0 + pml;
        int e = 0, tse = 0, ce = cnt[0];
#pragma unroll
        for (int k = 1; k < 8; ++k) { const bool sel = (rt >= ts[k]) && (ts[k + 1] > ts[k]); e = sel ? k : e; tse = sel ? ts[k] : tse; ce = sel ? cnt[k] : ce; }
        const int lt = rt - tse;
        u.pn = pn; u.b = W + (size_t)e * wsz + (size_t)pn * tB;
        if (up) { u.pm = pml; u.a = A; u.goff = e * LISTCAP + lt * 256; const int rem = ce - lt * 256; u.gcnt = rem < 256 ? rem : 256; }
        else { u.pm = rt; u.a = A + (size_t)pml * tA; u.goff = 0; u.gcnt = 0; }
        return true; }
};

#if ATT8_DEBUG
__device__ __forceinline__ void dbg_compare(ArgP a, Frame& F, int l) {
    const bf16* MIX = (const bf16*)(a->ws + WS_AR + AR_MIX); const bf16* O8 = (const bf16*)(a->ws + WS_AR + DO_O8);
    float sd = 0.f, so = 0.f;
    for (int row = F.gw; row < NR; row += F.NGW) { const int b = row / RB, jj = row - b * RB; if (jj < CTX && l == 1) continue;
        const v4u x = *(const v4u*)(MIX + (size_t)row * DM + 8 * F.lane), y = *(const v4u*)(O8 + (size_t)row * 512 + 8 * F.lane);
        const float xv[8] = {bf_lo(x.x), bf_hi(x.x), bf_lo(x.y), bf_hi(x.y), bf_lo(x.z), bf_hi(x.z), bf_lo(x.w), bf_hi(x.w)}, yv[8] = {bf_lo(y.x), bf_hi(y.x), bf_lo(y.y), bf_hi(y.y), bf_lo(y.z), bf_hi(y.z), bf_lo(y.w), bf_hi(y.w)};
#pragma unroll
        for (int j = 0; j < 8; ++j) { const float d = yv[j] - xv[j]; sd += d * d; so += xv[j] * xv[j]; } }
    sd = wave_sum(sd); so = wave_sum(so);
    if (F.lane == 0) { atomicAdd((float*)(a->ws + WS_CTL) + 2048, sd); atomicAdd((float*)(a->ws + WS_CTL) + 2049, so); }
}
#endif
constexpr int N_PHASES_K = 22;
__global__ void __launch_bounds__(NWAVES * 64, 2) mk_fwd(Args a_unused) {
    extern __shared__ __attribute__((aligned(16))) unsigned char lds[];
    Frame F; ArgP a = args_here();
    F.lds = (LAS unsigned char*)lds;
    relaunder(F);
    unsigned* ctl = (unsigned*)(a->ws + WS_CTL);
    for (int u = F.tid; u < (LDS_BYTES - RING_BYTES) / 4; u += NWAVES * 64) ((LAS unsigned*)(F.lds + RING_BYTES))[u] = 0u;
    __syncthreads();
    volatile LAS unsigned* MISC = (volatile LAS unsigned*)(F.lds + MISC_OFF);
    XcdBarrier bar = xcd_barrier_post(ctl + CW_BAR + a->li * XCD_BAR_WORDS, MISC + 8);
    LAS unsigned* gtab = (LAS unsigned*)(F.lds + GTAB_OFF);
    const int lo = a->ph_lo, hi = a->ph_hi; int ph = 0;
#define RUN (a = args_here(), relaunder(F), (ph >= lo && ph < hi))
#ifndef PROF_MASK
#define PROF_MASK 0
#endif
#ifndef PROF_AMP
#define PROF_AMP 10
#endif
#if PROF_MASK
#define PROF_STAMP(k_) do { if (blockIdx.x == 0 && threadIdx.x == 0) ((volatile unsigned long long*)(a->ws + WS_CTL + 32768))[k_] = wall_clock64(); } while (0)
#else
#define PROF_STAMP(k_) do { } while (0)
#endif
#define SEAM() do { if (ph >= lo && ph + 1 < hi) xcd_barrier(bar); ++ph; a = args_here(); PROF_STAMP(ph); } while (0)
    unsigned char* AR = a->ws + WS_AR;
    PROF_STAMP(0);

    if (RUN) phase_p0a(a, F);
    SEAM();
    if (RUN) phase_premix0(a, F);
    SEAM();
#pragma unroll 1
    for (int l = 0; l < 2; ++l) {
        if (RUN) {
            if ((IN_I8 >> l) & 1) {
                PlainSched S{NR / 256, INW / 256, F.G, F.bx, 0, (const char*)(AR + AR_MIX), (const char*)(a->ws + WS_WIN + l * SZ_WIN), (size_t)256 * DM, (size_t)256 * DM};
                pg8::EpiBf16S E{(bf16*)(AR + AR_P), INW, 1.0f / I8_WS, (const float*)(a->ws + WS_RSIN)};
                pg8::gemm_phase<pg8::EpiBf16S, PlainSched, true, false, 2>(F.tid, F.lds, gtab, nullptr, DM / 2, DM / 2, S, E);
            } else if (IN1_F8 && l == 1) {
                PlainSched S{NR / 256, INW / 256, F.G, F.bx, 0, (const char*)(AR + AR_MIX), (const char*)(a->ws + WS_WIN + SZ_WIN), (size_t)256 * DM, (size_t)256 * DM};
                pg8::EpiBf16S E{(bf16*)(AR + AR_P), INW, 1.0f / 64.0f};
                pg8::gemm_phase<pg8::EpiBf16S, PlainSched, true, false, 1>(F.tid, F.lds, gtab, nullptr, DM / 2, DM / 2, S, E);
            } else {
            PlainSched S{NR / 256, INW / 256, F.G, F.bx, 0, (const char*)(AR + AR_MIX), (const char*)(a->ws + WS_WIN + l * SZ_WIN), (size_t)256 * DM * 2, (size_t)256 * DM * 2};
            pg8::EpiBf16 E{(bf16*)(AR + AR_P), INW};
            pg8::gemm_phase<pg8::EpiBf16, PlainSched, true, false>(F.tid, F.lds, gtab, nullptr, DM, DM, S, E); }
        }
        SEAM();
        if (RUN) phase_prep(a, F, l);
        SEAM();
        if (RUN) phase_scan(a, F, l);
        SEAM();
        if (RUN) phase_mix(a, F, l, (F.G % 8 == 0) ? (F.bx % 8) * (F.G / 8) + (F.bx / 8) : F.bx);
        SEAM();
        if (RUN) {
#if ATT8_DEBUG
            dbg_compare(a, F, l);
#endif
            PlainSched S{NLAT / 256, DM / 256, F.G, F.bx, 1, (const char*)(AR + AR_MIX), (const char*)(a->ws + WS_WOUT + l * SZ_WOUT), (size_t)256 * DM * 2, (size_t)256 * DM * 2};
            pg8::EpiBf16 E{(bf16*)(AR + AR_MX), DM};
            pg8::gemm_phase<pg8::EpiBf16, PlainSched, true, false>(F.tid, F.lds, gtab, nullptr, DM, DM, S, E);
            if (l == 0) {
                CtxSplitSched S2{DM / 256, 4, F.G, F.bx, 256, (const char*)(AR + AR_MIX), (const char*)(a->ws + WS_WOUT), (size_t)256 * DM * 2, (size_t)256 * DM * 2};
                pg8::EpiF32 E2{(float*)(AR + AR_PART0), DM};
                pg8::gemm_phase<pg8::EpiF32, CtxSplitSched, true, false>(F.tid, F.lds, gtab, nullptr, DM, 256, S2, E2); }
        }
        SEAM();
        if (l == 0) {
            if (RUN) phase_resid<0>(a, F);
            SEAM();
            if (RUN) {
#if DENSE_F8
                PlainSched S{NR / 256, 2 * FF / 256, F.G, F.bx, 0, (const char*)(AR + AR_HX2), (const char*)(a->ws + WS_W13D), (size_t)256 * DM, (size_t)256 * DM};
                pg8::EpiSwiglu8 E{(unsigned char*)(AR + AR_ACT), FF, 1.0f / 64.0f, 8.0f};
                pg8::gemm_phase<pg8::EpiSwiglu8, PlainSched, true, false, 1>(F.tid, F.lds, gtab, nullptr, DM / 2, DM / 2, S, E);
#elif DENSE_I8UP
                PlainSched S{NR / 256, 2 * FF / 256, F.G, F.bx, 0, (const char*)(AR + AR_HX2), (const char*)(a->ws + WS_W13D), (size_t)256 * DM, (size_t)256 * DM};
#if DENSE_DOWN_F8
                pg8::EpiSwiglu8 E{(unsigned char*)(AR + AR_ACT), FF, 1.0f / I8_WS, 8.0f, (const float*)(a->ws + WS_RSFF)};
                pg8::gemm_phase<pg8::EpiSwiglu8, PlainSched, true, false, 2>(F.tid, F.lds, gtab, nullptr, DM / 2, DM / 2, S, E);
#else
                pg8::EpiSwigluS E{(bf16*)(AR + AR_ACT), FF, 1.0f / (I8_XS * I8_WS)};
                pg8::gemm_phase<pg8::EpiSwigluS, PlainSched, true, false, 2>(F.tid, F.lds, gtab, nullptr, DM / 2, DM / 2, S, E);
#endif
#else
                PlainSched S{NR / 256, 2 * FF / 256, F.G, F.bx, 0, (const char*)(AR + AR_HX2), (const char*)(a->ws + WS_W13D), (size_t)256 * DM * 2, (size_t)256 * DM * 2};
                pg8::EpiSwiglu E{(bf16*)(AR + AR_ACT), FF};
                pg8::gemm_phase<pg8::EpiSwiglu, PlainSched, true, false>(F.tid, F.lds, gtab, nullptr, DM, DM, S, E);
#endif
            }
            SEAM();
            if (RUN) {
#if DENSE_F8 || DENSE_DOWN_F8
                PlainSched S{NLAT / 256, DM / 256, F.G, F.bx, 1, (const char*)(AR + AR_ACT), (const char*)(a->ws + WS_W2D), (size_t)256 * FF, (size_t)256 * FF};
                pg8::EpiBf16S E{(bf16*)(AR + AR_YD), DM, 1.0f / 512.0f};
                pg8::gemm_phase<pg8::EpiBf16S, PlainSched, true, false, 1>(F.tid, F.lds, gtab, nullptr, FF / 2, FF / 2, S, E);
#if DENSE_DOWN_F8 && !DENSE_F8
                CtxFullSched S2{DM / 256, F.G, F.bx, (const char*)(AR + AR_ACT), (const char*)(a->ws + WS_W2D), (size_t)256 * FF, (size_t)256 * FF};
                pg8::gemm_phase<pg8::EpiBf16S, CtxFullSched, true, false, 1>(F.tid, F.lds, gtab, nullptr, FF / 2, FF / 2, S2, E);
#else
                CtxSplitSched S2{DM / 256, 11, F.G, F.bx, 128, (const char*)(AR + AR_ACT), (const char*)(a->ws + WS_W2D), (size_t)256 * FF, (size_t)256 * FF};
                pg8::EpiF32S E2{(float*)(AR + AR_PART1), DM, 1.0f / 512.0f};
                pg8::gemm_phase<pg8::EpiF32S, CtxSplitSched, true, false, 1>(F.tid, F.lds, gtab, nullptr, FF / 2, 128, S2, E2);
#endif
#else
                PlainSched S{NLAT / 256, DM / 256, F.G, F.bx, 1, (const char*)(AR + AR_ACT), (const char*)(a->ws + WS_W2D), (size_t)256 * FF * 2, (size_t)256 * FF * 2};
                pg8::EpiBf16 E{(bf16*)(AR + AR_YD), DM};
                pg8::gemm_phase<pg8::EpiBf16, PlainSched, true, false>(F.tid, F.lds, gtab, nullptr, FF, FF, S, E);
                CtxSplitSched S2{DM / 256, 11, F.G, F.bx, 256, (const char*)(AR + AR_ACT), (const char*)(a->ws + WS_W2D), (size_t)256 * FF * 2, (size_t)256 * FF * 2};
                pg8::EpiF32 E2{(float*)(AR + AR_PART1), DM};
                pg8::gemm_phase<pg8::EpiF32, CtxSplitSched, true, false>(F.tid, F.lds, gtab, nullptr, FF, 256, S2, E2);
#endif
            }
            SEAM();
            if (RUN) phase_resid<1>(a, F);
            SEAM();
        } else {
            if (RUN) phase_resid<2>(a, F);
            SEAM();
#pragma unroll 1
            for (int p = 0; p <= MOE_PASSES; ++p) {
                if (RUN) {
                    constexpr size_t ACTB = (size_t)MOE_TP * 256 * FF;
                    int nprev = 0;
                    if (p >= 1) {
                        MoeSched S; moe_prefix(a->ws, S.ts, S.cnt);
                        const int tot = S.ts[8]; int n = tot - (p - 1) * MOE_TP; n = n < 0 ? 0 : (n > MOE_TP ? MOE_TP : n); nprev = n;
                        S.nM = n; S.nN = DM / 256; S.G = F.G; S.c = F.bx; S.t0 = (p - 1) * MOE_TP; S.up = 0; S.c0 = 0; S.A = (const char*)(AR + AR_ACT + ((p - 1) & 1) * ACTB); S.W = (const char*)(a->ws + WS_W2M); S.tA = (size_t)256 * FF; S.tB = (size_t)256 * FF; S.wsz = SZ8_W2;
                        pg8::EpiBf16S E{(bf16*)(AR + AR_YM), DM, 1.0f / 512.0f};
                        pg8::gemm_phase<pg8::EpiBf16S, MoeSched, true, false, 1>(F.tid, F.lds, gtab, nullptr, FF / 2, FF / 2, S, E);
                    }
                    if (p < MOE_PASSES) {
                        a = args_here(); relaunder(F);
                        MoeSched S; moe_prefix(a->ws, S.ts, S.cnt);
                        const int tot = S.ts[8]; int n = tot - p * MOE_TP; n = n < 0 ? 0 : (n > MOE_TP ? MOE_TP : n);
                        S.nM = n; S.nN = 2 * FF / 256; S.G = F.G; S.c = F.bx; S.t0 = p * MOE_TP; S.up = 1; S.A = (const char*)(AR + AR_HX2); S.W = (const char*)(a->ws + WS_W13M); S.tA = 0; S.tB = (size_t)256 * DM; S.wsz = SZ8_W13;
                        { const int nd = nprev * (DM / 256), r = nd % F.G; S.c0 = (r != 0 && 3L * (F.G - r) <= (long)n * S.nN) ? r : 0; }
                        pg8::EpiSwiglu8 E{(unsigned char*)(AR + AR_ACT + (p & 1) * ACTB), FF, MOE_I8UP ? 1.0f / (I8_XS * I8_WS) : 1.0f / 64.0f, 8.0f};
                        pg8::gemm_phase<pg8::EpiSwiglu8, MoeSched, true, true, MOE_I8UP ? 2 : 1>(F.tid, F.lds, gtab, (const int*)(a->ws + WS_LIST), DM / 2, DM / 2, S, E);
                    }
                }
                SEAM();
            }
            if (RUN) phase_resid<3>(a, F);
            ++ph;
        }
    }
#if PROF_MASK
    a = args_here(); relaunder(F);
    if (F.bx == 0 && F.tid == 0) {
        PROF_STAMP(N_PHASES_K);
        const volatile unsigned long long* ts = (const volatile unsigned long long*)(a->ws + WS_CTL + 32768); long long sum = 0;
        for (int k = 0; k < N_PHASES_K; ++k) if ((PROF_MASK >> k) & 1) sum += (long long)(ts[k + 1] - ts[k]);
        const long long ticks = sum * PROF_AMP; const long long t0 = wall_clock64();
        while (wall_clock64() - t0 < ticks) __builtin_amdgcn_s_sleep(32);
    }
#endif
#if ATT8_DEBUG
    a = args_here(); relaunder(F);
    if (F.bx == 0 && F.tid == 0) {
        const float sd = __hip_atomic_load((float*)(a->ws + WS_CTL) + 2048, RLX_AGENT), so = __hip_atomic_load((float*)(a->ws + WS_CTL) + 2049, RLX_AGENT);
        float nl = -__log2f(sd / so); if (!(nl > 0.f)) nl = 0.f; if (nl > 40.f) nl = 40.f;
        const long long ticks = (long long)(nl * 200000.f); const long long t0 = wall_clock64();
        while (wall_clock64() - t0 < ticks) __builtin_amdgcn_s_sleep(32);
    }
#endif
#undef RUN
#undef SEAM
}
constexpr int N_PHASES = 22;

#ifndef DET_PROBE
#define DET_PROBE 0
#endif
#if DET_PROBE
__global__ void det_cksum(const unsigned* out, unsigned long long* dst, int n) {
    unsigned long long s = 0; for (int i = blockIdx.x * blockDim.x + threadIdx.x; i < n; i += gridDim.x * blockDim.x) s += (unsigned long long)out[i] * (unsigned)(2 * (i & 1023) + 1);
    for (int o = 32; o > 0; o >>= 1) s += __shfl_xor(s, o);
    if ((threadIdx.x & 63) == 0) atomicAdd(dst, s);
}
__global__ void det_fill(unsigned* p, size_t n, unsigned v) { for (size_t i = (size_t)blockIdx.x * blockDim.x + threadIdx.x; i < n; i += (size_t)gridDim.x * blockDim.x) p[i] = v; }
__global__ void det_cmp(const unsigned long long* c, float* out) { if (c[0] != c[1]) out[0] = __builtin_nanf(""); }
#endif
#ifndef MK_N_LAUNCHES
#define MK_N_LAUNCHES 1
#endif
extern "C" void kernel_launch(void* const* d_in, const int* in_sizes, int n_in, void* d_out, int out_size, void* d_ws, size_t ws_size, hipStream_t stream) {
    static int grid = 0;
    if (grid == 0) {
        if (n_in != 24 || out_size != NLAT * DM || ws_size < WS_END) { fprintf(stderr, "kernel_launch: unexpected shapes (n_in %d out %d ws %zu)\n", n_in, out_size, ws_size); grid = -1; return; }
        int dev = 0, cus = 0, per_cu = 0;
        if (hipGetDevice(&dev) != hipSuccess || hipDeviceGetAttribute(&cus, hipDeviceAttributeMultiprocessorCount, dev) != hipSuccess) { grid = -1; return; }
        if (hipFuncSetAttribute((const void*)mk_fwd, hipFuncAttributeMaxDynamicSharedMemorySize, LDS_BYTES) != hipSuccess) { fprintf(stderr, "kernel_launch: hipFuncSetAttribute failed\n"); grid = -1; return; }
        if (hipOccupancyMaxActiveBlocksPerMultiprocessor(&per_cu, (const void*)mk_fwd, NWAVES * 64, LDS_BYTES) != hipSuccess || per_cu < 1) fprintf(stderr, "kernel_launch: occupancy query says %d\n", per_cu);
        (void)hipGetLastError();
        grid = cus;
        while (grid > 8 && (NLAT % (2 * grid * NWAVES) != 0 || NLAT / (grid * NWAVES) > 64)) --grid;
    }
    if (grid < 0) return;
    if (hipMemsetAsync((char*)d_ws + WS_CTL, 0, CTL_ZERO_BYTES, stream) != hipSuccess) return;
    Args a{};
    for (int i = 0; i < 24; ++i) a.in[i] = (const float*)d_in[i];
    a.out = (float*)d_out; a.ws = (unsigned char*)d_ws; a.pad = 0;
#if DET_PROBE
    { a.ph_lo = 0; a.ph_hi = N_PHASES; a.li = 0;
      unsigned long long* ck = (unsigned long long*)((char*)d_ws + WS_CTL + 65536);
      hipLaunchKernelGGL(det_fill, dim3(2048), dim3(256), 0, stream, (unsigned*)((char*)d_ws + MiB), (WS_END - MiB) / 4, 0x3C3C3C3Cu);
      hipLaunchKernelGGL(mk_fwd, dim3(grid), dim3(NWAVES * 64), LDS_BYTES, stream, a);
      hipLaunchKernelGGL(det_cksum, dim3(1024), dim3(256), 0, stream, (const unsigned*)d_out, ck, out_size);
      if (hipMemsetAsync((char*)d_ws + WS_CTL, 0, 65536, stream) != hipSuccess) return;
      hipLaunchKernelGGL(det_fill, dim3(2048), dim3(256), 0, stream, (unsigned*)((char*)d_ws + MiB), (WS_END - MiB) / 4, 0xBDBDBDBDu);
      hipLaunchKernelGGL(det_fill, dim3(2048), dim3(256), 0, stream, (unsigned*)d_out, (size_t)out_size, 0xBDBDBDBDu);
      hipLaunchKernelGGL(mk_fwd, dim3(grid), dim3(NWAVES * 64), LDS_BYTES, stream, a);
      hipLaunchKernelGGL(det_cksum, dim3(1024), dim3(256), 0, stream, (const unsigned*)d_out, ck + 1, out_size);
      hipLaunchKernelGGL(det_cmp, dim3(1), dim3(1), 0, stream, (const unsigned long long*)ck, (float*)d_out);
      return; }
#endif
    if (MK_N_LAUNCHES == 1) { a.ph_lo = 0; a.ph_hi = N_PHASES; a.li = 0; hipLaunchKernelGGL(mk_fwd, dim3(grid), dim3(NWAVES * 64), LDS_BYTES, stream, a); }
    else { for (int p = 0; p < N_PHASES; ++p) { a.ph_lo = p; a.ph_hi = p + 1; a.li = p; hipLaunchKernelGGL(mk_fwd, dim3(grid), dim3(NWAVES * 64), LDS_BYTES, stream, a); } }
}
```

```cpp
#include <hip/hip_runtime.h>
#include <hip/hip_bf16.h>
#include <cstdio>
#include <cstdint>
#include <cmath>
namespace pg8 {
#define PG8_LAS __attribute__((address_space(3)))
typedef unsigned short bf16_t;
typedef short bf16x8 __attribute__((ext_vector_type(8)));
typedef float f32x4 __attribute__((ext_vector_type(4)));
typedef unsigned u32x4 __attribute__((ext_vector_type(4)));
typedef int i32x4_t __attribute__((ext_vector_type(4)));
typedef int i32x8_t __attribute__((ext_vector_type(8)));
typedef int i32x8_t __attribute__((ext_vector_type(8)));
constexpr int BM = 256, BK = 64, HALF = 128, HTB = HALF * BK * 2  , STAGE_BYTES = 8 * HTB, NXCD = 8, WGM = 8;

__host__ __device__ __forceinline__ int lds_byte(int r, int c) { const int st = (r >> 4) * 2 + (c >> 5), rr = r & 15, cc = c & 31, ob = rr * 64 + cc * 2; return st * 1024 + (ob ^ (((ob >> 9) & 1) << 5)); }
__host__ __device__ __forceinline__ void stage_rc(int b, int& R, int& C) { const int st = b / 1024, sb = b % 1024, swz = sb ^ (((sb >> 9) & 1) << 5); R = (st >> 1) * 16 + swz / 64; C = (st & 1) * 32 + (swz % 64) / 2; }
__host__ __device__ __forceinline__ int perm32(int rho) { const int n = rho >> 4, i = rho & 15; return 8 * (i >> 2) + 4 * n + (i & 3); }

struct Unit { int pm, pn; const char* a; const char* b; int goff, gcnt; };

__device__ __forceinline__ void deal(int L, int nM, int nN, int& pm, int& pn) {
    const int nwg = nM * nN; int wgid = L;
    { const int q = nwg / NXCD, r = nwg % NXCD, xcd = wgid % NXCD, off = wgid / NXCD; wgid = (xcd < r ? xcd * (q + 1) : r * (q + 1) + (xcd - r) * q) + off; }
    const int nig = WGM * nN, gid = wgid / nig, fm = gid * WGM, gsz = (nM - fm) < WGM ? (nM - fm) : WGM;
    pm = fm + ((wgid % nig) % gsz); pn = (wgid % nig) / gsz;
}

__device__ __forceinline__ float zero_v() { float z; asm volatile("v_mov_b32 %0, 0" : "=v"(z)); return z; }
__device__ __forceinline__ unsigned cvt_pk_bf16(float lo, float hi) { unsigned r; asm volatile("v_cvt_pk_bf16_f32 %0, %1, %2" : "=v"(r) : "v"(lo), "v"(hi)); return r; }

struct EpiBf16 {
    static constexpr bool PERM = true;
    bf16_t* O; int ldc;
    __device__ __forceinline__ void operator()(const f32x4 (&acc)[2][2][4][2], const Unit& u, int wr, int wc, int fr, int fq) const {
        const int row0 = u.pm * BM + wr * 64 + fr; const int col0 = u.pn * BM + wc * 32 + 8 * fq;
#pragma unroll
        for (int ai = 0; ai < 2; ++ai)
#pragma unroll
            for (int m = 0; m < 4; ++m) { bf16_t* rowp = O + (size_t)(row0 + ai * HALF + m * 16) * ldc + col0;
#pragma unroll
                for (int bj = 0; bj < 2; ++bj) { const f32x4 v0 = acc[ai][bj][m][0], v1 = acc[ai][bj][m][1];
                    u32x4 w; w.x = cvt_pk_bf16(v0[0], v0[1]); w.y = cvt_pk_bf16(v0[2], v0[3]); w.z = cvt_pk_bf16(v1[0], v1[1]); w.w = cvt_pk_bf16(v1[2], v1[3]);
                    *(u32x4*)(rowp + bj * HALF) = w; } }
    }
};
struct EpiF32 {
    static constexpr bool PERM = false;
    float* O; int ldc;
    __device__ __forceinline__ void operator()(const f32x4 (&acc)[2][2][4][2], const Unit& u, int wr, int wc, int fr, int fq) const {
        const int row0 = u.pm * BM + wr * 64 + fr; const int col0 = u.pn * BM + wc * 32 + 4 * fq;
#pragma unroll
        for (int ai = 0; ai < 2; ++ai)
#pragma unroll
            for (int m = 0; m < 4; ++m) { float* rowp = O + (size_t)(row0 + ai * HALF + m * 16) * ldc + col0;
#pragma unroll
                for (int bj = 0; bj < 2; ++bj)
#pragma unroll
                    for (int n = 0; n < 2; ++n) *(f32x4*)(rowp + bj * HALF + n * 16) = acc[ai][bj][m][n]; }
    }
};
__device__ __forceinline__ float silu_f(float x) { return x * __builtin_amdgcn_rcpf(1.0f + __builtin_amdgcn_exp2f(-1.4426950408889634f * x)); }
struct EpiSwiglu {
    static constexpr bool PERM = true;
    bf16_t* O; int ldc;
    __device__ __forceinline__ void operator()(const f32x4 (&acc)[2][2][4][2], const Unit& u, int wr, int wc, int fr, int fq) const {
        const int row0 = u.pm * BM + wr * 64 + fr; const int col0 = u.pn * HALF + wc * 32 + 8 * fq;
#pragma unroll
        for (int ai = 0; ai < 2; ++ai)
#pragma unroll
            for (int m = 0; m < 4; ++m) { bf16_t* rowp = O + (size_t)(row0 + ai * HALF + m * 16) * ldc + col0;
                const f32x4 a0 = acc[ai][0][m][0], a1 = acc[ai][0][m][1], g0 = acc[ai][1][m][0], g1 = acc[ai][1][m][1];
                u32x4 w; w.x = cvt_pk_bf16(silu_f(a0[0]) * g0[0], silu_f(a0[1]) * g0[1]); w.y = cvt_pk_bf16(silu_f(a0[2]) * g0[2], silu_f(a0[3]) * g0[3]);
                w.z = cvt_pk_bf16(silu_f(a1[0]) * g1[0], silu_f(a1[1]) * g1[1]); w.w = cvt_pk_bf16(silu_f(a1[2]) * g1[2], silu_f(a1[3]) * g1[3]);
                *(u32x4*)rowp = w; }
    }
};

struct EpiBf16S {
    static constexpr bool PERM = true;
    bf16_t* O; int ldc; float scl;
    __device__ __forceinline__ void operator()(const f32x4 (&acc)[2][2][4][2], const Unit& u, int wr, int wc, int fr, int fq) const {
        const int row0 = u.pm * BM + wr * 64 + fr; const int col0 = u.pn * BM + wc * 32 + 8 * fq;
#pragma unroll
        for (int ai = 0; ai < 2; ++ai)
#pragma unroll
            for (int m = 0; m < 4; ++m) { bf16_t* rowp = O + (size_t)(row0 + ai * HALF + m * 16) * ldc + col0;
#pragma unroll
                for (int bj = 0; bj < 2; ++bj) { const f32x4 v0 = acc[ai][bj][m][0] * scl, v1 = acc[ai][bj][m][1] * scl;
                    u32x4 w; w.x = cvt_pk_bf16(v0[0], v0[1]); w.y = cvt_pk_bf16(v0[2], v0[3]); w.z = cvt_pk_bf16(v1[0], v1[1]); w.w = cvt_pk_bf16(v1[2], v1[3]);
                    *(u32x4*)(rowp + bj * HALF) = w; } }
    }
};
struct EpiF32S {
    static constexpr bool PERM = false;
    float* O; int ldc; float scl;
    __device__ __forceinline__ void operator()(const f32x4 (&acc)[2][2][4][2], const Unit& u, int wr, int wc, int fr, int fq) const {
        const int row0 = u.pm * BM + wr * 64 + fr; const int col0 = u.pn * BM + wc * 32 + 4 * fq;
#pragma unroll
        for (int ai = 0; ai < 2; ++ai)
#pragma unroll
            for (int m = 0; m < 4; ++m) { float* rowp = O + (size_t)(row0 + ai * HALF + m * 16) * ldc + col0;
#pragma unroll
                for (int bj = 0; bj < 2; ++bj)
#pragma unroll
                    for (int n = 0; n < 2; ++n) *(f32x4*)(rowp + bj * HALF + n * 16) = acc[ai][bj][m][n] * scl; }
    }
};
__device__ __forceinline__ unsigned cvt_fp8x4(float a, float b, float c, float d) { int w = 0; w = __builtin_amdgcn_cvt_pk_fp8_f32(a, b, w, false); w = __builtin_amdgcn_cvt_pk_fp8_f32(c, d, w, true); return (unsigned)w; }
struct EpiSwigluS {
    static constexpr bool PERM = true;
    bf16_t* O; int ldc; float si;
    __device__ __forceinline__ void operator()(const f32x4 (&acc)[2][2][4][2], const Unit& u, int wr, int wc, int fr, int fq) const {
        const int row0 = u.pm * BM + wr * 64 + fr; const int col0 = u.pn * HALF + wc * 32 + 8 * fq;
#pragma unroll
        for (int ai = 0; ai < 2; ++ai)
#pragma unroll
            for (int m = 0; m < 4; ++m) { bf16_t* rowp = O + (size_t)(row0 + ai * HALF + m * 16) * ldc + col0;
                const f32x4 a0 = acc[ai][0][m][0] * si, a1 = acc[ai][0][m][1] * si, g0 = acc[ai][1][m][0] * si, g1 = acc[ai][1][m][1] * si;
                u32x4 w; w.x = cvt_pk_bf16(silu_f(a0[0]) * g0[0], silu_f(a0[1]) * g0[1]); w.y = cvt_pk_bf16(silu_f(a0[2]) * g0[2], silu_f(a0[3]) * g0[3]);
                w.z = cvt_pk_bf16(silu_f(a1[0]) * g1[0], silu_f(a1[1]) * g1[1]); w.w = cvt_pk_bf16(silu_f(a1[2]) * g1[2], silu_f(a1[3]) * g1[3]);
                *(u32x4*)rowp = w; }
    }
};
struct EpiSwiglu8 {
    static constexpr bool PERM = true;
    unsigned char* O; int ldc; float si, so;
    __device__ __forceinline__ f32x4 sw4(const f32x4 a, const f32x4 g, const float c1, const float k2) const {
        const f32x4 t = a * c1; f32x4 e; e[0] = __builtin_amdgcn_exp2f(t[0]); e[1] = __builtin_amdgcn_exp2f(t[1]); e[2] = __builtin_amdgcn_exp2f(t[2]); e[3] = __builtin_amdgcn_exp2f(t[3]);
        const f32x4 d = e + 1.0f; f32x4 r; r[0] = __builtin_amdgcn_rcpf(d[0]); r[1] = __builtin_amdgcn_rcpf(d[1]); r[2] = __builtin_amdgcn_rcpf(d[2]); r[3] = __builtin_amdgcn_rcpf(d[3]);
        return ((a * g) * k2) * r; }
    __device__ __forceinline__ void operator()(const f32x4 (&acc)[2][2][4][2], const Unit& u, int wr, int wc, int fr, int fq) const {
        const int row0 = u.pm * BM + wr * 64 + fr; const int col0 = u.pn * HALF + wc * 32 + 8 * fq; const float c1 = -1.4426950408889634f * si, k2 = si * si * so;
#pragma unroll
        for (int ai = 0; ai < 2; ++ai)
#pragma unroll
            for (int m = 0; m < 4; ++m) { unsigned char* rowp = O + (size_t)(row0 + ai * HALF + m * 16) * ldc + col0;
                const f32x4 o0 = sw4(acc[ai][0][m][0], acc[ai][1][m][0], c1, k2), o1 = sw4(acc[ai][0][m][1], acc[ai][1][m][1], c1, k2);
                const unsigned w0 = cvt_fp8x4(o0[0], o0[1], o0[2], o0[3]), w1 = cvt_fp8x4(o1[0], o1[1], o1[2], o1[3]);
                typedef unsigned u32x2_t __attribute__((ext_vector_type(2)));
                *(u32x2_t*)rowp = (u32x2_t){w0, w1}; }
    }
};

template <class Epi, class Sched, bool ALIGN_EPI, bool GATHER, int F8 = 0  >
__device__ __forceinline__ void gemm_phase(const int tid, PG8_LAS unsigned char* lds, PG8_LAS unsigned* gtab, const int* glist, const int K  , const int KL  , const Sched& S, const Epi& E) {
    const int wid = __builtin_amdgcn_readfirstlane(tid >> 6), lane = tid & 63, wr = wid >> 2, wc = wid & 3, fr = lane & 15, fq = lane >> 4;
    const int nt = KL / BK;
    unsigned voffA[2], voffB[2]; int RA[2], CA[2];
#pragma unroll
    for (int i = 0; i < 2; ++i) { int R, C; stage_rc(tid * 16 + i * 8192, R, C); const int Rb = Epi::PERM ? ((R & ~31) + perm32(R & 31)) : R;
        voffA[i] = (unsigned)(R * K + C) * 2u; voffB[i] = (unsigned)(Rb * K + C) * 2u; RA[i] = R; CA[i] = C; }
    const size_t kstep = (size_t)(BK * 2);
    const size_t hstep = (size_t)HALF * K * 2;
    const unsigned ldsw = (unsigned)wid * 1024u;
    const int aoff = lds_byte(wr * 64 + fr, fq * 8), boff = lds_byte(wc * 32 + fr, fq * 8);
    unsigned vc[2][2], vn[2][2], v2[2][2];
#define PG8_SA(b, h) (((b) * 2 + (h)) * HTB)
#define PG8_SB(b, h) ((4 + (b) * 2 + (h)) * HTB)
#define PG8_STAGE(bufoff, gbase, voff) do { _Pragma("unroll") for (int _i = 0; _i < 2; ++_i) \
        __builtin_amdgcn_global_load_lds((const unsigned*)((const char*)(gbase) + (voff)[_i]), (PG8_LAS unsigned*)(lds + (bufoff) + ldsw + _i * 8192), 16, 0, 0); } while (0)
#define PG8_STAGE_A(bufoff, gbase, h, VG) do { if constexpr (GATHER) { PG8_STAGE(bufoff, gbase, VG[h]); } else { PG8_STAGE(bufoff, (gbase) + (h) * hstep, voffA); } } while (0)
#define PG8_LDA(dst, b, h) do { _Pragma("unroll") for (int m = 0; m < 4; ++m) _Pragma("unroll") for (int k = 0; k < 2; ++k) dst[m][k] = *(const PG8_LAS bf16x8*)(lds + PG8_SA(b, h) + aoff + m * 2048 + k * 1024); } while (0)
#define PG8_LDB(dst, b, h) do { _Pragma("unroll") for (int n = 0; n < 2; ++n) _Pragma("unroll") for (int k = 0; k < 2; ++k) dst[n][k] = *(const PG8_LAS bf16x8*)(lds + PG8_SB(b, h) + boff + n * 2048 + k * 1024); } while (0)
#define PG8_CAT(x) __builtin_shufflevector(__builtin_bit_cast(i32x4_t, x[0]), __builtin_bit_cast(i32x4_t, x[1]), 0, 1, 2, 3, 4, 5, 6, 7)
#define PG8_MMA(ai, bj, At, Bt) do { __builtin_amdgcn_s_setprio(1); \
        if constexpr (F8 == 2) { _Pragma("unroll") for (int m = 0; m < 4; ++m) _Pragma("unroll") for (int n = 0; n < 2; ++n) _Pragma("unroll") for (int k = 0; k < 2; ++k) \
            asm volatile("v_mfma_i32_16x16x64_i8 %0, %1, %2, %0" : "+v"(acc[ai][bj][m][n]) : "v"(Bt[n][k]), "v"(At[m][k])); } \
        else if constexpr (F8 == 1) { _Pragma("unroll") for (int m = 0; m < 4; ++m) _Pragma("unroll") for (int n = 0; n < 2; ++n) \
            { const i32x8_t b8_ = PG8_CAT(Bt[n]), a8_ = PG8_CAT(At[m]); asm volatile("v_mfma_f32_16x16x128_f8f6f4 %0, %1, %2, %0" : "+v"(acc[ai][bj][m][n]) : "v"(b8_), "v"(a8_)); } } \
        else { _Pragma("unroll") for (int m = 0; m < 4; ++m) _Pragma("unroll") for (int n = 0; n < 2; ++n) _Pragma("unroll") for (int k = 0; k < 2; ++k) \
            acc[ai][bj][m][n] = __builtin_amdgcn_mfma_f32_16x16x32_bf16(Bt[n][k], At[m][k], acc[ai][bj][m][n], 0, 0, 0); } __builtin_amdgcn_s_setprio(0); } while (0)
#define PG8_WAIT_V(n) asm volatile("s_waitcnt vmcnt(" #n ")" ::: "memory")
#define PG8_WAIT_L(n) asm volatile("s_waitcnt lgkmcnt(" #n ")" ::: "memory")
#define PG8_BAR __builtin_amdgcn_s_barrier()
#define PG8_SCHED __builtin_amdgcn_sched_barrier(0)
#define PG8_GT_DMA(u) do { if (wid < 4) __builtin_amdgcn_global_load_lds((const unsigned*)(glist + (u).goff + wid * 64 + lane), (PG8_LAS unsigned*)(gtab + wid * 64), 4, 0, 0); } while (0)
#define PG8_GT_READ(V, u) do { _Pragma("unroll") for (int _h = 0; _h < 2; ++_h) _Pragma("unroll") for (int _i = 0; _i < 2; ++_i) { const int _p = _h * HALF + RA[_i]; int _r = (int)gtab[_p]; _r = (_p < (u).gcnt) ? _r : 0; \
        V[_h][_i] = ((unsigned)_r * (unsigned)K + (unsigned)CA[_i]) * 2u; } } while (0)
    Unit cur, nxt; int ui = 0;
    if (!S.next(0, cur)) return;
    f32x4 acc[2][2][4][2];
    { const float z = zero_v();
#pragma unroll
    for (int a = 0; a < 2; ++a)
#pragma unroll
        for (int b = 0; b < 2; ++b)
#pragma unroll
            for (int m = 0; m < 4; ++m)
#pragma unroll
                for (int n = 0; n < 2; ++n) acc[a][b][m][n] = (f32x4){z, z, z, z}; }
    bf16x8 At[4][2], B0[2][2], B1[2][2];
    const char* cA = cur.a; const char* cB = cur.b;
    if constexpr (GATHER) { PG8_GT_DMA(cur); PG8_WAIT_V(0); PG8_BAR; PG8_GT_READ(vc, cur); PG8_WAIT_L(0); PG8_BAR; }
    if constexpr (GATHER) {
#pragma unroll
        for (int _h = 0; _h < 2; ++_h) { vn[_h][0] = vc[_h][0]; vn[_h][1] = vc[_h][1]; } }
    PG8_STAGE(PG8_SB(0, 0), cB, voffB); PG8_STAGE(PG8_SB(0, 1), cB + hstep, voffB); PG8_STAGE_A(PG8_SA(0, 0), cA, 0, vc); PG8_STAGE_A(PG8_SA(0, 1), cA, 1, vc);
    if (wr == 1) PG8_BAR;
    PG8_WAIT_V(2); PG8_BAR;
    PG8_STAGE(PG8_SB(1, 0), cB + kstep, voffB); PG8_STAGE_A(PG8_SA(1, 0), cA + kstep, 0, vc); PG8_STAGE(PG8_SB(1, 1), cB + hstep + kstep, voffB);
    PG8_WAIT_V(6); PG8_BAR;
    for (;;) {
        const bool has_next = S.next(ui + 1, nxt);
        if constexpr (GATHER) { if (has_next) PG8_GT_DMA(nxt); }
        const char* nA = has_next ? nxt.a : cA; const char* nB = has_next ? nxt.b : cB;
        for (int t = 0; t < nt; t += 2) {
            const bool last = (t == nt - 2);
            const char* a1 = cA + (size_t)(t + 1) * kstep;
            const char* a2 = last ? nA : cA + (size_t)(t + 2) * kstep; const char* b2 = last ? nB : cB + (size_t)(t + 2) * kstep;
            const char* a3 = a2 + kstep; const char* b3 = b2 + kstep;
            if constexpr (GATHER) {
                if (last) { if (has_next) { PG8_GT_READ(vn, nxt); } else {
#pragma unroll
                        for (int _h = 0; _h < 2; ++_h) { vn[_h][0] = vc[_h][0]; vn[_h][1] = vc[_h][1]; } } }
#pragma unroll
                for (int _h = 0; _h < 2; ++_h) { v2[_h][0] = last ? vn[_h][0] : vc[_h][0]; v2[_h][1] = last ? vn[_h][1] : vc[_h][1]; }
            }
            PG8_LDB(B0, 0, 0); PG8_LDB(B1, 0, 1); PG8_SCHED; PG8_LDA(At, 0, 0); PG8_STAGE_A(PG8_SA(1, 1), a1, 1, vc);
            PG8_WAIT_V(8); PG8_WAIT_L(0); PG8_BAR; PG8_MMA(0, 0, At, B0); PG8_MMA(0, 1, At, B1); PG8_BAR; PG8_SCHED;
            PG8_LDA(At, 0, 1); PG8_STAGE(PG8_SB(0, 0), b2, voffB); PG8_STAGE(PG8_SB(0, 1), b2 + hstep, voffB); PG8_STAGE_A(PG8_SA(0, 0), a2, 0, v2);
            PG8_WAIT_V(8); PG8_WAIT_L(0); PG8_BAR; PG8_MMA(1, 0, At, B0); PG8_MMA(1, 1, At, B1); PG8_BAR; PG8_SCHED;
            PG8_LDB(B0, 1, 0); PG8_LDB(B1, 1, 1); PG8_SCHED; PG8_LDA(At, 1, 0); PG8_STAGE_A(PG8_SA(0, 1), a2, 1, v2);
            PG8_WAIT_V(8); PG8_WAIT_L(0); PG8_BAR; PG8_MMA(0, 0, At, B0); PG8_MMA(0, 1, At, B1); PG8_BAR; PG8_SCHED;
            PG8_LDA(At, 1, 1); PG8_STAGE(PG8_SB(1, 0), b3, voffB); PG8_STAGE(PG8_SB(1, 1), b3 + hstep, voffB); PG8_STAGE_A(PG8_SA(1, 0), a3, 0, v2);
            PG8_WAIT_V(8); PG8_WAIT_L(0); PG8_BAR; PG8_MMA(1, 0, At, B0); PG8_MMA(1, 1, At, B1); PG8_BAR; PG8_SCHED;
        }
        if constexpr (ALIGN_EPI) { if (wr == 0) PG8_BAR; }
        if constexpr (F8 != 0) {
            asm volatile("s_nop 15\n\ts_nop 15" : "+v"(acc[1][0][0][0]), "+v"(acc[1][0][0][1]), "+v"(acc[1][0][1][0]), "+v"(acc[1][0][1][1]), "+v"(acc[1][0][2][0]), "+v"(acc[1][0][2][1]), "+v"(acc[1][0][3][0]), "+v"(acc[1][0][3][1]) :: "memory");
            asm volatile("" : "+v"(acc[1][1][0][0]), "+v"(acc[1][1][0][1]), "+v"(acc[1][1][1][0]), "+v"(acc[1][1][1][1]), "+v"(acc[1][1][2][0]), "+v"(acc[1][1][2][1]), "+v"(acc[1][1][3][0]), "+v"(acc[1][1][3][1]) :: "memory"); }
        if constexpr (F8 == 2) {
#pragma unroll
            for (int a_ = 0; a_ < 2; ++a_)
#pragma unroll
                for (int b_ = 0; b_ < 2; ++b_)
#pragma unroll
                    for (int m = 0; m < 4; ++m)
#pragma unroll
                        for (int n = 0; n < 2; ++n) { const i32x4_t iv = __builtin_bit_cast(i32x4_t, acc[a_][b_][m][n]); acc[a_][b_][m][n] = (f32x4){(float)iv[0], (float)iv[1], (float)iv[2], (float)iv[3]}; } }
        E(acc, cur, wr, wc, fr, fq);
        if (!has_next) break;
        { const float z = zero_v();
#pragma unroll
        for (int a = 0; a < 2; ++a)
#pragma unroll
            for (int b = 0; b < 2; ++b)
#pragma unroll
                for (int m = 0; m < 4; ++m)
#pragma unroll
                    for (int n = 0; n < 2; ++n) acc[a][b][m][n] = (f32x4){z, z, z, z}; }
        cur = nxt; cA = nA; cB = nB; ++ui;
        if constexpr (GATHER) {
#pragma unroll
            for (int _h = 0; _h < 2; ++_h) { vc[_h][0] = vn[_h][0]; vc[_h][1] = vn[_h][1]; } }
        if constexpr (ALIGN_EPI) { if (wr == 1) PG8_BAR; }
    }
    PG8_WAIT_V(0);
    if constexpr (!ALIGN_EPI) { if (wr == 0) PG8_BAR; }
    PG8_BAR;
#undef PG8_SA
#undef PG8_SB
#undef PG8_STAGE
#undef PG8_STAGE_A
#undef PG8_LDA
#undef PG8_LDB
#undef PG8_CAT
#undef PG8_MMA
#undef PG8_WAIT_V
#undef PG8_WAIT_L
#undef PG8_BAR
#undef PG8_SCHED
#undef PG8_GT_DMA
#undef PG8_GT_READ
}
}
namespace attn_body {
using bf16=__hip_bfloat16;
using bf16x8=__attribute__((ext_vector_type(8)))short;
using s16x4=__attribute__((ext_vector_type(4)))short;
using f32x16=__attribute__((ext_vector_type(16)))float;
using u32x4=__attribute__((ext_vector_type(4)))unsigned;
constexpr int D=64,KP=64;
constexpr int NW=8,QBLK=32,QB=QBLK*NW,KVBLK=64;
__device__ __forceinline__ int crow(int r,int hi){return (r&3)+8*(r>>2)+4*hi;}
#define SBAR() __builtin_amdgcn_sched_barrier(0)
constexpr int NSLOT=3, SLOTB=8192;
constexpr int LDS_K=0, LDS_V=NSLOT*SLOTB, LDS_WS=2*NSLOT*SLOTB, LDS_OST=LDS_WS+NW*64*4, LDS_BYTES=LDS_OST+NW*4096;
constexpr float C2=0.125f*1.4426950408889634f;
__device__ __forceinline__ void glds16(const void*gsrc,unsigned lds_dst){unsigned keep;
  asm volatile("s_mov_b32 %0, m0\n\ts_mov_b32 m0, %2\n\ts_nop 0\n\tglobal_load_lds_dwordx4 %1, off\n\ts_mov_b32 m0, %0":"=&s"(keep):"v"(gsrc),"s"(lds_dst):"memory");}
__device__ __forceinline__ float max3f(float a,float b,float c){float r;asm("v_max3_f32 %0, %1, %2, %3":"=v"(r):"v"(a),"v"(b),"v"(c));return r;}
__device__ __forceinline__ float max2f(float a,float b){float r;asm("v_max_f32_e32 %0, %1, %2":"=v"(r):"v"(a),"v"(b));return r;}
__device__ __forceinline__ float fadd_s(float a,float b){float r;asm("v_add_f32_e32 %0, %1, %2":"=v"(r):"v"(a),"v"(b));return r;}
__device__ __forceinline__ float fsub_s(float a,float b){float r;asm("v_sub_f32_e32 %0, %1, %2":"=v"(r):"v"(a),"v"(b));return r;}
typedef float f32x2_t __attribute__((ext_vector_type(2))); typedef __bf16 bf16x2_t __attribute__((ext_vector_type(2)));
__device__ __forceinline__ unsigned cvtpk_s(float lo,float hi){f32x2_t v={lo,hi};bf16x2_t b=__builtin_convertvector(v,bf16x2_t);return __builtin_bit_cast(unsigned,b);}
#define WAIT_BAR(N) asm volatile("s_waitcnt vmcnt(" #N ") lgkmcnt(0)\n\ts_barrier":::"memory")

__device__ __forceinline__ void qkt(f32x16&p0,f32x16&p1,const char*Kslot,const bf16x8*qr,const f32x16&negm,int r32,int hi){
  const char*kb=Kslot+hi*1024+r32*16;
  #pragma unroll
  for(int d0=0;d0<4;++d0){
    const bf16x8 b0=*reinterpret_cast<const bf16x8*>(kb+d0*2048);
    const bf16x8 b1=*reinterpret_cast<const bf16x8*>(kb+d0*2048+512);
    if(d0==0){p0=__builtin_amdgcn_mfma_f32_32x32x16_bf16(b0,qr[0],negm,0,0,0);p1=__builtin_amdgcn_mfma_f32_32x32x16_bf16(b1,qr[0],negm,0,0,0);}
    else{p0=__builtin_amdgcn_mfma_f32_32x32x16_bf16(b0,qr[d0],p0,0,0,0);p1=__builtin_amdgcn_mfma_f32_32x32x16_bf16(b1,qr[d0],p1,0,0,0);}}
}
typedef __attribute__((address_space(3))) const char* lds_cptr;
typedef short v4i16_t __attribute__((ext_vector_type(4)));
__device__ __forceinline__ void kload8(bf16x8*kf,lds_cptr kp){
  kf[0]=*(const __attribute__((address_space(3))) bf16x8*)(kp);      kf[1]=*(const __attribute__((address_space(3))) bf16x8*)(kp+512);
  kf[2]=*(const __attribute__((address_space(3))) bf16x8*)(kp+2048); kf[3]=*(const __attribute__((address_space(3))) bf16x8*)(kp+2560);
  kf[4]=*(const __attribute__((address_space(3))) bf16x8*)(kp+4096); kf[5]=*(const __attribute__((address_space(3))) bf16x8*)(kp+4608);
  kf[6]=*(const __attribute__((address_space(3))) bf16x8*)(kp+6144); kf[7]=*(const __attribute__((address_space(3))) bf16x8*)(kp+6656);
}
__device__ __forceinline__ void kload2(bf16x8*kf,lds_cptr kp,int j){ kf[2*j]=*(const __attribute__((address_space(3))) bf16x8*)(kp+j*2048); kf[2*j+1]=*(const __attribute__((address_space(3))) bf16x8*)(kp+j*2048+512); }
__device__ __forceinline__ s16x4 vtr(lds_cptr p){ return __builtin_bit_cast(s16x4,__builtin_amdgcn_ds_read_tr16_b64_v4i16((__attribute__((address_space(3))) v4i16_t*)p)); }
__device__ __forceinline__ float rowmax(const f32x16&p0,const f32x16&p1){
  float a=max3f(p0[0],p0[1],p1[0]),b=max3f(p0[2],p0[3],p1[1]);a=max3f(a,p1[2],p1[3]);
  #pragma unroll
  for(int r=4;r<16;r+=4){a=max3f(a,p0[r],p0[r+1]);b=max3f(b,p0[r+2],p0[r+3]);a=max3f(a,p1[r],p1[r+1]);b=max3f(b,p1[r+2],p1[r+3]);}
  const float m=max2f(a,b);
  auto rr=__builtin_amdgcn_permlane32_swap(__float_as_uint(m),__float_as_uint(m),false,false);
  return max2f(__uint_as_float(rr[0]),__uint_as_float(rr[1]));
}
__device__ __forceinline__ void pv(f32x16*o,int vb,bf16x8 pa0,bf16x8 pa1,bf16x8 pa2,bf16x8 pa3){
  #pragma unroll
  for(int d0=0;d0<2;++d0){s16x4 lo[4],hi[4];
    #pragma unroll
    for(int ks=0;ks<4;++ks){
      asm volatile("ds_read_b64_tr_b16 %0,%1 offset:%c2":"=&v"(lo[ks]):"v"(vb),"i"(d0*4096+ks*1024):"memory");
      asm volatile("ds_read_b64_tr_b16 %0,%1 offset:%c2":"=&v"(hi[ks]):"v"(vb),"i"(d0*4096+ks*1024+512):"memory");}
    asm volatile("s_waitcnt lgkmcnt(0)":::"memory");SBAR();
    #define PK(k) (bf16x8){lo[k][0],lo[k][1],lo[k][2],lo[k][3],hi[k][0],hi[k][1],hi[k][2],hi[k][3]}
    o[d0]=__builtin_amdgcn_mfma_f32_32x32x16_bf16(pa0,PK(0),o[d0],0,0,0);
    o[d0]=__builtin_amdgcn_mfma_f32_32x32x16_bf16(pa1,PK(1),o[d0],0,0,0);
    o[d0]=__builtin_amdgcn_mfma_f32_32x32x16_bf16(pa2,PK(2),o[d0],0,0,0);
    o[d0]=__builtin_amdgcn_mfma_f32_32x32x16_bf16(pa3,PK(3),o[d0],0,0,0);
    #undef PK
  }
}

__device__ __forceinline__ void attn_unit(const int tid,const float mref,const bf16*Qu,int QP,const bf16*__restrict__ Kh,const bf16*__restrict__ Vh,int NT,bf16*Ou,int OP,char*shm){
  const int lane=tid&63,r32=lane&31,hi=lane>>5; const int wid=__builtin_amdgcn_readfirstlane(tid>>6);
  const bf16*Qw=Qu+(long)(wid*QBLK)*QP;
  const unsigned lds0=(unsigned)(uintptr_t)shm;
  float*wsf=(float*)(shm+LDS_WS)+wid*64;
  const bf16*ksrc=Kh+(long)lane*KP+wid*8;
  const bf16*vsrc=Vh+(long)(16*(wid&3)+(lane>>2))*KP+(wid>>2)*32+(lane&3)*8;
  const unsigned kdst=lds0+LDS_K+wid*1024, vdst=lds0+LDS_V+wid*1024;
  #define DMA_K(t,slot) glds16(ksrc+(long)(t)*KVBLK*KP,(unsigned)__builtin_amdgcn_readfirstlane(kdst+(slot)))
  #define DMA_V(t,slot) glds16(vsrc+(long)(t)*KVBLK*KP,(unsigned)__builtin_amdgcn_readfirstlane(vdst+(slot)))
  const int vb0=(int)(lds0+LDS_V)+((lane>>4)&1)*32+(lane&3)*8+(4*hi+((lane&15)>>2))*64;
  const char*Kbase=shm+LDS_K; bf16x8 kf[8];
  const lds_cptr shm3=(lds_cptr)shm; const lds_cptr kp0=shm3+LDS_K+hi*1024+r32*16; const lds_cptr vp0=shm3+LDS_V+((lane>>4)&1)*32+(lane&3)*8+(4*hi+((lane&15)>>2))*64;
  DMA_K(0,0);DMA_V(0,0);DMA_K(1,SLOTB);
  bf16x8 qr[4];
  #pragma unroll
  for(int d0=0;d0<4;++d0)qr[d0]=*reinterpret_cast<const bf16x8*>(&Qw[(long)r32*QP+d0*16+hi*8]);
  float l_reg=0.f;f32x16 o[2],negm; { const float z=pg8::zero_v(); _Pragma("unroll") for(int r=0;r<16;++r){o[0][r]=z;o[1][r]=z;negm[r]=z-mref;} } asm volatile("":"+v"(negm));
  f32x16 pA0,pA1,pB0,pB1;
  int sl_prev=0,sl_cur=0,sl_next=SLOTB;
  #define ROT() do{sl_prev=sl_cur;sl_cur=sl_next;sl_next=(sl_next==(NSLOT-1)*SLOTB)?0:sl_next+SLOTB;}while(0)
  DMA_K(2,2*SLOTB);
  WAIT_BAR(3);
  qkt(pA0,pA1,Kbase,qr,negm,r32,hi);asm volatile("s_nop 15\n\ts_nop 7":"+v"(pA0),"+v"(pA1));
  _Pragma("unroll") for(int r=0;r<16;++r){pA0[r]=__builtin_amdgcn_exp2f(pA0[r]);pA1[r]=__builtin_amdgcn_exp2f(pA1[r]);}
  WAIT_BAR(0);
  DMA_K(3,0);DMA_V(1,SLOTB);
  ROT();
  kload8(kf,kp0+sl_cur);
  WAIT_BAR(2);
  s16x4 vlo[8],vhi[8]; u32x4 pw0,pw1,pw2,pw3;
  #define MFX(a_,b_,c_) __builtin_amdgcn_mfma_f32_32x32x16_bf16(a_,b_,c_,0,0,0)
  #define PKW(P,B) cvtpk_s(P[B],P[B+1])
  #define PAF(k) __builtin_bit_cast(bf16x8,pw##k)
  #define VFR(i) (bf16x8){vlo[i][0],vlo[i][1],vlo[i][2],vlo[i][3],vhi[i][0],vhi[i][1],vhi[i][2],vhi[i][3]}
  #define PIN(x) asm volatile("":"+v"(x))
  #define GAPA(MF,A0,A1,A2,A3,W0,W1,PW) do{ MF; sacc+=A0; sacc+=A1; sacc+=A2; sacc+=A3; PIN(sacc); W0; W1; PIN(PW); SBAR(); }while(0)
  #define EX(v) __builtin_amdgcn_exp2f(v)
  #define GAPB(MF,X,B) do{ MF; X[B]=EX(X[B]); X[B+1]=EX(X[B+1]); X[B+2]=EX(X[B+2]); X[B+3]=EX(X[B+3]); PIN(X); SBAR(); }while(0)
  #define VRD(i) do{ vlo[i]=vtr(vp_+(((i)>>2)*4096+((i)&3)*1024)); vhi[i]=vtr(vp_+(((i)>>2)*4096+((i)&3)*1024+512)); }while(0)
  #define KRD(G,j) do{ if(G){ kload2(kf,kp0+sl_next,j); SBAR(); } }while(0)
  #define STEP(C0,C1,P0,P1,t,GK,GV,GL) do{ SBAR(); \
    const lds_cptr vp_=vp0+sl_prev; \
    VRD(0); SBAR(); float sacc=(P0[0]+P0[1]); \
    GAPA(C0=MFX(kf[0],qr[0],negm), P0[2],P0[3],P0[4],P0[5],     pw0[0]=PKW(P0,0), pw0[1]=PKW(P0,2), pw0); \
    VRD(4); SBAR(); GAPA(C1=MFX(kf[1],qr[0],negm), P0[6],P0[7],P0[8],P0[9],     pw0[2]=PKW(P0,4), pw0[3]=PKW(P0,6), pw0); \
    VRD(1); SBAR(); GAPA(C0=MFX(kf[2],qr[1],C0),   P0[10],P0[11],P0[12],P0[13], pw1[0]=PKW(P0,8), pw1[1]=PKW(P0,10), pw1); \
    VRD(5); SBAR(); GAPA(C1=MFX(kf[3],qr[1],C1),   P0[14],P0[15],P1[0],P1[1],   pw1[2]=PKW(P0,12),pw1[3]=PKW(P0,14), pw1); \
    VRD(2); SBAR(); GAPA(C0=MFX(kf[4],qr[2],C0),   P1[2],P1[3],P1[4],P1[5],     pw2[0]=PKW(P1,0), pw2[1]=PKW(P1,2), pw2); \
    VRD(6); SBAR(); GAPA(C1=MFX(kf[5],qr[2],C1),   P1[6],P1[7],P1[8],P1[9],     pw2[2]=PKW(P1,4), pw2[3]=PKW(P1,6), pw2); \
    VRD(3); SBAR(); GAPA(C0=MFX(kf[6],qr[3],C0),   P1[10],P1[11],P1[12],P1[13], pw3[0]=PKW(P1,8), pw3[1]=PKW(P1,10), pw3); \
    VRD(7); SBAR(); GAPA(C1=MFX(kf[7],qr[3],C1),   P1[14],P1[15],0.f,0.f,       pw3[2]=PKW(P1,12),pw3[3]=PKW(P1,14), pw3); \
    l_reg+=sacc; \
    if(GK){DMA_K((t)+3,sl_cur);} if(GV){DMA_V((t)+1,sl_next);} \
    SBAR(); \
    GAPB(o[0]=MFX(PAF(0),VFR(0),o[0]), C0,0); \
    GAPB(o[1]=MFX(PAF(0),VFR(4),o[1]), C0,4); \
    KRD(GL,0); GAPB(o[0]=MFX(PAF(1),VFR(1),o[0]), C0,8); \
    KRD(GL,1); GAPB(o[1]=MFX(PAF(1),VFR(5),o[1]), C0,12); \
    KRD(GL,2); GAPB(o[0]=MFX(PAF(2),VFR(2),o[0]), C1,0); \
    KRD(GL,3); GAPB(o[1]=MFX(PAF(2),VFR(6),o[1]), C1,4); \
    GAPB(o[0]=MFX(PAF(3),VFR(3),o[0]), C1,8); \
    GAPB(o[1]=MFX(PAF(3),VFR(7),o[1]), C1,12); \
    }while(0)
  int t=1;
  for(;t+5<NT;t+=2){
    STEP(pB0,pB1,pA0,pA1,t,true,true,true);     WAIT_BAR(2); ROT();
    STEP(pA0,pA1,pB0,pB1,t+1,true,true,true);   WAIT_BAR(2); ROT();
  }
  #define ENDW(tt) do{ if((tt)+3<NT){WAIT_BAR(2);} else if((tt)+2<NT){WAIT_BAR(1);} else {WAIT_BAR(0);} }while(0)
  for(;t+1<NT;t+=2){
    STEP(pB0,pB1,pA0,pA1,t,(t+3<NT),(t+1<NT),(t+1<NT));       ENDW(t);   ROT();
    STEP(pA0,pA1,pB0,pB1,t+1,(t+4<NT),(t+2<NT),(t+2<NT));     ENDW(t+1); ROT();
  }
  STEP(pB0,pB1,pA0,pA1,NT-1,false,false,false);
  { float sacc=pB0[0]+pB0[1]; _Pragma("unroll") for(int r=2;r<16;++r)sacc+=pB0[r]; _Pragma("unroll") for(int r=0;r<16;++r)sacc+=pB1[r]; l_reg+=sacc;
    pw0=(u32x4){PKW(pB0,0),PKW(pB0,2),PKW(pB0,4),PKW(pB0,6)};pw1=(u32x4){PKW(pB0,8),PKW(pB0,10),PKW(pB0,12),PKW(pB0,14)};pw2=(u32x4){PKW(pB1,0),PKW(pB1,2),PKW(pB1,4),PKW(pB1,6)};pw3=(u32x4){PKW(pB1,8),PKW(pB1,10),PKW(pB1,12),PKW(pB1,14)};
    SBAR(); pv(o,vb0+sl_cur,PAF(0),PAF(1),PAF(2),PAF(3)); }
  #undef PKW
  #undef PAF
  #undef VFR
  #undef PIN
  #undef GAPA
  #undef GAPB
  #undef EX
  #undef VRD
  #undef KRD
  #undef STEP
  #undef MFX
  #undef ENDW
  {auto rr=__builtin_amdgcn_permlane32_swap(__float_as_uint(l_reg),__float_as_uint(l_reg),false,false);l_reg=__uint_as_float(rr[0])+__uint_as_float(rr[1]);}
  if(hi==0)wsf[32+r32]=l_reg;asm volatile("s_waitcnt lgkmcnt(0)":::"memory");
  float rli[16];
  #pragma unroll
  for(int r=0;r<16;++r)rli[r]=__builtin_amdgcn_rcpf(wsf[32+crow(r,hi)]);
  bf16*Ow=Ou+(long)(wid*QBLK)*OP;
  { bf16*stg=(bf16*)(shm+LDS_OST)+wid*2048;
    #pragma unroll
    for(int r=0;r<16;++r){const int orow=crow(r,hi);
      #pragma unroll
      for(int d0=0;d0<2;++d0)stg[orow*64+d0*32+r32]=__float2bfloat16(o[d0][r]*rli[r]);}
    asm volatile("s_waitcnt lgkmcnt(0)":::"memory");
    #pragma unroll
    for(int i=0;i<4;++i){const int row=i*8+(lane>>3),ch=lane&7; const u32x4 v=*(const u32x4*)(stg+row*64+ch*8); *(u32x4*)(Ow+(long)row*OP+ch*8)=v;} }
  asm volatile("s_waitcnt lgkmcnt(0)\n\ts_barrier":::"memory");
  #undef DMA_K
  #undef DMA_V
  #undef ROT
}

typedef int v8i __attribute__((ext_vector_type(8)));
typedef int v4i __attribute__((ext_vector_type(4)));
typedef unsigned v2u_t __attribute__((ext_vector_type(2)));
constexpr int F8_SLOTB=4096, F8_LDS_K=0, F8_LDS_V=3*F8_SLOTB, F8_LDS_WS=6*F8_SLOTB, F8_OSTP=144, F8_LDS_OST=F8_LDS_WS+2048, F8_LDS_BYTES=F8_LDS_OST+NW*32*F8_OSTP;
constexpr float F8_SH=13.0f;
#define MF8(a_,b_,c_,BF) __builtin_amdgcn_mfma_scale_f32_32x32x64_f8f6f4(a_,b_,c_,0,BF,0,0,0,0)
typedef __attribute__((address_space(3))) const v4i* lds_v4p;
__device__ __forceinline__ v8i ld256(lds_cptr p){ const v4i a=*(lds_v4p)(p), b=*(lds_v4p)(p+1024); return __builtin_shufflevector(a,b,0,1,2,3,4,5,6,7); }
__device__ __forceinline__ void attn_unit8(const int tid,const float mref,const unsigned char*Qu,int QP,const unsigned char*__restrict__ Kh,const unsigned char*__restrict__ Vh,int NT,bf16*Ou,int OP,char*shm){
  const int lane=tid&63,r32=lane&31,hi=lane>>5; const int wid=__builtin_amdgcn_readfirstlane(tid>>6);
  const unsigned lds0=(unsigned)(uintptr_t)shm;
  const bool isK=wid<4;
  const unsigned char*dsrc=(isK?Kh:Vh)+(wid&3)*1024+lane*16;
  const unsigned ddst=lds0+(isK?F8_LDS_K:F8_LDS_V)+(wid&3)*1024;
  #define DMA8(tk,sk,tv,sv) glds16(dsrc+(long)(isK?(tk):(tv))*4096,(unsigned)__builtin_amdgcn_readfirstlane(ddst+(isK?(sk):(sv))))
  const lds_cptr shm3=(lds_cptr)shm; const lds_cptr kp0=shm3+F8_LDS_K+hi*2048+r32*16; const lds_cptr vp0=shm3+F8_LDS_V+hi*2048+r32*16;
  DMA8(0,0,0,0); if(isK){DMA8(1,F8_SLOTB,0,0);}
  v8i qf; { const unsigned char*qp=Qu+(long)(wid*QBLK+r32)*QP+32*hi; const v4i a=*(const v4i*)qp, b=*(const v4i*)(qp+16); qf=__builtin_shufflevector(a,b,0,1,2,3,4,5,6,7); }
  f32x16 o[2],lacc,negm; { const float z=pg8::zero_v(); _Pragma("unroll") for(int r=0;r<16;++r){o[0][r]=z;o[1][r]=z;lacc[r]=z;negm[r]=z-mref+F8_SH;} } asm volatile("":"+v"(negm));
  v8i ones,pw; { int o1; asm volatile("v_mov_b32 %0, 0x38383838":"=v"(o1)); _Pragma("unroll") for(int j=0;j<8;++j){ones[j]=o1;pw[j]=o1;} } asm volatile("":"+v"(ones));
  f32x16 pA0,pA1,pB0,pB1; v8i kf[2],vf[2];
  int sl_prev=0,sl_cur=0,sl_next=F8_SLOTB;
  #define ROT() do{sl_prev=sl_cur;sl_cur=sl_next;sl_next=(sl_next==2*F8_SLOTB)?0:sl_next+F8_SLOTB;}while(0)
  if(isK){DMA8(2,2*F8_SLOTB,0,0);}
  WAIT_BAR(3);
  kf[0]=ld256(kp0); kf[1]=ld256(kp0+512);
  pA0=MF8(kf[0],qf,negm,0); pA1=MF8(kf[1],qf,negm,0);
  _Pragma("unroll") for(int r=0;r<16;++r){pA0[r]=__builtin_amdgcn_exp2f(pA0[r]);pA1[r]=__builtin_amdgcn_exp2f(pA1[r]);}
  WAIT_BAR(0);
  DMA8(3,0,1,F8_SLOTB);
  ROT();
  kf[0]=ld256(kp0+sl_cur); kf[1]=ld256(kp0+sl_cur+512);
  WAIT_BAR(1);
  #define PIN(x) asm volatile("":"+v"(x))
  #define EX(v) __builtin_amdgcn_exp2f(v)
  #define CV4(W,P,B) do{ W=__builtin_amdgcn_cvt_pk_bf8_f32(P[B],P[(B)+1],W,false); W=__builtin_amdgcn_cvt_pk_bf8_f32(P[(B)+2],P[(B)+3],W,true); }while(0)
  #define STEP8(C0,C1,P0,P1,t,GK,GV,GL) do{ SBAR(); \
    const lds_cptr vp_=vp0+sl_prev; \
    vf[0]=ld256(vp_); SBAR(); \
    C0=MF8(kf[0],qf,negm,0); CV4(pw[0],P0,0); CV4(pw[1],P0,4); CV4(pw[2],P0,8); CV4(pw[3],P0,12); PIN(pw); SBAR(); \
    vf[1]=ld256(vp_+512); SBAR(); \
    C1=MF8(kf[1],qf,negm,0); CV4(pw[4],P1,0); CV4(pw[5],P1,4); CV4(pw[6],P1,8); CV4(pw[7],P1,12); PIN(pw); SBAR(); \
    if(isK?(GK):(GV)){DMA8((t)+3,sl_cur,(t)+1,sl_next);} \
    SBAR(); \
    o[0]=MF8(vf[0],pw,o[0],1); \
    C0[0]=EX(C0[0]);C0[1]=EX(C0[1]);C0[2]=EX(C0[2]);C0[3]=EX(C0[3]);C0[4]=EX(C0[4]);C0[5]=EX(C0[5]);C0[6]=EX(C0[6]);C0[7]=EX(C0[7]);C0[8]=EX(C0[8]);C0[9]=EX(C0[9]);C0[10]=EX(C0[10]); PIN(C0); SBAR(); \
    if(GL){ kf[0]=ld256(kp0+sl_next); SBAR(); } \
    o[1]=MF8(vf[1],pw,o[1],1); \
    C0[11]=EX(C0[11]);C0[12]=EX(C0[12]);C0[13]=EX(C0[13]);C0[14]=EX(C0[14]);C0[15]=EX(C0[15]);C1[0]=EX(C1[0]);C1[1]=EX(C1[1]);C1[2]=EX(C1[2]);C1[3]=EX(C1[3]);C1[4]=EX(C1[4]);C1[5]=EX(C1[5]); PIN(C0); PIN(C1); SBAR(); \
    if(GL){ kf[1]=ld256(kp0+sl_next+512); SBAR(); } \
    lacc=MF8(ones,pw,lacc,1); \
    C1[6]=EX(C1[6]);C1[7]=EX(C1[7]);C1[8]=EX(C1[8]);C1[9]=EX(C1[9]);C1[10]=EX(C1[10]);C1[11]=EX(C1[11]);C1[12]=EX(C1[12]);C1[13]=EX(C1[13]);C1[14]=EX(C1[14]);C1[15]=EX(C1[15]); PIN(C1); SBAR(); \
    }while(0)
  int t=1;
  for(;t+5<NT;t+=2){
    STEP8(pB0,pB1,pA0,pA1,t,true,true,true);     WAIT_BAR(1); ROT();
    STEP8(pA0,pA1,pB0,pB1,t+1,true,true,true);   WAIT_BAR(1); ROT();
  }
  #define ENDW8(tt) do{ if((tt)+3<NT){WAIT_BAR(1);} else {WAIT_BAR(0);} }while(0)
  for(;t+1<NT;t+=2){
    STEP8(pB0,pB1,pA0,pA1,t,(t+3<NT),(t+1<NT),(t+1<NT));       ENDW8(t);   ROT();
    STEP8(pA0,pA1,pB0,pB1,t+1,(t+4<NT),(t+2<NT),(t+2<NT));     ENDW8(t+1); ROT();
  }
  STEP8(pB0,pB1,pA0,pA1,NT-1,false,false,false);
  { CV4(pw[0],pB0,0); CV4(pw[1],pB0,4); CV4(pw[2],pB0,8); CV4(pw[3],pB0,12); CV4(pw[4],pB1,0); CV4(pw[5],pB1,4); CV4(pw[6],pB1,8); CV4(pw[7],pB1,12);
    const lds_cptr vp_=vp0+sl_cur; vf[0]=ld256(vp_); vf[1]=ld256(vp_+512);
    o[0]=MF8(vf[0],pw,o[0],1); o[1]=MF8(vf[1],pw,o[1],1); lacc=MF8(ones,pw,lacc,1); }
  #undef PIN
  #undef EX
  #undef CV4
  #undef STEP8
  #undef ENDW8
  { const float rl=__builtin_amdgcn_rcpf(lacc[0]);
    typedef __attribute__((address_space(3))) char* lds_wptr;
    const lds_wptr stg=(lds_wptr)shm+F8_LDS_OST+wid*(32*F8_OSTP);
    #pragma unroll
    for(int m=0;m<2;++m)
      #pragma unroll
      for(int g=0;g<4;++g){ v2u_t w; w.x=cvtpk_s(o[m][4*g]*rl,o[m][4*g+1]*rl); w.y=cvtpk_s(o[m][4*g+2]*rl,o[m][4*g+3]*rl);
        *(__attribute__((address_space(3))) v2u_t*)(stg+r32*F8_OSTP+(32*m+8*g+4*hi)*2)=w; }
    asm volatile("s_waitcnt lgkmcnt(0)":::"memory");
    bf16*Ow=Ou+(long)(wid*QBLK)*OP;
    #pragma unroll
    for(int i=0;i<4;++i){const int row=i*8+(lane>>3),ch=lane&7; const u32x4 v=*(const __attribute__((address_space(3))) u32x4*)(stg+row*F8_OSTP+ch*16); *(u32x4*)(Ow+(long)row*OP+ch*8)=v;} }
  asm volatile("s_waitcnt lgkmcnt(0)\n\ts_barrier":::"memory");
  #undef DMA8
  #undef ROT
}
constexpr int F8P_NS=5, F8P_LDS_V=F8P_NS*F8_SLOTB, F8P_LDS_OST=2*F8P_NS*F8_SLOTB, F8P_LDS_BYTES=F8P_LDS_OST+NW*32*F8_OSTP;
__device__ __forceinline__ void attn_unit8p(const int tid,const float mref,const unsigned char*Qu,int QP,const unsigned char*__restrict__ Kh,const unsigned char*__restrict__ Vh,int NT,bf16*Ou,int OP,char*shm){
  const int lane=tid&63,r32=lane&31,hi=lane>>5; const int wid=__builtin_amdgcn_readfirstlane(tid>>6);
  const unsigned lds0=(unsigned)(uintptr_t)shm;
  const bool isK=wid<4;
  const unsigned char*dsrc=(isK?Kh:Vh)+(wid&3)*1024+lane*16;
  const unsigned ddst=lds0+(isK?0:F8P_LDS_V)+(wid&3)*1024;
  #define DMA8(tk,sk,tv,sv) glds16(dsrc+(long)(isK?(tk):(tv))*4096,(unsigned)__builtin_amdgcn_readfirstlane(ddst+(isK?(sk):(sv))))
  #define WR(x) (((x)>=F8P_NS*F8_SLOTB)?((x)-F8P_NS*F8_SLOTB):(x))
  const lds_cptr shm3=(lds_cptr)shm; const lds_cptr kp0=shm3+hi*2048+r32*16; const lds_cptr vp0=shm3+F8P_LDS_V+hi*2048+r32*16;
  DMA8(0,0,0,0); DMA8(1,F8_SLOTB,1,F8_SLOTB); DMA8(2,2*F8_SLOTB,2,2*F8_SLOTB); if(isK){DMA8(3,3*F8_SLOTB,0,0); DMA8(4,4*F8_SLOTB,0,0);}
  v8i qf; { const unsigned char*qp=Qu+(long)(wid*QBLK+r32)*QP+32*hi; const v4i a=*(const v4i*)qp, b=*(const v4i*)(qp+16); qf=__builtin_shufflevector(a,b,0,1,2,3,4,5,6,7); }
  f32x16 o[2],lacc,negm; { const float z=pg8::zero_v(); _Pragma("unroll") for(int r=0;r<16;++r){o[0][r]=z;o[1][r]=z;lacc[r]=z;negm[r]=z-mref+F8_SH;} } asm volatile("":"+v"(negm));
  v8i ones,pw; { int o1; asm volatile("v_mov_b32 %0, 0x38383838":"=v"(o1)); _Pragma("unroll") for(int j=0;j<8;++j){ones[j]=o1;pw[j]=o1;} } asm volatile("":"+v"(ones));
  f32x16 pA0,pA1,pB0,pB1; v8i kf[2],vf[2];
  WAIT_BAR(0);
  kf[0]=ld256(kp0); kf[1]=ld256(kp0+512);
  pA0=MF8(kf[0],qf,negm,0); pA1=MF8(kf[1],qf,negm,0);
  _Pragma("unroll") for(int r=0;r<16;++r){pA0[r]=__builtin_amdgcn_exp2f(pA0[r]);pA1[r]=__builtin_amdgcn_exp2f(pA1[r]);}
  kf[0]=ld256(kp0+F8_SLOTB); kf[1]=ld256(kp0+F8_SLOTB+512);
  WAIT_BAR(0);
  int sl=F8_SLOTB;
  #define PIN(x) asm volatile("":"+v"(x))
  #define EX(v) __builtin_amdgcn_exp2f(v)
  #define CV4(W,P,B) do{ W=__builtin_amdgcn_cvt_pk_bf8_f32(P[B],P[(B)+1],W,false); W=__builtin_amdgcn_cvt_pk_bf8_f32(P[(B)+2],P[(B)+3],W,true); }while(0)
  #define STEP8(C0,C1,P0,P1,t,GK,GV,GL) do{ SBAR(); \
    const int sl_p1=(sl==0)?(F8P_NS-1)*F8_SLOTB:sl-F8_SLOTB, sl_n1=WR(sl+F8_SLOTB), sl_n2=WR(sl+2*F8_SLOTB); \
    const lds_cptr vp_=vp0+sl_p1; \
    vf[0]=ld256(vp_); SBAR(); \
    C0=MF8(kf[0],qf,negm,0); CV4(pw[0],P0,0); CV4(pw[1],P0,4); CV4(pw[2],P0,8); CV4(pw[3],P0,12); PIN(pw); SBAR(); \
    vf[1]=ld256(vp_+512); SBAR(); \
    C1=MF8(kf[1],qf,negm,0); CV4(pw[4],P1,0); CV4(pw[5],P1,4); CV4(pw[6],P1,8); CV4(pw[7],P1,12); PIN(pw); SBAR(); \
    if(isK?(GK):(GV)){DMA8((t)+4,sl_p1,(t)+2,sl_n2);} \
    SBAR(); \
    o[0]=MF8(vf[0],pw,o[0],1); \
    C0[0]=EX(C0[0]);C0[1]=EX(C0[1]);C0[2]=EX(C0[2]);C0[3]=EX(C0[3]);C0[4]=EX(C0[4]);C0[5]=EX(C0[5]);C0[6]=EX(C0[6]);C0[7]=EX(C0[7]);C0[8]=EX(C0[8]);C0[9]=EX(C0[9]);C0[10]=EX(C0[10]); PIN(C0); SBAR(); \
    if(GL){ kf[0]=ld256(kp0+sl_n1); SBAR(); } \
    o[1]=MF8(vf[1],pw,o[1],1); \
    C0[11]=EX(C0[11]);C0[12]=EX(C0[12]);C0[13]=EX(C0[13]);C0[14]=EX(C0[14]);C0[15]=EX(C0[15]);C1[0]=EX(C1[0]);C1[1]=EX(C1[1]);C1[2]=EX(C1[2]);C1[3]=EX(C1[3]);C1[4]=EX(C1[4]);C1[5]=EX(C1[5]); PIN(C0); PIN(C1); SBAR(); \
    if(GL){ kf[1]=ld256(kp0+sl_n1+512); SBAR(); } \
    lacc=MF8(ones,pw,lacc,1); \
    C1[6]=EX(C1[6]);C1[7]=EX(C1[7]);C1[8]=EX(C1[8]);C1[9]=EX(C1[9]);C1[10]=EX(C1[10]);C1[11]=EX(C1[11]);C1[12]=EX(C1[12]);C1[13]=EX(C1[13]);C1[14]=EX(C1[14]);C1[15]=EX(C1[15]); PIN(C1); SBAR(); \
    sl=sl_n1; \
    }while(0)
  int t=1;
  for(;t+6<NT;t+=2){
    STEP8(pB0,pB1,pA0,pA1,t,true,true,true);
    STEP8(pA0,pA1,pB0,pB1,t+1,true,true,true);   WAIT_BAR(1);
  }
  for(;t+1<NT;t+=2){
    STEP8(pB0,pB1,pA0,pA1,t,(t+4<NT),(t+2<NT),true);
    STEP8(pA0,pA1,pB0,pB1,t+1,(t+5<NT),(t+3<NT),(t+2<NT));
    if(t+5<NT){WAIT_BAR(1);} else {WAIT_BAR(0);}
  }
  STEP8(pB0,pB1,pA0,pA1,NT-1,false,false,false);
  { CV4(pw[0],pB0,0); CV4(pw[1],pB0,4); CV4(pw[2],pB0,8); CV4(pw[3],pB0,12); CV4(pw[4],pB1,0); CV4(pw[5],pB1,4); CV4(pw[6],pB1,8); CV4(pw[7],pB1,12);
    const int sl_last=(sl==0)?(F8P_NS-1)*F8_SLOTB:sl-F8_SLOTB;
    const lds_cptr vp_=vp0+sl_last; vf[0]=ld256(vp_); vf[1]=ld256(vp_+512);
    o[0]=MF8(vf[0],pw,o[0],1); o[1]=MF8(vf[1],pw,o[1],1); lacc=MF8(ones,pw,lacc,1); }
  #undef PIN
  #undef EX
  #undef CV4
  #undef STEP8
  #undef WR
  { const float rl=__builtin_amdgcn_rcpf(lacc[0]);
    typedef __attribute__((address_space(3))) char* lds_wptr;
    const lds_wptr stg=(lds_wptr)shm+F8P_LDS_OST+wid*(32*F8_OSTP);
    #pragma unroll
    for(int m=0;m<2;++m)
      #pragma unroll
      for(int g=0;g<4;++g){ v2u_t w; w.x=cvtpk_s(o[m][4*g]*rl,o[m][4*g+1]*rl); w.y=cvtpk_s(o[m][4*g+2]*rl,o[m][4*g+3]*rl);
        *(__attribute__((address_space(3))) v2u_t*)(stg+r32*F8_OSTP+(32*m+8*g+4*hi)*2)=w; }
    asm volatile("s_waitcnt lgkmcnt(0)":::"memory");
    bf16*Ow=Ou+(long)(wid*QBLK)*OP;
    #pragma unroll
    for(int i=0;i<4;++i){const int row=i*8+(lane>>3),ch=lane&7; const u32x4 v=*(const __attribute__((address_space(3))) u32x4*)(stg+row*F8_OSTP+ch*16); *(u32x4*)(Ow+(long)row*OP+ch*8)=v;} }
  asm volatile("s_waitcnt lgkmcnt(0)\n\ts_barrier":::"memory");
  #undef DMA8
}
#undef MF8
#undef SBAR
#undef WAIT_BAR
}
#define GAS __attribute__((address_space(1)))
#define LAS __attribute__((address_space(3)))
typedef unsigned short bf16;
typedef unsigned v4u __attribute__((ext_vector_type(4)));
typedef float f32x4 __attribute__((ext_vector_type(4)));
typedef short bf16x8 __attribute__((ext_vector_type(8)));
typedef GAS unsigned gu32;
typedef GAS unsigned long long gu64;
#define RLX_AGENT __ATOMIC_RELAXED, __HIP_MEMORY_SCOPE_AGENT
#define LDS_WAIT() asm volatile("s_waitcnt lgkmcnt(0)" ::: "memory")
#define VM_WAIT() asm volatile("s_waitcnt vmcnt(0)" ::: "memory")
__device__ __forceinline__ unsigned long long rt() { return __builtin_amdgcn_s_memrealtime(); }
__device__ __forceinline__ unsigned f2bf(float f) { unsigned u = __builtin_bit_cast(unsigned, f); return (u + 0x7fffu + ((u >> 16) & 1u)) >> 16; }
__device__ __forceinline__ unsigned pk2(float lo, float hi) { return f2bf(lo) | (f2bf(hi) << 16); }

#define XB_TMO      128
#define XB_XCNT(j)  (256  + 64 * (j))
#define XB_XSUB(j)  (1280 + 64 * (j))
#define XB_XGEN(j)  (2304 + 64 * (j))
#define XB_TOP      3328
#define XB_TOPGEN   3392
#define XCD_BAR_WORDS 3456
#define XB_SPIN_CAP (1u << 18)

__device__ __forceinline__ unsigned xb_ld(unsigned* p)              { return __hip_atomic_load(p, __ATOMIC_RELAXED, __HIP_MEMORY_SCOPE_AGENT); }
__device__ __forceinline__ unsigned xb_add(unsigned* p, unsigned v) { return __hip_atomic_fetch_add(p, v, __ATOMIC_RELAXED, __HIP_MEMORY_SCOPE_AGENT); }
__device__ __forceinline__ unsigned xb_xcc_id() { return (unsigned)__builtin_amdgcn_s_getreg((3 << 11) | 20) & 0xFu; }
#define XB_SPIN(cond, bar) do { unsigned _sp = 0; while (cond) { __builtin_amdgcn_s_sleep(1); \
    if ((++_sp & 255u) == 0u) { if (xb_ld(&(bar)[XB_TMO])) break; if (_sp > XB_SPIN_CAP) { atomicAdd(&(bar)[XB_TMO], 1u); break; } } } } while (0)

struct XcdBarrier {
    unsigned* bar; unsigned x;
    volatile LAS unsigned* st;
};

__device__ __forceinline__ XcdBarrier xcd_barrier_post(unsigned* bar, volatile LAS unsigned* st) {
    XcdBarrier b; b.bar = bar; b.x = xb_xcc_id(); b.st = st;
    if (threadIdx.x == 0) (void)xb_add(&bar[XB_XCNT(b.x)], 1u);
    return b;
}
__device__ __forceinline__ void xcd_barrier_complete(unsigned* bar, unsigned x, unsigned& nloc, unsigned& nx) {
    const unsigned G = gridDim.x * gridDim.y * gridDim.z;
    unsigned sum, cnt, mine, sp = 0u;
    for (;;) {
        sum = 0u; cnt = 0u; mine = 0u;
#pragma unroll
        for (unsigned j = 0; j < 16; ++j) { const unsigned c = xb_ld(&bar[XB_XCNT(j)]); sum += c; cnt += (c > 0u) ? 1u : 0u; mine = (j == x) ? c : mine; }
        if (sum == G) break;
        __builtin_amdgcn_s_sleep(1);
        if ((++sp & 255u) == 0u) { if (xb_ld(&bar[XB_TMO])) break; if (sp > XB_SPIN_CAP) { atomicAdd(&bar[XB_TMO], 1u); break; } }
    }
    nloc = mine > 0u ? mine : 1u; nx = cnt > 0u ? cnt : 1u;
}

__device__ __forceinline__ void xcd_barrier(const XcdBarrier& b) {
    asm volatile("s_waitcnt vmcnt(0)" ::: "memory");
    __syncthreads();
    if (threadIdx.x == 0) {
        unsigned* bar = b.bar;
        __builtin_amdgcn_s_waitcnt(0);
        unsigned nloc = b.st[0], nx = b.st[1];
        if (nloc == 0u) { xcd_barrier_complete(bar, b.x, nloc, nx); b.st[0] = nloc; b.st[1] = nx; }
        const unsigned old = xb_add(&bar[XB_XSUB(b.x)], 1u);
        const unsigned gen = old / nloc;
        if (old + 1u == (gen + 1u) * nloc) {
            __builtin_amdgcn_fence(__ATOMIC_RELEASE, "agent");
            asm volatile("s_waitcnt vmcnt(0)" ::: "memory");
            const unsigned og = xb_add(&bar[XB_TOP], 1u);
            const unsigned tg = og / nx;
            if (og + 1u == (tg + 1u) * nx) xb_add(&bar[XB_TOPGEN], 1u);
            else XB_SPIN(xb_ld(&bar[XB_TOPGEN]) == tg, bar);
            __builtin_amdgcn_fence(__ATOMIC_ACQUIRE, "agent");
            xb_add(&bar[XB_XGEN(b.x)], 1u);
            asm volatile("s_waitcnt vmcnt(0)" ::: "memory");
        } else {
            XB_SPIN(xb_ld(&bar[XB_XGEN(b.x)]) == gen, bar);
            __builtin_amdgcn_fence(__ATOMIC_ACQUIRE, "agent");
            asm volatile("s_waitcnt vmcnt(0)" ::: "memory");
        }
    }
    __syncthreads();
}
constexpr int NWAVES = 8;
constexpr int DM = 1024, NB = 2, SEQ = 16384, CTX = 256, RB = SEQ + CTX  , NR = NB * RB  ;
constexpr int INW = 2048, FF = 2816, NE = 8, NCH = RB / 128  , NLAT = NB * SEQ;
constexpr float EPS = 1e-6f;
constexpr int PC_K = 512, PC_V = 640, PC_RQ = 768, PC_RK = 1024, PC_RV = 1280, PC_RG = 1536, PC_PP = 1792;
constexpr int MOE_TP = 104, MOE_PASSES = 3, LISTCAP = 32768;

constexpr size_t MiB = 1u << 20, U128K = 131072;
constexpr size_t WS_CTL = 0, CTL_ZERO_BYTES = 1 * MiB;
constexpr size_t WS_MODV = 1 * MiB;
constexpr size_t WS_ROPE = 1 * MiB + 256 * 1024;
constexpr size_t WS_DEC = WS_ROPE + 32768;
constexpr size_t WS_TOK = 3 * MiB / 2;
constexpr size_t WS_LIST = 5 * MiB / 2;
constexpr size_t WS_XC = 7 * MiB / 2;
constexpr size_t WS_WIN = 6 * MiB, WS_WOUT = 14 * MiB, WS_W13D = 18 * MiB, WS_W2D = 29 * MiB, WS_W13M = 35 * MiB, WS_W2M = 80 * MiB  , WS_XB = 103 * MiB  ;
constexpr size_t SZ_WIN = (size_t)INW * DM * 2, SZ_WOUT = (size_t)DM * DM * 2, SZ_W13 = (size_t)2 * FF * DM * 2, SZ_W2 = (size_t)DM * FF * 2;
constexpr size_t SZ8_W13 = SZ_W13 / 2, SZ8_W2 = SZ_W2 / 2;
constexpr size_t WS_AR = 168 * MiB;
constexpr size_t AR_P = 0, AR_QB = 1040 * U128K, AR_KC = 1300 * U128K, AR_VC = 1365 * U128K, AR_US = 1430 * U128K, AR_MIX = 1690 * U128K, AR_MX = 2210 * U128K;
constexpr size_t AR_HX2 = 0, AR_ACT = 520 * U128K, AR_YD = 2210 * U128K, AR_YM = 1664 * U128K;
constexpr size_t AR_PART0 = 1040 * U128K  , AR_PART1 = 0  ;
constexpr size_t AR_Q8 = AR_QB, AR_K8 = AR_QB + 136 * U128K, AR_V8 = AR_QB + 176 * U128K;
constexpr size_t DO_Q8 = AR_MX + 20 * MiB, DO_K8 = AR_MX + 40 * MiB, DO_V8 = AR_MX + 46 * MiB, DO_O8 = AR_US;
constexpr size_t WS_END = 512 * MiB;
static_assert(WS_XB + (size_t)NLAT * DM * 2 <= WS_AR && WS_W2M + 8 * SZ8_W2 <= WS_XB && WS_W13M + 8 * SZ8_W13 <= WS_W2M && WS_W13D + SZ_W13 <= WS_W2D && WS_W2D + SZ_W2 <= WS_W13M, "weights map");
static_assert(AR_MX + (size_t)NR * DM * 2 <= WS_END - WS_AR && AR_ACT + (size_t)NR * FF * 2 <= AR_YD && AR_YM + (size_t)264 * 256 * DM * 2 <= WS_END - WS_AR && AR_ACT + (size_t)MOE_TP * 256 * FF * 2 <= AR_YM, "arena map");
static_assert(AR_QB == (size_t)NR * INW * 2 && AR_KC == AR_QB + (size_t)NR * 512 * 2 && AR_US == AR_VC + (size_t)NR * 128 * 2 && AR_MIX == AR_US + (size_t)16 * NCH * 16384 && AR_MX == AR_MIX + (size_t)NR * DM * 2, "arena map 2");
constexpr int CW_TMO = 0, CW_CODE = 1, CW_CNT = 64  , CW_BAR = 4096;
constexpr int RING_BYTES = 131072, MISC_OFF = RING_BYTES + 320, GTAB_OFF = RING_BYTES + 1024, MOE_OFF = RING_BYTES + 2048, LDS_BYTES = 147456;

typedef unsigned v2u __attribute__((ext_vector_type(2)));
typedef float f32x16 __attribute__((ext_vector_type(16)));

struct Args { const float* in[24]; float* out; unsigned char* ws; int ph_lo, ph_hi, li, pad; };
enum { I_X = 0, I_C, I_CTX, I_CCTX, I_WMOD, I_BMOD, I_NPREMIX, I_NPOSTMIX, I_NPREFFN, I_NPOSTFFN, I_WIN, I_WOUT, I_QN, I_KN, I_DECAY, I_POOLW, I_POOLS, I_FW1, I_FW3, I_FW2, I_ROUTER, I_MW1, I_MW3, I_MW2 };

typedef const __attribute__((address_space(4))) Args* ArgP;
__device__ __forceinline__ ArgP args_here() { ArgP p = (ArgP)__builtin_amdgcn_kernarg_segment_ptr(); asm volatile("" : "+s"(p)); return p; }
struct Frame { LAS unsigned char* lds; int tid, lane, wave, G, gw, NGW, bx; };
__device__ __forceinline__ void relaunder(Frame& F) { int t = threadIdx.x; asm volatile("" : "+v"(t)); F.tid = t; F.lane = t & 63; F.wave = __builtin_amdgcn_readfirstlane(t >> 6);
    int g = gridDim.x; asm volatile("" : "+s"(g)); F.G = g; int bx = blockIdx.x; asm volatile("" : "+s"(bx)); F.bx = bx; F.gw = bx * NWAVES + F.wave; F.NGW = F.G * NWAVES; }

#ifndef ATT8_DEBUG
#define ATT8_DEBUG 0
#endif
#ifndef DENSE_F8
#define DENSE_F8 0
#endif
#ifndef MOE_F8
#define MOE_F8 1
#endif
#ifndef DENSE_I8UP
#define DENSE_I8UP 1
#endif
#ifndef MOE_I8UP
#define MOE_I8UP 1
#endif
#ifndef DENSE_DOWN_F8
#define DENSE_DOWN_F8 1
#endif
#ifndef IN_I8
#define IN_I8 3
#endif
constexpr float I8_XS = 20.0f, I8_XI = 20.0f, I8_WS = 1024.0f;
#ifndef IN1_F8
#define IN1_F8 0
#endif
__device__ __forceinline__ unsigned char* q8_ptr(ArgP a) { return ATT8_DEBUG ? a->ws + WS_AR + DO_Q8 : a->ws + WS_AR + AR_Q8; }
__device__ __forceinline__ unsigned char* k8_ptr(ArgP a) { return ATT8_DEBUG ? a->ws + WS_AR + DO_K8 : a->ws + WS_AR + AR_K8; }
__device__ __forceinline__ unsigned char* v8_ptr(ArgP a) { return ATT8_DEBUG ? a->ws + WS_AR + DO_V8 : a->ws + WS_AR + AR_V8; }
__device__ __forceinline__ unsigned fp8x4(float a, float b, float c, float d) { int w = 0; w = __builtin_amdgcn_cvt_pk_fp8_f32(a, b, w, false); w = __builtin_amdgcn_cvt_pk_fp8_f32(c, d, w, true); return (unsigned)w; }
__device__ __forceinline__ unsigned i8x4(float a, float b, float c, float d, float s) {
    unsigned w = 0;
    w = __builtin_amdgcn_cvt_pk_u8_f32(__builtin_amdgcn_fmed3f(__builtin_rintf(__builtin_fmaf(a, s, 128.0f)), 1.0f, 255.0f), 0, w);
    w = __builtin_amdgcn_cvt_pk_u8_f32(__builtin_amdgcn_fmed3f(__builtin_rintf(__builtin_fmaf(b, s, 128.0f)), 1.0f, 255.0f), 1, w);
    w = __builtin_amdgcn_cvt_pk_u8_f32(__builtin_amdgcn_fmed3f(__builtin_rintf(__builtin_fmaf(c, s, 128.0f)), 1.0f, 255.0f), 2, w);
    w = __builtin_amdgcn_cvt_pk_u8_f32(__builtin_amdgcn_fmed3f(__builtin_rintf(__builtin_fmaf(d, s, 128.0f)), 1.0f, 255.0f), 3, w);
    return w ^ 0x80808080u; }
__device__ __forceinline__ float bf_lo(unsigned u) { return __uint_as_float(u << 16); }
__device__ __forceinline__ float bf_hi(unsigned u) { return __uint_as_float(u & 0xffff0000u); }
__device__ __forceinline__ unsigned pkbf(float lo, float hi) { return attn_body::cvtpk_s(lo, hi); }
template <int M> __device__ __forceinline__ float shx(float v) { return __builtin_bit_cast(float, __builtin_amdgcn_ds_swizzle(__builtin_bit_cast(int, v), 0x1F | (M << 10))); }
__device__ __forceinline__ float half_sum(float v) { auto rr = __builtin_amdgcn_permlane32_swap(__float_as_uint(v), __float_as_uint(v), false, false); return __uint_as_float(rr[0]) + __uint_as_float(rr[1]); }
__device__ __forceinline__ float half_max(float v) { auto rr = __builtin_amdgcn_permlane32_swap(__float_as_uint(v), __float_as_uint(v), false, false); return fmaxf(__uint_as_float(rr[0]), __uint_as_float(rr[1])); }
__device__ __forceinline__ float wave_sum(float v) { v += shx<1>(v); v += shx<2>(v); v += shx<4>(v); v += shx<8>(v); v += shx<16>(v); return half_sum(v); }
__device__ __forceinline__ float siluf(float x) { return x / (1.0f + __expf(-x)); }
__device__ __forceinline__ float logsig(float x) { return -log1pf(expf(-x)); }
#define ROWCOL(j) (512 * ((j) >> 1) + 4 * ((j) & 1))
__device__ __forceinline__ void ld16(f32x4 (&v)[4], const float* p, int lane) {
#pragma unroll
    for (int j = 0; j < 4; ++j) v[j] = *(const f32x4*)(p + ROWCOL(j) + 8 * lane);
}
__device__ __forceinline__ void ld16b(f32x4 (&v)[4], const bf16* p, int lane) {
#pragma unroll
    for (int h = 0; h < 2; ++h) { const v4u u = *(const v4u*)(p + 512 * h + 8 * lane); v[2 * h] = (f32x4){bf_lo(u.x), bf_hi(u.x), bf_lo(u.y), bf_hi(u.y)}; v[2 * h + 1] = (f32x4){bf_lo(u.z), bf_hi(u.z), bf_lo(u.w), bf_hi(u.w)}; }
}
__device__ __forceinline__ void st16(float* p, const f32x4 (&v)[4], int lane) {
#pragma unroll
    for (int j = 0; j < 4; ++j) *(f32x4*)(p + ROWCOL(j) + 8 * lane) = v[j];
}
__device__ __forceinline__ void st16b(bf16* p, const f32x4 (&v)[4], int lane) {
#pragma unroll
    for (int h = 0; h < 2; ++h) { v4u u; u.x = pkbf(v[2 * h][0], v[2 * h][1]); u.y = pkbf(v[2 * h][2], v[2 * h][3]); u.z = pkbf(v[2 * h + 1][0], v[2 * h + 1][1]); u.w = pkbf(v[2 * h + 1][2], v[2 * h + 1][3]); *(v4u*)(p + 512 * h + 8 * lane) = u; }
}
__device__ __forceinline__ void st16f8(unsigned char* p, const f32x4 (&v)[4], int lane) {
#pragma unroll
    for (int h = 0; h < 2; ++h) { v2u u; u.x = fp8x4(v[2 * h][0], v[2 * h][1], v[2 * h][2], v[2 * h][3]); u.y = fp8x4(v[2 * h + 1][0], v[2 * h + 1][1], v[2 * h + 1][2], v[2 * h + 1][3]); *(v2u*)(p + 512 * h + 8 * lane) = u; }
}
__device__ __forceinline__ void st16i8(unsigned char* p, const f32x4 (&v)[4], int lane, const float I8_XS = ::I8_XS) {
#pragma unroll
    for (int h = 0; h < 2; ++h) { v2u u; u.x = i8x4(v[2 * h][0], v[2 * h][1], v[2 * h][2], v[2 * h][3], I8_XS); u.y = i8x4(v[2 * h + 1][0], v[2 * h + 1][1], v[2 * h + 1][2], v[2 * h + 1][3], I8_XS); *(v2u*)(p + 512 * h + 8 * lane) = u; }
}
__device__ __forceinline__ float sumsq16(const f32x4 (&v)[4]) {
    float s = 0.f;
#pragma unroll
    for (int j = 0; j < 4; ++j) s += (v[j][0] * v[j][0] + v[j][1] * v[j][1]) + (v[j][2] * v[j][2] + v[j][3] * v[j][3]);
    return s;
}
__device__ __forceinline__ const float* modv(const unsigned char* ws, int l, int cls, int chunk) { return (const float*)(ws + WS_MODV) + ((size_t)(l * 3 + cls) * 6 + chunk) * DM; }

template <int F8 = 0  > __device__ __forceinline__ void p0_transpose_item(const float* W, int K, int N, bf16* WT, int k0, int n0, int drow0, LAS float* scr, int lane) {
    { const int c4 = (lane & 7) * 4, r8 = lane >> 3;
#pragma unroll
        for (int i = 0; i < 8; ++i) { const int kk = 8 * i + r8; const f32x4 v = *(const f32x4*)(W + (size_t)(k0 + kk) * N + n0 + c4);
            LAS float* d = scr + kk * 33 + c4; d[0] = v[0]; d[1] = v[1]; d[2] = v[2]; d[3] = v[3]; } }
    LDS_WAIT(); asm volatile("" ::: "memory");
    const int c = lane & 7;
#pragma unroll
    for (int j = 0; j < 4; ++j) { const int n = (lane >> 3) + 8 * j; const LAS float* s = scr + (8 * c) * 33 + n;
        if constexpr (F8 == 2) { v2u o; o.x = i8x4(s[0 * 33], s[1 * 33], s[2 * 33], s[3 * 33], I8_WS); o.y = i8x4(s[4 * 33], s[5 * 33], s[6 * 33], s[7 * 33], I8_WS);
            *(v2u*)((unsigned char*)WT + (size_t)(drow0 + n) * K + k0 + 8 * c) = o; }
        else if constexpr (F8 == 1) { v2u o; o.x = fp8x4(s[0 * 33] * 64.0f, s[1 * 33] * 64.0f, s[2 * 33] * 64.0f, s[3 * 33] * 64.0f); o.y = fp8x4(s[4 * 33] * 64.0f, s[5 * 33] * 64.0f, s[6 * 33] * 64.0f, s[7 * 33] * 64.0f);
            *(v2u*)((unsigned char*)WT + (size_t)(drow0 + n) * K + k0 + 8 * c) = o; }
        else { v4u o; o.x = pkbf(s[0 * 33], s[1 * 33]); o.y = pkbf(s[2 * 33], s[3 * 33]); o.z = pkbf(s[4 * 33], s[5 * 33]); o.w = pkbf(s[6 * 33], s[7 * 33]);
        *(v4u*)(WT + (size_t)(drow0 + n) * K + k0 + 8 * c) = o; } }
    LDS_WAIT(); asm volatile("" ::: "memory");
}
constexpr int WC_IN = 16 * 64, WC_OUT = 16 * 32, WC_F = 1408, WCOPY_ITEMS = 2 * WC_IN + 2 * WC_OUT + 27 * WC_F;
constexpr int WCOPY_SPLIT1 = WCOPY_ITEMS - 21120, WCOPY_SPLIT2 = WCOPY_ITEMS - 12800;
struct WItem { const float* src; unsigned char* dst; int N, K, mode; };
__device__ __forceinline__ WItem wc_decode(ArgP a, int it) {
    WItem w; int r = it;
    if (r < 2 * WC_IN) { const int l = r / WC_IN, q = r % WC_IN, kb = q / 64, nb = q % 64;
        w.mode = ((IN_I8 >> l) & 1) ? 2 : ((IN1_F8 && l == 1) ? 1 : 0); w.N = INW; w.K = DM; w.src = a->in[I_WIN] + (size_t)l * DM * INW + (size_t)(64 * kb) * INW + 32 * nb;
        w.dst = a->ws + WS_WIN + l * SZ_WIN + ((size_t)(32 * nb) * DM + 64 * kb) * (w.mode ? 1 : 2); return w; }
    r -= 2 * WC_IN;
    if (r < 2 * WC_OUT) { const int l = r / WC_OUT, q = r % WC_OUT, kb = q / 32, nb = q % 32;
        w.mode = 0; w.N = DM; w.K = DM; w.src = a->in[I_WOUT] + (size_t)l * DM * DM + (size_t)(64 * kb) * DM + 32 * nb; w.dst = a->ws + WS_WOUT + l * SZ_WOUT + ((size_t)(32 * nb) * DM + 64 * kb) * 2; return w; }
    r -= 2 * WC_OUT;
    const int mat = r / WC_F, q = r % WC_F;
    int which, e; bool moe;
    if (mat < 3) { which = mat; e = 0; moe = false; } else { which = (mat - 3) % 3; e = (mat - 3) / 3; moe = true; }
    if (which < 2) {
        const float* W = (moe ? a->in[which == 0 ? I_MW1 : I_MW3] + (size_t)e * DM * FF : a->in[which == 0 ? I_FW1 : I_FW3]);
        unsigned char* WT = a->ws + (moe ? WS_W13M + e * (MOE_F8 ? SZ8_W13 : SZ_W13) : WS_W13D);
        const int kb = q / 88, nb = q % 88, n0 = 32 * nb; const int drow0 = (n0 >> 7) * 256 + which * 128 + (n0 & 127);
        w.mode = moe ? ((MOE_F8 && !MOE_I8UP) ? 1 : (MOE_I8UP ? 2 : 0)) : (DENSE_F8 ? 1 : (DENSE_I8UP ? 2 : 0));
        w.N = FF; w.K = DM; w.src = W + (size_t)(64 * kb) * FF + n0; w.dst = WT + ((size_t)drow0 * DM + 64 * kb) * (w.mode ? 1 : 2);
    } else {
        const float* W = (moe ? a->in[I_MW2] + (size_t)e * FF * DM : a->in[I_FW2]);
        unsigned char* WT = a->ws + (moe ? WS_W2M + e * (MOE_F8 ? SZ8_W2 : SZ_W2) : WS_W2D);
        const int kb = q / 32, nb = q % 32;
        w.mode = moe ? (MOE_F8 ? 1 : 0) : ((DENSE_F8 || DENSE_DOWN_F8) ? 1 : 0);
        w.N = DM; w.K = FF; w.src = W + (size_t)(64 * kb) * DM + 32 * nb; w.dst = WT + ((size_t)(32 * nb) * FF + 64 * kb) * (w.mode ? 1 : 2);
    }
    return w;
}
__device__ __forceinline__ void wc_load(const WItem& w, f32x4 (&v)[8], int lane) {
    const int c4 = (lane & 7) * 4, r8 = lane >> 3;
#pragma unroll
    for (int i = 0; i < 8; ++i) v[i] = *(const f32x4*)(w.src + (size_t)(8 * i + r8) * w.N + c4);
}
__device__ __forceinline__ void wc_process(const WItem& w, const f32x4 (&v)[8], LAS float* scr, int lane) {
    { const int c4 = (lane & 7) * 4, r8 = lane >> 3;
#pragma unroll
        for (int i = 0; i < 8; ++i) { LAS float* d = scr + (8 * i + r8) * 33 + c4; d[0] = v[i][0]; d[1] = v[i][1]; d[2] = v[i][2]; d[3] = v[i][3]; } }
    LDS_WAIT(); asm volatile("" ::: "memory");
    const int c = lane & 7;
#pragma unroll
    for (int j = 0; j < 4; ++j) { const int n = (lane >> 3) + 8 * j; const LAS float* s = scr + (8 * c) * 33 + n;
        const float s0 = s[0 * 33], s1 = s[1 * 33], s2 = s[2 * 33], s3 = s[3 * 33], s4 = s[4 * 33], s5 = s[5 * 33], s6 = s[6 * 33], s7 = s[7 * 33];
        if (w.mode == 2) { v2u o; o.x = i8x4(s0, s1, s2, s3, I8_WS); o.y = i8x4(s4, s5, s6, s7, I8_WS); *(v2u*)(w.dst + (size_t)n * w.K + 8 * c) = o; }
        else if (w.mode == 1) { v2u o; o.x = fp8x4(s0 * 64.0f, s1 * 64.0f, s2 * 64.0f, s3 * 64.0f); o.y = fp8x4(s4 * 64.0f, s5 * 64.0f, s6 * 64.0f, s7 * 64.0f); *(v2u*)(w.dst + (size_t)n * w.K + 8 * c) = o; }
        else { v4u o; o.x = pkbf(s0, s1); o.y = pkbf(s2, s3); o.z = pkbf(s4, s5); o.w = pkbf(s6, s7); *(v4u*)(w.dst + ((size_t)n * w.K + 8 * c) * 2) = o; } }
    LDS_WAIT(); asm volatile("" ::: "memory");
}
__device__ __forceinline__ void weight_copy_items(ArgP a, Frame& F, const int lo_, const int hi_, const int rk, const int nrk) {
    LAS float* scr = (LAS float*)(F.lds + F.wave * 16384);
    int it = lo_ + rk; if (it >= hi_) return;
    WItem cur = wc_decode(a, it); f32x4 vc[8]; wc_load(cur, vc, F.lane);
    for (;;) {
        const int itn = it + nrk; const bool more = itn < hi_;
        const WItem nx = wc_decode(a, more ? itn : it); f32x4 vn[8]; wc_load(nx, vn, F.lane);
        wc_process(cur, vc, scr, F.lane);
        if (!more) break;
        cur = nx; it = itn;
#pragma unroll
        for (int i = 0; i < 8; ++i) vc[i] = vn[i];
    }
}
__device__ __forceinline__ void phase_p0a(ArgP a, Frame& F) {
    LAS float* sv = (LAS float*)F.lds;
    LAS float* red = (LAS float*)(F.lds + 12288);
    for (int i = F.tid; i < 3072; i += 512) { const int v = i >> 10, k = i & 1023; const float x = (v < 2) ? a->in[I_C][v * 1024 + k] : a->in[I_CCTX][k]; sv[i] = siluf(x); }
    __syncthreads();
    for (int it = F.bx; it < 256; it += F.G) {
        const int l = it >> 7, cg = it & 127; const int r5 = F.lane / 12, c12 = F.lane % 12; const bool act = F.lane < 60;
        f32x4 acc[3]; acc[0] = acc[1] = acc[2] = (f32x4){0.f, 0.f, 0.f, 0.f};
        const float* Wl = a->in[I_WMOD] + (size_t)l * DM * 6144 + 48 * cg + 4 * c12;
#pragma unroll
        for (int hb = 0; hb < 2; ++hb) { f32x4 w4[13];
#pragma unroll
            for (int j = 0; j < 13; ++j) { const int kk = r5 + 5 * (13 * hb + j); const int kc = (act && kk < 128) ? 128 * F.wave + kk : 128 * F.wave; w4[j] = *(const f32x4*)(Wl + (size_t)kc * 6144); }
#pragma unroll
            for (int j = 0; j < 13; ++j) { const int kk = r5 + 5 * (13 * hb + j); const int k = 128 * F.wave + kk;
                if (act && kk < 128) { acc[0] += sv[k] * w4[j]; acc[1] += sv[1024 + k] * w4[j]; acc[2] += sv[2048 + k] * w4[j]; } } }
        if (act) {
#pragma unroll
            for (int v = 0; v < 3; ++v)
#pragma unroll
                for (int e = 0; e < 4; ++e) red[(F.wave * 60 + F.lane) * 12 + v * 4 + e] = acc[v][e]; }
        __syncthreads();
        if (F.tid < 144) { const int v = F.tid / 48, col = F.tid % 48, c12b = col >> 2, e = col & 3; float s = 0.f;
            for (int w = 0; w < 8; ++w)
                for (int r = 0; r < 5; ++r) s += red[(w * 60 + r * 12 + c12b) * 12 + v * 4 + e];
            ((float*)(a->ws + WS_MODV))[((size_t)(l * 3 + v)) * 6144 + 48 * cg + col] = s + a->in[I_BMOD][l * 6144 + 48 * cg + col]; }
        __syncthreads();
    }
    if (F.bx == F.G - 1 && F.tid >= 64 && F.tid < 80) { const int t = F.tid - 64; const float lg = logsig(a->in[I_DECAY][t]); ((float*)(a->ws + WS_DEC))[t] = lg; ((float*)(a->ws + WS_DEC))[16 + t] = expf(128.0f * lg); }
    if (F.tid < 16)
        for (int i = F.bx * 16 + F.tid; i < 4096; i += F.G * 16) { const int pos = i >> 4, fi = i & 15; const double inv = pow(10000.0, -(double)fi / 16.0); const double ang = (double)pos * inv;
            ((float*)(a->ws + WS_ROPE))[i] = (float)cos(ang); ((float*)(a->ws + WS_ROPE))[4096 + i] = (float)sin(ang); }
    weight_copy_items(a, F, 0, WCOPY_ITEMS, F.gw, F.NGW);
}

struct RowLoc { int b, jj, cls; size_t xoff; bool isctx; };
__device__ __forceinline__ RowLoc rowloc(int r) { RowLoc L; L.b = r / RB; L.jj = r - L.b * RB; L.isctx = L.jj < CTX; L.cls = L.isctx ? 2 : L.b;
    L.xoff = L.isctx ? (size_t)(L.b * CTX + L.jj) * DM : (size_t)(L.b * SEQ + (L.jj - CTX)) * DM; return L; }

__device__ __forceinline__ void wave_sum2(float& a, float& b) {
    for (int o = 0; o < 1; ++o) { float ta, tb; ta = shx<1>(a); tb = shx<1>(b); a += ta; b += tb; ta = shx<2>(a); tb = shx<2>(b); a += ta; b += tb; ta = shx<4>(a); tb = shx<4>(b); a += ta; b += tb;
        ta = shx<8>(a); tb = shx<8>(b); a += ta; b += tb; ta = shx<16>(a); tb = shx<16>(b); a += ta; b += tb; a = half_sum(a); b = half_sum(b); }
}
__device__ __forceinline__ void premix_rows(ArgP a, Frame& F, const int r0  , const int stride, const int nrows  , const bool isctx) {
    bf16* HX = (bf16*)(a->ws + WS_AR + AR_MIX);
    const float* xsrc = isctx ? a->in[I_CTX] : a->in[I_X];
    f32x4 A[4], B[4], t0[4]; int curcls = -1;
    f32x4 v0[4], v1[4], n0[4], n1[4]; ld16(v0, xsrc + (size_t)r0 * DM, F.lane); ld16(v1, xsrc + (size_t)(r0 + stride) * DM, F.lane);
#pragma unroll 1
    for (int rr = 0; rr < nrows; rr += 2) {
        const int ra = r0 + rr * stride, rb = ra + stride;
        if (rr + 2 < nrows) { ld16(n0, xsrc + (size_t)(ra + 2 * stride) * DM, F.lane); ld16(n1, xsrc + (size_t)(rb + 2 * stride) * DM, F.lane); }
        const int ba = isctx ? ra / CTX : ra / SEQ, bb = isctx ? rb / CTX : rb / SEQ; const int cls = isctx ? 2 : ba;
        if (cls != curcls) { curcls = cls; ld16(A, a->in[I_NPREMIX], F.lane); ld16(t0, modv(a->ws, 0, cls, 1), F.lane); ld16(B, modv(a->ws, 0, cls, 0), F.lane);
#pragma unroll
            for (int j = 0; j < 4; ++j) A[j] = A[j] * (1.0f + t0[j]); }
        const int ua = isctx ? ba * RB + (ra - ba * CTX) : ra + CTX * (ba + 1), ub = isctx ? bb * RB + (rb - bb * CTX) : rb + CTX * (bb + 1);
        float q0 = sumsq16(v0), q1 = sumsq16(v1); wave_sum2(q0, q1);
        const float r0s = 1.0f / sqrtf(q0 * (1.0f / DM) + EPS), r1s = 1.0f / sqrtf(q1 * (1.0f / DM) + EPS);
#pragma unroll
        for (int j = 0; j < 4; ++j) { v0[j] = v0[j] * r0s * A[j] + B[j]; v1[j] = v1[j] * r1s * A[j] + B[j]; }
        if (IN_I8 & 1) { st16i8((unsigned char*)HX + (size_t)ua * DM, v0, F.lane, I8_XI); st16i8((unsigned char*)HX + (size_t)ub * DM, v1, F.lane, I8_XI); }
        else { st16b(HX + (size_t)ua * DM, v0, F.lane); st16b(HX + (size_t)ub * DM, v1, F.lane); }
#pragma unroll
        for (int j = 0; j < 4; ++j) { v0[j] = n0[j]; v1[j] = n1[j]; }
    }
}
__device__ __forceinline__ void phase_premix0(ArgP a, Frame& F) {
    const int per = NLAT / F.NGW;
    if (F.gw < NLAT) premix_rows(a, F, F.gw, F.NGW, per, false);
    for (int j = F.gw; j < 8 * NB * CTX / 2; j += F.NGW) if ((j & 7) == 0) premix_rows(a, F, (j >> 3) * 2, 1, 2, true);
}

__device__ __forceinline__ void moe_prefix(const unsigned char* ws, int (&tstart)[9], int (&cnt)[8]) {
    const unsigned* cw = (const unsigned*)(ws + WS_CTL) + CW_CNT; int s = 0;
#pragma unroll
    for (int e = 0; e < 8; ++e) { cnt[e] = (int)__builtin_amdgcn_readfirstlane(cw[64 * e]); tstart[e] = s; s += (cnt[e] + 255) >> 8; }
    tstart[8] = s;
}

template <int MODE> __device__ __forceinline__ void resid_rows(ArgP a, Frame& F, const int r0, const int stride, const int nrows, const bool isctx,
                                                               const int (&tstart)[9], int& myE0, int& myE1, float& myW0, float& myW1) {
    constexpr int l = MODE >> 1; constexpr bool post_ffn = MODE & 1;
    const bf16* SRC = (const bf16*)(a->ws + WS_AR + (MODE == 1 ? AR_YD : (MODE == 3 ? AR_YM : AR_MX)));
    bf16* H = (bf16*)(a->ws + WS_AR + (MODE == 1 ? AR_MIX : AR_HX2));
    const float* gpost = a->in[post_ffn ? I_NPOSTFFN : I_NPOSTMIX] + l * DM;
    const float* gnext = (MODE == 1) ? a->in[I_NPREMIX] + DM : a->in[I_NPREFFN] + l * DM;
    constexpr int gate_chunk = post_ffn ? 5 : 2, sc_chunk = (MODE == 1) ? 1 : 4, sh_chunk = (MODE == 1) ? 0 : 3, lnext = (MODE == 1) ? 1 : l;
    const LAS float* rts = (const LAS float*)F.lds;
    float* XC = (float*)(a->ws + WS_XC);
    const float* xin = isctx ? (MODE == 0 ? a->in[I_CTX] : (const float*)XC) : a->in[I_X];
    float* xout = isctx ? XC : a->out;
    bf16* XB = (bf16*)(a->ws + WS_XB);
    f32x4 G1[4], A2[4], B2[4], t0[4]; int curcls = -1;
#define UROW(r_) (isctx ? ((r_) / CTX) * RB + ((r_) % CTX) : (r_) + CTX * ((r_) / SEQ + 1))
    v4u tiv = (v4u){0u, 0u, 0u, 0u}; float tw0 = 0.f, tw1 = 0.f;
    if constexpr (MODE == 3) { if (F.lane < nrows) { const unsigned char* tp = a->ws + WS_TOK + (size_t)(r0 + F.lane * stride) * 32; tiv = *(const v4u*)tp; tw0 = *(const float*)(tp + 16); tw1 = *(const float*)(tp + 20); } }
    f32x4 s0[4], x0[4], s1[4], x1[4], sn0[4], xn0[4], sn1[4], xn1[4], y1[4];
#define RESID_LOAD(S_, X_, rr_) do { \
        if constexpr (MODE == 3) { const int e0 = __builtin_amdgcn_readlane((int)tiv.x, rr_), p0l = __builtin_amdgcn_readlane((int)tiv.y, rr_), e1 = __builtin_amdgcn_readlane((int)tiv.z, rr_), p1l = __builtin_amdgcn_readlane((int)tiv.w, rr_); \
            const float w0 = __builtin_bit_cast(float, __builtin_amdgcn_readlane(__builtin_bit_cast(int, tw0), rr_)), w1 = __builtin_bit_cast(float, __builtin_amdgcn_readlane(__builtin_bit_cast(int, tw1), rr_)); \
            int ts0 = 0, ts1 = 0; _Pragma("unroll") for (int e = 0; e < 8; ++e) { ts0 = (e0 == e) ? tstart[e] : ts0; ts1 = (e1 == e) ? tstart[e] : ts1; } \
            ld16b(S_, SRC + ((size_t)ts0 * 256 + p0l) * DM, F.lane); ld16b(y1, SRC + ((size_t)ts1 * 256 + p1l) * DM, F.lane); \
            _Pragma("unroll") for (int j = 0; j < 4; ++j) S_[j] = w0 * S_[j] + w1 * y1[j]; } \
        else if (isctx && (MODE == 0 || (MODE == 1 && !DENSE_DOWN_F8))) { const int cr_ = r0 + (rr_) * stride; const float* pp_ = (const float*)(a->ws + WS_AR + (MODE == 0 ? AR_PART0 : AR_PART1)) + (size_t)((cr_ >> 8) * 256 + (cr_ & 255)) * DM; \
            ld16(S_, pp_, F.lane); for (int ks_ = 1; ks_ < (MODE == 0 ? 4 : 11); ++ks_) { ld16(y1, pp_ + (size_t)ks_ * 512 * DM, F.lane); _Pragma("unroll") for (int j = 0; j < 4; ++j) S_[j] += y1[j]; } } \
        else ld16b(S_, SRC + (size_t)UROW(r0 + (rr_) * stride) * DM, F.lane); \
        if (!isctx && MODE != 0) ld16b(X_, XB + (size_t)(r0 + (rr_) * stride) * DM, F.lane); else ld16(X_, xin + (size_t)(r0 + (rr_) * stride) * DM, F.lane); } while (0)
    RESID_LOAD(s0, x0, 0); RESID_LOAD(s1, x1, 1);
#pragma unroll 1
    for (int rr = 0; rr < nrows; rr += 2) {
        if (rr + 2 < nrows) { RESID_LOAD(sn0, xn0, rr + 2); RESID_LOAD(sn1, xn1, rr + 3); }
        const int ra = r0 + rr * stride, rb = ra + stride; const int cls = isctx ? 2 : ra / SEQ;
        if (cls != curcls) { curcls = cls; ld16(G1, gpost, F.lane); ld16(t0, modv(a->ws, l, cls, gate_chunk), F.lane);
#pragma unroll
            for (int j = 0; j < 4; ++j) G1[j] = G1[j] * t0[j];
            if constexpr (MODE != 3) { ld16(A2, gnext, F.lane); ld16(t0, modv(a->ws, lnext, cls, sc_chunk), F.lane); ld16(B2, modv(a->ws, lnext, cls, sh_chunk), F.lane);
#pragma unroll
                for (int j = 0; j < 4; ++j) A2[j] = A2[j] * (1.0f + t0[j]); } }
        float q0 = sumsq16(s0), q1 = sumsq16(s1); wave_sum2(q0, q1);
        const float rs0 = 1.0f / sqrtf(q0 * (1.0f / DM) + EPS), rs1 = 1.0f / sqrtf(q1 * (1.0f / DM) + EPS);
#pragma unroll
        for (int j = 0; j < 4; ++j) { x0[j] = x0[j] + G1[j] * (s0[j] * rs0); x1[j] = x1[j] + G1[j] * (s1[j] * rs1); }
        if (!isctx && MODE != 3) { st16b(XB + (size_t)ra * DM, x0, F.lane); st16b(XB + (size_t)rb * DM, x1, F.lane); } else { st16(xout + (size_t)ra * DM, x0, F.lane); st16(xout + (size_t)rb * DM, x1, F.lane); }
        if constexpr (MODE != 3) {
            float u0 = sumsq16(x0), u1 = sumsq16(x1); wave_sum2(u0, u1);
            const float t0r = 1.0f / sqrtf(u0 * (1.0f / DM) + EPS), t1r = 1.0f / sqrtf(u1 * (1.0f / DM) + EPS);
#pragma unroll
            for (int j = 0; j < 4; ++j) { x0[j] = x0[j] * t0r * A2[j] + B2[j]; x1[j] = x1[j] * t1r * A2[j] + B2[j]; }
            if constexpr (MODE == 1 && (IN_I8 & 2)) { st16i8((unsigned char*)H + (size_t)UROW(ra) * DM, x0, F.lane, I8_XI); st16i8((unsigned char*)H + (size_t)UROW(rb) * DM, x1, F.lane, I8_XI); }
            else if constexpr (MODE == 2 && MOE_F8 && MOE_I8UP) { st16i8((unsigned char*)H + (size_t)ra * DM, x0, F.lane); st16i8((unsigned char*)H + (size_t)rb * DM, x1, F.lane); }
            else if constexpr (MODE == 0 && DENSE_I8UP && !DENSE_F8) { st16i8((unsigned char*)H + (size_t)UROW(ra) * DM, x0, F.lane); st16i8((unsigned char*)H + (size_t)UROW(rb) * DM, x1, F.lane); }
            else if constexpr ((MODE == 1 && !IN1_F8) || (MODE == 0 && !DENSE_F8) || (MODE == 2 && !MOE_F8)) { st16b(H + (size_t)(MODE == 2 ? ra : UROW(ra)) * DM, x0, F.lane); st16b(H + (size_t)(MODE == 2 ? rb : UROW(rb)) * DM, x1, F.lane); }
            else { st16f8((unsigned char*)H + (size_t)(MODE == 2 ? ra : UROW(ra)) * DM, x0, F.lane); st16f8((unsigned char*)H + (size_t)(MODE == 2 ? rb : UROW(rb)) * DM, x1, F.lane); }
            if constexpr (MODE == 2) {
                asm volatile("" ::: "memory");
                float lgA[8], lgB[8];
#pragma unroll
                for (int e = 0; e < 8; ++e) { float pA = 0.f, pB = 0.f;
#pragma unroll
                    for (int j = 0; j < 4; ++j) { const f32x4 rv = *(const LAS f32x4*)(rts + e * 1024 + ROWCOL(j) + 8 * F.lane);
                        pA += (x0[j][0] * rv[0] + x0[j][1] * rv[1]) + (x0[j][2] * rv[2] + x0[j][3] * rv[3]); pB += (x1[j][0] * rv[0] + x1[j][1] * rv[1]) + (x1[j][2] * rv[2] + x1[j][3] * rv[3]); }
                    wave_sum2(pA, pB); lgA[e] = pA; lgB[e] = pB; }
#define TOP2(lg, rrow) do { int i0 = 0; float v0 = lg[0]; _Pragma("unroll") for (int e = 1; e < 8; ++e) if (lg[e] > v0) { v0 = lg[e]; i0 = e; } \
                    int i1 = -1; float v1 = -INFINITY; _Pragma("unroll") for (int e = 0; e < 8; ++e) if (e != i0 && lg[e] > v1) { v1 = lg[e]; i1 = e; } \
                    const float w0 = 1.0f / (1.0f + __expf(v1 - v0)); if (F.lane == (rrow)) { myE0 = i0; myE1 = i1; myW0 = w0; myW1 = 1.0f - w0; } } while (0)
                TOP2(lgA, rr); TOP2(lgB, rr + 1);
#undef TOP2
            }
        }
#pragma unroll
        for (int j = 0; j < 4; ++j) { s0[j] = sn0[j]; x0[j] = xn0[j]; s1[j] = sn1[j]; x1[j] = xn1[j]; }
    }
#undef RESID_LOAD
#undef UROW
}
template <int MODE> __device__ __forceinline__ void phase_resid(ArgP a, Frame& F) {
    float* XC = (float*)(a->ws + WS_XC);
    int tstart[9], ecnt[8];
    if constexpr (MODE == 3) moe_prefix(a->ws, tstart, ecnt); else {
#pragma unroll
        for (int e = 0; e < 9; ++e) tstart[e] = 0; }
    int myE0 = -1, myE1 = -1; float myW0 = 0.f, myW1 = 0.f;
    if constexpr (MODE < 2) {
        if (F.gw < NLAT) resid_rows<MODE>(a, F, F.gw, F.NGW, NLAT / F.NGW, false, tstart, myE0, myE1, myW0, myW1);
        for (int j = F.gw; j < 8 * NB * CTX / 2; j += F.NGW) if ((j & 7) == 0) resid_rows<MODE>(a, F, (j >> 3) * 2, 1, 2, true, tstart, myE0, myE1, myW0, myW1);
    } else {
        LAS float* rts = (LAS float*)F.lds;
        LAS int* wcnt = (LAS int*)(F.lds + 32768);
        LAS int* bbase = (LAS int*)(F.lds + 32768 + 256);
        if constexpr (MODE == 2) { for (int i = F.tid; i < 8192; i += 512) { const int k = i >> 3, e = i & 7; rts[e * 1024 + k] = a->in[I_ROUTER][i]; } __syncthreads(); }
        const int per = NLAT / F.NGW;
        for (int rd = 0; rd < 1; ++rd) {
            const bool active = F.gw < NLAT;
            myE0 = -1; myE1 = -1;
            if (active) resid_rows<MODE>(a, F, F.gw, F.NGW, per, false, tstart, myE0, myE1, myW0, myW1);
            if constexpr (MODE == 2) {
                int tid2 = F.tid; asm volatile("" : "+v"(tid2)); const int lane2 = tid2 & 63;
                if (lane2 < 8) wcnt[F.wave * 8 + lane2] = 0;
                LDS_WAIT();
                int r0 = 0, r1 = 0;
                if (active && lane2 < per) { r0 = __hip_atomic_fetch_add(wcnt + F.wave * 8 + myE0, 1, __ATOMIC_RELAXED, __HIP_MEMORY_SCOPE_WORKGROUP); r1 = __hip_atomic_fetch_add(wcnt + F.wave * 8 + myE1, 1, __ATOMIC_RELAXED, __HIP_MEMORY_SCOPE_WORKGROUP); }
                __syncthreads();
                if (tid2 < 8) { int tot = 0; for (int w = 0; w < 8; ++w) tot += wcnt[w * 8 + tid2];
                    int base = 0; if (tot > 0) base = (int)__hip_atomic_fetch_add((unsigned*)(a->ws + WS_CTL) + CW_CNT + 64 * tid2, (unsigned)tot, RLX_AGENT);
                    bbase[tid2] = base; }
                __syncthreads();
                if (active && lane2 < per) {
                    int wb0 = bbase[myE0], wb1 = bbase[myE1];
                    for (int w = 0; w < F.wave; ++w) { wb0 += wcnt[w * 8 + myE0]; wb1 += wcnt[w * 8 + myE1]; }
                    const int lp0 = wb0 + r0, lp1 = wb1 + r1;
                    const int tk = F.gw + lane2 * F.NGW; int* lists = (int*)(a->ws + WS_LIST);
                    lists[myE0 * LISTCAP + lp0] = tk; lists[myE1 * LISTCAP + lp1] = tk;
                    v4u ti; ti.x = (unsigned)myE0; ti.y = (unsigned)lp0; ti.z = (unsigned)myE1; ti.w = (unsigned)lp1;
                    *(v4u*)(a->ws + WS_TOK + (size_t)tk * 32) = ti; *(float*)(a->ws + WS_TOK + (size_t)tk * 32 + 16) = myW0; *(float*)(a->ws + WS_TOK + (size_t)tk * 32 + 20) = myW1;
                }
                __syncthreads();
            }
        }
    }
}
typedef float f32x16v __attribute__((ext_vector_type(16)));
__device__ __forceinline__ int crow32(int r, int hi) { return (r & 3) + 8 * (r >> 2) + 4 * hi; }
__device__ __forceinline__ int chain_id(int b, int h, int dir) { return (b * 4 + h) * 2 + dir; }

__device__ __forceinline__ void qkv_items(ArgP a, Frame& F, int l, LAS int* cnt) {
    const bf16* P = (const bf16*)(a->ws + WS_AR + AR_P);
    bf16* QB = (bf16*)(a->ws + WS_AR + AR_QB); bf16* KC = (bf16*)(a->ws + WS_AR + AR_KC); bf16* VC = (bf16*)(a->ws + WS_AR + AR_VC);
    unsigned char* Q8 = q8_ptr(a); unsigned char* K8 = k8_ptr(a); unsigned char* V8 = v8_ptr(a);
    const float* ropec = (const float*)(a->ws + WS_ROPE); const float* ropes = ropec + 4096;
    {
        const int rr = F.lane >> 3, c = F.lane & 7;
        float gq[8], gk[8];
#pragma unroll
        for (int j = 0; j < 8; ++j) { gq[j] = a->in[I_QN][l * 64 + 8 * c + j]; gk[j] = a->in[I_KN][l * 64 + 8 * c + j]; }
        for (;;) { int k_ = 0; if (F.lane == 0) k_ = __hip_atomic_fetch_add(cnt, 1, __ATOMIC_RELAXED, __HIP_MEMORY_SCOPE_WORKGROUP); k_ = __builtin_amdgcn_readfirstlane(k_); const int it = F.bx + k_ * F.G; if (it >= NR / 8) break;
            const int row = it * 8 + rr; const int b = row / RB, jj = row - b * RB; const bool lat = jj >= CTX; const int t = jj - CTX;
            float cs[8], sn[8];
            if (lat) { const int pos = (c < 4) ? (t >> 6) : (t & 63); const int fi = 8 * (c & 1);
#pragma unroll
                for (int j = 0; j < 8; ++j) { cs[j] = ropec[pos * 16 + fi + j]; sn[j] = ropes[pos * 16 + fi + j]; } }
            else {
#pragma unroll
                for (int j = 0; j < 8; ++j) { cs[j] = 1.f; sn[j] = 0.f; } }
            const float sgn = (c & 2) ? 1.f : -1.f;
            const bf16* prow = P + (size_t)row * INW;
#pragma unroll 2
            for (int hs = 0; hs < 10; ++hs) {
                const v4u u = *(const v4u*)(prow + hs * 64 + 8 * c);
                float x[8] = {bf_lo(u.x), bf_hi(u.x), bf_lo(u.y), bf_hi(u.y), bf_lo(u.z), bf_hi(u.z), bf_lo(u.w), bf_hi(u.w)};
                float ss = 0.f;
#pragma unroll
                for (int j = 0; j < 8; ++j) ss += x[j] * x[j];
                ss += shx<1>(ss); ss += shx<2>(ss); ss += shx<4>(ss);
                const float rstd = 1.0f / sqrtf(ss * (1.0f / 64.0f) + EPS);
                float y[8];
#pragma unroll
                for (int j = 0; j < 8; ++j) { y[j] = x[j] * rstd * (hs < 8 ? gq[j] : gk[j]); }
#pragma unroll
                for (int j = 0; j < 8; ++j) { const float p = shx<2>(y[j]); x[j] = y[j] * cs[j] + sgn * p * sn[j]; }
                const float sc = (hs < 8) ? attn_body::C2 : 1.0f;
#if ATT8_DEBUG
                { v4u o; o.x = pkbf(x[0] * sc, x[1] * sc); o.y = pkbf(x[2] * sc, x[3] * sc); o.z = pkbf(x[4] * sc, x[5] * sc); o.w = pkbf(x[6] * sc, x[7] * sc);
                if (hs < 8) *(v4u*)(QB + (size_t)row * 512 + hs * 64 + 8 * c) = o;
                else *(v4u*)(KC + ((size_t)(b * 2 + (hs - 8)) * RB + jj) * 64 + 8 * c) = o; }
#endif
                { v2u o8; o8.x = fp8x4(x[0] * sc, x[1] * sc, x[2] * sc, x[3] * sc); o8.y = fp8x4(x[4] * sc, x[5] * sc, x[6] * sc, x[7] * sc);
                if (hs < 8) *(v2u*)(Q8 + (size_t)row * 512 + hs * 64 + 8 * c) = o8;
                else *(v2u*)(K8 + ((size_t)((b * 2 + (hs - 8)) * (RB / 64) + (jj >> 6))) * 4096 + (c >> 1) * 1024 + (jj & 63) * 16 + 8 * (c & 1)) = o8; }
            }
#if ATT8_DEBUG
#pragma unroll
            for (int kv = 0; kv < 2; ++kv) *(v4u*)(VC + ((size_t)(b * 2 + kv) * RB + jj) * 64 + 8 * c) = *(const v4u*)(prow + PC_V + kv * 64 + 8 * c);
#endif
        }
    }
    for (;;) { int k_ = 0; if (F.lane == 0) k_ = __hip_atomic_fetch_add(cnt + 1, 1, __ATOMIC_RELAXED, __HIP_MEMORY_SCOPE_WORKGROUP); k_ = __builtin_amdgcn_readfirstlane(k_); const int it = F.bx + k_ * F.G; if (it >= NR / 32) break;
        const int b = it / (RB / 32), g = it - b * (RB / 32), tile = g >> 1, c2 = g & 1, kv = F.lane >> 5, kg = (F.lane >> 4) & 1, d4 = F.lane & 15;
        const bf16* src = P + (size_t)(b * RB + 32 * g + 4 * kg) * INW + PC_V + kv * 64 + 4 * d4;
        v2u u[16];
#pragma unroll
        for (int j = 0; j < 16; ++j) u[j] = *(const v2u*)(src + (size_t)((j & 3) + 8 * (j >> 2)) * INW);
        unsigned char* dst = V8 + ((size_t)((b * 2 + kv) * (RB / 64) + tile)) * 4096 + ((kg * 2 + c2) * 64 + 4 * d4) * 16;
        v4u o0, o1, o2, o3;
        o0.x = fp8x4(bf_lo(u[0].x), bf_lo(u[1].x), bf_lo(u[2].x), bf_lo(u[3].x)); o0.y = fp8x4(bf_lo(u[4].x), bf_lo(u[5].x), bf_lo(u[6].x), bf_lo(u[7].x)); o0.z = fp8x4(bf_lo(u[8].x), bf_lo(u[9].x), bf_lo(u[10].x), bf_lo(u[11].x)); o0.w = fp8x4(bf_lo(u[12].x), bf_lo(u[13].x), bf_lo(u[14].x), bf_lo(u[15].x));
        o1.x = fp8x4(bf_hi(u[0].x), bf_hi(u[1].x), bf_hi(u[2].x), bf_hi(u[3].x)); o1.y = fp8x4(bf_hi(u[4].x), bf_hi(u[5].x), bf_hi(u[6].x), bf_hi(u[7].x)); o1.z = fp8x4(bf_hi(u[8].x), bf_hi(u[9].x), bf_hi(u[10].x), bf_hi(u[11].x)); o1.w = fp8x4(bf_hi(u[12].x), bf_hi(u[13].x), bf_hi(u[14].x), bf_hi(u[15].x));
        o2.x = fp8x4(bf_lo(u[0].y), bf_lo(u[1].y), bf_lo(u[2].y), bf_lo(u[3].y)); o2.y = fp8x4(bf_lo(u[4].y), bf_lo(u[5].y), bf_lo(u[6].y), bf_lo(u[7].y)); o2.z = fp8x4(bf_lo(u[8].y), bf_lo(u[9].y), bf_lo(u[10].y), bf_lo(u[11].y)); o2.w = fp8x4(bf_lo(u[12].y), bf_lo(u[13].y), bf_lo(u[14].y), bf_lo(u[15].y));
        o3.x = fp8x4(bf_hi(u[0].y), bf_hi(u[1].y), bf_hi(u[2].y), bf_hi(u[3].y)); o3.y = fp8x4(bf_hi(u[4].y), bf_hi(u[5].y), bf_hi(u[6].y), bf_hi(u[7].y)); o3.z = fp8x4(bf_hi(u[8].y), bf_hi(u[9].y), bf_hi(u[10].y), bf_hi(u[11].y)); o3.w = fp8x4(bf_hi(u[12].y), bf_hi(u[13].y), bf_hi(u[14].y), bf_hi(u[15].y));
        *(v4u*)(dst) = o0; *(v4u*)(dst + 16) = o1; *(v4u*)(dst + 32) = o2; *(v4u*)(dst + 48) = o3;
    }
}

__device__ __forceinline__ void phase_prep(ArgP a, Frame& F, int l) {
    const bf16* P = (const bf16*)(a->ws + WS_AR + AR_P);
    bf16* QB = (bf16*)(a->ws + WS_AR + AR_QB); bf16* KC = (bf16*)(a->ws + WS_AR + AR_KC); bf16* VC = (bf16*)(a->ws + WS_AR + AR_VC);
    unsigned char* Q8 = q8_ptr(a); unsigned char* K8 = k8_ptr(a); unsigned char* V8 = v8_ptr(a);
    const float* ropec = (const float*)(a->ws + WS_ROPE); const float* ropes = ropec + 4096;
    __syncthreads();
    typedef short bf16x8_t __attribute__((ext_vector_type(8)));
    LAS unsigned char* VT = F.lds; LAS unsigned char* KTf = F.lds + 17536; LAS unsigned char* KTb = F.lds + 2 * 17536;
    float* US = (float*)(a->ws + WS_AR + AR_US);
    for (int it = F.bx; it < NB * 4 * NCH; it += F.G) {
        const int c = it % NCH, bh = it / NCH, b = bh >> 2, h = bh & 3;
        const float lgf = ((const float*)(a->ws + WS_DEC))[l * 8 + h], lgb = ((const float*)(a->ws + WS_DEC))[l * 8 + 4 + h];
        { const int p = F.tid >> 2, sg = F.tid & 3; const bf16* prow = P + (size_t)(b * RB + c * 128 + p) * INW;
            const float zf = __expf(lgf * (float)(127 - p)) * 0.125f, zb = __expf(lgb * (float)p) * 0.125f;
#pragma unroll
            for (int q = 0; q < 2; ++q) { const v4u uk = *(const v4u*)(prow + PC_RK + h * 64 + sg * 16 + q * 8), uv = *(const v4u*)(prow + PC_RV + h * 64 + sg * 16 + q * 8);
                const unsigned kw[4] = {uk.x, uk.y, uk.z, uk.w}, vw[4] = {uv.x, uv.y, uv.z, uv.w};
#pragma unroll
                for (int i = 0; i < 8; ++i) { const int ch = sg * 16 + q * 8 + i; const int off = ch * 272 + sg * 32 + 2 * p;
                    const unsigned kwv = kw[i >> 1], vwv = vw[i >> 1]; const float kf = (i & 1) ? bf_hi(kwv) : bf_lo(kwv);
                    *(LAS bf16*)(VT + off) = (bf16)((i & 1) ? (vwv >> 16) : (vwv & 0xffffu));
                    *(LAS bf16*)(KTf + off) = (bf16)(pkbf(kf * zf, 0.f) & 0xffffu); *(LAS bf16*)(KTb + off) = (bf16)(pkbf(kf * zb, 0.f) & 0xffffu); } } }
        __syncthreads();
        { const int dir = F.wave >> 2, di = (F.wave >> 1) & 1, ei = F.wave & 1, r32 = F.lane & 31, hh = F.lane >> 5;
            f32x16v acc; { const float z = pg8::zero_v(); _Pragma("unroll") for (int r = 0; r < 16; ++r) acc[r] = z; }
            const int erow = 32 * ei + r32, drow = 32 * di + r32;
            const LAS unsigned char* ap = VT + erow * 272 + (erow >> 4) * 32 + 16 * hh; const LAS unsigned char* bp = (dir ? KTb : KTf) + drow * 272 + (drow >> 4) * 32 + 16 * hh;
#pragma unroll
            for (int s8 = 0; s8 < 8; ++s8) { const bf16x8_t av = *(const LAS bf16x8_t*)(ap + 32 * s8), bv = *(const LAS bf16x8_t*)(bp + 32 * s8);
                acc = __builtin_amdgcn_mfma_f32_32x32x16_bf16(av, bv, acc, 0, 0, 0); }
            float* dst = US + ((size_t)(chain_id(b, h, dir) * NCH + c)) * 4096;
#pragma unroll
            for (int r = 0; r < 16; ++r) dst[(32 * ei + crow32(r, hh)) * 64 + 32 * di + r32] = acc[r]; }
        __syncthreads();
    }
}

__device__ __forceinline__ void phase_scan(ArgP a, Frame& F, int l) {
    float* US = (float*)(a->ws + WS_AR + AR_US);
    LAS int* cnt = (LAS int*)F.lds;
    if (F.tid == 0) { int z; asm volatile("v_mov_b32 %0, 0" : "=v"(z)); cnt[0] = z; cnt[1] = z; }
    __syncthreads();
    if (F.tid < 256) {
        for (int id = F.bx * 256 + F.tid; id < 16 * 4096; id += F.G * 256) {
            const int chain = id >> 12, e = id & 4095, dir = chain & 1, h = (chain >> 1) & 3;
            const float dec = ((const float*)(a->ws + WS_DEC))[16 + l * 8 + dir * 4 + h];
            float* base = US + (size_t)chain * NCH * 4096 + e; float st = 0.f;
            bf16* sb = (bf16*)(a->ws + WS_AR + AR_MX) + (size_t)chain * NCH * 4096 + e;
            for (int s0 = 0; s0 < NCH; s0 += 10) { float u[10]; int ci[10];
#pragma unroll
                for (int q = 0; q < 10; ++q) { const int s = s0 + q; ci[q] = dir == 0 ? s : (s < 2 ? 1 - s : NCH + 1 - s); u[q] = base[(size_t)ci[q] * 4096]; }
#pragma unroll
                for (int q = 0; q < 10; ++q) { base[(size_t)ci[q] * 4096] = st; sb[(size_t)ci[q] * 4096] = (bf16)(pkbf(st, 0.f) & 0xffffu); st = dec * st + u[q]; } }
        }
    }
    a = args_here(); relaunder(F);
    qkv_items(a, F, l, (LAS int*)F.lds);
}

__device__ __forceinline__ void ret_out_item(ArgP a, Frame& F, int l, int b, int c, int hp, int buf) {
    typedef short bf16x8_t __attribute__((ext_vector_type(8)));
    const bf16* P = (const bf16*)(a->ws + WS_AR + AR_P); bf16* MIX = (bf16*)(a->ws + WS_AR + AR_MIX);
    LAS bf16* VT = (LAS bf16*)(F.lds + buf * 34816);
    const int hl = F.wave >> 2, head = 2 * hp + hl, pi = F.wave & 3, r32 = F.lane & 31, hh = F.lane >> 5;
    const int row0 = b * RB + c * 128;
    { const int m = F.tid >> 2, qd = F.tid & 3; const bf16* src = P + (size_t)(row0 + m) * INW + PC_RV + (2 * hp) * 64 + 32 * qd;
        LAS bf16* dst = VT + (size_t)((qd >> 1) * 64 + 32 * (qd & 1)) * 132 + m;
#pragma unroll
        for (int q = 0; q < 4; ++q) { const v4u u = *(const v4u*)(src + 8 * q);
            dst[(8 * q + 0) * 132] = (bf16)(u.x & 0xffffu); dst[(8 * q + 1) * 132] = (bf16)(u.x >> 16); dst[(8 * q + 2) * 132] = (bf16)(u.y & 0xffffu); dst[(8 * q + 3) * 132] = (bf16)(u.y >> 16);
            dst[(8 * q + 4) * 132] = (bf16)(u.z & 0xffffu); dst[(8 * q + 5) * 132] = (bf16)(u.z >> 16); dst[(8 * q + 6) * 132] = (bf16)(u.w & 0xffffu); dst[(8 * q + 7) * 132] = (bf16)(u.w >> 16); } }
    bf16x8_t qf[4], kf[4][4];
    { const bf16* qrow = P + (size_t)(row0 + 32 * pi + r32) * INW + PC_RQ + head * 64 + 8 * hh;
#pragma unroll
        for (int d0 = 0; d0 < 4; ++d0) qf[d0] = *(const bf16x8_t*)(qrow + 16 * d0);
#pragma unroll
        for (int mb = 0; mb < 4; ++mb) { const bf16* krow = P + (size_t)(row0 + 32 * mb + r32) * INW + PC_RK + head * 64 + 8 * hh;
#pragma unroll
            for (int d0 = 0; d0 < 4; ++d0) kf[mb][d0] = *(const bf16x8_t*)(krow + 16 * d0); } }
    const float L2E = 1.4426950408889634f;
    const float lgf2 = ((const float*)(a->ws + WS_DEC))[l * 8 + head] * L2E, lgb2 = ((const float*)(a->ws + WS_DEC))[l * 8 + 4 + head] * L2E;
    int p = 32 * pi + r32; asm volatile("" : "+v"(p));
    bf16x8_t pk[8];
#pragma unroll
    for (int mb = 0; mb < 4; ++mb) {
        f32x16v st; { const float z = pg8::zero_v(); _Pragma("unroll") for (int r = 0; r < 16; ++r) st[r] = z; }
#pragma unroll
        for (int d0 = 0; d0 < 4; ++d0) st = __builtin_amdgcn_mfma_f32_32x32x16_bf16(kf[mb][d0], qf[d0], st, 0, 0, 0);
#pragma unroll
        for (int r = 0; r < 16; ++r) { const float fd = (float)(p - (32 * mb + crow32(r, hh)));
            const float arg = lgf2 * fmaxf(fd, 0.f) + lgb2 * fmaxf(-fd, 0.f) + fmaxf(1.0f - fabsf(fd), 0.f) - 3.0f;
            st[r] = st[r] * __builtin_amdgcn_exp2f(arg); }
        v4u w0, w1; w0.x = pkbf(st[0], st[1]); w0.y = pkbf(st[2], st[3]); w0.z = pkbf(st[4], st[5]); w0.w = pkbf(st[6], st[7]);
        w1.x = pkbf(st[8], st[9]); w1.y = pkbf(st[10], st[11]); w1.z = pkbf(st[12], st[13]); w1.w = pkbf(st[14], st[15]);
        pk[2 * mb] = __builtin_bit_cast(bf16x8_t, w0); pk[2 * mb + 1] = __builtin_bit_cast(bf16x8_t, w1);
    }
    __builtin_amdgcn_sched_barrier(0);
    const float ef = __builtin_amdgcn_exp2f(lgf2 * (float)(p + 1)), ebk = __builtin_amdgcn_exp2f(lgb2 * (float)(128 - p));
    f32x16v ot[2];
    { const float z = pg8::zero_v(); _Pragma("unroll") for (int r = 0; r < 16; ++r) { ot[0][r] = z; ot[1][r] = z; } }
    { const bf16* SB = (const bf16*)(a->ws + WS_AR + AR_MX);
      const bf16* Sf = SB + ((size_t)(chain_id(b, head, 0) * NCH + c)) * 4096; const bf16* Sb = SB + ((size_t)(chain_id(b, head, 1) * NCH + c)) * 4096;
#pragma unroll
        for (int s4 = 0; s4 < 4; ++s4) {
            const v4u qu = __builtin_bit_cast(v4u, qf[s4]); v4u qa, qb;
            qa.x = pkbf(bf_lo(qu.x) * ef, bf_hi(qu.x) * ef); qa.y = pkbf(bf_lo(qu.y) * ef, bf_hi(qu.y) * ef); qa.z = pkbf(bf_lo(qu.z) * ef, bf_hi(qu.z) * ef); qa.w = pkbf(bf_lo(qu.w) * ef, bf_hi(qu.w) * ef);
            qb.x = pkbf(bf_lo(qu.x) * ebk, bf_hi(qu.x) * ebk); qb.y = pkbf(bf_lo(qu.y) * ebk, bf_hi(qu.y) * ebk); qb.z = pkbf(bf_lo(qu.z) * ebk, bf_hi(qu.z) * ebk); qb.w = pkbf(bf_lo(qu.w) * ebk, bf_hi(qu.w) * ebk);
#pragma unroll
            for (int eb = 0; eb < 2; ++eb) { const int off = (32 * eb + r32) * 64 + 16 * s4 + 8 * hh;
                const bf16x8_t wf = *(const bf16x8_t*)(Sf + off), wb = *(const bf16x8_t*)(Sb + off);
                ot[eb] = __builtin_amdgcn_mfma_f32_32x32x16_bf16(wf, __builtin_bit_cast(bf16x8_t, qa), ot[eb], 0, 0, 0);
                ot[eb] = __builtin_amdgcn_mfma_f32_32x32x16_bf16(wb, __builtin_bit_cast(bf16x8_t, qb), ot[eb], 0, 0, 0); } } }
    __builtin_amdgcn_sched_barrier(0);
    __syncthreads();
    { const LAS bf16* vrow = VT + (size_t)(hl * 64 + r32) * 132 + 4 * hh;
#pragma unroll
        for (int eb = 0; eb < 2; ++eb)
#pragma unroll
            for (int sg = 0; sg < 8; ++sg) { const LAS bf16* vp = vrow + (size_t)(32 * eb) * 132 + 16 * sg;
                const v2u lo = *(const LAS v2u*)vp, hi = *(const LAS v2u*)(vp + 8);
                const v4u av = (v4u){lo.x, lo.y, hi.x, hi.y};
                ot[eb] = __builtin_amdgcn_mfma_f32_32x32x16_bf16(__builtin_bit_cast(bf16x8_t, av), pk[sg], ot[eb], 0, 0, 0); } }
    __builtin_amdgcn_sched_barrier(0);
    float s1 = 0.f, s2 = 0.f;
#pragma unroll
    for (int eb = 0; eb < 2; ++eb)
#pragma unroll
        for (int r = 0; r < 16; ++r) { const float v = ot[eb][r]; s1 += v; s2 += v * v; }
    { auto rr = __builtin_amdgcn_permlane32_swap(__float_as_uint(s1), __float_as_uint(s1), false, false); s1 = __uint_as_float(rr[0]) + __uint_as_float(rr[1]); }
    { auto rr = __builtin_amdgcn_permlane32_swap(__float_as_uint(s2), __float_as_uint(s2), false, false); s2 = __uint_as_float(rr[0]) + __uint_as_float(rr[1]); }
    const float mu = s1 * (1.0f / 64.0f); const float var = fmaxf(s2 * (1.0f / 64.0f) - mu * mu, 0.f); const float rstd = 1.0f / sqrtf(var + EPS);
    const size_t orow = (size_t)(row0 + p);
#pragma unroll
    for (int eb = 0; eb < 2; ++eb)
#pragma unroll
        for (int g = 0; g < 4; ++g) { const int e0 = 32 * eb + 8 * g + 4 * hh;
            const v2u gu = *(const v2u*)(P + orow * INW + PC_RG + head * 64 + e0);
            const float g0 = bf_lo(gu.x), g1 = bf_hi(gu.x), g2 = bf_lo(gu.y), g3 = bf_hi(gu.y);
            v2u w; w.x = pkbf(siluf(g0) * ((ot[eb][4 * g] - mu) * rstd), siluf(g1) * ((ot[eb][4 * g + 1] - mu) * rstd)); w.y = pkbf(siluf(g2) * ((ot[eb][4 * g + 2] - mu) * rstd), siluf(g3) * ((ot[eb][4 * g + 3] - mu) * rstd));
            *(v2u*)(MIX + orow * DM + 512 + head * 64 + e0) = w; }
}
__device__ __forceinline__ void pool_item(ArgP a, Frame& F, int l, int b, int tl, int g) {
    typedef short bf16x8_t __attribute__((ext_vector_type(8)));
    const bf16* P = (const bf16*)(a->ws + WS_AR + AR_P); bf16* MIX = (bf16*)(a->ws + WS_AR + AR_MIX);
    LAS bf16* msb = (LAS bf16*)F.lds;
    LAS bf16* wt = (LAS bf16*)(F.lds + 18432);
    LAS bf16* ost = (LAS bf16*)(F.lds + 18432 + 9216);
    const int sb = (tl < 2) ? 0 : CTX, T = (tl < 2) ? CTX : SEQ, hw = 1 << g  ;
    { const int d = F.tid & 63, cq = F.tid >> 6; const float* W = a->in[I_POOLW] + ((size_t)(l * 4 + g)) * 4096 + d;
        v4u o; o.x = pkbf(W[(8 * cq + 0) * 64], W[(8 * cq + 1) * 64]); o.y = pkbf(W[(8 * cq + 2) * 64], W[(8 * cq + 3) * 64]); o.z = pkbf(W[(8 * cq + 4) * 64], W[(8 * cq + 5) * 64]); o.w = pkbf(W[(8 * cq + 6) * 64], W[(8 * cq + 7) * 64]);
        *(LAS v4u*)(wt + d * 72 + 8 * cq) = o; }
    { const int p = F.tid >> 2, qd = F.tid & 3; const int t = tl * 128 - sb + p; const int lo = max(t - hw, 0), hi = min(t + hw, T);
        float acc[16];
#pragma unroll
        for (int e = 0; e < 16; ++e) acc[e] = 0.f;
        const bf16* colp = P + (size_t)(b * RB + sb) * INW + PC_PP + g * 64 + 16 * qd;
        for (int tt = lo; tt < hi; ++tt) { const v4u u0 = *(const v4u*)(colp + (size_t)tt * INW), u1 = *(const v4u*)(colp + (size_t)tt * INW + 8);
            acc[0] += bf_lo(u0.x); acc[1] += bf_hi(u0.x); acc[2] += bf_lo(u0.y); acc[3] += bf_hi(u0.y); acc[4] += bf_lo(u0.z); acc[5] += bf_hi(u0.z); acc[6] += bf_lo(u0.w); acc[7] += bf_hi(u0.w);
            acc[8] += bf_lo(u1.x); acc[9] += bf_hi(u1.x); acc[10] += bf_lo(u1.y); acc[11] += bf_hi(u1.y); acc[12] += bf_lo(u1.z); acc[13] += bf_hi(u1.z); acc[14] += bf_lo(u1.w); acc[15] += bf_hi(u1.w); }
        const v4u s0 = *(const v4u*)(colp + (size_t)t * INW), s1 = *(const v4u*)(colp + (size_t)t * INW + 8);
        const float sf[16] = {bf_lo(s0.x), bf_hi(s0.x), bf_lo(s0.y), bf_hi(s0.y), bf_lo(s0.z), bf_hi(s0.z), bf_lo(s0.w), bf_hi(s0.w), bf_lo(s1.x), bf_hi(s1.x), bf_lo(s1.y), bf_hi(s1.y), bf_lo(s1.z), bf_hi(s1.z), bf_lo(s1.w), bf_hi(s1.w)};
        const float inv = 1.0f / (float)(hi - lo);
        float m[16];
#pragma unroll
        for (int e = 0; e < 16; ++e) m[e] = acc[e] * inv - sf[e];
        v4u o0, o1; o0.x = pkbf(m[0], m[1]); o0.y = pkbf(m[2], m[3]); o0.z = pkbf(m[4], m[5]); o0.w = pkbf(m[6], m[7]); o1.x = pkbf(m[8], m[9]); o1.y = pkbf(m[10], m[11]); o1.z = pkbf(m[12], m[13]); o1.w = pkbf(m[14], m[15]);
        *(LAS v4u*)(msb + p * 72 + 16 * qd) = o0; *(LAS v4u*)(msb + p * 72 + 16 * qd + 8) = o1; }
    __syncthreads();
    { const int pi = F.wave >> 1, di = F.wave & 1, i = F.lane & 31, kk = F.lane >> 5; f32x16v o; { const float z = pg8::zero_v(); _Pragma("unroll") for (int r = 0; r < 16; ++r) o[r] = z; }
        const LAS bf16* ap = msb + (32 * pi + i) * 72 + 8 * kk; const LAS bf16* bp = wt + (32 * di + i) * 72 + 8 * kk;
#pragma unroll
        for (int s4 = 0; s4 < 4; ++s4) o = __builtin_amdgcn_mfma_f32_32x32x16_bf16(*(const LAS bf16x8_t*)(ap + 16 * s4), *(const LAS bf16x8_t*)(bp + 16 * s4), o, 0, 0, 0);
        const float scl = a->in[I_POOLS][l * 256 + g * 64 + 32 * di + i];
#pragma unroll
        for (int r = 0; r < 16; ++r) ost[(32 * pi + crow32(r, kk)) * 72 + 32 * di + i] = (bf16)(pkbf(o[r] * scl, 0.f) & 0xffffu); }
    __syncthreads();
    { bf16* obase = MIX + (size_t)(b * RB + tl * 128) * DM + 768 + g * 64;
#pragma unroll
        for (int k = 0; k < 2; ++k) { const int idx = F.tid + 512 * k, row = idx >> 3, ch = idx & 7; *(v4u*)(obase + (size_t)row * DM + 8 * ch) = *(const LAS v4u*)(ost + row * 72 + 8 * ch); } }
    __syncthreads();
}
__device__ __forceinline__ void phase_mix(ArgP a, Frame& F, int l, int vcu) {
    { int nb = 0;
      for (int it = F.bx; it < NB * NCH * 2; it += F.G) { const int hp = it & 1, r = it >> 1, c = r % NCH, b = r / NCH;
          if (l == 1 && c < 2) continue;
          ret_out_item(a, F, l, b, c, hp, nb & 1); ++nb; }
      __syncthreads(); }
    for (int it = (F.bx + F.G - 16) % F.G; it < NB * 4 * NCH; it += F.G) { const int c = it % NCH, bh = it / NCH, b = bh >> 2, hg = bh & 3;
        if (l == 1 && c < 2) continue;
        pool_item(a, F, l, b, c, hg); }
    const bf16* QBp = (const bf16*)(a->ws + WS_AR + AR_QB); const bf16* KC = (const bf16*)(a->ws + WS_AR + AR_KC); const bf16* VC = (const bf16*)(a->ws + WS_AR + AR_VC); bf16* MIX = (bf16*)(a->ws + WS_AR + AR_MIX);
    const unsigned char* Q8 = q8_ptr(a); const unsigned char* K8 = k8_ptr(a); const unsigned char* V8 = v8_ptr(a);
    const int NU = NB * 8 * (SEQ / 256);
    float mref;
    { float gq = fabsf(a->in[I_QN][l * 64 + F.lane]), gk = fabsf(a->in[I_KN][l * 64 + F.lane]);
#pragma unroll
      for (int o = 0; o < 1; ++o) { gq = fmaxf(gq, shx<1>(gq)); gk = fmaxf(gk, shx<1>(gk)); gq = fmaxf(gq, shx<2>(gq)); gk = fmaxf(gk, shx<2>(gk)); gq = fmaxf(gq, shx<4>(gq)); gk = fmaxf(gk, shx<4>(gk));
          gq = fmaxf(gq, shx<8>(gq)); gk = fmaxf(gk, shx<8>(gk)); gq = fmaxf(gq, shx<16>(gq)); gk = fmaxf(gk, shx<16>(gk)); gq = half_max(gq); gk = half_max(gk); }
      mref = fminf(64.0f * gq * gk * attn_body::C2 * 1.01f + 0.125f, 64.0f); mref = __builtin_amdgcn_readfirstlane(mref); }
    for (int i = 0; ; ++i) {
        int u;
        if (F.G == 256) { if (i >= 4) break; const int x = vcu >> 5, cu = vcu & 31; const int grp = x >> 1; u = grp * 256 + (x & 1) * 128 + cu * 4 + i; }
        else { u = F.bx + i * F.G; if (u >= NU) break; }
        const int grp = u >> 8, w = u & 255, b = grp >> 1, kvh = grp & 1, hd = kvh * 4 + (w >> 6), qb = w & 63;
        const size_t qrow = (size_t)b * RB + CTX + qb * 256;
#if ATT8_DEBUG
        attn_body::attn_unit(F.tid, mref, (const attn_body::bf16*)(QBp + qrow * 512 + hd * 64), 512, (const attn_body::bf16*)(KC + (size_t)(b * 2 + kvh) * RB * 64), (const attn_body::bf16*)(VC + (size_t)(b * 2 + kvh) * RB * 64), RB / 64,
                                (attn_body::bf16*)(MIX + qrow * DM + hd * 64), DM, (char*)F.lds);
        attn_body::attn_unit8(F.tid, mref, Q8 + qrow * 512 + hd * 64, 512, K8 + (size_t)(b * 2 + kvh) * (RB / 64) * 4096, V8 + (size_t)(b * 2 + kvh) * (RB / 64) * 4096, RB / 64,
                                (attn_body::bf16*)((bf16*)(a->ws + WS_AR + DO_O8) + qrow * 512 + hd * 64), 512, (char*)F.lds);
#else
        attn_body::attn_unit8(F.tid, mref, Q8 + qrow * 512 + hd * 64, 512, K8 + (size_t)(b * 2 + kvh) * (RB / 64) * 4096, V8 + (size_t)(b * 2 + kvh) * (RB / 64) * 4096, RB / 64,
                                (attn_body::bf16*)(MIX + qrow * DM + hd * 64), DM, (char*)F.lds);
#endif
    }
    if (l == 0) {
        for (int u = (F.bx + F.G - 32) % F.G; u < NB * 8; u += F.G) { const int b = u >> 3, hd = u & 7, kvh = hd >> 2; const size_t qrow = (size_t)b * RB;
#if ATT8_DEBUG
            attn_body::attn_unit(F.tid, mref, (const attn_body::bf16*)(QBp + qrow * 512 + hd * 64), 512, (const attn_body::bf16*)(KC + (size_t)(b * 2 + kvh) * RB * 64), (const attn_body::bf16*)(VC + (size_t)(b * 2 + kvh) * RB * 64), CTX / 64,
                                    (attn_body::bf16*)(MIX + qrow * DM + hd * 64), DM, (char*)F.lds);
            attn_body::attn_unit8(F.tid, mref, Q8 + qrow * 512 + hd * 64, 512, K8 + (size_t)(b * 2 + kvh) * (RB / 64) * 4096, V8 + (size_t)(b * 2 + kvh) * (RB / 64) * 4096, CTX / 64,
                                    (attn_body::bf16*)((bf16*)(a->ws + WS_AR + DO_O8) + qrow * 512 + hd * 64), 512, (char*)F.lds);
#else
            attn_body::attn_unit8(F.tid, mref, Q8 + qrow * 512 + hd * 64, 512, K8 + (size_t)(b * 2 + kvh) * (RB / 64) * 4096, V8 + (size_t)(b * 2 + kvh) * (RB / 64) * 4096, CTX / 64,
                                    (attn_body::bf16*)(MIX + qrow * DM + hd * 64), DM, (char*)F.lds);
#endif
        }
    }
}
struct PlainSched {
    int nM, nN, G, c, skipctx; const char* A; const char* B; size_t tA, tB;
    __device__ __forceinline__ bool next(int i, pg8::Unit& u) const {
        const long L = (long)i * G + c; if (L >= (long)nM * nN) return false;
        int pm, pn; pg8::deal((int)L, nM, nN, pm, pn); if (skipctx) pm = pm + 1 + (pm >= 64 ? 1 : 0);
        u.pm = pm; u.pn = pn; u.a = A + (size_t)pm * tA; u.b = B + (size_t)pn * tB; u.goff = 0; u.gcnt = 0; return true; }
};
struct CtxSplitSched {
    int nN, nsp, G, c, KL; const char* A; const char* B; size_t tA, tB;
    __device__ __forceinline__ bool next(int i, pg8::Unit& u) const {
        const long L = (long)i * G + c; if (L >= (long)2 * nN * nsp) return false;
        const int ct = (int)L & 1, r = (int)L >> 1, pn = r % nN, ks = r / nN;
        u.pm = 2 * ks + ct; u.pn = pn; u.a = A + (size_t)(ct * 65) * tA + (size_t)ks * KL * 2; u.b = B + (size_t)pn * tB + (size_t)ks * KL * 2; u.goff = 0; u.gcnt = 0; return true; }
};
struct CtxFullSched {
    int nN, G, c; const char* A; const char* B; size_t tA, tB;
    __device__ __forceinline__ bool next(int i, pg8::Unit& u) const {
        const long L = (long)i * G + c; if (L >= (long)2 * nN) return false;
        const int ct = (int)L & 1, pn = (int)L >> 1;
        u.pm = ct * 65; u.pn = pn; u.a = A + (size_t)(ct * 65) * tA; u.b = B + (size_t)pn * tB; u.goff = 0; u.gcnt = 0; return true; }
};
struct MoeSched {
    int nM, nN, G, c, t0, up, c0; const char* A; const char* W; size_t tA, tB, wsz; int ts[9], cnt[8];
    __device__ __forceinline__ bool next(int i, pg8::Unit& u) const {
        long L = (long)i * G + c;
        if (c0 > 0) { const int w = G - c0; const long E = 3L * w; L = (c >= c0) ? ((i < 3) ? (long)i * w + (c - c0) : E + (long)(i - 3) * G + c) : E + (long)i * G + c; }
        if (L >= (long)nM * nN) return false;
        int pml, pn; pg8::deal((int)L, nM, nN, pml, pn); const int rt = t0 + pml;
        int e = 0, tse = 0, ce = cnt[0];
#pragma unroll
        for (int k = 1; k < 8; ++k) { const bool sel = (rt >= ts[k]) && (ts[k + 1] > ts[k]); e = sel ? k : e; tse = sel ? ts[k] : tse; ce = sel ? cnt[k] : ce; }
        const int lt = rt - tse;
        u.pn = pn; u.b = W + (size_t)e * wsz + (size_t)pn * tB;
        if (up) { u.pm = pml; u.a = A; u.goff = e * LISTCAP + lt * 256; const int rem = ce - lt * 256; u.gcnt = rem < 256 ? rem : 256; }
        else { u.pm = rt; u.a = A + (size_t)pml * tA; u.goff = 0; u.gcnt = 0; }
        return true; }
};

#if ATT8_DEBUG
__device__ __forceinline__ void dbg_compare(ArgP a, Frame& F, int l) {
    const bf16* MIX = (const bf16*)(a->ws + WS_AR + AR_MIX); const bf16* O8 = (const bf16*)(a->ws + WS_AR + DO_O8);
    float sd = 0.f, so = 0.f;
    for (int row = F.gw; row < NR; row += F.NGW) { const int b = row / RB, jj = row - b * RB; if (jj < CTX && l == 1) continue;
        const v4u x = *(const v4u*)(MIX + (size_t)row * DM + 8 * F.lane), y = *(const v4u*)(O8 + (size_t)row * 512 + 8 * F.lane);
        const float xv[8] = {bf_lo(x.x), bf_hi(x.x), bf_lo(x.y), bf_hi(x.y), bf_lo(x.z), bf_hi(x.z), bf_lo(x.w), bf_hi(x.w)}, yv[8] = {bf_lo(y.x), bf_hi(y.x), bf_lo(y.y), bf_hi(y.y), bf_lo(y.z), bf_hi(y.z), bf_lo(y.w), bf_hi(y.w)};
#pragma unroll
        for (int j = 0; j < 8; ++j) { const float d = yv[j] - xv[j]; sd += d * d; so += xv[j] * xv[j]; } }
    sd = wave_sum(sd); so = wave_sum(so);
    if (F.lane == 0) { atomicAdd((float*)(a->ws + WS_CTL) + 2048, sd); atomicAdd((float*)(a->ws + WS_CTL) + 2049, so); }
}
#endif
constexpr int N_PHASES_K = 22;
__global__ void __launch_bounds__(NWAVES * 64, 2) mk_fwd(Args a_unused) {
    extern __shared__ __attribute__((aligned(16))) unsigned char lds[];
    Frame F; ArgP a = args_here();
    F.lds = (LAS unsigned char*)lds;
    relaunder(F);
    unsigned* ctl = (unsigned*)(a->ws + WS_CTL);
    for (int u = F.tid; u < (LDS_BYTES - RING_BYTES) / 4; u += NWAVES * 64) ((LAS unsigned*)(F.lds + RING_BYTES))[u] = 0u;
    __syncthreads();
    volatile LAS unsigned* MISC = (volatile LAS unsigned*)(F.lds + MISC_OFF);
    XcdBarrier bar = xcd_barrier_post(ctl + CW_BAR + a->li * XCD_BAR_WORDS, MISC + 8);
    LAS unsigned* gtab = (LAS unsigned*)(F.lds + GTAB_OFF);
    const int lo = a->ph_lo, hi = a->ph_hi; int ph = 0;
#define RUN (a = args_here(), relaunder(F), (ph >= lo && ph < hi))
#ifndef PROF_MASK
#define PROF_MASK 0
#endif
#ifndef PROF_AMP
#define PROF_AMP 10
#endif
#if PROF_MASK
#define PROF_STAMP(k_) do { if (blockIdx.x == 0 && threadIdx.x == 0) ((volatile unsigned long long*)(a->ws + WS_CTL + 32768))[k_] = wall_clock64(); } while (0)
#else
#define PROF_STAMP(k_) do { } while (0)
#endif
#define SEAM() do { if (ph >= lo && ph + 1 < hi) xcd_barrier(bar); ++ph; a = args_here(); PROF_STAMP(ph); } while (0)
    unsigned char* AR = a->ws + WS_AR;
    PROF_STAMP(0);

    if (RUN) phase_p0a(a, F);
    SEAM();
    if (RUN) phase_premix0(a, F);
    SEAM();
#pragma unroll 1
    for (int l = 0; l < 2; ++l) {
        if (RUN) {
            if ((IN_I8 >> l) & 1) {
                PlainSched S{NR / 256, INW / 256, F.G, F.bx, 0, (const char*)(AR + AR_MIX), (const char*)(a->ws + WS_WIN + l * SZ_WIN), (size_t)256 * DM, (size_t)256 * DM};
                pg8::EpiBf16S E{(bf16*)(AR + AR_P), INW, 1.0f / (I8_XI * I8_WS)};
                pg8::gemm_phase<pg8::EpiBf16S, PlainSched, true, false, 2>(F.tid, F.lds, gtab, nullptr, DM / 2, DM / 2, S, E);
            } else if (IN1_F8 && l == 1) {
                PlainSched S{NR / 256, INW / 256, F.G, F.bx, 0, (const char*)(AR + AR_MIX), (const char*)(a->ws + WS_WIN + SZ_WIN), (size_t)256 * DM, (size_t)256 * DM};
                pg8::EpiBf16S E{(bf16*)(AR + AR_P), INW, 1.0f / 64.0f};
                pg8::gemm_phase<pg8::EpiBf16S, PlainSched, true, false, 1>(F.tid, F.lds, gtab, nullptr, DM / 2, DM / 2, S, E);
            } else {
            PlainSched S{NR / 256, INW / 256, F.G, F.bx, 0, (const char*)(AR + AR_MIX), (const char*)(a->ws + WS_WIN + l * SZ_WIN), (size_t)256 * DM * 2, (size_t)256 * DM * 2};
            pg8::EpiBf16 E{(bf16*)(AR + AR_P), INW};
            pg8::gemm_phase<pg8::EpiBf16, PlainSched, true, false>(F.tid, F.lds, gtab, nullptr, DM, DM, S, E); }
        }
        SEAM();
        if (RUN) phase_prep(a, F, l);
        SEAM();
        if (RUN) phase_scan(a, F, l);
        SEAM();
        if (RUN) phase_mix(a, F, l, (F.G % 8 == 0) ? (F.bx % 8) * (F.G / 8) + (F.bx / 8) : F.bx);
        SEAM();
        if (RUN) {
#if ATT8_DEBUG
            dbg_compare(a, F, l);
#endif
            PlainSched S{NLAT / 256, DM / 256, F.G, F.bx, 1, (const char*)(AR + AR_MIX), (const char*)(a->ws + WS_WOUT + l * SZ_WOUT), (size_t)256 * DM * 2, (size_t)256 * DM * 2};
            pg8::EpiBf16 E{(bf16*)(AR + AR_MX), DM};
            pg8::gemm_phase<pg8::EpiBf16, PlainSched, true, false>(F.tid, F.lds, gtab, nullptr, DM, DM, S, E);
            if (l == 0) {
                CtxSplitSched S2{DM / 256, 4, F.G, F.bx, 256, (const char*)(AR + AR_MIX), (const char*)(a->ws + WS_WOUT), (size_t)256 * DM * 2, (size_t)256 * DM * 2};
                pg8::EpiF32 E2{(float*)(AR + AR_PART0), DM};
                pg8::gemm_phase<pg8::EpiF32, CtxSplitSched, true, false>(F.tid, F.lds, gtab, nullptr, DM, 256, S2, E2); }
        }
        SEAM();
        if (l == 0) {
            if (RUN) phase_resid<0>(a, F);
            SEAM();
            if (RUN) {
#if DENSE_F8
                PlainSched S{NR / 256, 2 * FF / 256, F.G, F.bx, 0, (const char*)(AR + AR_HX2), (const char*)(a->ws + WS_W13D), (size_t)256 * DM, (size_t)256 * DM};
                pg8::EpiSwiglu8 E{(unsigned char*)(AR + AR_ACT), FF, 1.0f / 64.0f, 8.0f};
                pg8::gemm_phase<pg8::EpiSwiglu8, PlainSched, true, false, 1>(F.tid, F.lds, gtab, nullptr, DM / 2, DM / 2, S, E);
#elif DENSE_I8UP
                PlainSched S{NR / 256, 2 * FF / 256, F.G, F.bx, 0, (const char*)(AR + AR_HX2), (const char*)(a->ws + WS_W13D), (size_t)256 * DM, (size_t)256 * DM};
#if DENSE_DOWN_F8
                pg8::EpiSwiglu8 E{(unsigned char*)(AR + AR_ACT), FF, 1.0f / (I8_XS * I8_WS), 8.0f};
                pg8::gemm_phase<pg8::EpiSwiglu8, PlainSched, true, false, 2>(F.tid, F.lds, gtab, nullptr, DM / 2, DM / 2, S, E);
#else
                pg8::EpiSwigluS E{(bf16*)(AR + AR_ACT), FF, 1.0f / (I8_XS * I8_WS)};
                pg8::gemm_phase<pg8::EpiSwigluS, PlainSched, true, false, 2>(F.tid, F.lds, gtab, nullptr, DM / 2, DM / 2, S, E);
#endif
#else
                PlainSched S{NR / 256, 2 * FF / 256, F.G, F.bx, 0, (const char*)(AR + AR_HX2), (const char*)(a->ws + WS_W13D), (size_t)256 * DM * 2, (size_t)256 * DM * 2};
                pg8::EpiSwiglu E{(bf16*)(AR + AR_ACT), FF};
                pg8::gemm_phase<pg8::EpiSwiglu, PlainSched, true, false>(F.tid, F.lds, gtab, nullptr, DM, DM, S, E);
#endif
            }
            SEAM();
            if (RUN) {
#if DENSE_F8 || DENSE_DOWN_F8
                PlainSched S{NLAT / 256, DM / 256, F.G, F.bx, 1, (const char*)(AR + AR_ACT), (const char*)(a->ws + WS_W2D), (size_t)256 * FF, (size_t)256 * FF};
                pg8::EpiBf16S E{(bf16*)(AR + AR_YD), DM, 1.0f / 512.0f};
                pg8::gemm_phase<pg8::EpiBf16S, PlainSched, true, false, 1>(F.tid, F.lds, gtab, nullptr, FF / 2, FF / 2, S, E);
#if DENSE_DOWN_F8 && !DENSE_F8
                CtxFullSched S2{DM / 256, F.G, F.bx, (const char*)(AR + AR_ACT), (const char*)(a->ws + WS_W2D), (size_t)256 * FF, (size_t)256 * FF};
                pg8::gemm_phase<pg8::EpiBf16S, CtxFullSched, true, false, 1>(F.tid, F.lds, gtab, nullptr, FF / 2, FF / 2, S2, E);
#else
                CtxSplitSched S2{DM / 256, 11, F.G, F.bx, 128, (const char*)(AR + AR_ACT), (const char*)(a->ws + WS_W2D), (size_t)256 * FF, (size_t)256 * FF};
                pg8::EpiF32S E2{(float*)(AR + AR_PART1), DM, 1.0f / 512.0f};
                pg8::gemm_phase<pg8::EpiF32S, CtxSplitSched, true, false, 1>(F.tid, F.lds, gtab, nullptr, FF / 2, 128, S2, E2);
#endif
#else
                PlainSched S{NLAT / 256, DM / 256, F.G, F.bx, 1, (const char*)(AR + AR_ACT), (const char*)(a->ws + WS_W2D), (size_t)256 * FF * 2, (size_t)256 * FF * 2};
                pg8::EpiBf16 E{(bf16*)(AR + AR_YD), DM};
                pg8::gemm_phase<pg8::EpiBf16, PlainSched, true, false>(F.tid, F.lds, gtab, nullptr, FF, FF, S, E);
                CtxSplitSched S2{DM / 256, 11, F.G, F.bx, 256, (const char*)(AR + AR_ACT), (const char*)(a->ws + WS_W2D), (size_t)256 * FF * 2, (size_t)256 * FF * 2};
                pg8::EpiF32 E2{(float*)(AR + AR_PART1), DM};
                pg8::gemm_phase<pg8::EpiF32, CtxSplitSched, true, false>(F.tid, F.lds, gtab, nullptr, FF, 256, S2, E2);
#endif
            }
            SEAM();
            if (RUN) phase_resid<1>(a, F);
            SEAM();
        } else {
            if (RUN) phase_resid<2>(a, F);
            SEAM();
#pragma unroll 1
            for (int p = 0; p <= MOE_PASSES; ++p) {
                if (RUN) {
                    constexpr size_t ACTB = (size_t)MOE_TP * 256 * FF;
                    int nprev = 0;
                    if (p >= 1) {
                        MoeSched S; moe_prefix(a->ws, S.ts, S.cnt);
                        const int tot = S.ts[8]; int n = tot - (p - 1) * MOE_TP; n = n < 0 ? 0 : (n > MOE_TP ? MOE_TP : n); nprev = n;
                        S.nM = n; S.nN = DM / 256; S.G = F.G; S.c = F.bx; S.t0 = (p - 1) * MOE_TP; S.up = 0; S.c0 = 0; S.A = (const char*)(AR + AR_ACT + ((p - 1) & 1) * ACTB); S.W = (const char*)(a->ws + WS_W2M); S.tA = (size_t)256 * FF; S.tB = (size_t)256 * FF; S.wsz = SZ8_W2;
                        pg8::EpiBf16S E{(bf16*)(AR + AR_YM), DM, 1.0f / 512.0f};
                        pg8::gemm_phase<pg8::EpiBf16S, MoeSched, true, false, 1>(F.tid, F.lds, gtab, nullptr, FF / 2, FF / 2, S, E);
                    }
                    if (p < MOE_PASSES) {
                        a = args_here(); relaunder(F);
                        MoeSched S; moe_prefix(a->ws, S.ts, S.cnt);
                        const int tot = S.ts[8]; int n = tot - p * MOE_TP; n = n < 0 ? 0 : (n > MOE_TP ? MOE_TP : n);
                        S.nM = n; S.nN = 2 * FF / 256; S.G = F.G; S.c = F.bx; S.t0 = p * MOE_TP; S.up = 1; S.A = (const char*)(AR + AR_HX2); S.W = (const char*)(a->ws + WS_W13M); S.tA = 0; S.tB = (size_t)256 * DM; S.wsz = SZ8_W13;
                        { const int nd = nprev * (DM / 256), r = nd % F.G; S.c0 = (r != 0 && 3L * (F.G - r) <= (long)n * S.nN) ? r : 0; }
                        pg8::EpiSwiglu8 E{(unsigned char*)(AR + AR_ACT + (p & 1) * ACTB), FF, MOE_I8UP ? 1.0f / (I8_XS * I8_WS) : 1.0f / 64.0f, 8.0f};
                        pg8::gemm_phase<pg8::EpiSwiglu8, MoeSched, true, true, MOE_I8UP ? 2 : 1>(F.tid, F.lds, gtab, (const int*)(a->ws + WS_LIST), DM / 2, DM / 2, S, E);
                    }
                }
                SEAM();
            }
            if (RUN) phase_resid<3>(a, F);
            ++ph;
        }
    }
#if PROF_MASK
    a = args_here(); relaunder(F);
    if (F.bx == 0 && F.tid == 0) {
        PROF_STAMP(N_PHASES_K);
        const volatile unsigned long long* ts = (const volatile unsigned long long*)(a->ws + WS_CTL + 32768); long long sum = 0;
        for (int k = 0; k < N_PHASES_K; ++k) if ((PROF_MASK >> k) & 1) sum += (long long)(ts[k + 1] - ts[k]);
        const long long ticks = sum * PROF_AMP; const long long t0 = wall_clock64();
        while (wall_clock64() - t0 < ticks) __builtin_amdgcn_s_sleep(32);
    }
#endif
#if ATT8_DEBUG
    a = args_here(); relaunder(F);
    if (F.bx == 0 && F.tid == 0) {
        const float sd = __hip_atomic_load((float*)(a->ws + WS_CTL) + 2048, RLX_AGENT), so = __hip_atomic_load((float*)(a->ws + WS_CTL) + 2049, RLX_AGENT);
        float nl = -__log2f(sd / so); if (!(nl > 0.f)) nl = 0.f; if (nl > 40.f) nl = 40.f;
        const long long ticks = (long long)(nl * 200000.f); const long long t0 = wall_clock64();
        while (wall_clock64() - t0 < ticks) __builtin_amdgcn_s_sleep(32);
    }
#endif
#undef RUN
#undef SEAM
}
constexpr int N_PHASES = 22;

#ifndef DET_PROBE
#define DET_PROBE 0
#endif
#if DET_PROBE
__global__ void det_cksum(const unsigned* out, unsigned long long* dst, int n) {
    unsigned long long s = 0; for (int i = blockIdx.x * blockDim.x + threadIdx.x; i < n; i += gridDim.x * blockDim.x) s += (unsigned long long)out[i] * (unsigned)(2 * (i & 1023) + 1);
    for (int o = 32; o > 0; o >>= 1) s += __shfl_xor(s, o);
    if ((threadIdx.x & 63) == 0) atomicAdd(dst, s);
}
__global__ void det_fill(unsigned* p, size_t n, unsigned v) { for (size_t i = (size_t)blockIdx.x * blockDim.x + threadIdx.x; i < n; i += (size_t)gridDim.x * blockDim.x) p[i] = v; }
__global__ void det_cmp(const unsigned long long* c, float* out) { if (c[0] != c[1]) out[0] = __builtin_nanf(""); }
#endif
#ifndef MK_N_LAUNCHES
#define MK_N_LAUNCHES 1
#endif
extern "C" void kernel_launch(void* const* d_in, const int* in_sizes, int n_in, void* d_out, int out_size, void* d_ws, size_t ws_size, hipStream_t stream) {
    static int grid = 0;
    if (grid == 0) {
        if (n_in != 24 || out_size != NLAT * DM || ws_size < WS_END) { fprintf(stderr, "kernel_launch: unexpected shapes (n_in %d out %d ws %zu)\n", n_in, out_size, ws_size); grid = -1; return; }
        int dev = 0, cus = 0, per_cu = 0;
        if (hipGetDevice(&dev) != hipSuccess || hipDeviceGetAttribute(&cus, hipDeviceAttributeMultiprocessorCount, dev) != hipSuccess) { grid = -1; return; }
        if (hipFuncSetAttribute((const void*)mk_fwd, hipFuncAttributeMaxDynamicSharedMemorySize, LDS_BYTES) != hipSuccess) { fprintf(stderr, "kernel_launch: hipFuncSetAttribute failed\n"); grid = -1; return; }
        if (hipOccupancyMaxActiveBlocksPerMultiprocessor(&per_cu, (const void*)mk_fwd, NWAVES * 64, LDS_BYTES) != hipSuccess || per_cu < 1) fprintf(stderr, "kernel_launch: occupancy query says %d\n", per_cu);
        (void)hipGetLastError();
        grid = cus;
        while (grid > 8 && (NLAT % (2 * grid * NWAVES) != 0 || NLAT / (grid * NWAVES) > 64)) --grid;
    }
    if (grid < 0) return;
    if (hipMemsetAsync((char*)d_ws + WS_CTL, 0, CTL_ZERO_BYTES, stream) != hipSuccess) return;
    Args a{};
    for (int i = 0; i < 24; ++i) a.in[i] = (const float*)d_in[i];
    a.out = (float*)d_out; a.ws = (unsigned char*)d_ws; a.pad = 0;
#if DET_PROBE
    { a.ph_lo = 0; a.ph_hi = N_PHASES; a.li = 0;
      unsigned long long* ck = (unsigned long long*)((char*)d_ws + WS_CTL + 65536);
      hipLaunchKernelGGL(det_fill, dim3(2048), dim3(256), 0, stream, (unsigned*)((char*)d_ws + MiB), (WS_END - MiB) / 4, 0x3C3C3C3Cu);
      hipLaunchKernelGGL(mk_fwd, dim3(grid), dim3(NWAVES * 64), LDS_BYTES, stream, a);
      hipLaunchKernelGGL(det_cksum, dim3(1024), dim3(256), 0, stream, (const unsigned*)d_out, ck, out_size);
      if (hipMemsetAsync((char*)d_ws + WS_CTL, 0, 65536, stream) != hipSuccess) return;
      hipLaunchKernelGGL(det_fill, dim3(2048), dim3(256), 0, stream, (unsigned*)((char*)d_ws + MiB), (WS_END - MiB) / 4, 0xBDBDBDBDu);
      hipLaunchKernelGGL(det_fill, dim3(2048), dim3(256), 0, stream, (unsigned*)d_out, (size_t)out_size, 0xBDBDBDBDu);
      hipLaunchKernelGGL(mk_fwd, dim3(grid), dim3(NWAVES * 64), LDS_BYTES, stream, a);
      hipLaunchKernelGGL(det_cksum, dim3(1024), dim3(256), 0, stream, (const unsigned*)d_out, ck + 1, out_size);
      hipLaunchKernelGGL(det_cmp, dim3(1), dim3(1), 0, stream, (const unsigned long long*)ck, (float*)d_out);
      return; }
#endif
    if (MK_N_LAUNCHES == 1) { a.ph_lo = 0; a.ph_hi = N_PHASES; a.li = 0; hipLaunchKernelGGL(mk_fwd, dim3(grid), dim3(NWAVES * 64), LDS_BYTES, stream, a); }
    else { for (int p = 0; p < N_PHASES; ++p) { a.ph_lo = p; a.ph_hi = p + 1; a.li = p; hipLaunchKernelGGL(mk_fwd, dim3(grid), dim3(NWAVES * 64), LDS_BYTES, stream, a); } }
}
```

```cpp
#include <hip/hip_runtime.h>
#include <hip/hip_bf16.h>
#include <cstdio>
#include <cstdint>
#include <cmath>
namespace pg8 {
#define PG8_LAS __attribute__((address_space(3)))
typedef unsigned short bf16_t;
typedef short bf16x8 __attribute__((ext_vector_type(8)));
typedef float f32x4 __attribute__((ext_vector_type(4)));
typedef unsigned u32x4 __attribute__((ext_vector_type(4)));
typedef int i32x4_t __attribute__((ext_vector_type(4)));
typedef int i32x8_t __attribute__((ext_vector_type(8)));
typedef int i32x8_t __attribute__((ext_vector_type(8)));
constexpr int BM = 256, BK = 64, HALF = 128, HTB = HALF * BK * 2  , STAGE_BYTES = 8 * HTB, NXCD = 8, WGM = 8;

__host__ __device__ __forceinline__ int lds_byte(int r, int c) { const int st = (r >> 4) * 2 + (c >> 5), rr = r & 15, cc = c & 31, ob = rr * 64 + cc * 2; return st * 1024 + (ob ^ (((ob >> 9) & 1) << 5)); }
__host__ __device__ __forceinline__ void stage_rc(int b, int& R, int& C) { const int st = b / 1024, sb = b % 1024, swz = sb ^ (((sb >> 9) & 1) << 5); R = (st >> 1) * 16 + swz / 64; C = (st & 1) * 32 + (swz % 64) / 2; }
__host__ __device__ __forceinline__ int perm32(int rho) { const int n = rho >> 4, i = rho & 15; return 8 * (i >> 2) + 4 * n + (i & 3); }

struct Unit { int pm, pn; const char* a; const char* b; int goff, gcnt; };

__device__ __forceinline__ void deal(int L, int nM, int nN, int& pm, int& pn) {
    const int nwg = nM * nN; int wgid = L;
    { const int q = nwg / NXCD, r = nwg % NXCD, xcd = wgid % NXCD, off = wgid / NXCD; wgid = (xcd < r ? xcd * (q + 1) : r * (q + 1) + (xcd - r) * q) + off; }
    const int nig = WGM * nN, gid = wgid / nig, fm = gid * WGM, gsz = (nM - fm) < WGM ? (nM - fm) : WGM;
    pm = fm + ((wgid % nig) % gsz); pn = (wgid % nig) / gsz;
}

__device__ __forceinline__ float zero_v() { float z; asm volatile("v_mov_b32 %0, 0" : "=v"(z)); return z; }
__device__ __forceinline__ unsigned cvt_pk_bf16(float lo, float hi) { unsigned r; asm volatile("v_cvt_pk_bf16_f32 %0, %1, %2" : "=v"(r) : "v"(lo), "v"(hi)); return r; }

struct EpiBf16 {
    static constexpr bool PERM = true;
    bf16_t* O; int ldc;
    __device__ __forceinline__ void operator()(const f32x4 (&acc)[2][2][4][2], const Unit& u, int wr, int wc, int fr, int fq) const {
        const int row0 = u.pm * BM + wr * 64 + fr; const int col0 = u.pn * BM + wc * 32 + 8 * fq;
#pragma unroll
        for (int ai = 0; ai < 2; ++ai)
#pragma unroll
            for (int m = 0; m < 4; ++m) { bf16_t* rowp = O + (size_t)(row0 + ai * HALF + m * 16) * ldc + col0;
#pragma unroll
                for (int bj = 0; bj < 2; ++bj) { const f32x4 v0 = acc[ai][bj][m][0], v1 = acc[ai][bj][m][1];
                    u32x4 w; w.x = cvt_pk_bf16(v0[0], v0[1]); w.y = cvt_pk_bf16(v0[2], v0[3]); w.z = cvt_pk_bf16(v1[0], v1[1]); w.w = cvt_pk_bf16(v1[2], v1[3]);
                    *(u32x4*)(rowp + bj * HALF) = w; } }
    }
};
struct EpiF32 {
    static constexpr bool PERM = false;
    float* O; int ldc;
    __device__ __forceinline__ void operator()(const f32x4 (&acc)[2][2][4][2], const Unit& u, int wr, int wc, int fr, int fq) const {
        const int row0 = u.pm * BM + wr * 64 + fr; const int col0 = u.pn * BM + wc * 32 + 4 * fq;
#pragma unroll
        for (int ai = 0; ai < 2; ++ai)
#pragma unroll
            for (int m = 0; m < 4; ++m) { float* rowp = O + (size_t)(row0 + ai * HALF + m * 16) * ldc + col0;
#pragma unroll
                for (int bj = 0; bj < 2; ++bj)
#pragma unroll
                    for (int n = 0; n < 2; ++n) *(f32x4*)(rowp + bj * HALF + n * 16) = acc[ai][bj][m][n]; }
    }
};
__device__ __forceinline__ float silu_f(float x) { return x * __builtin_amdgcn_rcpf(1.0f + __builtin_amdgcn_exp2f(-1.4426950408889634f * x)); }
struct EpiSwiglu {
    static constexpr bool PERM = true;
    bf16_t* O; int ldc;
    __device__ __forceinline__ void operator()(const f32x4 (&acc)[2][2][4][2], const Unit& u, int wr, int wc, int fr, int fq) const {
        const int row0 = u.pm * BM + wr * 64 + fr; const int col0 = u.pn * HALF + wc * 32 + 8 * fq;
#pragma unroll
        for (int ai = 0; ai < 2; ++ai)
#pragma unroll
            for (int m = 0; m < 4; ++m) { bf16_t* rowp = O + (size_t)(row0 + ai * HALF + m * 16) * ldc + col0;
                const f32x4 a0 = acc[ai][0][m][0], a1 = acc[ai][0][m][1], g0 = acc[ai][1][m][0], g1 = acc[ai][1][m][1];
                u32x4 w; w.x = cvt_pk_bf16(silu_f(a0[0]) * g0[0], silu_f(a0[1]) * g0[1]); w.y = cvt_pk_bf16(silu_f(a0[2]) * g0[2], silu_f(a0[3]) * g0[3]);
                w.z = cvt_pk_bf16(silu_f(a1[0]) * g1[0], silu_f(a1[1]) * g1[1]); w.w = cvt_pk_bf16(silu_f(a1[2]) * g1[2], silu_f(a1[3]) * g1[3]);
                *(u32x4*)rowp = w; }
    }
};

struct EpiBf16S {
    static constexpr bool PERM = true;
    bf16_t* O; int ldc; float scl;
    __device__ __forceinline__ void operator()(const f32x4 (&acc)[2][2][4][2], const Unit& u, int wr, int wc, int fr, int fq) const {
        const int row0 = u.pm * BM + wr * 64 + fr; const int col0 = u.pn * BM + wc * 32 + 8 * fq;
#pragma unroll
        for (int ai = 0; ai < 2; ++ai)
#pragma unroll
            for (int m = 0; m < 4; ++m) { bf16_t* rowp = O + (size_t)(row0 + ai * HALF + m * 16) * ldc + col0;
#pragma unroll
                for (int bj = 0; bj < 2; ++bj) { const f32x4 v0 = acc[ai][bj][m][0] * scl, v1 = acc[ai][bj][m][1] * scl;
                    u32x4 w; w.x = cvt_pk_bf16(v0[0], v0[1]); w.y = cvt_pk_bf16(v0[2], v0[3]); w.z = cvt_pk_bf16(v1[0], v1[1]); w.w = cvt_pk_bf16(v1[2], v1[3]);
                    *(u32x4*)(rowp + bj * HALF) = w; } }
    }
};
struct EpiF32S {
    static constexpr bool PERM = false;
    float* O; int ldc; float scl;
    __device__ __forceinline__ void operator()(const f32x4 (&acc)[2][2][4][2], const Unit& u, int wr, int wc, int fr, int fq) const {
        const int row0 = u.pm * BM + wr * 64 + fr; const int col0 = u.pn * BM + wc * 32 + 4 * fq;
#pragma unroll
        for (int ai = 0; ai < 2; ++ai)
#pragma unroll
            for (int m = 0; m < 4; ++m) { float* rowp = O + (size_t)(row0 + ai * HALF + m * 16) * ldc + col0;
#pragma unroll
                for (int bj = 0; bj < 2; ++bj)
#pragma unroll
                    for (int n = 0; n < 2; ++n) *(f32x4*)(rowp + bj * HALF + n * 16) = acc[ai][bj][m][n] * scl; }
    }
};
__device__ __forceinline__ unsigned cvt_fp8x4(float a, float b, float c, float d) { int w = 0; w = __builtin_amdgcn_cvt_pk_fp8_f32(a, b, w, false); w = __builtin_amdgcn_cvt_pk_fp8_f32(c, d, w, true); return (unsigned)w; }
struct EpiSwigluS {
    static constexpr bool PERM = true;
    bf16_t* O; int ldc; float si;
    __device__ __forceinline__ void operator()(const f32x4 (&acc)[2][2][4][2], const Unit& u, int wr, int wc, int fr, int fq) const {
        const int row0 = u.pm * BM + wr * 64 + fr; const int col0 = u.pn * HALF + wc * 32 + 8 * fq;
#pragma unroll
        for (int ai = 0; ai < 2; ++ai)
#pragma unroll
            for (int m = 0; m < 4; ++m) { bf16_t* rowp = O + (size_t)(row0 + ai * HALF + m * 16) * ldc + col0;
                const f32x4 a0 = acc[ai][0][m][0] * si, a1 = acc[ai][0][m][1] * si, g0 = acc[ai][1][m][0] * si, g1 = acc[ai][1][m][1] * si;
                u32x4 w; w.x = cvt_pk_bf16(silu_f(a0[0]) * g0[0], silu_f(a0[1]) * g0[1]); w.y = cvt_pk_bf16(silu_f(a0[2]) * g0[2], silu_f(a0[3]) * g0[3]);
                w.z = cvt_pk_bf16(silu_f(a1[0]) * g1[0], silu_f(a1[1]) * g1[1]); w.w = cvt_pk_bf16(silu_f(a1[2]) * g1[2], silu_f(a1[3]) * g1[3]);
                *(u32x4*)rowp = w; }
    }
};
struct EpiSwiglu8 {
    static constexpr bool PERM = true;
    unsigned char* O; int ldc; float si, so;
    __device__ __forceinline__ f32x4 sw4(const f32x4 a, const f32x4 g, const float c1, const float k2) const {
        const f32x4 t = a * c1; f32x4 e; e[0] = __builtin_amdgcn_exp2f(t[0]); e[1] = __builtin_amdgcn_exp2f(t[1]); e[2] = __builtin_amdgcn_exp2f(t[2]); e[3] = __builtin_amdgcn_exp2f(t[3]);
        const f32x4 d = e + 1.0f; f32x4 r; r[0] = __builtin_amdgcn_rcpf(d[0]); r[1] = __builtin_amdgcn_rcpf(d[1]); r[2] = __builtin_amdgcn_rcpf(d[2]); r[3] = __builtin_amdgcn_rcpf(d[3]);
        return ((a * g) * k2) * r; }
    __device__ __forceinline__ void operator()(const f32x4 (&acc)[2][2][4][2], const Unit& u, int wr, int wc, int fr, int fq) const {
        const int row0 = u.pm * BM + wr * 64 + fr; const int col0 = u.pn * HALF + wc * 32 + 8 * fq; const float c1 = -1.4426950408889634f * si, k2 = si * si * so;
#pragma unroll
        for (int ai = 0; ai < 2; ++ai)
#pragma unroll
            for (int m = 0; m < 4; ++m) { unsigned char* rowp = O + (size_t)(row0 + ai * HALF + m * 16) * ldc + col0;
                const f32x4 o0 = sw4(acc[ai][0][m][0], acc[ai][1][m][0], c1, k2), o1 = sw4(acc[ai][0][m][1], acc[ai][1][m][1], c1, k2);
                const unsigned w0 = cvt_fp8x4(o0[0], o0[1], o0[2], o0[3]), w1 = cvt_fp8x4(o1[0], o1[1], o1[2], o1[3]);
                typedef unsigned u32x2_t __attribute__((ext_vector_type(2)));
                *(u32x2_t*)rowp = (u32x2_t){w0, w1}; }
    }
};

template <class Epi, class Sched, bool ALIGN_EPI, bool GATHER, int F8 = 0  >
__device__ __forceinline__ void gemm_phase(const int tid, PG8_LAS unsigned char* lds, PG8_LAS unsigned* gtab, const int* glist, const int K  , const int KL  , const Sched& S, const Epi& E) {
    const int wid = __builtin_amdgcn_readfirstlane(tid >> 6), lane = tid & 63, wr = wid >> 2, wc = wid & 3, fr = lane & 15, fq = lane >> 4;
    const int nt = KL / BK;
    unsigned voffA[2], voffB[2]; int RA[2], CA[2];
#pragma unroll
    for (int i = 0; i < 2; ++i) { int R, C; stage_rc(tid * 16 + i * 8192, R, C); const int Rb = Epi::PERM ? ((R & ~31) + perm32(R & 31)) : R;
        voffA[i] = (unsigned)(R * K + C) * 2u; voffB[i] = (unsigned)(Rb * K + C) * 2u; RA[i] = R; CA[i] = C; }
    const size_t kstep = (size_t)(BK * 2);
    const size_t hstep = (size_t)HALF * K * 2;
    const unsigned ldsw = (unsigned)wid * 1024u;
    const int aoff = lds_byte(wr * 64 + fr, fq * 8), boff = lds_byte(wc * 32 + fr, fq * 8);
    unsigned vc[2][2], vn[2][2], v2[2][2];
#define PG8_SA(b, h) (((b) * 2 + (h)) * HTB)
#define PG8_SB(b, h) ((4 + (b) * 2 + (h)) * HTB)
#define PG8_STAGE(bufoff, gbase, voff) do { _Pragma("unroll") for (int _i = 0; _i < 2; ++_i) \
        __builtin_amdgcn_global_load_lds((const unsigned*)((const char*)(gbase) + (voff)[_i]), (PG8_LAS unsigned*)(lds + (bufoff) + ldsw + _i * 8192), 16, 0, 0); } while (0)
#define PG8_STAGE_A(bufoff, gbase, h, VG) do { if constexpr (GATHER) { PG8_STAGE(bufoff, gbase, VG[h]); } else { PG8_STAGE(bufoff, (gbase) + (h) * hstep, voffA); } } while (0)
#define PG8_LDA(dst, b, h) do { _Pragma("unroll") for (int m = 0; m < 4; ++m) _Pragma("unroll") for (int k = 0; k < 2; ++k) dst[m][k] = *(const PG8_LAS bf16x8*)(lds + PG8_SA(b, h) + aoff + m * 2048 + k * 1024); } while (0)
#define PG8_LDB(dst, b, h) do { _Pragma("unroll") for (int n = 0; n < 2; ++n) _Pragma("unroll") for (int k = 0; k < 2; ++k) dst[n][k] = *(const PG8_LAS bf16x8*)(lds + PG8_SB(b, h) + boff + n * 2048 + k * 1024); } while (0)
#define PG8_CAT(x) __builtin_shufflevector(__builtin_bit_cast(i32x4_t, x[0]), __builtin_bit_cast(i32x4_t, x[1]), 0, 1, 2, 3, 4, 5, 6, 7)
#define PG8_MMA(ai, bj, At, Bt) do { __builtin_amdgcn_s_setprio(1); \
        if constexpr (F8 == 2) { _Pragma("unroll") for (int m = 0; m < 4; ++m) _Pragma("unroll") for (int n = 0; n < 2; ++n) _Pragma("unroll") for (int k = 0; k < 2; ++k) \
            asm volatile("v_mfma_i32_16x16x64_i8 %0, %1, %2, %0" : "+v"(acc[ai][bj][m][n]) : "v"(Bt[n][k]), "v"(At[m][k])); } \
        else if constexpr (F8 == 1) { _Pragma("unroll") for (int m = 0; m < 4; ++m) _Pragma("unroll") for (int n = 0; n < 2; ++n) \
            { const i32x8_t b8_ = PG8_CAT(Bt[n]), a8_ = PG8_CAT(At[m]); asm volatile("v_mfma_f32_16x16x128_f8f6f4 %0, %1, %2, %0" : "+v"(acc[ai][bj][m][n]) : "v"(b8_), "v"(a8_)); } } \
        else { _Pragma("unroll") for (int m = 0; m < 4; ++m) _Pragma("unroll") for (int n = 0; n < 2; ++n) _Pragma("unroll") for (int k = 0; k < 2; ++k) \
            acc[ai][bj][m][n] = __builtin_amdgcn_mfma_f32_16x16x32_bf16(Bt[n][k], At[m][k], acc[ai][bj][m][n], 0, 0, 0); } __builtin_amdgcn_s_setprio(0); } while (0)
#define PG8_WAIT_V(n) asm volatile("s_waitcnt vmcnt(" #n ")" ::: "memory")
#define PG8_WAIT_L(n) asm volatile("s_waitcnt lgkmcnt(" #n ")" ::: "memory")
#define PG8_BAR __builtin_amdgcn_s_barrier()
#define PG8_SCHED __builtin_amdgcn_sched_barrier(0)
#define PG8_GT_DMA(u) do { if (wid < 4) __builtin_amdgcn_global_load_lds((const unsigned*)(glist + (u).goff + wid * 64 + lane), (PG8_LAS unsigned*)(gtab + wid * 64), 4, 0, 0); } while (0)
#define PG8_GT_READ(V, u) do { _Pragma("unroll") for (int _h = 0; _h < 2; ++_h) _Pragma("unroll") for (int _i = 0; _i < 2; ++_i) { const int _p = _h * HALF + RA[_i]; int _r = (int)gtab[_p]; _r = (_p < (u).gcnt) ? _r : 0; \
        V[_h][_i] = ((unsigned)_r * (unsigned)K + (unsigned)CA[_i]) * 2u; } } while (0)
    Unit cur, nxt; int ui = 0;
    if (!S.next(0, cur)) return;
    f32x4 acc[2][2][4][2];
    { const float z = zero_v();
#pragma unroll
    for (int a = 0; a < 2; ++a)
#pragma unroll
        for (int b = 0; b < 2; ++b)
#pragma unroll
            for (int m = 0; m < 4; ++m)
#pragma unroll
                for (int n = 0; n < 2; ++n) acc[a][b][m][n] = (f32x4){z, z, z, z}; }
    bf16x8 At[4][2], B0[2][2], B1[2][2];
    const char* cA = cur.a; const char* cB = cur.b;
    if constexpr (GATHER) { PG8_GT_DMA(cur); PG8_WAIT_V(0); PG8_BAR; PG8_GT_READ(vc, cur); PG8_WAIT_L(0); PG8_BAR; }
    if constexpr (GATHER) {
#pragma unroll
        for (int _h = 0; _h < 2; ++_h) { vn[_h][0] = vc[_h][0]; vn[_h][1] = vc[_h][1]; } }
    PG8_STAGE(PG8_SB(0, 0), cB, voffB); PG8_STAGE(PG8_SB(0, 1), cB + hstep, voffB); PG8_STAGE_A(PG8_SA(0, 0), cA, 0, vc); PG8_STAGE_A(PG8_SA(0, 1), cA, 1, vc);
    if (wr == 1) PG8_BAR;
    PG8_WAIT_V(2); PG8_BAR;
    PG8_STAGE(PG8_SB(1, 0), cB + kstep, voffB); PG8_STAGE_A(PG8_SA(1, 0), cA + kstep, 0, vc); PG8_STAGE(PG8_SB(1, 1), cB + hstep + kstep, voffB);
    PG8_WAIT_V(6); PG8_BAR;
    for (;;) {
        const bool has_next = S.next(ui + 1, nxt);
        if constexpr (GATHER) { if (has_next) PG8_GT_DMA(nxt); }
        const char* nA = has_next ? nxt.a : cA; const char* nB = has_next ? nxt.b : cB;
        for (int t = 0; t < nt; t += 2) {
            const bool last = (t == nt - 2);
            const char* a1 = cA + (size_t)(t + 1) * kstep;
            const char* a2 = last ? nA : cA + (size_t)(t + 2) * kstep; const char* b2 = last ? nB : cB + (size_t)(t + 2) * kstep;
            const char* a3 = a2 + kstep; const char* b3 = b2 + kstep;
            if constexpr (GATHER) {
                if (last) { if (has_next) { PG8_GT_READ(vn, nxt); } else {
#pragma unroll
                        for (int _h = 0; _h < 2; ++_h) { vn[_h][0] = vc[_h][0]; vn[_h][1] = vc[_h][1]; } } }
#pragma unroll
                for (int _h = 0; _h < 2; ++_h) { v2[_h][0] = last ? vn[_h][0] : vc[_h][0]; v2[_h][1] = last ? vn[_h][1] : vc[_h][1]; }
            }
            PG8_LDB(B0, 0, 0); PG8_LDB(B1, 0, 1); PG8_SCHED; PG8_LDA(At, 0, 0); PG8_STAGE_A(PG8_SA(1, 1), a1, 1, vc);
            PG8_WAIT_V(8); PG8_WAIT_L(0); PG8_BAR; PG8_MMA(0, 0, At, B0); PG8_MMA(0, 1, At, B1); PG8_BAR; PG8_SCHED;
            PG8_LDA(At, 0, 1); PG8_STAGE(PG8_SB(0, 0), b2, voffB); PG8_STAGE(PG8_SB(0, 1), b2 + hstep, voffB); PG8_STAGE_A(PG8_SA(0, 0), a2, 0, v2);
            PG8_WAIT_V(8); PG8_WAIT_L(0); PG8_BAR; PG8_MMA(1, 0, At, B0); PG8_MMA(1, 1, At, B1); PG8_BAR; PG8_SCHED;
            PG8_LDB(B0, 1, 0); PG8_LDB(B1, 1, 1); PG8_SCHED; PG8_LDA(At, 1, 0); PG8_STAGE_A(PG8_SA(0, 1), a2, 1, v2);
            PG8_WAIT_V(8); PG8_WAIT_L(0); PG8_BAR; PG8_MMA(0, 0, At, B0); PG8_MMA(0, 1, At, B1); PG8_BAR; PG8_SCHED;
            PG8_LDA(At, 1, 1); PG8_STAGE(PG8_SB(1, 0), b3, voffB); PG8_STAGE(PG8_SB(1, 1), b3 + hstep, voffB); PG8_STAGE_A(PG8_SA(1, 0), a3, 0, v2);
            PG8_WAIT_V(8); PG8_WAIT_L(0); PG8_BAR; PG8_MMA(1, 0, At, B0); PG8_MMA(1, 1, At, B1); PG8_BAR; PG8_SCHED;
        }
        if constexpr (ALIGN_EPI) { if (wr == 0) PG8_BAR; }
        if constexpr (F8 != 0) {
            asm volatile("s_nop 15\n\ts_nop 15" : "+v"(acc[1][0][0][0]), "+v"(acc[1][0][0][1]), "+v"(acc[1][0][1][0]), "+v"(acc[1][0][1][1]), "+v"(acc[1][0][2][0]), "+v"(acc[1][0][2][1]), "+v"(acc[1][0][3][0]), "+v"(acc[1][0][3][1]) :: "memory");
            asm volatile("" : "+v"(acc[1][1][0][0]), "+v"(acc[1][1][0][1]), "+v"(acc[1][1][1][0]), "+v"(acc[1][1][1][1]), "+v"(acc[1][1][2][0]), "+v"(acc[1][1][2][1]), "+v"(acc[1][1][3][0]), "+v"(acc[1][1][3][1]) :: "memory"); }
        if constexpr (F8 == 2) {
#pragma unroll
            for (int a_ = 0; a_ < 2; ++a_)
#pragma unroll
                for (int b_ = 0; b_ < 2; ++b_)
#pragma unroll
                    for (int m = 0; m < 4; ++m)
#pragma unroll
                        for (int n = 0; n < 2; ++n) { const i32x4_t iv = __builtin_bit_cast(i32x4_t, acc[a_][b_][m][n]); acc[a_][b_][m][n] = (f32x4){(float)iv[0], (float)iv[1], (float)iv[2], (float)iv[3]}; } }
        E(acc, cur, wr, wc, fr, fq);
        if (!has_next) break;
        { const float z = zero_v();
#pragma unroll
        for (int a = 0; a < 2; ++a)
#pragma unroll
            for (int b = 0; b < 2; ++b)
#pragma unroll
                for (int m = 0; m < 4; ++m)
#pragma unroll
                    for (int n = 0; n < 2; ++n) acc[a][b][m][n] = (f32x4){z, z, z, z}; }
        cur = nxt; cA = nA; cB = nB; ++ui;
        if constexpr (GATHER) {
#pragma unroll
            for (int _h = 0; _h < 2; ++_h) { vc[_h][0] = vn[_h][0]; vc[_h][1] = vn[_h][1]; } }
        if constexpr (ALIGN_EPI) { if (wr == 1) PG8_BAR; }
    }
    PG8_WAIT_V(0);
    if constexpr (!ALIGN_EPI) { if (wr == 0) PG8_BAR; }
    PG8_BAR;
#undef PG8_SA
#undef PG8_SB
#undef PG8_STAGE
#undef PG8_STAGE_A
#undef PG8_LDA
#undef PG8_LDB
#undef PG8_CAT
#undef PG8_MMA
#undef PG8_WAIT_V
#undef PG8_WAIT_L
#undef PG8_BAR
#undef PG8_SCHED
#undef PG8_GT_DMA
#undef PG8_GT_READ
}
}
namespace attn_body {
using bf16=__hip_bfloat16;
using bf16x8=__attribute__((ext_vector_type(8)))short;
using s16x4=__attribute__((ext_vector_type(4)))short;
using f32x16=__attribute__((ext_vector_type(16)))float;
using u32x4=__attribute__((ext_vector_type(4)))unsigned;
constexpr int D=64,KP=64;
constexpr int NW=8,QBLK=32,QB=QBLK*NW,KVBLK=64;
__device__ __forceinline__ int crow(int r,int hi){return (r&3)+8*(r>>2)+4*hi;}
#define SBAR() __builtin_amdgcn_sched_barrier(0)
constexpr int NSLOT=3, SLOTB=8192;
constexpr int LDS_K=0, LDS_V=NSLOT*SLOTB, LDS_WS=2*NSLOT*SLOTB, LDS_OST=LDS_WS+NW*64*4, LDS_BYTES=LDS_OST+NW*4096;
constexpr float C2=0.125f*1.4426950408889634f;
__device__ __forceinline__ void glds16(const void*gsrc,unsigned lds_dst){unsigned keep;
  asm volatile("s_mov_b32 %0, m0\n\ts_mov_b32 m0, %2\n\ts_nop 0\n\tglobal_load_lds_dwordx4 %1, off\n\ts_mov_b32 m0, %0":"=&s"(keep):"v"(gsrc),"s"(lds_dst):"memory");}
__device__ __forceinline__ float max3f(float a,float b,float c){float r;asm("v_max3_f32 %0, %1, %2, %3":"=v"(r):"v"(a),"v"(b),"v"(c));return r;}
__device__ __forceinline__ float max2f(float a,float b){float r;asm("v_max_f32_e32 %0, %1, %2":"=v"(r):"v"(a),"v"(b));return r;}
__device__ __forceinline__ float fadd_s(float a,float b){float r;asm("v_add_f32_e32 %0, %1, %2":"=v"(r):"v"(a),"v"(b));return r;}
__device__ __forceinline__ float fsub_s(float a,float b){float r;asm("v_sub_f32_e32 %0, %1, %2":"=v"(r):"v"(a),"v"(b));return r;}
typedef float f32x2_t __attribute__((ext_vector_type(2))); typedef __bf16 bf16x2_t __attribute__((ext_vector_type(2)));
__device__ __forceinline__ unsigned cvtpk_s(float lo,float hi){f32x2_t v={lo,hi};bf16x2_t b=__builtin_convertvector(v,bf16x2_t);return __builtin_bit_cast(unsigned,b);}
#define WAIT_BAR(N) asm volatile("s_waitcnt vmcnt(" #N ") lgkmcnt(0)\n\ts_barrier":::"memory")

__device__ __forceinline__ void qkt(f32x16&p0,f32x16&p1,const char*Kslot,const bf16x8*qr,const f32x16&negm,int r32,int hi){
  const char*kb=Kslot+hi*1024+r32*16;
  #pragma unroll
  for(int d0=0;d0<4;++d0){
    const bf16x8 b0=*reinterpret_cast<const bf16x8*>(kb+d0*2048);
    const bf16x8 b1=*reinterpret_cast<const bf16x8*>(kb+d0*2048+512);
    if(d0==0){p0=__builtin_amdgcn_mfma_f32_32x32x16_bf16(b0,qr[0],negm,0,0,0);p1=__builtin_amdgcn_mfma_f32_32x32x16_bf16(b1,qr[0],negm,0,0,0);}
    else{p0=__builtin_amdgcn_mfma_f32_32x32x16_bf16(b0,qr[d0],p0,0,0,0);p1=__builtin_amdgcn_mfma_f32_32x32x16_bf16(b1,qr[d0],p1,0,0,0);}}
}
typedef __attribute__((address_space(3))) const char* lds_cptr;
typedef short v4i16_t __attribute__((ext_vector_type(4)));
__device__ __forceinline__ void kload8(bf16x8*kf,lds_cptr kp){
  kf[0]=*(const __attribute__((address_space(3))) bf16x8*)(kp);      kf[1]=*(const __attribute__((address_space(3))) bf16x8*)(kp+512);
  kf[2]=*(const __attribute__((address_space(3))) bf16x8*)(kp+2048); kf[3]=*(const __attribute__((address_space(3))) bf16x8*)(kp+2560);
  kf[4]=*(const __attribute__((address_space(3))) bf16x8*)(kp+4096); kf[5]=*(const __attribute__((address_space(3))) bf16x8*)(kp+4608);
  kf[6]=*(const __attribute__((address_space(3))) bf16x8*)(kp+6144); kf[7]=*(const __attribute__((address_space(3))) bf16x8*)(kp+6656);
}
__device__ __forceinline__ void kload2(bf16x8*kf,lds_cptr kp,int j){ kf[2*j]=*(const __attribute__((address_space(3))) bf16x8*)(kp+j*2048); kf[2*j+1]=*(const __attribute__((address_space(3))) bf16x8*)(kp+j*2048+512); }
__device__ __forceinline__ s16x4 vtr(lds_cptr p){ return __builtin_bit_cast(s16x4,__builtin_amdgcn_ds_read_tr16_b64_v4i16((__attribute__((address_space(3))) v4i16_t*)p)); }
__device__ __forceinline__ float rowmax(const f32x16&p0,const f32x16&p1){
  float a=max3f(p0[0],p0[1],p1[0]),b=max3f(p0[2],p0[3],p1[1]);a=max3f(a,p1[2],p1[3]);
  #pragma unroll
  for(int r=4;r<16;r+=4){a=max3f(a,p0[r],p0[r+1]);b=max3f(b,p0[r+2],p0[r+3]);a=max3f(a,p1[r],p1[r+1]);b=max3f(b,p1[r+2],p1[r+3]);}
  const float m=max2f(a,b);
  auto rr=__builtin_amdgcn_permlane32_swap(__float_as_uint(m),__float_as_uint(m),false,false);
  return max2f(__uint_as_float(rr[0]),__uint_as_float(rr[1]));
}
__device__ __forceinline__ void pv(f32x16*o,int vb,bf16x8 pa0,bf16x8 pa1,bf16x8 pa2,bf16x8 pa3){
  #pragma unroll
  for(int d0=0;d0<2;++d0){s16x4 lo[4],hi[4];
    #pragma unroll
    for(int ks=0;ks<4;++ks){
      asm volatile("ds_read_b64_tr_b16 %0,%1 offset:%c2":"=&v"(lo[ks]):"v"(vb),"i"(d0*4096+ks*1024):"memory");
      asm volatile("ds_read_b64_tr_b16 %0,%1 offset:%c2":"=&v"(hi[ks]):"v"(vb),"i"(d0*4096+ks*1024+512):"memory");}
    asm volatile("s_waitcnt lgkmcnt(0)":::"memory");SBAR();
    #define PK(k) (bf16x8){lo[k][0],lo[k][1],lo[k][2],lo[k][3],hi[k][0],hi[k][1],hi[k][2],hi[k][3]}
    o[d0]=__builtin_amdgcn_mfma_f32_32x32x16_bf16(pa0,PK(0),o[d0],0,0,0);
    o[d0]=__builtin_amdgcn_mfma_f32_32x32x16_bf16(pa1,PK(1),o[d0],0,0,0);
    o[d0]=__builtin_amdgcn_mfma_f32_32x32x16_bf16(pa2,PK(2),o[d0],0,0,0);
    o[d0]=__builtin_amdgcn_mfma_f32_32x32x16_bf16(pa3,PK(3),o[d0],0,0,0);
    #undef PK
  }
}

__device__ __forceinline__ void attn_unit(const int tid,const float mref,const bf16*Qu,int QP,const bf16*__restrict__ Kh,const bf16*__restrict__ Vh,int NT,bf16*Ou,int OP,char*shm){
  const int lane=tid&63,r32=lane&31,hi=lane>>5; const int wid=__builtin_amdgcn_readfirstlane(tid>>6);
  const bf16*Qw=Qu+(long)(wid*QBLK)*QP;
  const unsigned lds0=(unsigned)(uintptr_t)shm;
  float*wsf=(float*)(shm+LDS_WS)+wid*64;
  const bf16*ksrc=Kh+(long)lane*KP+wid*8;
  const bf16*vsrc=Vh+(long)(16*(wid&3)+(lane>>2))*KP+(wid>>2)*32+(lane&3)*8;
  const unsigned kdst=lds0+LDS_K+wid*1024, vdst=lds0+LDS_V+wid*1024;
  #define DMA_K(t,slot) glds16(ksrc+(long)(t)*KVBLK*KP,(unsigned)__builtin_amdgcn_readfirstlane(kdst+(slot)))
  #define DMA_V(t,slot) glds16(vsrc+(long)(t)*KVBLK*KP,(unsigned)__builtin_amdgcn_readfirstlane(vdst+(slot)))
  const int vb0=(int)(lds0+LDS_V)+((lane>>4)&1)*32+(lane&3)*8+(4*hi+((lane&15)>>2))*64;
  const char*Kbase=shm+LDS_K; bf16x8 kf[8];
  const lds_cptr shm3=(lds_cptr)shm; const lds_cptr kp0=shm3+LDS_K+hi*1024+r32*16; const lds_cptr vp0=shm3+LDS_V+((lane>>4)&1)*32+(lane&3)*8+(4*hi+((lane&15)>>2))*64;
  DMA_K(0,0);DMA_V(0,0);DMA_K(1,SLOTB);
  bf16x8 qr[4];
  #pragma unroll
  for(int d0=0;d0<4;++d0)qr[d0]=*reinterpret_cast<const bf16x8*>(&Qw[(long)r32*QP+d0*16+hi*8]);
  float l_reg=0.f;f32x16 o[2],negm; { const float z=pg8::zero_v(); _Pragma("unroll") for(int r=0;r<16;++r){o[0][r]=z;o[1][r]=z;negm[r]=z-mref;} } asm volatile("":"+v"(negm));
  f32x16 pA0,pA1,pB0,pB1;
  int sl_prev=0,sl_cur=0,sl_next=SLOTB;
  #define ROT() do{sl_prev=sl_cur;sl_cur=sl_next;sl_next=(sl_next==(NSLOT-1)*SLOTB)?0:sl_next+SLOTB;}while(0)
  DMA_K(2,2*SLOTB);
  WAIT_BAR(3);
  qkt(pA0,pA1,Kbase,qr,negm,r32,hi);asm volatile("s_nop 15\n\ts_nop 7":"+v"(pA0),"+v"(pA1));
  _Pragma("unroll") for(int r=0;r<16;++r){pA0[r]=__builtin_amdgcn_exp2f(pA0[r]);pA1[r]=__builtin_amdgcn_exp2f(pA1[r]);}
  WAIT_BAR(0);
  DMA_K(3,0);DMA_V(1,SLOTB);
  ROT();
  kload8(kf,kp0+sl_cur);
  WAIT_BAR(2);
  s16x4 vlo[8],vhi[8]; u32x4 pw0,pw1,pw2,pw3;
  #define MFX(a_,b_,c_) __builtin_amdgcn_mfma_f32_32x32x16_bf16(a_,b_,c_,0,0,0)
  #define PKW(P,B) cvtpk_s(P[B],P[B+1])
  #define PAF(k) __builtin_bit_cast(bf16x8,pw##k)
  #define VFR(i) (bf16x8){vlo[i][0],vlo[i][1],vlo[i][2],vlo[i][3],vhi[i][0],vhi[i][1],vhi[i][2],vhi[i][3]}
  #define PIN(x) asm volatile("":"+v"(x))
  #define GAPA(MF,A0,A1,A2,A3,W0,W1,PW) do{ MF; sacc+=A0; sacc+=A1; sacc+=A2; sacc+=A3; PIN(sacc); W0; W1; PIN(PW); SBAR(); }while(0)
  #define EX(v) __builtin_amdgcn_exp2f(v)
  #define GAPB(MF,X,B) do{ MF; X[B]=EX(X[B]); X[B+1]=EX(X[B+1]); X[B+2]=EX(X[B+2]); X[B+3]=EX(X[B+3]); PIN(X); SBAR(); }while(0)
  #define VRD(i) do{ vlo[i]=vtr(vp_+(((i)>>2)*4096+((i)&3)*1024)); vhi[i]=vtr(vp_+(((i)>>2)*4096+((i)&3)*1024+512)); }while(0)
  #define KRD(G,j) do{ if(G){ kload2(kf,kp0+sl_next,j); SBAR(); } }while(0)
  #define STEP(C0,C1,P0,P1,t,GK,GV,GL) do{ SBAR(); \
    const lds_cptr vp_=vp0+sl_prev; \
    VRD(0); SBAR(); float sacc=(P0[0]+P0[1]); \
    GAPA(C0=MFX(kf[0],qr[0],negm), P0[2],P0[3],P0[4],P0[5],     pw0[0]=PKW(P0,0), pw0[1]=PKW(P0,2), pw0); \
    VRD(4); SBAR(); GAPA(C1=MFX(kf[1],qr[0],negm), P0[6],P0[7],P0[8],P0[9],     pw0[2]=PKW(P0,4), pw0[3]=PKW(P0,6), pw0); \
    VRD(1); SBAR(); GAPA(C0=MFX(kf[2],qr[1],C0),   P0[10],P0[11],P0[12],P0[13], pw1[0]=PKW(P0,8), pw1[1]=PKW(P0,10), pw1); \
    VRD(5); SBAR(); GAPA(C1=MFX(kf[3],qr[1],C1),   P0[14],P0[15],P1[0],P1[1],   pw1[2]=PKW(P0,12),pw1[3]=PKW(P0,14), pw1); \
    VRD(2); SBAR(); GAPA(C0=MFX(kf[4],qr[2],C0),   P1[2],P1[3],P1[4],P1[5],     pw2[0]=PKW(P1,0), pw2[1]=PKW(P1,2), pw2); \
    VRD(6); SBAR(); GAPA(C1=MFX(kf[5],qr[2],C1),   P1[6],P1[7],P1[8],P1[9],     pw2[2]=PKW(P1,4), pw2[3]=PKW(P1,6), pw2); \
    VRD(3); SBAR(); GAPA(C0=MFX(kf[6],qr[3],C0),   P1[10],P1[11],P1[12],P1[13], pw3[0]=PKW(P1,8), pw3[1]=PKW(P1,10), pw3); \
    VRD(7); SBAR(); GAPA(C1=MFX(kf[7],qr[3],C1),   P1[14],P1[15],0.f,0.f,       pw3[2]=PKW(P1,12),pw3[3]=PKW(P1,14), pw3); \
    l_reg+=sacc; \
    if(GK){DMA_K((t)+3,sl_cur);} if(GV){DMA_V((t)+1,sl_next);} \
    SBAR(); \
    GAPB(o[0]=MFX(PAF(0),VFR(0),o[0]), C0,0); \
    GAPB(o[1]=MFX(PAF(0),VFR(4),o[1]), C0,4); \
    KRD(GL,0); GAPB(o[0]=MFX(PAF(1),VFR(1),o[0]), C0,8); \
    KRD(GL,1); GAPB(o[1]=MFX(PAF(1),VFR(5),o[1]), C0,12); \
    KRD(GL,2); GAPB(o[0]=MFX(PAF(2),VFR(2),o[0]), C1,0); \
    KRD(GL,3); GAPB(o[1]=MFX(PAF(2),VFR(6),o[1]), C1,4); \
    GAPB(o[0]=MFX(PAF(3),VFR(3),o[0]), C1,8); \
    GAPB(o[1]=MFX(PAF(3),VFR(7),o[1]), C1,12); \
    }while(0)
  int t=1;
  for(;t+5<NT;t+=2){
    STEP(pB0,pB1,pA0,pA1,t,true,true,true);     WAIT_BAR(2); ROT();
    STEP(pA0,pA1,pB0,pB1,t+1,true,true,true);   WAIT_BAR(2); ROT();
  }
  #define ENDW(tt) do{ if((tt)+3<NT){WAIT_BAR(2);} else if((tt)+2<NT){WAIT_BAR(1);} else {WAIT_BAR(0);} }while(0)
  for(;t+1<NT;t+=2){
    STEP(pB0,pB1,pA0,pA1,t,(t+3<NT),(t+1<NT),(t+1<NT));       ENDW(t);   ROT();
    STEP(pA0,pA1,pB0,pB1,t+1,(t+4<NT),(t+2<NT),(t+2<NT));     ENDW(t+1); ROT();
  }
  STEP(pB0,pB1,pA0,pA1,NT-1,false,false,false);
  { float sacc=pB0[0]+pB0[1]; _Pragma("unroll") for(int r=2;r<16;++r)sacc+=pB0[r]; _Pragma("unroll") for(int r=0;r<16;++r)sacc+=pB1[r]; l_reg+=sacc;
    pw0=(u32x4){PKW(pB0,0),PKW(pB0,2),PKW(pB0,4),PKW(pB0,6)};pw1=(u32x4){PKW(pB0,8),PKW(pB0,10),PKW(pB0,12),PKW(pB0,14)};pw2=(u32x4){PKW(pB1,0),PKW(pB1,2),PKW(pB1,4),PKW(pB1,6)};pw3=(u32x4){PKW(pB1,8),PKW(pB1,10),PKW(pB1,12),PKW(pB1,14)};
    SBAR(); pv(o,vb0+sl_cur,PAF(0),PAF(1),PAF(2),PAF(3)); }
  #undef PKW
  #undef PAF
  #undef VFR
  #undef PIN
  #undef GAPA
  #undef GAPB
  #undef EX
  #undef VRD
  #undef KRD
  #undef STEP
  #undef MFX
  #undef ENDW
  {auto rr=__builtin_amdgcn_permlane32_swap(__float_as_uint(l_reg),__float_as_uint(l_reg),false,false);l_reg=__uint_as_float(rr[0])+__uint_as_float(rr[1]);}
  if(hi==0)wsf[32+r32]=l_reg;asm volatile("s_waitcnt lgkmcnt(0)":::"memory");
  float rli[16];
  #pragma unroll
  for(int r=0;r<16;++r)rli[r]=__builtin_amdgcn_rcpf(wsf[32+crow(r,hi)]);
  bf16*Ow=Ou+(long)(wid*QBLK)*OP;
  { bf16*stg=(bf16*)(shm+LDS_OST)+wid*2048;
    #pragma unroll
    for(int r=0;r<16;++r){const int orow=crow(r,hi);
      #pragma unroll
      for(int d0=0;d0<2;++d0)stg[orow*64+d0*32+r32]=__float2bfloat16(o[d0][r]*rli[r]);}
    asm volatile("s_waitcnt lgkmcnt(0)":::"memory");
    #pragma unroll
    for(int i=0;i<4;++i){const int row=i*8+(lane>>3),ch=lane&7; const u32x4 v=*(const u32x4*)(stg+row*64+ch*8); *(u32x4*)(Ow+(long)row*OP+ch*8)=v;} }
  asm volatile("s_waitcnt lgkmcnt(0)\n\ts_barrier":::"memory");
  #undef DMA_K
  #undef DMA_V
  #undef ROT
}

typedef int v8i __attribute__((ext_vector_type(8)));
typedef int v4i __attribute__((ext_vector_type(4)));
typedef unsigned v2u_t __attribute__((ext_vector_type(2)));
constexpr int F8_SLOTB=4096, F8_LDS_K=0, F8_LDS_V=3*F8_SLOTB, F8_LDS_WS=6*F8_SLOTB, F8_OSTP=144, F8_LDS_OST=F8_LDS_WS+2048, F8_LDS_BYTES=F8_LDS_OST+NW*32*F8_OSTP;
constexpr float F8_SH=13.0f;
#define MF8(a_,b_,c_,BF) __builtin_amdgcn_mfma_scale_f32_32x32x64_f8f6f4(a_,b_,c_,0,BF,0,0,0,0)
typedef __attribute__((address_space(3))) const v4i* lds_v4p;
__device__ __forceinline__ v8i ld256(lds_cptr p){ const v4i a=*(lds_v4p)(p), b=*(lds_v4p)(p+1024); return __builtin_shufflevector(a,b,0,1,2,3,4,5,6,7); }
__device__ __forceinline__ void attn_unit8(const int tid,const float mref,const unsigned char*Qu,int QP,const unsigned char*__restrict__ Kh,const unsigned char*__restrict__ Vh,int NT,bf16*Ou,int OP,char*shm){
  const int lane=tid&63,r32=lane&31,hi=lane>>5; const int wid=__builtin_amdgcn_readfirstlane(tid>>6);
  const unsigned lds0=(unsigned)(uintptr_t)shm;
  const bool isK=wid<4;
  const unsigned char*dsrc=(isK?Kh:Vh)+(wid&3)*1024+lane*16;
  const unsigned ddst=lds0+(isK?F8_LDS_K:F8_LDS_V)+(wid&3)*1024;
  #define DMA8(tk,sk,tv,sv) glds16(dsrc+(long)(isK?(tk):(tv))*4096,(unsigned)__builtin_amdgcn_readfirstlane(ddst+(isK?(sk):(sv))))
  const lds_cptr shm3=(lds_cptr)shm; const lds_cptr kp0=shm3+F8_LDS_K+hi*2048+r32*16; const lds_cptr vp0=shm3+F8_LDS_V+hi*2048+r32*16;
  DMA8(0,0,0,0); if(isK){DMA8(1,F8_SLOTB,0,0);}
  v8i qf; { const unsigned char*qp=Qu+(long)(wid*QBLK+r32)*QP+32*hi; const v4i a=*(const v4i*)qp, b=*(const v4i*)(qp+16); qf=__builtin_shufflevector(a,b,0,1,2,3,4,5,6,7); }
  f32x16 o[2],lacc,negm; { const float z=pg8::zero_v(); _Pragma("unroll") for(int r=0;r<16;++r){o[0][r]=z;o[1][r]=z;lacc[r]=z;negm[r]=z-mref+F8_SH;} } asm volatile("":"+v"(negm));
  v8i ones,pw; { int o1; asm volatile("v_mov_b32 %0, 0x38383838":"=v"(o1)); _Pragma("unroll") for(int j=0;j<8;++j){ones[j]=o1;pw[j]=o1;} } asm volatile("":"+v"(ones));
  f32x16 pA0,pA1,pB0,pB1; v8i kf[2],vf[2];
  int sl_prev=0,sl_cur=0,sl_next=F8_SLOTB;
  #define ROT() do{sl_prev=sl_cur;sl_cur=sl_next;sl_next=(sl_next==2*F8_SLOTB)?0:sl_next+F8_SLOTB;}while(0)
  if(isK){DMA8(2,2*F8_SLOTB,0,0);}
  WAIT_BAR(3);
  kf[0]=ld256(kp0); kf[1]=ld256(kp0+512);
  pA0=MF8(kf[0],qf,negm,0); pA1=MF8(kf[1],qf,negm,0);
  _Pragma("unroll") for(int r=0;r<16;++r){pA0[r]=__builtin_amdgcn_exp2f(pA0[r]);pA1[r]=__builtin_amdgcn_exp2f(pA1[r]);}
  WAIT_BAR(0);
  DMA8(3,0,1,F8_SLOTB);
  ROT();
  kf[0]=ld256(kp0+sl_cur); kf[1]=ld256(kp0+sl_cur+512);
  WAIT_BAR(1);
  #define PIN(x) asm volatile("":"+v"(x))
  #define EX(v) __builtin_amdgcn_exp2f(v)
  #define CV4(W,P,B) do{ W=__builtin_amdgcn_cvt_pk_bf8_f32(P[B],P[(B)+1],W,false); W=__builtin_amdgcn_cvt_pk_bf8_f32(P[(B)+2],P[(B)+3],W,true); }while(0)
  #define STEP8(C0,C1,P0,P1,t,GK,GV,GL) do{ SBAR(); \
    const lds_cptr vp_=vp0+sl_prev; \
    vf[0]=ld256(vp_); SBAR(); \
    C0=MF8(kf[0],qf,negm,0); CV4(pw[0],P0,0); CV4(pw[1],P0,4); CV4(pw[2],P0,8); CV4(pw[3],P0,12); PIN(pw); SBAR(); \
    vf[1]=ld256(vp_+512); SBAR(); \
    C1=MF8(kf[1],qf,negm,0); CV4(pw[4],P1,0); CV4(pw[5],P1,4); CV4(pw[6],P1,8); CV4(pw[7],P1,12); PIN(pw); SBAR(); \
    if(isK?(GK):(GV)){DMA8((t)+3,sl_cur,(t)+1,sl_next);} \
    SBAR(); \
    o[0]=MF8(vf[0],pw,o[0],1); \
    C0[0]=EX(C0[0]);C0[1]=EX(C0[1]);C0[2]=EX(C0[2]);C0[3]=EX(C0[3]);C0[4]=EX(C0[4]);C0[5]=EX(C0[5]);C0[6]=EX(C0[6]);C0[7]=EX(C0[7]);C0[8]=EX(C0[8]);C0[9]=EX(C0[9]);C0[10]=EX(C0[10]); PIN(C0); SBAR(); \
    if(GL){ kf[0]=ld256(kp0+sl_next); SBAR(); } \
    o[1]=MF8(vf[1],pw,o[1],1); \
    C0[11]=EX(C0[11]);C0[12]=EX(C0[12]);C0[13]=EX(C0[13]);C0[14]=EX(C0[14]);C0[15]=EX(C0[15]);C1[0]=EX(C1[0]);C1[1]=EX(C1[1]);C1[2]=EX(C1[2]);C1[3]=EX(C1[3]);C1[4]=EX(C1[4]);C1[5]=EX(C1[5]); PIN(C0); PIN(C1); SBAR(); \
    if(GL){ kf[1]=ld256(kp0+sl_next+512); SBAR(); } \
    lacc=MF8(ones,pw,lacc,1); \
    C1[6]=EX(C1[6]);C1[7]=EX(C1[7]);C1[8]=EX(C1[8]);C1[9]=EX(C1[9]);C1[10]=EX(C1[10]);C1[11]=EX(C1[11]);C1[12]=EX(C1[12]);C1[13]=EX(C1[13]);C1[14]=EX(C1[14]);C1[15]=EX(C1[15]); PIN(C1); SBAR(); \
    }while(0)
  int t=1;
  for(;t+5<NT;t+=2){
    STEP8(pB0,pB1,pA0,pA1,t,true,true,true);     WAIT_BAR(1); ROT();
    STEP8(pA0,pA1,pB0,pB1,t+1,true,true,true);   WAIT_BAR(1); ROT();
  }
  #define ENDW8(tt) do{ if((tt)+3<NT){WAIT_BAR(1);} else {WAIT_BAR(0);} }while(0)
  for(;t+1<NT;t+=2){
    STEP8(pB0,pB1,pA0,pA1,t,(t+3<NT),(t+1<NT),(t+1<NT));       ENDW8(t);   ROT();
    STEP8(pA0,pA1,pB0,pB1,t+1,(t+4<NT),(t+2<NT),(t+2<NT));     ENDW8(t+1); ROT();
  }
  STEP8(pB0,pB1,pA0,pA1,NT-1,false,false,false);
  { CV4(pw[0],pB0,0); CV4(pw[1],pB0,4); CV4(pw[2],pB0,8); CV4(pw[3],pB0,12); CV4(pw[4],pB1,0); CV4(pw[5],pB1,4); CV4(pw[6],pB1,8); CV4(pw[7],pB1,12);
    const lds_cptr vp_=vp0+sl_cur; vf[0]=ld256(vp_); vf[1]=ld256(vp_+512);
    o[0]=MF8(vf[0],pw,o[0],1); o[1]=MF8(vf[1],pw,o[1],1); lacc=MF8(ones,pw,lacc,1); }
  #undef PIN
  #undef EX
  #undef CV4
  #undef STEP8
  #undef ENDW8
  { const float rl=__builtin_amdgcn_rcpf(lacc[0]);
    typedef __attribute__((address_space(3))) char* lds_wptr;
    const lds_wptr stg=(lds_wptr)shm+F8_LDS_OST+wid*(32*F8_OSTP);
    #pragma unroll
    for(int m=0;m<2;++m)
      #pragma unroll
      for(int g=0;g<4;++g){ v2u_t w; w.x=cvtpk_s(o[m][4*g]*rl,o[m][4*g+1]*rl); w.y=cvtpk_s(o[m][4*g+2]*rl,o[m][4*g+3]*rl);
        *(__attribute__((address_space(3))) v2u_t*)(stg+r32*F8_OSTP+(32*m+8*g+4*hi)*2)=w; }
    asm volatile("s_waitcnt lgkmcnt(0)":::"memory");
    bf16*Ow=Ou+(long)(wid*QBLK)*OP;
    #pragma unroll
    for(int i=0;i<4;++i){const int row=i*8+(lane>>3),ch=lane&7; const u32x4 v=*(const __attribute__((address_space(3))) u32x4*)(stg+row*F8_OSTP+ch*16); *(u32x4*)(Ow+(long)row*OP+ch*8)=v;} }
  asm volatile("s_waitcnt lgkmcnt(0)\n\ts_barrier":::"memory");
  #undef DMA8
  #undef ROT
}
constexpr int F8P_NS=5, F8P_LDS_V=F8P_NS*F8_SLOTB, F8P_LDS_OST=2*F8P_NS*F8_SLOTB, F8P_LDS_BYTES=F8P_LDS_OST+NW*32*F8_OSTP;
__device__ __forceinline__ void attn_unit8p(const int tid,const float mref,const unsigned char*Qu,int QP,const unsigned char*__restrict__ Kh,const unsigned char*__restrict__ Vh,int NT,bf16*Ou,int OP,char*shm){
  const int lane=tid&63,r32=lane&31,hi=lane>>5; const int wid=__builtin_amdgcn_readfirstlane(tid>>6);
  const unsigned lds0=(unsigned)(uintptr_t)shm;
  const bool isK=wid<4;
  const unsigned char*dsrc=(isK?Kh:Vh)+(wid&3)*1024+lane*16;
  const unsigned ddst=lds0+(isK?0:F8P_LDS_V)+(wid&3)*1024;
  #define DMA8(tk,sk,tv,sv) glds16(dsrc+(long)(isK?(tk):(tv))*4096,(unsigned)__builtin_amdgcn_readfirstlane(ddst+(isK?(sk):(sv))))
  #define WR(x) (((x)>=F8P_NS*F8_SLOTB)?((x)-F8P_NS*F8_SLOTB):(x))
  const lds_cptr shm3=(lds_cptr)shm; const lds_cptr kp0=shm3+hi*2048+r32*16; const lds_cptr vp0=shm3+F8P_LDS_V+hi*2048+r32*16;
  DMA8(0,0,0,0); DMA8(1,F8_SLOTB,1,F8_SLOTB); DMA8(2,2*F8_SLOTB,2,2*F8_SLOTB); if(isK){DMA8(3,3*F8_SLOTB,0,0); DMA8(4,4*F8_SLOTB,0,0);}
  v8i qf; { const unsigned char*qp=Qu+(long)(wid*QBLK+r32)*QP+32*hi; const v4i a=*(const v4i*)qp, b=*(const v4i*)(qp+16); qf=__builtin_shufflevector(a,b,0,1,2,3,4,5,6,7); }
  f32x16 o[2],lacc,negm; { const float z=pg8::zero_v(); _Pragma("unroll") for(int r=0;r<16;++r){o[0][r]=z;o[1][r]=z;lacc[r]=z;negm[r]=z-mref+F8_SH;} } asm volatile("":"+v"(negm));
  v8i ones,pw; { int o1; asm volatile("v_mov_b32 %0, 0x38383838":"=v"(o1)); _Pragma("unroll") for(int j=0;j<8;++j){ones[j]=o1;pw[j]=o1;} } asm volatile("":"+v"(ones));
  f32x16 pA0,pA1,pB0,pB1; v8i kf[2],vf[2];
  WAIT_BAR(0);
  kf[0]=ld256(kp0); kf[1]=ld256(kp0+512);
  pA0=MF8(kf[0],qf,negm,0); pA1=MF8(kf[1],qf,negm,0);
  _Pragma("unroll") for(int r=0;r<16;++r){pA0[r]=__builtin_amdgcn_exp2f(pA0[r]);pA1[r]=__builtin_amdgcn_exp2f(pA1[r]);}
  kf[0]=ld256(kp0+F8_SLOTB); kf[1]=ld256(kp0+F8_SLOTB+512);
  WAIT_BAR(0);
  int sl=F8_SLOTB;
  #define PIN(x) asm volatile("":"+v"(x))
  #define EX(v) __builtin_amdgcn_exp2f(v)
  #define CV4(W,P,B) do{ W=__builtin_amdgcn_cvt_pk_bf8_f32(P[B],P[(B)+1],W,false); W=__builtin_amdgcn_cvt_pk_bf8_f32(P[(B)+2],P[(B)+3],W,true); }while(0)
  #define STEP8(C0,C1,P0,P1,t,GK,GV,GL) do{ SBAR(); \
    const int sl_p1=(sl==0)?(F8P_NS-1)*F8_SLOTB:sl-F8_SLOTB, sl_n1=WR(sl+F8_SLOTB), sl_n2=WR(sl+2*F8_SLOTB); \
    const lds_cptr vp_=vp0+sl_p1; \
    vf[0]=ld256(vp_); SBAR(); \
    C0=MF8(kf[0],qf,negm,0); CV4(pw[0],P0,0); CV4(pw[1],P0,4); CV4(pw[2],P0,8); CV4(pw[3],P0,12); PIN(pw); SBAR(); \
    vf[1]=ld256(vp_+512); SBAR(); \
    C1=MF8(kf[1],qf,negm,0); CV4(pw[4],P1,0); CV4(pw[5],P1,4); CV4(pw[6],P1,8); CV4(pw[7],P1,12); PIN(pw); SBAR(); \
    if(isK?(GK):(GV)){DMA8((t)+4,sl_p1,(t)+2,sl_n2);} \
    SBAR(); \
    o[0]=MF8(vf[0],pw,o[0],1); \
    C0[0]=EX(C0[0]);C0[1]=EX(C0[1]);C0[2]=EX(C0[2]);C0[3]=EX(C0[3]);C0[4]=EX(C0[4]);C0[5]=EX(C0[5]);C0[6]=EX(C0[6]);C0[7]=EX(C0[7]);C0[8]=EX(C0[8]);C0[9]=EX(C0[9]);C0[10]=EX(C0[10]); PIN(C0); SBAR(); \
    if(GL){ kf[0]=ld256(kp0+sl_n1); SBAR(); } \
    o[1]=MF8(vf[1],pw,o[1],1); \
    C0[11]=EX(C0[11]);C0[12]=EX(C0[12]);C0[13]=EX(C0[13]);C0[14]=EX(C0[14]);C0[15]=EX(C0[15]);C1[0]=EX(C1[0]);C1[1]=EX(C1[1]);C1[2]=EX(C1[2]);C1[3]=EX(C1[3]);C1[4]=EX(C1[4]);C1[5]=EX(C1[5]); PIN(C0); PIN(C1); SBAR(); \
    if(GL){ kf[1]=ld256(kp0+sl_n1+512); SBAR(); } \
    lacc=MF8(ones,pw,lacc,1); \
    C1[6]=EX(C1[6]);C1[7]=EX(C1[7]);C1[8]=EX(C1[8]);C1[9]=EX(C1[9]);C1[10]=EX(C1[10]);C1[11]=EX(C1[11]);C1[12]=EX(C1[12]);C1[13]=EX(C1[13]);C1[14]=EX(C1[14]);C1[15]=EX(C1[15]); PIN(C1); SBAR(); \
    sl=sl_n1; \
    }while(0)
  int t=1;
  for(;t+6<NT;t+=2){
    STEP8(pB0,pB1,pA0,pA1,t,true,true,true);
    STEP8(pA0,pA1,pB0,pB1,t+1,true,true,true);   WAIT_BAR(1);
  }
  for(;t+1<NT;t+=2){
    STEP8(pB0,pB1,pA0,pA1,t,(t+4<NT),(t+2<NT),true);
    STEP8(pA0,pA1,pB0,pB1,t+1,(t+5<NT),(t+3<NT),(t+2<NT));
    if(t+5<NT){WAIT_BAR(1);} else {WAIT_BAR(0);}
  }
  STEP8(pB0,pB1,pA0,pA1,NT-1,false,false,false);
  { CV4(pw[0],pB0,0); CV4(pw[1],pB0,4); CV4(pw[2],pB0,8); CV4(pw[3],pB0,12); CV4(pw[4],pB1,0); CV4(pw[5],pB1,4); CV4(pw[6],pB1,8); CV4(pw[7],pB1,12);
    const int sl_last=(sl==0)?(F8P_NS-1)*F8_SLOTB:sl-F8_SLOTB;
    const lds_cptr vp_=vp0+sl_last; vf[0]=ld256(vp_); vf[1]=ld256(vp_+512);
    o[0]=MF8(vf[0],pw,o[0],1); o[1]=MF8(vf[1],pw,o[1],1); lacc=MF8(ones,pw,lacc,1); }
  #undef PIN
  #undef EX
  #undef CV4
  #undef STEP8
  #undef WR
  { const float rl=__builtin_amdgcn_rcpf(lacc[0]);
    typedef __attribute__((address_space(3))) char* lds_wptr;
    const lds_wptr stg=(lds_wptr)shm+F8P_LDS_OST+wid*(32*F8_OSTP);
    #pragma unroll
    for(int m=0;m<2;++m)
      #pragma unroll
      for(int g=0;g<4;++g){ v2u_t w; w.x=cvtpk_s(o[m][4*g]*rl,o[m][4*g+1]*rl); w.y=cvtpk_s(o[m][4*g+2]*rl,o[m][4*g+3]*rl);
        *(__attribute__((address_space(3))) v2u_t*)(stg+r32*F8_OSTP+(32*m+8*g+4*hi)*2)=w; }
    asm volatile("s_waitcnt lgkmcnt(0)":::"memory");
    bf16*Ow=Ou+(long)(wid*QBLK)*OP;
    #pragma unroll
    for(int i=0;i<4;++i){const int row=i*8+(lane>>3),ch=lane&7; const u32x4 v=*(const __attribute__((address_space(3))) u32x4*)(stg+row*F8_OSTP+ch*16); *(u32x4*)(Ow+(long)row*OP+ch*8)=v;} }
  asm volatile("s_waitcnt lgkmcnt(0)\n\ts_barrier":::"memory");
  #undef DMA8
}
#undef MF8
#undef SBAR
#undef WAIT_BAR
}
#define GAS __attribute__((address_space(1)))
#define LAS __attribute__((address_space(3)))
typedef unsigned short bf16;
typedef unsigned v4u __attribute__((ext_vector_type(4)));
typedef float f32x4 __attribute__((ext_vector_type(4)));
typedef short bf16x8 __attribute__((ext_vector_type(8)));
typedef GAS unsigned gu32;
typedef GAS unsigned long long gu64;
#define RLX_AGENT __ATOMIC_RELAXED, __HIP_MEMORY_SCOPE_AGENT
#define LDS_WAIT() asm volatile("s_waitcnt lgkmcnt(0)" ::: "memory")
#define VM_WAIT() asm volatile("s_waitcnt vmcnt(0)" ::: "memory")
__device__ __forceinline__ unsigned long long rt() { return __builtin_amdgcn_s_memrealtime(); }
__device__ __forceinline__ unsigned f2bf(float f) { unsigned u = __builtin_bit_cast(unsigned, f); return (u + 0x7fffu + ((u >> 16) & 1u)) >> 16; }
__device__ __forceinline__ unsigned pk2(float lo, float hi) { return f2bf(lo) | (f2bf(hi) << 16); }

#define XB_TMO      128
#define XB_XCNT(j)  (256  + 64 * (j))
#define XB_XSUB(j)  (1280 + 64 * (j))
#define XB_XGEN(j)  (2304 + 64 * (j))
#define XB_TOP      3328
#define XB_TOPGEN   3392
#define XCD_BAR_WORDS 3456
#define XB_SPIN_CAP (1u << 18)

__device__ __forceinline__ unsigned xb_ld(unsigned* p)              { return __hip_atomic_load(p, __ATOMIC_RELAXED, __HIP_MEMORY_SCOPE_AGENT); }
__device__ __forceinline__ unsigned xb_add(unsigned* p, unsigned v) { return __hip_atomic_fetch_add(p, v, __ATOMIC_RELAXED, __HIP_MEMORY_SCOPE_AGENT); }
__device__ __forceinline__ unsigned xb_xcc_id() { return (unsigned)__builtin_amdgcn_s_getreg((3 << 11) | 20) & 0xFu; }
#define XB_SPIN(cond, bar) do { unsigned _sp = 0; while (cond) { __builtin_amdgcn_s_sleep(1); \
    if ((++_sp & 255u) == 0u) { if (xb_ld(&(bar)[XB_TMO])) break; if (_sp > XB_SPIN_CAP) { atomicAdd(&(bar)[XB_TMO], 1u); break; } } } } while (0)

struct XcdBarrier {
    unsigned* bar; unsigned x;
    volatile LAS unsigned* st;
};

__device__ __forceinline__ XcdBarrier xcd_barrier_post(unsigned* bar, volatile LAS unsigned* st) {
    XcdBarrier b; b.bar = bar; b.x = xb_xcc_id(); b.st = st;
    if (threadIdx.x == 0) (void)xb_add(&bar[XB_XCNT(b.x)], 1u);
    return b;
}
__device__ __forceinline__ void xcd_barrier_complete(unsigned* bar, unsigned x, unsigned& nloc, unsigned& nx) {
    const unsigned G = gridDim.x * gridDim.y * gridDim.z;
    unsigned sum, cnt, mine, sp = 0u;
    for (;;) {
        sum = 0u; cnt = 0u; mine = 0u;
#pragma unroll
        for (unsigned j = 0; j < 16; ++j) { const unsigned c = xb_ld(&bar[XB_XCNT(j)]); sum += c; cnt += (c > 0u) ? 1u : 0u; mine = (j == x) ? c : mine; }
        if (sum == G) break;
        __builtin_amdgcn_s_sleep(1);
        if ((++sp & 255u) == 0u) { if (xb_ld(&bar[XB_TMO])) break; if (sp > XB_SPIN_CAP) { atomicAdd(&bar[XB_TMO], 1u); break; } }
    }
    nloc = mine > 0u ? mine : 1u; nx = cnt > 0u ? cnt : 1u;
}

__device__ __forceinline__ void xcd_barrier(const XcdBarrier& b) {
    asm volatile("s_waitcnt vmcnt(0)" ::: "memory");
    __syncthreads();
    if (threadIdx.x == 0) {
        unsigned* bar = b.bar;
        __builtin_amdgcn_s_waitcnt(0);
        unsigned nloc = b.st[0], nx = b.st[1];
        if (nloc == 0u) { xcd_barrier_complete(bar, b.x, nloc, nx); b.st[0] = nloc; b.st[1] = nx; }
        const unsigned old = xb_add(&bar[XB_XSUB(b.x)], 1u);
        const unsigned gen = old / nloc;
        if (old + 1u == (gen + 1u) * nloc) {
            __builtin_amdgcn_fence(__ATOMIC_RELEASE, "agent");
            asm volatile("s_waitcnt vmcnt(0)" ::: "memory");
            const unsigned og = xb_add(&bar[XB_TOP], 1u);
            const unsigned tg = og / nx;
            if (og + 1u == (tg + 1u) * nx) xb_add(&bar[XB_TOPGEN], 1u);
            else XB_SPIN(xb_ld(&bar[XB_TOPGEN]) == tg, bar);
            __builtin_amdgcn_fence(__ATOMIC_ACQUIRE, "agent");
            xb_add(&bar[XB_XGEN(b.x)], 1u);
            asm volatile("s_waitcnt vmcnt(0)" ::: "memory");
        } else {
            XB_SPIN(xb_ld(&bar[XB_XGEN(b.x)]) == gen, bar);
            __builtin_amdgcn_fence(__ATOMIC_ACQUIRE, "agent");
            asm volatile("s_waitcnt vmcnt(0)" ::: "memory");
        }
    }
    __syncthreads();
}
constexpr int NWAVES = 8;
constexpr int DM = 1024, NB = 2, SEQ = 16384, CTX = 256, RB = SEQ + CTX  , NR = NB * RB  ;
constexpr int INW = 2048, FF = 2816, NE = 8, NCH = RB / 128  , NLAT = NB * SEQ;
constexpr float EPS = 1e-6f;
constexpr int PC_K = 512, PC_V = 640, PC_RQ = 768, PC_RK = 1024, PC_RV = 1280, PC_RG = 1536, PC_PP = 1792;
constexpr int MOE_TP = 104, MOE_PASSES = 3, LISTCAP = 32768;

constexpr size_t MiB = 1u << 20, U128K = 131072;
constexpr size_t WS_CTL = 0, CTL_ZERO_BYTES = 1 * MiB;
constexpr size_t WS_MODV = 1 * MiB;
constexpr size_t WS_ROPE = 1 * MiB + 256 * 1024;
constexpr size_t WS_DEC = WS_ROPE + 32768;
constexpr size_t WS_TOK = 3 * MiB / 2;
constexpr size_t WS_LIST = 5 * MiB / 2;
constexpr size_t WS_XC = 7 * MiB / 2;
constexpr size_t WS_WIN = 6 * MiB, WS_WOUT = 14 * MiB, WS_W13D = 18 * MiB, WS_W2D = 29 * MiB, WS_W13M = 35 * MiB, WS_W2M = 80 * MiB  , WS_XB = 103 * MiB  ;
constexpr size_t SZ_WIN = (size_t)INW * DM * 2, SZ_WOUT = (size_t)DM * DM * 2, SZ_W13 = (size_t)2 * FF * DM * 2, SZ_W2 = (size_t)DM * FF * 2;
constexpr size_t SZ8_W13 = SZ_W13 / 2, SZ8_W2 = SZ_W2 / 2;
constexpr size_t WS_AR = 168 * MiB;
constexpr size_t AR_P = 0, AR_QB = 1040 * U128K, AR_KC = 1300 * U128K, AR_VC = 1365 * U128K, AR_US = 1430 * U128K, AR_MIX = 1690 * U128K, AR_MX = 2210 * U128K;
constexpr size_t AR_HX2 = 0, AR_ACT = 520 * U128K, AR_YD = 2210 * U128K, AR_YM = 1664 * U128K;
constexpr size_t AR_PART0 = 1040 * U128K  , AR_PART1 = 0  ;
constexpr size_t AR_Q8 = AR_QB, AR_K8 = AR_QB + 136 * U128K, AR_V8 = AR_QB + 176 * U128K;
constexpr size_t DO_Q8 = AR_MX + 20 * MiB, DO_K8 = AR_MX + 40 * MiB, DO_V8 = AR_MX + 46 * MiB, DO_O8 = AR_US;
constexpr size_t WS_END = 512 * MiB;
static_assert(WS_XB + (size_t)NLAT * DM * 2 <= WS_AR && WS_W2M + 8 * SZ8_W2 <= WS_XB && WS_W13M + 8 * SZ8_W13 <= WS_W2M && WS_W13D + SZ_W13 <= WS_W2D && WS_W2D + SZ_W2 <= WS_W13M, "weights map");
static_assert(AR_MX + (size_t)NR * DM * 2 <= WS_END - WS_AR && AR_ACT + (size_t)NR * FF * 2 <= AR_YD && AR_YM + (size_t)264 * 256 * DM * 2 <= WS_END - WS_AR && AR_ACT + (size_t)MOE_TP * 256 * FF * 2 <= AR_YM, "arena map");
static_assert(AR_QB == (size_t)NR * INW * 2 && AR_KC == AR_QB + (size_t)NR * 512 * 2 && AR_US == AR_VC + (size_t)NR * 128 * 2 && AR_MIX == AR_US + (size_t)16 * NCH * 16384 && AR_MX == AR_MIX + (size_t)NR * DM * 2, "arena map 2");
constexpr int CW_TMO = 0, CW_CODE = 1, CW_CNT = 64  , CW_BAR = 4096;
constexpr int RING_BYTES = 131072, MISC_OFF = RING_BYTES + 320, GTAB_OFF = RING_BYTES + 1024, MOE_OFF = RING_BYTES + 2048, LDS_BYTES = 147456;

typedef unsigned v2u __attribute__((ext_vector_type(2)));
typedef float f32x16 __attribute__((ext_vector_type(16)));

struct Args { const float* in[24]; float* out; unsigned char* ws; int ph_lo, ph_hi, li, pad; };
enum { I_X = 0, I_C, I_CTX, I_CCTX, I_WMOD, I_BMOD, I_NPREMIX, I_NPOSTMIX, I_NPREFFN, I_NPOSTFFN, I_WIN, I_WOUT, I_QN, I_KN, I_DECAY, I_POOLW, I_POOLS, I_FW1, I_FW3, I_FW2, I_ROUTER, I_MW1, I_MW3, I_MW2 };

typedef const __attribute__((address_space(4))) Args* ArgP;
__device__ __forceinline__ ArgP args_here() { ArgP p = (ArgP)__builtin_amdgcn_kernarg_segment_ptr(); asm volatile("" : "+s"(p)); return p; }
struct Frame { LAS unsigned char* lds; int tid, lane, wave, G, gw, NGW, bx; };
__device__ __forceinline__ void relaunder(Frame& F) { int t = threadIdx.x; asm volatile("" : "+v"(t)); F.tid = t; F.lane = t & 63; F.wave = __builtin_amdgcn_readfirstlane(t >> 6);
    int g = gridDim.x; asm volatile("" : "+s"(g)); F.G = g; int bx = blockIdx.x; asm volatile("" : "+s"(bx)); F.bx = bx; F.gw = bx * NWAVES + F.wave; F.NGW = F.G * NWAVES; }

#ifndef ATT8_DEBUG
#define ATT8_DEBUG 0
#endif
#ifndef DENSE_F8
#define DENSE_F8 0
#endif
#ifndef MOE_F8
#define MOE_F8 1
#endif
#ifndef DENSE_I8UP
#define DENSE_I8UP 1
#endif
#ifndef MOE_I8UP
#define MOE_I8UP 1
#endif
#ifndef DENSE_DOWN_F8
#define DENSE_DOWN_F8 1
#endif
#ifndef IN_I8
#define IN_I8 3
#endif
constexpr float I8_XS = 20.0f, I8_XI = 20.0f, I8_WS = 1024.0f;
#ifndef IN1_F8
#define IN1_F8 0
#endif
__device__ __forceinline__ unsigned char* q8_ptr(ArgP a) { return ATT8_DEBUG ? a->ws + WS_AR + DO_Q8 : a->ws + WS_AR + AR_Q8; }
__device__ __forceinline__ unsigned char* k8_ptr(ArgP a) { return ATT8_DEBUG ? a->ws + WS_AR + DO_K8 : a->ws + WS_AR + AR_K8; }
__device__ __forceinline__ unsigned char* v8_ptr(ArgP a) { return ATT8_DEBUG ? a->ws + WS_AR + DO_V8 : a->ws + WS_AR + AR_V8; }
__device__ __forceinline__ unsigned fp8x4(float a, float b, float c, float d) { int w = 0; w = __builtin_amdgcn_cvt_pk_fp8_f32(a, b, w, false); w = __builtin_amdgcn_cvt_pk_fp8_f32(c, d, w, true); return (unsigned)w; }
__device__ __forceinline__ unsigned i8x4(float a, float b, float c, float d, float s) {
    unsigned w = 0;
    w = __builtin_amdgcn_cvt_pk_u8_f32(__builtin_amdgcn_fmed3f(__builtin_rintf(__builtin_fmaf(a, s, 128.0f)), 1.0f, 255.0f), 0, w);
    w = __builtin_amdgcn_cvt_pk_u8_f32(__builtin_amdgcn_fmed3f(__builtin_rintf(__builtin_fmaf(b, s, 128.0f)), 1.0f, 255.0f), 1, w);
    w = __builtin_amdgcn_cvt_pk_u8_f32(__builtin_amdgcn_fmed3f(__builtin_rintf(__builtin_fmaf(c, s, 128.0f)), 1.0f, 255.0f), 2, w);
    w = __builtin_amdgcn_cvt_pk_u8_f32(__builtin_amdgcn_fmed3f(__builtin_rintf(__builtin_fmaf(d, s, 128.0f)), 1.0f, 255.0f), 3, w);
    return w ^ 0x80808080u; }
__device__ __forceinline__ float bf_lo(unsigned u) { return __uint_as_float(u << 16); }
__device__ __forceinline__ float bf_hi(unsigned u) { return __uint_as_float(u & 0xffff0000u); }
__device__ __forceinline__ unsigned pkbf(float lo, float hi) { return attn_body::cvtpk_s(lo, hi); }
template <int M> __device__ __forceinline__ float shx(float v) { return __builtin_bit_cast(float, __builtin_amdgcn_ds_swizzle(__builtin_bit_cast(int, v), 0x1F | (M << 10))); }
__device__ __forceinline__ float half_sum(float v) { auto rr = __builtin_amdgcn_permlane32_swap(__float_as_uint(v), __float_as_uint(v), false, false); return __uint_as_float(rr[0]) + __uint_as_float(rr[1]); }
__device__ __forceinline__ float half_max(float v) { auto rr = __builtin_amdgcn_permlane32_swap(__float_as_uint(v), __float_as_uint(v), false, false); return fmaxf(__uint_as_float(rr[0]), __uint_as_float(rr[1])); }
__device__ __forceinline__ float wave_sum(float v) { v += shx<1>(v); v += shx<2>(v); v += shx<4>(v); v += shx<8>(v); v += shx<16>(v); return half_sum(v); }
__device__ __forceinline__ float siluf(float x) { return x / (1.0f + __expf(-x)); }
__device__ __forceinline__ float logsig(float x) { return -log1pf(expf(-x)); }
#define ROWCOL(j) (512 * ((j) >> 1) + 4 * ((j) & 1))
__device__ __forceinline__ void ld16(f32x4 (&v)[4], const float* p, int lane) {
#pragma unroll
    for (int j = 0; j < 4; ++j) v[j] = *(const f32x4*)(p + ROWCOL(j) + 8 * lane);
}
__device__ __forceinline__ void ld16b(f32x4 (&v)[4], const bf16* p, int lane) {
#pragma unroll
    for (int h = 0; h < 2; ++h) { const v4u u = *(const v4u*)(p + 512 * h + 8 * lane); v[2 * h] = (f32x4){bf_lo(u.x), bf_hi(u.x), bf_lo(u.y), bf_hi(u.y)}; v[2 * h + 1] = (f32x4){bf_lo(u.z), bf_hi(u.z), bf_lo(u.w), bf_hi(u.w)}; }
}
__device__ __forceinline__ void st16(float* p, const f32x4 (&v)[4], int lane) {
#pragma unroll
    for (int j = 0; j < 4; ++j) *(f32x4*)(p + ROWCOL(j) + 8 * lane) = v[j];
}
__device__ __forceinline__ void st16b(bf16* p, const f32x4 (&v)[4], int lane) {
#pragma unroll
    for (int h = 0; h < 2; ++h) { v4u u; u.x = pkbf(v[2 * h][0], v[2 * h][1]); u.y = pkbf(v[2 * h][2], v[2 * h][3]); u.z = pkbf(v[2 * h + 1][0], v[2 * h + 1][1]); u.w = pkbf(v[2 * h + 1][2], v[2 * h + 1][3]); *(v4u*)(p + 512 * h + 8 * lane) = u; }
}
__device__ __forceinline__ void st16f8(unsigned char* p, const f32x4 (&v)[4], int lane) {
#pragma unroll
    for (int h = 0; h < 2; ++h) { v2u u; u.x = fp8x4(v[2 * h][0], v[2 * h][1], v[2 * h][2], v[2 * h][3]); u.y = fp8x4(v[2 * h + 1][0], v[2 * h + 1][1], v[2 * h + 1][2], v[2 * h + 1][3]); *(v2u*)(p + 512 * h + 8 * lane) = u; }
}
__device__ __forceinline__ void st16i8(unsigned char* p, const f32x4 (&v)[4], int lane, const float I8_XS = ::I8_XS) {
#pragma unroll
    for (int h = 0; h < 2; ++h) { v2u u; u.x = i8x4(v[2 * h][0], v[2 * h][1], v[2 * h][2], v[2 * h][3], I8_XS); u.y = i8x4(v[2 * h + 1][0], v[2 * h + 1][1], v[2 * h + 1][2], v[2 * h + 1][3], I8_XS); *(v2u*)(p + 512 * h + 8 * lane) = u; }
}
__device__ __forceinline__ float sumsq16(const f32x4 (&v)[4]) {
    float s = 0.f;
#pragma unroll
    for (int j = 0; j < 4; ++j) s += (v[j][0] * v[j][0] + v[j][1] * v[j][1]) + (v[j][2] * v[j][2] + v[j][3] * v[j][3]);
    return s;
}
__device__ __forceinline__ const float* modv(const unsigned char* ws, int l, int cls, int chunk) { return (const float*)(ws + WS_MODV) + ((size_t)(l * 3 + cls) * 6 + chunk) * DM; }

template <int F8 = 0  > __device__ __forceinline__ void p0_transpose_item(const float* W, int K, int N, bf16* WT, int k0, int n0, int drow0, LAS float* scr, int lane) {
    { const int c4 = (lane & 7) * 4, r8 = lane >> 3;
#pragma unroll
        for (int i = 0; i < 8; ++i) { const int kk = 8 * i + r8; const f32x4 v = *(const f32x4*)(W + (size_t)(k0 + kk) * N + n0 + c4);
            LAS float* d = scr + kk * 33 + c4; d[0] = v[0]; d[1] = v[1]; d[2] = v[2]; d[3] = v[3]; } }
    LDS_WAIT(); asm volatile("" ::: "memory");
    const int c = lane & 7;
#pragma unroll
    for (int j = 0; j < 4; ++j) { const int n = (lane >> 3) + 8 * j; const LAS float* s = scr + (8 * c) * 33 + n;
        if constexpr (F8 == 2) { v2u o; o.x = i8x4(s[0 * 33], s[1 * 33], s[2 * 33], s[3 * 33], I8_WS); o.y = i8x4(s[4 * 33], s[5 * 33], s[6 * 33], s[7 * 33], I8_WS);
            *(v2u*)((unsigned char*)WT + (size_t)(drow0 + n) * K + k0 + 8 * c) = o; }
        else if constexpr (F8 == 1) { v2u o; o.x = fp8x4(s[0 * 33] * 64.0f, s[1 * 33] * 64.0f, s[2 * 33] * 64.0f, s[3 * 33] * 64.0f); o.y = fp8x4(s[4 * 33] * 64.0f, s[5 * 33] * 64.0f, s[6 * 33] * 64.0f, s[7 * 33] * 64.0f);
            *(v2u*)((unsigned char*)WT + (size_t)(drow0 + n) * K + k0 + 8 * c) = o; }
        else { v4u o; o.x = pkbf(s[0 * 33], s[1 * 33]); o.y = pkbf(s[2 * 33], s[3 * 33]); o.z = pkbf(s[4 * 33], s[5 * 33]); o.w = pkbf(s[6 * 33], s[7 * 33]);
        *(v4u*)(WT + (size_t)(drow0 + n) * K + k0 + 8 * c) = o; } }
    LDS_WAIT(); asm volatile("" ::: "memory");
}
constexpr int WC_IN = 16 * 64, WC_OUT = 16 * 32, WC_F = 1408, WCOPY_ITEMS = 2 * WC_IN + 2 * WC_OUT + 27 * WC_F;
constexpr int WCOPY_SPLIT1 = WCOPY_ITEMS - 21120, WCOPY_SPLIT2 = WCOPY_ITEMS - 12800;
struct WItem { const float* src; unsigned char* dst; int N, K, mode; };
__device__ __forceinline__ WItem wc_decode(ArgP a, int it) {
    WItem w; int r = it;
    if (r < 2 * WC_IN) { const int l = r / WC_IN, q = r % WC_IN, kb = q / 64, nb = q % 64;
        w.mode = ((IN_I8 >> l) & 1) ? 2 : ((IN1_F8 && l == 1) ? 1 : 0); w.N = INW; w.K = DM; w.src = a->in[I_WIN] + (size_t)l * DM * INW + (size_t)(64 * kb) * INW + 32 * nb;
        w.dst = a->ws + WS_WIN + l * SZ_WIN + ((size_t)(32 * nb) * DM + 64 * kb) * (w.mode ? 1 : 2); return w; }
    r -= 2 * WC_IN;
    if (r < 2 * WC_OUT) { const int l = r / WC_OUT, q = r % WC_OUT, kb = q / 32, nb = q % 32;
        w.mode = 0; w.N = DM; w.K = DM; w.src = a->in[I_WOUT] + (size_t)l * DM * DM + (size_t)(64 * kb) * DM + 32 * nb; w.dst = a->ws + WS_WOUT + l * SZ_WOUT + ((size_t)(32 * nb) * DM + 64 * kb) * 2; return w; }
    r -= 2 * WC_OUT;
    const int mat = r / WC_F, q = r % WC_F;
    int which, e; bool moe;
    if (mat < 3) { which = mat; e = 0; moe = false; } else { which = (mat - 3) % 3; e = (mat - 3) / 3; moe = true; }
    if (which < 2) {
        const float* W = (moe ? a->in[which == 0 ? I_MW1 : I_MW3] + (size_t)e * DM * FF : a->in[which == 0 ? I_FW1 : I_FW3]);
        unsigned char* WT = a->ws + (moe ? WS_W13M + e * (MOE_F8 ? SZ8_W13 : SZ_W13) : WS_W13D);
        const int kb = q / 88, nb = q % 88, n0 = 32 * nb; const int drow0 = (n0 >> 7) * 256 + which * 128 + (n0 & 127);
        w.mode = moe ? ((MOE_F8 && !MOE_I8UP) ? 1 : (MOE_I8UP ? 2 : 0)) : (DENSE_F8 ? 1 : (DENSE_I8UP ? 2 : 0));
        w.N = FF; w.K = DM; w.src = W + (size_t)(64 * kb) * FF + n0; w.dst = WT + ((size_t)drow0 * DM + 64 * kb) * (w.mode ? 1 : 2);
    } else {
        const float* W = (moe ? a->in[I_MW2] + (size_t)e * FF * DM : a->in[I_FW2]);
        unsigned char* WT = a->ws + (moe ? WS_W2M + e * (MOE_F8 ? SZ8_W2 : SZ_W2) : WS_W2D);
        const int kb = q / 32, nb = q % 32;
        w.mode = moe ? (MOE_F8 ? 1 : 0) : ((DENSE_F8 || DENSE_DOWN_F8) ? 1 : 0);
        w.N = DM; w.K = FF; w.src = W + (size_t)(64 * kb) * DM + 32 * nb; w.dst = WT + ((size_t)(32 * nb) * FF + 64 * kb) * (w.mode ? 1 : 2);
    }
    return w;
}
__device__ __forceinline__ void wc_load(const WItem& w, f32x4 (&v)[8], int lane) {
    const int c4 = (lane & 7) * 4, r8 = lane >> 3;
#pragma unroll
    for (int i = 0; i < 8; ++i) v[i] = *(const f32x4*)(w.src + (size_t)(8 * i + r8) * w.N + c4);
}
__device__ __forceinline__ void wc_process(const WItem& w, const f32x4 (&v)[8], LAS float* scr, int lane) {
    { const int c4 = (lane & 7) * 4, r8 = lane >> 3;
#pragma unroll
        for (int i = 0; i < 8; ++i) { LAS float* d = scr + (8 * i + r8) * 33 + c4; d[0] = v[i][0]; d[1] = v[i][1]; d[2] = v[i][2]; d[3] = v[i][3]; } }
    LDS_WAIT(); asm volatile("" ::: "memory");
    const int c = lane & 7;
#pragma unroll
    for (int j = 0; j < 4; ++j) { const int n = (lane >> 3) + 8 * j; const LAS float* s = scr + (8 * c) * 33 + n;
        const float s0 = s[0 * 33], s1 = s[1 * 33], s2 = s[2 * 33], s3 = s[3 * 33], s4 = s[4 * 33], s5 = s[5 * 33], s6 = s[6 * 33], s7 = s[7 * 33];
        if (w.mode == 2) { v2u o; o.x = i8x4(s0, s1, s2, s3, I8_WS); o.y = i8x4(s4, s5, s6, s7, I8_WS); *(v2u*)(w.dst + (size_t)n * w.K + 8 * c) = o; }
        else if (w.mode == 1) { v2u o; o.x = fp8x4(s0 * 64.0f, s1 * 64.0f, s2 * 64.0f, s3 * 64.0f); o.y = fp8x4(s4 * 64.0f, s5 * 64.0f, s6 * 64.0f, s7 * 64.0f); *(v2u*)(w.dst + (size_t)n * w.K + 8 * c) = o; }
        else { v4u o; o.x = pkbf(s0, s1); o.y = pkbf(s2, s3); o.z = pkbf(s4, s5); o.w = pkbf(s6, s7); *(v4u*)(w.dst + ((size_t)n * w.K + 8 * c) * 2) = o; } }
    LDS_WAIT(); asm volatile("" ::: "memory");
}
__device__ __forceinline__ void weight_copy_items(ArgP a, Frame& F, const int lo_, const int hi_, const int rk, const int nrk) {
    LAS float* scr = (LAS float*)(F.lds + F.wave * 16384);
    int it = lo_ + rk; if (it >= hi_) return;
    WItem cur = wc_decode(a, it); f32x4 vc[8]; wc_load(cur, vc, F.lane);
    for (;;) {
        const int itn = it + nrk; const bool more = itn < hi_;
        const WItem nx = wc_decode(a, more ? itn : it); f32x4 vn[8]; wc_load(nx, vn, F.lane);
        wc_process(cur, vc, scr, F.lane);
        if (!more) break;
        cur = nx; it = itn;
#pragma unroll
        for (int i = 0; i < 8; ++i) vc[i] = vn[i];
    }
}
__device__ __forceinline__ void phase_p0a(ArgP a, Frame& F) {
    LAS float* sv = (LAS float*)F.lds;
    LAS float* red = (LAS float*)(F.lds + 12288);
    for (int i = F.tid; i < 3072; i += 512) { const int v = i >> 10, k = i & 1023; const float x = (v < 2) ? a->in[I_C][v * 1024 + k] : a->in[I_CCTX][k]; sv[i] = siluf(x); }
    __syncthreads();
    for (int it = F.bx; it < 256; it += F.G) {
        const int l = it >> 7, cg = it & 127; const int r5 = F.lane / 12, c12 = F.lane % 12; const bool act = F.lane < 60;
        f32x4 acc[3]; acc[0] = acc[1] = acc[2] = (f32x4){0.f, 0.f, 0.f, 0.f};
        const float* Wl = a->in[I_WMOD] + (size_t)l * DM * 6144 + 48 * cg + 4 * c12;
#pragma unroll
        for (int hb = 0; hb < 2; ++hb) { f32x4 w4[13];
#pragma unroll
            for (int j = 0; j < 13; ++j) { const int kk = r5 + 5 * (13 * hb + j); const int kc = (act && kk < 128) ? 128 * F.wave + kk : 128 * F.wave; w4[j] = *(const f32x4*)(Wl + (size_t)kc * 6144); }
#pragma unroll
            for (int j = 0; j < 13; ++j) { const int kk = r5 + 5 * (13 * hb + j); const int k = 128 * F.wave + kk;
                if (act && kk < 128) { acc[0] += sv[k] * w4[j]; acc[1] += sv[1024 + k] * w4[j]; acc[2] += sv[2048 + k] * w4[j]; } } }
        if (act) {
#pragma unroll
            for (int v = 0; v < 3; ++v)
#pragma unroll
                for (int e = 0; e < 4; ++e) red[(F.wave * 60 + F.lane) * 12 + v * 4 + e] = acc[v][e]; }
        __syncthreads();
        if (F.tid < 144) { const int v = F.tid / 48, col = F.tid % 48, c12b = col >> 2, e = col & 3; float s = 0.f;
            for (int w = 0; w < 8; ++w)
                for (int r = 0; r < 5; ++r) s += red[(w * 60 + r * 12 + c12b) * 12 + v * 4 + e];
            ((float*)(a->ws + WS_MODV))[((size_t)(l * 3 + v)) * 6144 + 48 * cg + col] = s + a->in[I_BMOD][l * 6144 + 48 * cg + col]; }
        __syncthreads();
    }
    if (F.bx == F.G - 1 && F.tid >= 64 && F.tid < 80) { const int t = F.tid - 64; const float lg = logsig(a->in[I_DECAY][t]); ((float*)(a->ws + WS_DEC))[t] = lg; ((float*)(a->ws + WS_DEC))[16 + t] = expf(128.0f * lg); }
    if (F.tid < 16)
        for (int i = F.bx * 16 + F.tid; i < 4096; i += F.G * 16) { const int pos = i >> 4, fi = i & 15; const double inv = pow(10000.0, -(double)fi / 16.0); const double ang = (double)pos * inv;
            ((float*)(a->ws + WS_ROPE))[i] = (float)cos(ang); ((float*)(a->ws + WS_ROPE))[4096 + i] = (float)sin(ang); }
    weight_copy_items(a, F, 0, WCOPY_ITEMS, F.gw, F.NGW);
}

struct RowLoc { int b, jj, cls; size_t xoff; bool isctx; };
__device__ __forceinline__ RowLoc rowloc(int r) { RowLoc L; L.b = r / RB; L.jj = r - L.b * RB; L.isctx = L.jj < CTX; L.cls = L.isctx ? 2 : L.b;
    L.xoff = L.isctx ? (size_t)(L.b * CTX + L.jj) * DM : (size_t)(L.b * SEQ + (L.jj - CTX)) * DM; return L; }

__device__ __forceinline__ void wave_sum2(float& a, float& b) {
    for (int o = 0; o < 1; ++o) { float ta, tb; ta = shx<1>(a); tb = shx<1>(b); a += ta; b += tb; ta = shx<2>(a); tb = shx<2>(b); a += ta; b += tb; ta = shx<4>(a); tb = shx<4>(b); a += ta; b += tb;
        ta = shx<8>(a); tb = shx<8>(b); a += ta; b += tb; ta = shx<16>(a); tb = shx<16>(b); a += ta; b += tb; a = half_sum(a); b = half_sum(b); }
}
__device__ __forceinline__ void premix_rows(ArgP a, Frame& F, const int r0  , const int stride, const int nrows  , const bool isctx) {
    bf16* HX = (bf16*)(a->ws + WS_AR + AR_MIX);
    const float* xsrc = isctx ? a->in[I_CTX] : a->in[I_X];
    f32x4 A[4], B[4], t0[4]; int curcls = -1;
    f32x4 v0[4], v1[4], n0[4], n1[4]; ld16(v0, xsrc + (size_t)r0 * DM, F.lane); ld16(v1, xsrc + (size_t)(r0 + stride) * DM, F.lane);
#pragma unroll 1
    for (int rr = 0; rr < nrows; rr += 2) {
        const int ra = r0 + rr * stride, rb = ra + stride;
        if (rr + 2 < nrows) { ld16(n0, xsrc + (size_t)(ra + 2 * stride) * DM, F.lane); ld16(n1, xsrc + (size_t)(rb + 2 * stride) * DM, F.lane); }
        const int ba = isctx ? ra / CTX : ra / SEQ, bb = isctx ? rb / CTX : rb / SEQ; const int cls = isctx ? 2 : ba;
        if (cls != curcls) { curcls = cls; ld16(A, a->in[I_NPREMIX], F.lane); ld16(t0, modv(a->ws, 0, cls, 1), F.lane); ld16(B, modv(a->ws, 0, cls, 0), F.lane);
#pragma unroll
            for (int j = 0; j < 4; ++j) A[j] = A[j] * (1.0f + t0[j]); }
        const int ua = isctx ? ba * RB + (ra - ba * CTX) : ra + CTX * (ba + 1), ub = isctx ? bb * RB + (rb - bb * CTX) : rb + CTX * (bb + 1);
        float q0 = sumsq16(v0), q1 = sumsq16(v1); wave_sum2(q0, q1);
        const float r0s = 1.0f / sqrtf(q0 * (1.0f / DM) + EPS), r1s = 1.0f / sqrtf(q1 * (1.0f / DM) + EPS);
#pragma unroll
        for (int j = 0; j < 4; ++j) { v0[j] = v0[j] * r0s * A[j] + B[j]; v1[j] = v1[j] * r1s * A[j] + B[j]; }
        if (IN_I8 & 1) { st16i8((unsigned char*)HX + (size_t)ua * DM, v0, F.lane, I8_XI); st16i8((unsigned char*)HX + (size_t)ub * DM, v1, F.lane, I8_XI); }
        else { st16b(HX + (size_t)ua * DM, v0, F.lane); st16b(HX + (size_t)ub * DM, v1, F.lane); }
#pragma unroll
        for (int j = 0; j < 4; ++j) { v0[j] = n0[j]; v1[j] = n1[j]; }
    }
}
__device__ __forceinline__ void phase_premix0(ArgP a, Frame& F) {
    const int per = NLAT / F.NGW;
    if (F.gw < NLAT) premix_rows(a, F, F.gw, F.NGW, per, false);
    for (int j = F.gw; j < 8 * NB * CTX / 2; j += F.NGW) if ((j & 7) == 0) premix_rows(a, F, (j >> 3) * 2, 1, 2, true);
}

__device__ __forceinline__ void moe_prefix(const unsigned char* ws, int (&tstart)[9], int (&cnt)[8]) {
    const unsigned* cw = (const unsigned*)(ws + WS_CTL) + CW_CNT; int s = 0;
#pragma unroll
    for (int e = 0; e < 8; ++e) { cnt[e] = (int)__builtin_amdgcn_readfirstlane(cw[64 * e]); tstart[e] = s; s += (cnt[e] + 255) >> 8; }
    tstart[8] = s;
}

template <int MODE> __device__ __forceinline__ void resid_rows(ArgP a, Frame& F, const int r0, const int stride, const int nrows, const bool isctx,
                                                               const int (&tstart)[9], int& myE0, int& myE1, float& myW0, float& myW1) {
    constexpr int l = MODE >> 1; constexpr bool post_ffn = MODE & 1;
    const bf16* SRC = (const bf16*)(a->ws + WS_AR + (MODE == 1 ? AR_YD : (MODE == 3 ? AR_YM : AR_MX)));
    bf16* H = (bf16*)(a->ws + WS_AR + (MODE == 1 ? AR_MIX : AR_HX2));
    const float* gpost = a->in[post_ffn ? I_NPOSTFFN : I_NPOSTMIX] + l * DM;
    const float* gnext = (MODE == 1) ? a->in[I_NPREMIX] + DM : a->in[I_NPREFFN] + l * DM;
    constexpr int gate_chunk = post_ffn ? 5 : 2, sc_chunk = (MODE == 1) ? 1 : 4, sh_chunk = (MODE == 1) ? 0 : 3, lnext = (MODE == 1) ? 1 : l;
    const LAS float* rts = (const LAS float*)F.lds;
    float* XC = (float*)(a->ws + WS_XC);
    const float* xin = isctx ? (MODE == 0 ? a->in[I_CTX] : (const float*)XC) : a->in[I_X];
    float* xout = isctx ? XC : a->out;
    bf16* XB = (bf16*)(a->ws + WS_XB);
    f32x4 G1[4], A2[4], B2[4], t0[4]; int curcls = -1;
#define UROW(r_) (isctx ? ((r_) / CTX) * RB + ((r_) % CTX) : (r_) + CTX * ((r_) / SEQ + 1))
    v4u tiv = (v4u){0u, 0u, 0u, 0u}; float tw0 = 0.f, tw1 = 0.f;
    if constexpr (MODE == 3) { if (F.lane < nrows) { const unsigned char* tp = a->ws + WS_TOK + (size_t)(r0 + F.lane * stride) * 32; tiv = *(const v4u*)tp; tw0 = *(const float*)(tp + 16); tw1 = *(const float*)(tp + 20); } }
    f32x4 s0[4], x0[4], s1[4], x1[4], sn0[4], xn0[4], sn1[4], xn1[4], y1[4];
#define RESID_LOAD(S_, X_, rr_) do { \
        if constexpr (MODE == 3) { const int e0 = __builtin_amdgcn_readlane((int)tiv.x, rr_), p0l = __builtin_amdgcn_readlane((int)tiv.y, rr_), e1 = __builtin_amdgcn_readlane((int)tiv.z, rr_), p1l = __builtin_amdgcn_readlane((int)tiv.w, rr_); \
            const float w0 = __builtin_bit_cast(float, __builtin_amdgcn_readlane(__builtin_bit_cast(int, tw0), rr_)), w1 = __builtin_bit_cast(float, __builtin_amdgcn_readlane(__builtin_bit_cast(int, tw1), rr_)); \
            int ts0 = 0, ts1 = 0; _Pragma("unroll") for (int e = 0; e < 8; ++e) { ts0 = (e0 == e) ? tstart[e] : ts0; ts1 = (e1 == e) ? tstart[e] : ts1; } \
            ld16b(S_, SRC + ((size_t)ts0 * 256 + p0l) * DM, F.lane); ld16b(y1, SRC + ((size_t)ts1 * 256 + p1l) * DM, F.lane); \
            _Pragma("unroll") for (int j = 0; j < 4; ++j) S_[j] = w0 * S_[j] + w1 * y1[j]; } \
        else if (isctx && (MODE == 0 || (MODE == 1 && !DENSE_DOWN_F8))) { const int cr_ = r0 + (rr_) * stride; const float* pp_ = (const float*)(a->ws + WS_AR + (MODE == 0 ? AR_PART0 : AR_PART1)) + (size_t)((cr_ >> 8) * 256 + (cr_ & 255)) * DM; \
            ld16(S_, pp_, F.lane); for (int ks_ = 1; ks_ < (MODE == 0 ? 4 : 11); ++ks_) { ld16(y1, pp_ + (size_t)ks_ * 512 * DM, F.lane); _Pragma("unroll") for (int j = 0; j < 4; ++j) S_[j] += y1[j]; } } \
        else ld16b(S_, SRC + (size_t)UROW(r0 + (rr_) * stride) * DM, F.lane); \
        if (!isctx && MODE != 0) ld16b(X_, XB + (size_t)(r0 + (rr_) * stride) * DM, F.lane); else ld16(X_, xin + (size_t)(r0 + (rr_) * stride) * DM, F.lane); } while (0)
    RESID_LOAD(s0, x0, 0); RESID_LOAD(s1, x1, 1);
#pragma unroll 1
    for (int rr = 0; rr < nrows; rr += 2) {
        if (rr + 2 < nrows) { RESID_LOAD(sn0, xn0, rr + 2); RESID_LOAD(sn1, xn1, rr + 3); }
        const int ra = r0 + rr * stride, rb = ra + stride; const int cls = isctx ? 2 : ra / SEQ;
        if (cls != curcls) { curcls = cls; ld16(G1, gpost, F.lane); ld16(t0, modv(a->ws, l, cls, gate_chunk), F.lane);
#pragma unroll
            for (int j = 0; j < 4; ++j) G1[j] = G1[j] * t0[j];
            if constexpr (MODE != 3) { ld16(A2, gnext, F.lane); ld16(t0, modv(a->ws, lnext, cls, sc_chunk), F.lane); ld16(B2, modv(a->ws, lnext, cls, sh_chunk), F.lane);
#pragma unroll
                for (int j = 0; j < 4; ++j) A2[j] = A2[j] * (1.0f + t0[j]); } }
        float q0 = sumsq16(s0), q1 = sumsq16(s1); wave_sum2(q0, q1);
        const float rs0 = 1.0f / sqrtf(q0 * (1.0f / DM) + EPS), rs1 = 1.0f / sqrtf(q1 * (1.0f / DM) + EPS);
#pragma unroll
        for (int j = 0; j < 4; ++j) { x0[j] = x0[j] + G1[j] * (s0[j] * rs0); x1[j] = x1[j] + G1[j] * (s1[j] * rs1); }
        if (!isctx && MODE != 3) { st16b(XB + (size_t)ra * DM, x0, F.lane); st16b(XB + (size_t)rb * DM, x1, F.lane); } else { st16(xout + (size_t)ra * DM, x0, F.lane); st16(xout + (size_t)rb * DM, x1, F.lane); }
        if constexpr (MODE != 3) {
            float u0 = sumsq16(x0), u1 = sumsq16(x1); wave_sum2(u0, u1);
            const float t0r = 1.0f / sqrtf(u0 * (1.0f / DM) + EPS), t1r = 1.0f / sqrtf(u1 * (1.0f / DM) + EPS);
#pragma unroll
            for (int j = 0; j < 4; ++j) { x0[j] = x0[j] * t0r * A2[j] + B2[j]; x1[j] = x1[j] * t1r * A2[j] + B2[j]; }
            if constexpr (MODE == 1 && (IN_I8 & 2)) { st16i8((unsigned char*)H + (size_t)UROW(ra) * DM, x0, F.lane, I8_XI); st16i8((unsigned char*)H + (size_t)UROW(rb) * DM, x1, F.lane, I8_XI); }
            else if constexpr (MODE == 2 && MOE_F8 && MOE_I8UP) { st16i8((unsigned char*)H + (size_t)ra * DM, x0, F.lane); st16i8((unsigned char*)H + (size_t)rb * DM, x1, F.lane); }
            else if constexpr (MODE == 0 && DENSE_I8UP && !DENSE_F8) { st16i8((unsigned char*)H + (size_t)UROW(ra) * DM, x0, F.lane); st16i8((unsigned char*)H + (size_t)UROW(rb) * DM, x1, F.lane); }
            else if constexpr ((MODE == 1 && !IN1_F8) || (MODE == 0 && !DENSE_F8) || (MODE == 2 && !MOE_F8)) { st16b(H + (size_t)(MODE == 2 ? ra : UROW(ra)) * DM, x0, F.lane); st16b(H + (size_t)(MODE == 2 ? rb : UROW(rb)) * DM, x1, F.lane); }
            else { st16f8((unsigned char*)H + (size_t)(MODE == 2 ? ra : UROW(ra)) * DM, x0, F.lane); st16f8((unsigned char*)H + (size_t)(MODE == 2 ? rb : UROW(rb)) * DM, x1, F.lane); }
            if constexpr (MODE == 2) {
                asm volatile("" ::: "memory");
                float lgA[8], lgB[8];
#pragma unroll
                for (int e = 0; e < 8; ++e) { float pA = 0.f, pB = 0.f;
#pragma unroll
                    for (int j = 0; j < 4; ++j) { const f32x4 rv = *(const LAS f32x4*)(rts + e * 1024 + ROWCOL(j) + 8 * F.lane);
                        pA += (x0[j][0] * rv[0] + x0[j][1] * rv[1]) + (x0[j][2] * rv[2] + x0[j][3] * rv[3]); pB += (x1[j][0] * rv[0] + x1[j][1] * rv[1]) + (x1[j][2] * rv[2] + x1[j][3] * rv[3]); }
                    wave_sum2(pA, pB); lgA[e] = pA; lgB[e] = pB; }
#define TOP2(lg, rrow) do { int i0 = 0; float v0 = lg[0]; _Pragma("unroll") for (int e = 1; e < 8; ++e) if (lg[e] > v0) { v0 = lg[e]; i0 = e; } \
                    int i1 = -1; float v1 = -INFINITY; _Pragma("unroll") for (int e = 0; e < 8; ++e) if (e != i0 && lg[e] > v1) { v1 = lg[e]; i1 = e; } \
                    const float w0 = 1.0f / (1.0f + __expf(v1 - v0)); if (F.lane == (rrow)) { myE0 = i0; myE1 = i1; myW0 = w0; myW1 = 1.0f - w0; } } while (0)
                TOP2(lgA, rr); TOP2(lgB, rr + 1);
#undef TOP2
            }
        }
#pragma unroll
        for (int j = 0; j < 4; ++j) { s0[j] = sn0[j]; x0[j] = xn0[j]; s1[j] = sn1[j]; x1[j] = xn1[j]; }
    }
#undef RESID_LOAD
#undef UROW
}
template <int MODE> __device__ __forceinline__ void phase_resid(ArgP a, Frame& F) {
    float* XC = (float*)(a->ws + WS_XC);
    int tstart[9], ecnt[8];
    if constexpr (MODE == 3) moe_prefix(a->ws, tstart, ecnt); else {
#pragma unroll
        for (int e = 0; e < 9; ++e) tstart[e] = 0; }
    int myE0 = -1, myE1 = -1; float myW0 = 0.f, myW1 = 0.f;
    if constexpr (MODE < 2) {
        if (F.gw < NLAT) resid_rows<MODE>(a, F, F.gw, F.NGW, NLAT / F.NGW, false, tstart, myE0, myE1, myW0, myW1);
        for (int j = F.gw; j < 8 * NB * CTX / 2; j += F.NGW) if ((j & 7) == 0) resid_rows<MODE>(a, F, (j >> 3) * 2, 1, 2, true, tstart, myE0, myE1, myW0, myW1);
    } else {
        LAS float* rts = (LAS float*)F.lds;
        LAS int* wcnt = (LAS int*)(F.lds + 32768);
        LAS int* bbase = (LAS int*)(F.lds + 32768 + 256);
        if constexpr (MODE == 2) { for (int i = F.tid; i < 8192; i += 512) { const int k = i >> 3, e = i & 7; rts[e * 1024 + k] = a->in[I_ROUTER][i]; } __syncthreads(); }
        const int per = NLAT / F.NGW;
        for (int rd = 0; rd < 1; ++rd) {
            const bool active = F.gw < NLAT;
            myE0 = -1; myE1 = -1;
            if (active) resid_rows<MODE>(a, F, F.gw, F.NGW, per, false, tstart, myE0, myE1, myW0, myW1);
            if constexpr (MODE == 2) {
                int tid2 = F.tid; asm volatile("" : "+v"(tid2)); const int lane2 = tid2 & 63;
                if (lane2 < 8) wcnt[F.wave * 8 + lane2] = 0;
                LDS_WAIT();
                int r0 = 0, r1 = 0;
                if (active && lane2 < per) { r0 = __hip_atomic_fetch_add(wcnt + F.wave * 8 + myE0, 1, __ATOMIC_RELAXED, __HIP_MEMORY_SCOPE_WORKGROUP); r1 = __hip_atomic_fetch_add(wcnt + F.wave * 8 + myE1, 1, __ATOMIC_RELAXED, __HIP_MEMORY_SCOPE_WORKGROUP); }
                __syncthreads();
                if (tid2 < 8) { int tot = 0; for (int w = 0; w < 8; ++w) tot += wcnt[w * 8 + tid2];
                    int base = 0; if (tot > 0) base = (int)__hip_atomic_fetch_add((unsigned*)(a->ws + WS_CTL) + CW_CNT + 64 * tid2, (unsigned)tot, RLX_AGENT);
                    bbase[tid2] = base; }
                __syncthreads();
                if (active && lane2 < per) {
                    int wb0 = bbase[myE0], wb1 = bbase[myE1];
                    for (int w = 0; w < F.wave; ++w) { wb0 += wcnt[w * 8 + myE0]; wb1 += wcnt[w * 8 + myE1]; }
                    const int lp0 = wb0 + r0, lp1 = wb1 + r1;
                    const int tk = F.gw + lane2 * F.NGW; int* lists = (int*)(a->ws + WS_LIST);
                    lists[myE0 * LISTCAP + lp0] = tk; lists[myE1 * LISTCAP + lp1] = tk;
                    v4u ti; ti.x = (unsigned)myE0; ti.y = (unsigned)lp0; ti.z = (unsigned)myE1; ti.w = (unsigned)lp1;
                    *(v4u*)(a->ws + WS_TOK + (size_t)tk * 32) = ti; *(float*)(a->ws + WS_TOK + (size_t)tk * 32 + 16) = myW0; *(float*)(a->ws + WS_TOK + (size_t)tk * 32 + 20) = myW1;
                }
                __syncthreads();
            }
        }
    }
}
typedef float f32x16v __attribute__((ext_vector_type(16)));
__device__ __forceinline__ int crow32(int r, int hi) { return (r & 3) + 8 * (r >> 2) + 4 * hi; }
__device__ __forceinline__ int chain_id(int b, int h, int dir) { return (b * 4 + h) * 2 + dir; }

__device__ __forceinline__ void phase_prep(ArgP a, Frame& F, int l) {
    const bf16* P = (const bf16*)(a->ws + WS_AR + AR_P);
    bf16* QB = (bf16*)(a->ws + WS_AR + AR_QB); bf16* KC = (bf16*)(a->ws + WS_AR + AR_KC); bf16* VC = (bf16*)(a->ws + WS_AR + AR_VC);
    unsigned char* Q8 = q8_ptr(a); unsigned char* K8 = k8_ptr(a); unsigned char* V8 = v8_ptr(a);
    const float* ropec = (const float*)(a->ws + WS_ROPE); const float* ropes = ropec + 4096;
    {
        const int rr = F.lane >> 3, c = F.lane & 7;
        float gq[8], gk[8];
#pragma unroll
        for (int j = 0; j < 8; ++j) { gq[j] = a->in[I_QN][l * 64 + 8 * c + j]; gk[j] = a->in[I_KN][l * 64 + 8 * c + j]; }
        for (int it = F.gw; it < NR / 8; it += F.NGW) {
            const int row = it * 8 + rr; const int b = row / RB, jj = row - b * RB; const bool lat = jj >= CTX; const int t = jj - CTX;
            float cs[8], sn[8];
            if (lat) { const int pos = (c < 4) ? (t >> 6) : (t & 63); const int fi = 8 * (c & 1);
#pragma unroll
                for (int j = 0; j < 8; ++j) { cs[j] = ropec[pos * 16 + fi + j]; sn[j] = ropes[pos * 16 + fi + j]; } }
            else {
#pragma unroll
                for (int j = 0; j < 8; ++j) { cs[j] = 1.f; sn[j] = 0.f; } }
            const float sgn = (c & 2) ? 1.f : -1.f;
            const bf16* prow = P + (size_t)row * INW;
#pragma unroll 2
            for (int hs = 0; hs < 10; ++hs) {
                const v4u u = *(const v4u*)(prow + hs * 64 + 8 * c);
                float x[8] = {bf_lo(u.x), bf_hi(u.x), bf_lo(u.y), bf_hi(u.y), bf_lo(u.z), bf_hi(u.z), bf_lo(u.w), bf_hi(u.w)};
                float ss = 0.f;
#pragma unroll
                for (int j = 0; j < 8; ++j) ss += x[j] * x[j];
                ss += shx<1>(ss); ss += shx<2>(ss); ss += shx<4>(ss);
                const float rstd = 1.0f / sqrtf(ss * (1.0f / 64.0f) + EPS);
                float y[8];
#pragma unroll
                for (int j = 0; j < 8; ++j) { y[j] = x[j] * rstd * (hs < 8 ? gq[j] : gk[j]); }
#pragma unroll
                for (int j = 0; j < 8; ++j) { const float p = shx<2>(y[j]); x[j] = y[j] * cs[j] + sgn * p * sn[j]; }
                const float sc = (hs < 8) ? attn_body::C2 : 1.0f;
#if ATT8_DEBUG
                { v4u o; o.x = pkbf(x[0] * sc, x[1] * sc); o.y = pkbf(x[2] * sc, x[3] * sc); o.z = pkbf(x[4] * sc, x[5] * sc); o.w = pkbf(x[6] * sc, x[7] * sc);
                if (hs < 8) *(v4u*)(QB + (size_t)row * 512 + hs * 64 + 8 * c) = o;
                else *(v4u*)(KC + ((size_t)(b * 2 + (hs - 8)) * RB + jj) * 64 + 8 * c) = o; }
#endif
                { v2u o8; o8.x = fp8x4(x[0] * sc, x[1] * sc, x[2] * sc, x[3] * sc); o8.y = fp8x4(x[4] * sc, x[5] * sc, x[6] * sc, x[7] * sc);
                if (hs < 8) *(v2u*)(Q8 + (size_t)row * 512 + hs * 64 + 8 * c) = o8;
                else *(v2u*)(K8 + ((size_t)((b * 2 + (hs - 8)) * (RB / 64) + (jj >> 6))) * 4096 + (c >> 1) * 1024 + (jj & 63) * 16 + 8 * (c & 1)) = o8; }
            }
#if ATT8_DEBUG
#pragma unroll
            for (int kv = 0; kv < 2; ++kv) *(v4u*)(VC + ((size_t)(b * 2 + kv) * RB + jj) * 64 + 8 * c) = *(const v4u*)(prow + PC_V + kv * 64 + 8 * c);
#endif
        }
    }
    for (int it = F.gw; it < NR / 32; it += F.NGW) {
        const int b = it / (RB / 32), g = it - b * (RB / 32), tile = g >> 1, c2 = g & 1, kv = F.lane >> 5, kg = (F.lane >> 4) & 1, d4 = F.lane & 15;
        const bf16* src = P + (size_t)(b * RB + 32 * g + 4 * kg) * INW + PC_V + kv * 64 + 4 * d4;
        v2u u[16];
#pragma unroll
        for (int j = 0; j < 16; ++j) u[j] = *(const v2u*)(src + (size_t)((j & 3) + 8 * (j >> 2)) * INW);
        unsigned char* dst = V8 + ((size_t)((b * 2 + kv) * (RB / 64) + tile)) * 4096 + ((kg * 2 + c2) * 64 + 4 * d4) * 16;
        v4u o0, o1, o2, o3;
        o0.x = fp8x4(bf_lo(u[0].x), bf_lo(u[1].x), bf_lo(u[2].x), bf_lo(u[3].x)); o0.y = fp8x4(bf_lo(u[4].x), bf_lo(u[5].x), bf_lo(u[6].x), bf_lo(u[7].x)); o0.z = fp8x4(bf_lo(u[8].x), bf_lo(u[9].x), bf_lo(u[10].x), bf_lo(u[11].x)); o0.w = fp8x4(bf_lo(u[12].x), bf_lo(u[13].x), bf_lo(u[14].x), bf_lo(u[15].x));
        o1.x = fp8x4(bf_hi(u[0].x), bf_hi(u[1].x), bf_hi(u[2].x), bf_hi(u[3].x)); o1.y = fp8x4(bf_hi(u[4].x), bf_hi(u[5].x), bf_hi(u[6].x), bf_hi(u[7].x)); o1.z = fp8x4(bf_hi(u[8].x), bf_hi(u[9].x), bf_hi(u[10].x), bf_hi(u[11].x)); o1.w = fp8x4(bf_hi(u[12].x), bf_hi(u[13].x), bf_hi(u[14].x), bf_hi(u[15].x));
        o2.x = fp8x4(bf_lo(u[0].y), bf_lo(u[1].y), bf_lo(u[2].y), bf_lo(u[3].y)); o2.y = fp8x4(bf_lo(u[4].y), bf_lo(u[5].y), bf_lo(u[6].y), bf_lo(u[7].y)); o2.z = fp8x4(bf_lo(u[8].y), bf_lo(u[9].y), bf_lo(u[10].y), bf_lo(u[11].y)); o2.w = fp8x4(bf_lo(u[12].y), bf_lo(u[13].y), bf_lo(u[14].y), bf_lo(u[15].y));
        o3.x = fp8x4(bf_hi(u[0].y), bf_hi(u[1].y), bf_hi(u[2].y), bf_hi(u[3].y)); o3.y = fp8x4(bf_hi(u[4].y), bf_hi(u[5].y), bf_hi(u[6].y), bf_hi(u[7].y)); o3.z = fp8x4(bf_hi(u[8].y), bf_hi(u[9].y), bf_hi(u[10].y), bf_hi(u[11].y)); o3.w = fp8x4(bf_hi(u[12].y), bf_hi(u[13].y), bf_hi(u[14].y), bf_hi(u[15].y));
        *(v4u*)(dst) = o0; *(v4u*)(dst + 16) = o1; *(v4u*)(dst + 32) = o2; *(v4u*)(dst + 48) = o3;
    }
    __syncthreads();
    typedef short bf16x8_t __attribute__((ext_vector_type(8)));
    LAS unsigned char* VT = F.lds; LAS unsigned char* KTf = F.lds + 17536; LAS unsigned char* KTb = F.lds + 2 * 17536;
    float* US = (float*)(a->ws + WS_AR + AR_US);
    for (int it = F.bx; it < NB * 4 * NCH; it += F.G) {
        const int c = it % NCH, bh = it / NCH, b = bh >> 2, h = bh & 3;
        const float lgf = ((const float*)(a->ws + WS_DEC))[l * 8 + h], lgb = ((const float*)(a->ws + WS_DEC))[l * 8 + 4 + h];
        { const int p = F.tid >> 2, sg = F.tid & 3; const bf16* prow = P + (size_t)(b * RB + c * 128 + p) * INW;
            const float zf = __expf(lgf * (float)(127 - p)) * 0.125f, zb = __expf(lgb * (float)p) * 0.125f;
#pragma unroll
            for (int q = 0; q < 2; ++q) { const v4u uk = *(const v4u*)(prow + PC_RK + h * 64 + sg * 16 + q * 8), uv = *(const v4u*)(prow + PC_RV + h * 64 + sg * 16 + q * 8);
                const unsigned kw[4] = {uk.x, uk.y, uk.z, uk.w}, vw[4] = {uv.x, uv.y, uv.z, uv.w};
#pragma unroll
                for (int i = 0; i < 8; ++i) { const int ch = sg * 16 + q * 8 + i; const int off = ch * 272 + sg * 32 + 2 * p;
                    const unsigned kwv = kw[i >> 1], vwv = vw[i >> 1]; const float kf = (i & 1) ? bf_hi(kwv) : bf_lo(kwv);
                    *(LAS bf16*)(VT + off) = (bf16)((i & 1) ? (vwv >> 16) : (vwv & 0xffffu));
                    *(LAS bf16*)(KTf + off) = (bf16)(pkbf(kf * zf, 0.f) & 0xffffu); *(LAS bf16*)(KTb + off) = (bf16)(pkbf(kf * zb, 0.f) & 0xffffu); } } }
        __syncthreads();
        { const int dir = F.wave >> 2, di = (F.wave >> 1) & 1, ei = F.wave & 1, r32 = F.lane & 31, hh = F.lane >> 5;
            f32x16v acc; { const float z = pg8::zero_v(); _Pragma("unroll") for (int r = 0; r < 16; ++r) acc[r] = z; }
            const int erow = 32 * ei + r32, drow = 32 * di + r32;
            const LAS unsigned char* ap = VT + erow * 272 + (erow >> 4) * 32 + 16 * hh; const LAS unsigned char* bp = (dir ? KTb : KTf) + drow * 272 + (drow >> 4) * 32 + 16 * hh;
#pragma unroll
            for (int s8 = 0; s8 < 8; ++s8) { const bf16x8_t av = *(const LAS bf16x8_t*)(ap + 32 * s8), bv = *(const LAS bf16x8_t*)(bp + 32 * s8);
                acc = __builtin_amdgcn_mfma_f32_32x32x16_bf16(av, bv, acc, 0, 0, 0); }
            float* dst = US + ((size_t)(chain_id(b, h, dir) * NCH + c)) * 4096;
#pragma unroll
            for (int r = 0; r < 16; ++r) dst[(32 * ei + crow32(r, hh)) * 64 + 32 * di + r32] = acc[r]; }
        __syncthreads();
    }
}

__device__ __forceinline__ void phase_scan(ArgP a, Frame& F, int l) {
    float* US = (float*)(a->ws + WS_AR + AR_US);
    if (F.tid < 256) {
        for (int id = F.bx * 256 + F.tid; id < 16 * 4096; id += F.G * 256) {
            const int chain = id >> 12, e = id & 4095, dir = chain & 1, h = (chain >> 1) & 3;
            const float dec = ((const float*)(a->ws + WS_DEC))[16 + l * 8 + dir * 4 + h];
            const float* base = US + (size_t)chain * NCH * 4096 + e; float st = 0.f;
            bf16* sb = (bf16*)(a->ws + WS_AR + AR_MX) + (size_t)chain * NCH * 4096 + e;
            for (int s0 = 0; s0 < NCH; s0 += 10) { float u[10]; int ci[10];
#pragma unroll
                for (int q = 0; q < 10; ++q) { const int s = s0 + q; ci[q] = dir == 0 ? s : (s < 2 ? 1 - s : NCH + 1 - s); u[q] = base[(size_t)ci[q] * 4096]; }
#pragma unroll
                for (int q = 0; q < 10; ++q) { sb[(size_t)ci[q] * 4096] = (bf16)(pkbf(st, 0.f) & 0xffffu); st = dec * st + u[q]; } }
        }
    }
}

__device__ __forceinline__ void ret_out_item(ArgP a, Frame& F, int l, int b, int c, int hp, int buf) {
    typedef short bf16x8_t __attribute__((ext_vector_type(8)));
    const bf16* P = (const bf16*)(a->ws + WS_AR + AR_P); bf16* MIX = (bf16*)(a->ws + WS_AR + AR_MIX);
    LAS bf16* VT = (LAS bf16*)(F.lds + buf * 34816);
    const int hl = F.wave >> 2, head = 2 * hp + hl, pi = F.wave & 3, r32 = F.lane & 31, hh = F.lane >> 5;
    const int row0 = b * RB + c * 128;
    { const int m = F.tid >> 2, qd = F.tid & 3; const bf16* src = P + (size_t)(row0 + m) * INW + PC_RV + (2 * hp) * 64 + 32 * qd;
        LAS bf16* dst = VT + (size_t)((qd >> 1) * 64 + 32 * (qd & 1)) * 132 + m;
#pragma unroll
        for (int q = 0; q < 4; ++q) { const v4u u = *(const v4u*)(src + 8 * q);
            dst[(8 * q + 0) * 132] = (bf16)(u.x & 0xffffu); dst[(8 * q + 1) * 132] = (bf16)(u.x >> 16); dst[(8 * q + 2) * 132] = (bf16)(u.y & 0xffffu); dst[(8 * q + 3) * 132] = (bf16)(u.y >> 16);
            dst[(8 * q + 4) * 132] = (bf16)(u.z & 0xffffu); dst[(8 * q + 5) * 132] = (bf16)(u.z >> 16); dst[(8 * q + 6) * 132] = (bf16)(u.w & 0xffffu); dst[(8 * q + 7) * 132] = (bf16)(u.w >> 16); } }
    bf16x8_t qf[4], kf[4][4];
    { const bf16* qrow = P + (size_t)(row0 + 32 * pi + r32) * INW + PC_RQ + head * 64 + 8 * hh;
#pragma unroll
        for (int d0 = 0; d0 < 4; ++d0) qf[d0] = *(const bf16x8_t*)(qrow + 16 * d0);
#pragma unroll
        for (int mb = 0; mb < 4; ++mb) { const bf16* krow = P + (size_t)(row0 + 32 * mb + r32) * INW + PC_RK + head * 64 + 8 * hh;
#pragma unroll
            for (int d0 = 0; d0 < 4; ++d0) kf[mb][d0] = *(const bf16x8_t*)(krow + 16 * d0); } }
    const float L2E = 1.4426950408889634f;
    const float lgf2 = ((const float*)(a->ws + WS_DEC))[l * 8 + head] * L2E, lgb2 = ((const float*)(a->ws + WS_DEC))[l * 8 + 4 + head] * L2E;
    int p = 32 * pi + r32; asm volatile("" : "+v"(p));
    bf16x8_t pk[8];
#pragma unroll
    for (int mb = 0; mb < 4; ++mb) {
        f32x16v st; { const float z = pg8::zero_v(); _Pragma("unroll") for (int r = 0; r < 16; ++r) st[r] = z; }
#pragma unroll
        for (int d0 = 0; d0 < 4; ++d0) st = __builtin_amdgcn_mfma_f32_32x32x16_bf16(kf[mb][d0], qf[d0], st, 0, 0, 0);
#pragma unroll
        for (int r = 0; r < 16; ++r) { const float fd = (float)(p - (32 * mb + crow32(r, hh)));
            const float arg = lgf2 * fmaxf(fd, 0.f) + lgb2 * fmaxf(-fd, 0.f) + fmaxf(1.0f - fabsf(fd), 0.f) - 3.0f;
            st[r] = st[r] * __builtin_amdgcn_exp2f(arg); }
        v4u w0, w1; w0.x = pkbf(st[0], st[1]); w0.y = pkbf(st[2], st[3]); w0.z = pkbf(st[4], st[5]); w0.w = pkbf(st[6], st[7]);
        w1.x = pkbf(st[8], st[9]); w1.y = pkbf(st[10], st[11]); w1.z = pkbf(st[12], st[13]); w1.w = pkbf(st[14], st[15]);
        pk[2 * mb] = __builtin_bit_cast(bf16x8_t, w0); pk[2 * mb + 1] = __builtin_bit_cast(bf16x8_t, w1);
    }
    __builtin_amdgcn_sched_barrier(0);
    const float ef = __builtin_amdgcn_exp2f(lgf2 * (float)(p + 1)), ebk = __builtin_amdgcn_exp2f(lgb2 * (float)(128 - p));
    f32x16v ot[2];
    { const float z = pg8::zero_v(); _Pragma("unroll") for (int r = 0; r < 16; ++r) { ot[0][r] = z; ot[1][r] = z; } }
    { const bf16* SB = (const bf16*)(a->ws + WS_AR + AR_MX);
      const bf16* Sf = SB + ((size_t)(chain_id(b, head, 0) * NCH + c)) * 4096; const bf16* Sb = SB + ((size_t)(chain_id(b, head, 1) * NCH + c)) * 4096;
#pragma unroll
        for (int s4 = 0; s4 < 4; ++s4) {
            const v4u qu = __builtin_bit_cast(v4u, qf[s4]); v4u qa, qb;
            qa.x = pkbf(bf_lo(qu.x) * ef, bf_hi(qu.x) * ef); qa.y = pkbf(bf_lo(qu.y) * ef, bf_hi(qu.y) * ef); qa.z = pkbf(bf_lo(qu.z) * ef, bf_hi(qu.z) * ef); qa.w = pkbf(bf_lo(qu.w) * ef, bf_hi(qu.w) * ef);
            qb.x = pkbf(bf_lo(qu.x) * ebk, bf_hi(qu.x) * ebk); qb.y = pkbf(bf_lo(qu.y) * ebk, bf_hi(qu.y) * ebk); qb.z = pkbf(bf_lo(qu.z) * ebk, bf_hi(qu.z) * ebk); qb.w = pkbf(bf_lo(qu.w) * ebk, bf_hi(qu.w) * ebk);
#pragma unroll
            for (int eb = 0; eb < 2; ++eb) { const int off = (32 * eb + r32) * 64 + 16 * s4 + 8 * hh;
                const bf16x8_t wf = *(const bf16x8_t*)(Sf + off), wb = *(const bf16x8_t*)(Sb + off);
                ot[eb] = __builtin_amdgcn_mfma_f32_32x32x16_bf16(wf, __builtin_bit_cast(bf16x8_t, qa), ot[eb], 0, 0, 0);
                ot[eb] = __builtin_amdgcn_mfma_f32_32x32x16_bf16(wb, __builtin_bit_cast(bf16x8_t, qb), ot[eb], 0, 0, 0); } } }
    __builtin_amdgcn_sched_barrier(0);
    __syncthreads();
    { const LAS bf16* vrow = VT + (size_t)(hl * 64 + r32) * 132 + 4 * hh;
#pragma unroll
        for (int eb = 0; eb < 2; ++eb)
#pragma unroll
            for (int sg = 0; sg < 8; ++sg) { const LAS bf16* vp = vrow + (size_t)(32 * eb) * 132 + 16 * sg;
                const v2u lo = *(const LAS v2u*)vp, hi = *(const LAS v2u*)(vp + 8);
                const v4u av = (v4u){lo.x, lo.y, hi.x, hi.y};
                ot[eb] = __builtin_amdgcn_mfma_f32_32x32x16_bf16(__builtin_bit_cast(bf16x8_t, av), pk[sg], ot[eb], 0, 0, 0); } }
    __builtin_amdgcn_sched_barrier(0);
    float s1 = 0.f, s2 = 0.f;
#pragma unroll
    for (int eb = 0; eb < 2; ++eb)
#pragma unroll
        for (int r = 0; r < 16; ++r) { const float v = ot[eb][r]; s1 += v; s2 += v * v; }
    { auto rr = __builtin_amdgcn_permlane32_swap(__float_as_uint(s1), __float_as_uint(s1), false, false); s1 = __uint_as_float(rr[0]) + __uint_as_float(rr[1]); }
    { auto rr = __builtin_amdgcn_permlane32_swap(__float_as_uint(s2), __float_as_uint(s2), false, false); s2 = __uint_as_float(rr[0]) + __uint_as_float(rr[1]); }
    const float mu = s1 * (1.0f / 64.0f); const float var = fmaxf(s2 * (1.0f / 64.0f) - mu * mu, 0.f); const float rstd = 1.0f / sqrtf(var + EPS);
    const size_t orow = (size_t)(row0 + p);
#pragma unroll
    for (int eb = 0; eb < 2; ++eb)
#pragma unroll
        for (int g = 0; g < 4; ++g) { const int e0 = 32 * eb + 8 * g + 4 * hh;
            const v2u gu = *(const v2u*)(P + orow * INW + PC_RG + head * 64 + e0);
            const float g0 = bf_lo(gu.x), g1 = bf_hi(gu.x), g2 = bf_lo(gu.y), g3 = bf_hi(gu.y);
            v2u w; w.x = pkbf(siluf(g0) * ((ot[eb][4 * g] - mu) * rstd), siluf(g1) * ((ot[eb][4 * g + 1] - mu) * rstd)); w.y = pkbf(siluf(g2) * ((ot[eb][4 * g + 2] - mu) * rstd), siluf(g3) * ((ot[eb][4 * g + 3] - mu) * rstd));
            *(v2u*)(MIX + orow * DM + 512 + head * 64 + e0) = w; }
}
__device__ __forceinline__ void pool_item(ArgP a, Frame& F, int l, int b, int tl, int g) {
    typedef short bf16x8_t __attribute__((ext_vector_type(8)));
    const bf16* P = (const bf16*)(a->ws + WS_AR + AR_P); bf16* MIX = (bf16*)(a->ws + WS_AR + AR_MIX);
    LAS bf16* msb = (LAS bf16*)F.lds;
    LAS bf16* wt = (LAS bf16*)(F.lds + 18432);
    LAS bf16* ost = (LAS bf16*)(F.lds + 18432 + 9216);
    const int sb = (tl < 2) ? 0 : CTX, T = (tl < 2) ? CTX : SEQ, hw = 1 << g  ;
    { const int d = F.tid & 63, cq = F.tid >> 6; const float* W = a->in[I_POOLW] + ((size_t)(l * 4 + g)) * 4096 + d;
        v4u o; o.x = pkbf(W[(8 * cq + 0) * 64], W[(8 * cq + 1) * 64]); o.y = pkbf(W[(8 * cq + 2) * 64], W[(8 * cq + 3) * 64]); o.z = pkbf(W[(8 * cq + 4) * 64], W[(8 * cq + 5) * 64]); o.w = pkbf(W[(8 * cq + 6) * 64], W[(8 * cq + 7) * 64]);
        *(LAS v4u*)(wt + d * 72 + 8 * cq) = o; }
    { const int p = F.tid >> 2, qd = F.tid & 3; const int t = tl * 128 - sb + p; const int lo = max(t - hw, 0), hi = min(t + hw, T);
        float acc[16];
#pragma unroll
        for (int e = 0; e < 16; ++e) acc[e] = 0.f;
        const bf16* colp = P + (size_t)(b * RB + sb) * INW + PC_PP + g * 64 + 16 * qd;
        for (int tt = lo; tt < hi; ++tt) { const v4u u0 = *(const v4u*)(colp + (size_t)tt * INW), u1 = *(const v4u*)(colp + (size_t)tt * INW + 8);
            acc[0] += bf_lo(u0.x); acc[1] += bf_hi(u0.x); acc[2] += bf_lo(u0.y); acc[3] += bf_hi(u0.y); acc[4] += bf_lo(u0.z); acc[5] += bf_hi(u0.z); acc[6] += bf_lo(u0.w); acc[7] += bf_hi(u0.w);
            acc[8] += bf_lo(u1.x); acc[9] += bf_hi(u1.x); acc[10] += bf_lo(u1.y); acc[11] += bf_hi(u1.y); acc[12] += bf_lo(u1.z); acc[13] += bf_hi(u1.z); acc[14] += bf_lo(u1.w); acc[15] += bf_hi(u1.w); }
        const v4u s0 = *(const v4u*)(colp + (size_t)t * INW), s1 = *(const v4u*)(colp + (size_t)t * INW + 8);
        const float sf[16] = {bf_lo(s0.x), bf_hi(s0.x), bf_lo(s0.y), bf_hi(s0.y), bf_lo(s0.z), bf_hi(s0.z), bf_lo(s0.w), bf_hi(s0.w), bf_lo(s1.x), bf_hi(s1.x), bf_lo(s1.y), bf_hi(s1.y), bf_lo(s1.z), bf_hi(s1.z), bf_lo(s1.w), bf_hi(s1.w)};
        const float inv = 1.0f / (float)(hi - lo);
        float m[16];
#pragma unroll
        for (int e = 0; e < 16; ++e) m[e] = acc[e] * inv - sf[e];
        v4u o0, o1; o0.x = pkbf(m[0], m[1]); o0.y = pkbf(m[2], m[3]); o0.z = pkbf(m[4], m[5]); o0.w = pkbf(m[6], m[7]); o1.x = pkbf(m[8], m[9]); o1.y = pkbf(m[10], m[11]); o1.z = pkbf(m[12], m[13]); o1.w = pkbf(m[14], m[15]);
        *(LAS v4u*)(msb + p * 72 + 16 * qd) = o0; *(LAS v4u*)(msb + p * 72 + 16 * qd + 8) = o1; }
    __syncthreads();
    { const int pi = F.wave >> 1, di = F.wave & 1, i = F.lane & 31, kk = F.lane >> 5; f32x16v o; { const float z = pg8::zero_v(); _Pragma("unroll") for (int r = 0; r < 16; ++r) o[r] = z; }
        const LAS bf16* ap = msb + (32 * pi + i) * 72 + 8 * kk; const LAS bf16* bp = wt + (32 * di + i) * 72 + 8 * kk;
#pragma unroll
        for (int s4 = 0; s4 < 4; ++s4) o = __builtin_amdgcn_mfma_f32_32x32x16_bf16(*(const LAS bf16x8_t*)(ap + 16 * s4), *(const LAS bf16x8_t*)(bp + 16 * s4), o, 0, 0, 0);
        const float scl = a->in[I_POOLS][l * 256 + g * 64 + 32 * di + i];
#pragma unroll
        for (int r = 0; r < 16; ++r) ost[(32 * pi + crow32(r, kk)) * 72 + 32 * di + i] = (bf16)(pkbf(o[r] * scl, 0.f) & 0xffffu); }
    __syncthreads();
    { bf16* obase = MIX + (size_t)(b * RB + tl * 128) * DM + 768 + g * 64;
#pragma unroll
        for (int k = 0; k < 2; ++k) { const int idx = F.tid + 512 * k, row = idx >> 3, ch = idx & 7; *(v4u*)(obase + (size_t)row * DM + 8 * ch) = *(const LAS v4u*)(ost + row * 72 + 8 * ch); } }
    __syncthreads();
}
__device__ __forceinline__ void phase_mix(ArgP a, Frame& F, int l, int vcu) {
    { int nb = 0;
      for (int it = F.bx; it < NB * NCH * 2; it += F.G) { const int hp = it & 1, r = it >> 1, c = r % NCH, b = r / NCH;
          if (l == 1 && c < 2) continue;
          ret_out_item(a, F, l, b, c, hp, nb & 1); ++nb; }
      __syncthreads(); }
    for (int it = (F.bx + F.G - 16) % F.G; it < NB * 4 * NCH; it += F.G) { const int c = it % NCH, bh = it / NCH, b = bh >> 2, hg = bh & 3;
        if (l == 1 && c < 2) continue;
        pool_item(a, F, l, b, c, hg); }
    const bf16* QBp = (const bf16*)(a->ws + WS_AR + AR_QB); const bf16* KC = (const bf16*)(a->ws + WS_AR + AR_KC); const bf16* VC = (const bf16*)(a->ws + WS_AR + AR_VC); bf16* MIX = (bf16*)(a->ws + WS_AR + AR_MIX);
    const unsigned char* Q8 = q8_ptr(a); const unsigned char* K8 = k8_ptr(a); const unsigned char* V8 = v8_ptr(a);
    const int NU = NB * 8 * (SEQ / 256);
    float mref;
    { float gq = fabsf(a->in[I_QN][l * 64 + F.lane]), gk = fabsf(a->in[I_KN][l * 64 + F.lane]);
#pragma unroll
      for (int o = 0; o < 1; ++o) { gq = fmaxf(gq, shx<1>(gq)); gk = fmaxf(gk, shx<1>(gk)); gq = fmaxf(gq, shx<2>(gq)); gk = fmaxf(gk, shx<2>(gk)); gq = fmaxf(gq, shx<4>(gq)); gk = fmaxf(gk, shx<4>(gk));
          gq = fmaxf(gq, shx<8>(gq)); gk = fmaxf(gk, shx<8>(gk)); gq = fmaxf(gq, shx<16>(gq)); gk = fmaxf(gk, shx<16>(gk)); gq = half_max(gq); gk = half_max(gk); }
      mref = fminf(64.0f * gq * gk * attn_body::C2 * 1.01f + 0.125f, 64.0f); mref = __builtin_amdgcn_readfirstlane(mref); }
    for (int i = 0; ; ++i) {
        int u;
        if (F.G == 256) { if (i >= 4) break; const int x = vcu >> 5, cu = vcu & 31; const int grp = x >> 1; u = grp * 256 + (x & 1) * 128 + cu * 4 + i; }
        else { u = F.bx + i * F.G; if (u >= NU) break; }
        const int grp = u >> 8, w = u & 255, b = grp >> 1, kvh = grp & 1, hd = kvh * 4 + (w >> 6), qb = w & 63;
        const size_t qrow = (size_t)b * RB + CTX + qb * 256;
#if ATT8_DEBUG
        attn_body::attn_unit(F.tid, mref, (const attn_body::bf16*)(QBp + qrow * 512 + hd * 64), 512, (const attn_body::bf16*)(KC + (size_t)(b * 2 + kvh) * RB * 64), (const attn_body::bf16*)(VC + (size_t)(b * 2 + kvh) * RB * 64), RB / 64,
                                (attn_body::bf16*)(MIX + qrow * DM + hd * 64), DM, (char*)F.lds);
        attn_body::attn_unit8(F.tid, mref, Q8 + qrow * 512 + hd * 64, 512, K8 + (size_t)(b * 2 + kvh) * (RB / 64) * 4096, V8 + (size_t)(b * 2 + kvh) * (RB / 64) * 4096, RB / 64,
                                (attn_body::bf16*)((bf16*)(a->ws + WS_AR + DO_O8) + qrow * 512 + hd * 64), 512, (char*)F.lds);
#else
        attn_body::attn_unit8(F.tid, mref, Q8 + qrow * 512 + hd * 64, 512, K8 + (size_t)(b * 2 + kvh) * (RB / 64) * 4096, V8 + (size_t)(b * 2 + kvh) * (RB / 64) * 4096, RB / 64,
                                (attn_body::bf16*)(MIX + qrow * DM + hd * 64), DM, (char*)F.lds);
#endif
    }
    if (l == 0) {
        for (int u = (F.bx + F.G - 32) % F.G; u < NB * 8; u += F.G) { const int b = u >> 3, hd = u & 7, kvh = hd >> 2; const size_t qrow = (size_t)b * RB;
#if ATT8_DEBUG
            attn_body::attn_unit(F.tid, mref, (const attn_body::bf16*)(QBp + qrow * 512 + hd * 64), 512, (const attn_body::bf16*)(KC + (size_t)(b * 2 + kvh) * RB * 64), (const attn_body::bf16*)(VC + (size_t)(b * 2 + kvh) * RB * 64), CTX / 64,
                                    (attn_body::bf16*)(MIX + qrow * DM + hd * 64), DM, (char*)F.lds);
            attn_body::attn_unit8(F.tid, mref, Q8 + qrow * 512 + hd * 64, 512, K8 + (size_t)(b * 2 + kvh) * (RB / 64) * 4096, V8 + (size_t)(b * 2 + kvh) * (RB / 64) * 4096, CTX / 64,
                                    (attn_body::bf16*)((bf16*)(a->ws + WS_AR + DO_O8) + qrow * 512 + hd * 64), 512, (char*)F.lds);
#else
            attn_body::attn_unit8(F.tid, mref, Q8 + qrow * 512 + hd * 64, 512, K8 + (size_t)(b * 2 + kvh) * (RB / 64) * 4096, V8 + (size_t)(b * 2 + kvh) * (RB / 64) * 4096, CTX / 64,
                                    (attn_body::bf16*)(MIX + qrow * DM + hd * 64), DM, (char*)F.lds);
#endif
        }
    }
}
struct PlainSched {
    int nM, nN, G, c, skipctx; const char* A; const char* B; size_t tA, tB;
    __device__ __forceinline__ bool next(int i, pg8::Unit& u) const {
        const long L = (long)i * G + c; if (L >= (long)nM * nN) return false;
        int pm, pn; pg8::deal((int)L, nM, nN, pm, pn); if (skipctx) pm = pm + 1 + (pm >= 64 ? 1 : 0);
        u.pm = pm; u.pn = pn; u.a = A + (size_t)pm * tA; u.b = B + (size_t)pn * tB; u.goff = 0; u.gcnt = 0; return true; }
};
struct CtxSplitSched {
    int nN, nsp, G, c, KL; const char* A; const char* B; size_t tA, tB;
    __device__ __forceinline__ bool next(int i, pg8::Unit& u) const {
        const long L = (long)i * G + c; if (L >= (long)2 * nN * nsp) return false;
        const int ct = (int)L & 1, r = (int)L >> 1, pn = r % nN, ks = r / nN;
        u.pm = 2 * ks + ct; u.pn = pn; u.a = A + (size_t)(ct * 65) * tA + (size_t)ks * KL * 2; u.b = B + (size_t)pn * tB + (size_t)ks * KL * 2; u.goff = 0; u.gcnt = 0; return true; }
};
struct CtxFullSched {
    int nN, G, c; const char* A; const char* B; size_t tA, tB;
    __device__ __forceinline__ bool next(int i, pg8::Unit& u) const {
        const long L = (long)i * G + c; if (L >= (long)2 * nN) return false;
        const int ct = (int)L & 1, pn = (int)L >> 1;
        u.pm = ct * 65; u.pn = pn; u.a = A + (size_t)(ct * 65) * tA; u.b = B + (size_t)pn * tB; u.goff = 0; u.gcnt = 0; return true; }
};
struct MoeSched {
    int nM, nN, G, c, t0, up, c0; const char* A; const char* W; size_t tA, tB, wsz; int ts[9], cnt[8];
    __device__ __forceinline__ bool next(int i, pg8::Unit& u) const {
        long L = (long)i * G + c;
        if (c0 > 0) { const int w = G - c0; const long E = 3L * w; L = (c >= c0) ? ((i < 3) ? (long)i * w + (c - c0) : E + (long)(i - 3) * G + c) : E + (long)i * G + c; }
        if (L >= (long)nM * nN) return false;
        int pml, pn; pg8::deal((int)L, nM, nN, pml, pn); const int rt = t0 + pml;
        int e = 0, tse = 0, ce = cnt[0];
#pragma unroll
        for (int k = 1; k < 8; ++k) { const bool sel = (rt >= ts[k]) && (ts[k + 1] > ts[k]); e = sel ? k : e; tse = sel ? ts[k] : tse; ce = sel ? cnt[k] : ce; }
        const int lt = rt - tse;
        u.pn = pn; u.b = W + (size_t)e * wsz + (size_t)pn * tB;
        if (up) { u.pm = pml; u.a = A; u.goff = e * LISTCAP + lt * 256; const int rem = ce - lt * 256; u.gcnt = rem < 256 ? rem : 256; }
        else { u.pm = rt; u.a = A + (size_t)pml * tA; u.goff = 0; u.gcnt = 0; }
        return true; }
};

#if ATT8_DEBUG
__device__ __forceinline__ void dbg_compare(ArgP a, Frame& F, int l) {
    const bf16* MIX = (const bf16*)(a->ws + WS_AR + AR_MIX); const bf16* O8 = (const bf16*)(a->ws + WS_AR + DO_O8);
    float sd = 0.f, so = 0.f;
    for (int row = F.gw; row < NR; row += F.NGW) { const int b = row / RB, jj = row - b * RB; if (jj < CTX && l == 1) continue;
        const v4u x = *(const v4u*)(MIX + (size_t)row * DM + 8 * F.lane), y = *(const v4u*)(O8 + (size_t)row * 512 + 8 * F.lane);
        const float xv[8] = {bf_lo(x.x), bf_hi(x.x), bf_lo(x.y), bf_hi(x.y), bf_lo(x.z), bf_hi(x.z), bf_lo(x.w), bf_hi(x.w)}, yv[8] = {bf_lo(y.x), bf_hi(y.x), bf_lo(y.y), bf_hi(y.y), bf_lo(y.z), bf_hi(y.z), bf_lo(y.w), bf_hi(y.w)};
#pragma unroll
        for (int j = 0; j < 8; ++j) { const float d = yv[j] - xv[j]; sd += d * d; so += xv[j] * xv[j]; } }
    sd = wave_sum(sd); so = wave_sum(so);
    if (F.lane == 0) { atomicAdd((float*)(a->ws + WS_CTL) + 2048, sd); atomicAdd((float*)(a->ws + WS_CTL) + 2049, so); }
}
#endif
constexpr int N_PHASES_K = 22;
__global__ void __launch_bounds__(NWAVES * 64, 2) mk_fwd(Args a_unused) {
    extern __shared__ __attribute__((aligned(16))) unsigned char lds[];
    Frame F; ArgP a = args_here();
    F.lds = (LAS unsigned char*)lds;
    relaunder(F);
    unsigned* ctl = (unsigned*)(a->ws + WS_CTL);
    for (int u = F.tid; u < (LDS_BYTES - RING_BYTES) / 4; u += NWAVES * 64) ((LAS unsigned*)(F.lds + RING_BYTES))[u] = 0u;
    __syncthreads();
    volatile LAS unsigned* MISC = (volatile LAS unsigned*)(F.lds + MISC_OFF);
    XcdBarrier bar = xcd_barrier_post(ctl + CW_BAR + a->li * XCD_BAR_WORDS, MISC + 8);
    LAS unsigned* gtab = (LAS unsigned*)(F.lds + GTAB_OFF);
    const int lo = a->ph_lo, hi = a->ph_hi; int ph = 0;
#define RUN (a = args_here(), relaunder(F), (ph >= lo && ph < hi))
#ifndef PROF_MASK
#define PROF_MASK 0
#endif
#ifndef PROF_AMP
#define PROF_AMP 10
#endif
#if PROF_MASK
#define PROF_STAMP(k_) do { if (blockIdx.x == 0 && threadIdx.x == 0) ((volatile unsigned long long*)(a->ws + WS_CTL + 32768))[k_] = wall_clock64(); } while (0)
#else
#define PROF_STAMP(k_) do { } while (0)
#endif
#define SEAM() do { if (ph >= lo && ph + 1 < hi) xcd_barrier(bar); ++ph; a = args_here(); PROF_STAMP(ph); } while (0)
    unsigned char* AR = a->ws + WS_AR;
    PROF_STAMP(0);

    if (RUN) phase_p0a(a, F);
    SEAM();
    if (RUN) phase_premix0(a, F);
    SEAM();
#pragma unroll 1
    for (int l = 0; l < 2; ++l) {
        if (RUN) {
            if ((IN_I8 >> l) & 1) {
                PlainSched S{NR / 256, INW / 256, F.G, F.bx, 0, (const char*)(AR + AR_MIX), (const char*)(a->ws + WS_WIN + l * SZ_WIN), (size_t)256 * DM, (size_t)256 * DM};
                pg8::EpiBf16S E{(bf16*)(AR + AR_P), INW, 1.0f / (I8_XI * I8_WS)};
                pg8::gemm_phase<pg8::EpiBf16S, PlainSched, true, false, 2>(F.tid, F.lds, gtab, nullptr, DM / 2, DM / 2, S, E);
            } else if (IN1_F8 && l == 1) {
                PlainSched S{NR / 256, INW / 256, F.G, F.bx, 0, (const char*)(AR + AR_MIX), (const char*)(a->ws + WS_WIN + SZ_WIN), (size_t)256 * DM, (size_t)256 * DM};
                pg8::EpiBf16S E{(bf16*)(AR + AR_P), INW, 1.0f / 64.0f};
                pg8::gemm_phase<pg8::EpiBf16S, PlainSched, true, false, 1>(F.tid, F.lds, gtab, nullptr, DM / 2, DM / 2, S, E);
            } else {
            PlainSched S{NR / 256, INW / 256, F.G, F.bx, 0, (const char*)(AR + AR_MIX), (const char*)(a->ws + WS_WIN + l * SZ_WIN), (size_t)256 * DM * 2, (size_t)256 * DM * 2};
            pg8::EpiBf16 E{(bf16*)(AR + AR_P), INW};
            pg8::gemm_phase<pg8::EpiBf16, PlainSched, true, false>(F.tid, F.lds, gtab, nullptr, DM, DM, S, E); }
        }
        SEAM();
        if (RUN) phase_prep(a, F, l);
        SEAM();
        if (RUN) phase_scan(a, F, l);
        SEAM();
        if (RUN) phase_mix(a, F, l, (F.G % 8 == 0) ? (F.bx % 8) * (F.G / 8) + (F.bx / 8) : F.bx);
        SEAM();
        if (RUN) {
#if ATT8_DEBUG
            dbg_compare(a, F, l);
#endif
            PlainSched S{NLAT / 256, DM / 256, F.G, F.bx, 1, (const char*)(AR + AR_MIX), (const char*)(a->ws + WS_WOUT + l * SZ_WOUT), (size_t)256 * DM * 2, (size_t)256 * DM * 2};
            pg8::EpiBf16 E{(bf16*)(AR + AR_MX), DM};
            pg8::gemm_phase<pg8::EpiBf16, PlainSched, true, false>(F.tid, F.lds, gtab, nullptr, DM, DM, S, E);
            if (l == 0) {
                CtxSplitSched S2{DM / 256, 4, F.G, F.bx, 256, (const char*)(AR + AR_MIX), (const char*)(a->ws + WS_WOUT), (size_t)256 * DM * 2, (size_t)256 * DM * 2};
                pg8::EpiF32 E2{(float*)(AR + AR_PART0), DM};
                pg8::gemm_phase<pg8::EpiF32, CtxSplitSched, true, false>(F.tid, F.lds, gtab, nullptr, DM, 256, S2, E2); }
        }
        SEAM();
        if (l == 0) {
            if (RUN) phase_resid<0>(a, F);
            SEAM();
            if (RUN) {
#if DENSE_F8
                PlainSched S{NR / 256, 2 * FF / 256, F.G, F.bx, 0, (const char*)(AR + AR_HX2), (const char*)(a->ws + WS_W13D), (size_t)256 * DM, (size_t)256 * DM};
                pg8::EpiSwiglu8 E{(unsigned char*)(AR + AR_ACT), FF, 1.0f / 64.0f, 8.0f};
                pg8::gemm_phase<pg8::EpiSwiglu8, PlainSched, true, false, 1>(F.tid, F.lds, gtab, nullptr, DM / 2, DM / 2, S, E);
#elif DENSE_I8UP
                PlainSched S{NR / 256, 2 * FF / 256, F.G, F.bx, 0, (const char*)(AR + AR_HX2), (const char*)(a->ws + WS_W13D), (size_t)256 * DM, (size_t)256 * DM};
#if DENSE_DOWN_F8
                pg8::EpiSwiglu8 E{(unsigned char*)(AR + AR_ACT), FF, 1.0f / (I8_XS * I8_WS), 8.0f};
                pg8::gemm_phase<pg8::EpiSwiglu8, PlainSched, true, false, 2>(F.tid, F.lds, gtab, nullptr, DM / 2, DM / 2, S, E);
#else
                pg8::EpiSwigluS E{(bf16*)(AR + AR_ACT), FF, 1.0f / (I8_XS * I8_WS)};
                pg8::gemm_phase<pg8::EpiSwigluS, PlainSched, true, false, 2>(F.tid, F.lds, gtab, nullptr, DM / 2, DM / 2, S, E);
#endif
#else
                PlainSched S{NR / 256, 2 * FF / 256, F.G, F.bx, 0, (const char*)(AR + AR_HX2), (const char*)(a->ws + WS_W13D), (size_t)256 * DM * 2, (size_t)256 * DM * 2};
                pg8::EpiSwiglu E{(bf16*)(AR + AR_ACT), FF};
                pg8::gemm_phase<pg8::EpiSwiglu, PlainSched, true, false>(F.tid, F.lds, gtab, nullptr, DM, DM, S, E);
#endif
            }
            SEAM();
            if (RUN) {
#if DENSE_F8 || DENSE_DOWN_F8
                PlainSched S{NLAT / 256, DM / 256, F.G, F.bx, 1, (const char*)(AR + AR_ACT), (const char*)(a->ws + WS_W2D), (size_t)256 * FF, (size_t)256 * FF};
                pg8::EpiBf16S E{(bf16*)(AR + AR_YD), DM, 1.0f / 512.0f};
                pg8::gemm_phase<pg8::EpiBf16S, PlainSched, true, false, 1>(F.tid, F.lds, gtab, nullptr, FF / 2, FF / 2, S, E);
#if DENSE_DOWN_F8 && !DENSE_F8
                CtxFullSched S2{DM / 256, F.G, F.bx, (const char*)(AR + AR_ACT), (const char*)(a->ws + WS_W2D), (size_t)256 * FF, (size_t)256 * FF};
                pg8::gemm_phase<pg8::EpiBf16S, CtxFullSched, true, false, 1>(F.tid, F.lds, gtab, nullptr, FF / 2, FF / 2, S2, E);
#else
                CtxSplitSched S2{DM / 256, 11, F.G, F.bx, 128, (const char*)(AR + AR_ACT), (const char*)(a->ws + WS_W2D), (size_t)256 * FF, (size_t)256 * FF};
                pg8::EpiF32S E2{(float*)(AR + AR_PART1), DM, 1.0f / 512.0f};
                pg8::gemm_phase<pg8::EpiF32S, CtxSplitSched, true, false, 1>(F.tid, F.lds, gtab, nullptr, FF / 2, 128, S2, E2);
#endif
#else
                PlainSched S{NLAT / 256, DM / 256, F.G, F.bx, 1, (const char*)(AR + AR_ACT), (const char*)(a->ws + WS_W2D), (size_t)256 * FF * 2, (size_t)256 * FF * 2};
                pg8::EpiBf16 E{(bf16*)(AR + AR_YD), DM};
                pg8::gemm_phase<pg8::EpiBf16, PlainSched, true, false>(F.tid, F.lds, gtab, nullptr, FF, FF, S, E);
                CtxSplitSched S2{DM / 256, 11, F.G, F.bx, 256, (const char*)(AR + AR_ACT), (const char*)(a->ws + WS_W2D), (size_t)256 * FF * 2, (size_t)256 * FF * 2};
                pg8::EpiF32 E2{(float*)(AR + AR_PART1), DM};
                pg8::gemm_phase<pg8::EpiF32, CtxSplitSched, true, false>(F.tid, F.lds, gtab, nullptr, FF, 256, S2, E2);
#endif
            }
            SEAM();
            if (RUN) phase_resid<1>(a, F);
            SEAM();
        } else {
            if (RUN) phase_resid<2>(a, F);
            SEAM();
#pragma unroll 1
            for (int p = 0; p <= MOE_PASSES; ++p) {
                if (RUN) {
                    constexpr size_t ACTB = (size_t)MOE_TP * 256 * FF;
                    int nprev = 0;
                    if (p >= 1) {
                        MoeSched S; moe_prefix(a->ws, S.ts, S.cnt);
                        const int tot = S.ts[8]; int n = tot - (p - 1) * MOE_TP; n = n < 0 ? 0 : (n > MOE_TP ? MOE_TP : n); nprev = n;
                        S.nM = n; S.nN = DM / 256; S.G = F.G; S.c = F.bx; S.t0 = (p - 1) * MOE_TP; S.up = 0; S.c0 = 0; S.A = (const char*)(AR + AR_ACT + ((p - 1) & 1) * ACTB); S.W = (const char*)(a->ws + WS_W2M); S.tA = (size_t)256 * FF; S.tB = (size_t)256 * FF; S.wsz = SZ8_W2;
                        pg8::EpiBf16S E{(bf16*)(AR + AR_YM), DM, 1.0f / 512.0f};
                        pg8::gemm_phase<pg8::EpiBf16S, MoeSched, true, false, 1>(F.tid, F.lds, gtab, nullptr, FF / 2, FF / 2, S, E);
                    }
                    if (p < MOE_PASSES) {
                        a = args_here(); relaunder(F);
                        MoeSched S; moe_prefix(a->ws, S.ts, S.cnt);
                        const int tot = S.ts[8]; int n = tot - p * MOE_TP; n = n < 0 ? 0 : (n > MOE_TP ? MOE_TP : n);
                        S.nM = n; S.nN = 2 * FF / 256; S.G = F.G; S.c = F.bx; S.t0 = p * MOE_TP; S.up = 1; S.A = (const char*)(AR + AR_HX2); S.W = (const char*)(a->ws + WS_W13M); S.tA = 0; S.tB = (size_t)256 * DM; S.wsz = SZ8_W13;
                        { const int nd = nprev * (DM / 256), r = nd % F.G; S.c0 = (r != 0 && 3L * (F.G - r) <= (long)n * S.nN) ? r : 0; }
                        pg8::EpiSwiglu8 E{(unsigned char*)(AR + AR_ACT + (p & 1) * ACTB), FF, MOE_I8UP ? 1.0f / (I8_XS * I8_WS) : 1.0f / 64.0f, 8.0f};
                        pg8::gemm_phase<pg8::EpiSwiglu8, MoeSched, true, true, MOE_I8UP ? 2 : 1>(F.tid, F.lds, gtab, (const int*)(a->ws + WS_LIST), DM / 2, DM / 2, S, E);
                    }
                }
                SEAM();
            }
            if (RUN) phase_resid<3>(a, F);
            ++ph;
        }
    }
#if PROF_MASK
    a = args_here(); relaunder(F);
    if (F.bx == 0 && F.tid == 0) {
        PROF_STAMP(N_PHASES_K);
        const volatile unsigned long long* ts = (const volatile unsigned long long*)(a->ws + WS_CTL + 32768); long long sum = 0;
        for (int k = 0; k < N_PHASES_K; ++k) if ((PROF_MASK >> k) & 1) sum += (long long)(ts[k + 1] - ts[k]);
        const long long ticks = sum * PROF_AMP; const long long t0 = wall_clock64();
        while (wall_clock64() - t0 < ticks) __builtin_amdgcn_s_sleep(32);
    }
#endif
#if ATT8_DEBUG
    a = args_here(); relaunder(F);
    if (F.bx == 0 && F.tid == 0) {
        const float sd = __hip_atomic_load((float*)(a->ws + WS_CTL) + 2048, RLX_AGENT), so = __hip_atomic_load((float*)(a->ws + WS_CTL) + 2049, RLX_AGENT);
        float nl = -__log2f(sd / so); if (!(nl > 0.f)) nl = 0.f; if (nl > 40.f) nl = 40.f;
        const long long ticks = (long long)(nl * 200000.f); const long long t0 = wall_clock64();
        while (wall_clock64() - t0 < ticks) __builtin_amdgcn_s_sleep(32);
    }
#endif
#undef RUN
#undef SEAM
}
constexpr int N_PHASES = 22;

#ifndef DET_PROBE
#define DET_PROBE 0
#endif
#if DET_PROBE
__global__ void det_cksum(const unsigned* out, unsigned long long* dst, int n) {
    unsigned long long s = 0; for (int i = blockIdx.x * blockDim.x + threadIdx.x; i < n; i += gridDim.x * blockDim.x) s += (unsigned long long)out[i] * (unsigned)(2 * (i & 1023) + 1);
    for (int o = 32; o > 0; o >>= 1) s += __shfl_xor(s, o);
    if ((threadIdx.x & 63) == 0) atomicAdd(dst, s);
}
__global__ void det_fill(unsigned* p, size_t n, unsigned v) { for (size_t i = (size_t)blockIdx.x * blockDim.x + threadIdx.x; i < n; i += (size_t)gridDim.x * blockDim.x) p[i] = v; }
__global__ void det_cmp(const unsigned long long* c, float* out) { if (c[0] != c[1]) out[0] = __builtin_nanf(""); }
#endif
#ifndef MK_N_LAUNCHES
#define MK_N_LAUNCHES 1
#endif
extern "C" void kernel_launch(void* const* d_in, const int* in_sizes, int n_in, void* d_out, int out_size, void* d_ws, size_t ws_size, hipStream_t stream) {
    static int grid = 0;
    if (grid == 0) {
        if (n_in != 24 || out_size != NLAT * DM || ws_size < WS_END) { fprintf(stderr, "kernel_launch: unexpected shapes (n_in %d out %d ws %zu)\n", n_in, out_size, ws_size); grid = -1; return; }
        int dev = 0, cus = 0, per_cu = 0;
        if (hipGetDevice(&dev) != hipSuccess || hipDeviceGetAttribute(&cus, hipDeviceAttributeMultiprocessorCount, dev) != hipSuccess) { grid = -1; return; }
        if (hipFuncSetAttribute((const void*)mk_fwd, hipFuncAttributeMaxDynamicSharedMemorySize, LDS_BYTES) != hipSuccess) { fprintf(stderr, "kernel_launch: hipFuncSetAttribute failed\n"); grid = -1; return; }
        if (hipOccupancyMaxActiveBlocksPerMultiprocessor(&per_cu, (const void*)mk_fwd, NWAVES * 64, LDS_BYTES) != hipSuccess || per_cu < 1) fprintf(stderr, "kernel_launch: occupancy query says %d\n", per_cu);
        (void)hipGetLastError();
        grid = cus;
        while (grid > 8 && (NLAT % (2 * grid * NWAVES) != 0 || NLAT / (grid * NWAVES) > 64)) --grid;
    }
    if (grid < 0) return;
    if (hipMemsetAsync((char*)d_ws + WS_CTL, 0, CTL_ZERO_BYTES, stream) != hipSuccess) return;
    Args a{};
    for (int i = 0; i < 24; ++i) a.in[i] = (const float*)d_in[i];
    a.out = (float*)d_out; a.ws = (unsigned char*)d_ws; a.pad = 0;
#if DET_PROBE
    { a.ph_lo = 0; a.ph_hi = N_PHASES; a.li = 0;
      unsigned long long* ck = (unsigned long long*)((char*)d_ws + WS_CTL + 65536);
      hipLaunchKernelGGL(det_fill, dim3(2048), dim3(256), 0, stream, (unsigned*)((char*)d_ws + MiB), (WS_END - MiB) / 4, 0x3C3C3C3Cu);
      hipLaunchKernelGGL(mk_fwd, dim3(grid), dim3(NWAVES * 64), LDS_BYTES, stream, a);
      hipLaunchKernelGGL(det_cksum, dim3(1024), dim3(256), 0, stream, (const unsigned*)d_out, ck, out_size);
      if (hipMemsetAsync((char*)d_ws + WS_CTL, 0, 65536, stream) != hipSuccess) return;
      hipLaunchKernelGGL(det_fill, dim3(2048), dim3(256), 0, stream, (unsigned*)((char*)d_ws + MiB), (WS_END - MiB) / 4, 0xBDBDBDBDu);
      hipLaunchKernelGGL(det_fill, dim3(2048), dim3(256), 0, stream, (unsigned*)d_out, (size_t)out_size, 0xBDBDBDBDu);
      hipLaunchKernelGGL(mk_fwd, dim3(grid), dim3(NWAVES * 64), LDS_BYTES, stream, a);
      hipLaunchKernelGGL(det_cksum, dim3(1024), dim3(256), 0, stream, (const unsigned*)d_out, ck + 1, out_size);
      hipLaunchKernelGGL(det_cmp, dim3(1), dim3(1), 0, stream, (const unsigned long long*)ck, (float*)d_out);
      return; }
#endif
    if (MK_N_LAUNCHES == 1) { a.ph_lo = 0; a.ph_hi = N_PHASES; a.li = 0; hipLaunchKernelGGL(mk_fwd, dim3(grid), dim3(NWAVES * 64), LDS_BYTES, stream, a); }
    else { for (int p = 0; p < N_PHASES; ++p) { a.ph_lo = p; a.ph_hi = p + 1; a.li = p; hipLaunchKernelGGL(mk_fwd, dim3(grid), dim3(NWAVES * 64), LDS_BYTES, stream, a); } }
}
```

```cpp
#include <hip/hip_runtime.h>
#include <hip/hip_bf16.h>
#include <cstdio>
#include <cstdint>
#include <cmath>
namespace pg8 {
#define PG8_LAS __attribute__((address_space(3)))
typedef unsigned short bf16_t;
typedef short bf16x8 __attribute__((ext_vector_type(8)));
typedef float f32x4 __attribute__((ext_vector_type(4)));
typedef unsigned u32x4 __attribute__((ext_vector_type(4)));
typedef int i32x4_t __attribute__((ext_vector_type(4)));
typedef int i32x8_t __attribute__((ext_vector_type(8)));
typedef int i32x8_t __attribute__((ext_vector_type(8)));
constexpr int BM = 256, BK = 64, HALF = 128, HTB = HALF * BK * 2  , STAGE_BYTES = 8 * HTB, NXCD = 8, WGM = 8;

__host__ __device__ __forceinline__ int lds_byte(int r, int c) { const int st = (r >> 4) * 2 + (c >> 5), rr = r & 15, cc = c & 31, ob = rr * 64 + cc * 2; return st * 1024 + (ob ^ (((ob >> 9) & 1) << 5)); }
__host__ __device__ __forceinline__ void stage_rc(int b, int& R, int& C) { const int st = b / 1024, sb = b % 1024, swz = sb ^ (((sb >> 9) & 1) << 5); R = (st >> 1) * 16 + swz / 64; C = (st & 1) * 32 + (swz % 64) / 2; }
__host__ __device__ __forceinline__ int perm32(int rho) { const int n = rho >> 4, i = rho & 15; return 8 * (i >> 2) + 4 * n + (i & 3); }

struct Unit { int pm, pn; const char* a; const char* b; int goff, gcnt; };

__device__ __forceinline__ void deal(int L, int nM, int nN, int& pm, int& pn) {
    const int nwg = nM * nN; int wgid = L;
    { const int q = nwg / NXCD, r = nwg % NXCD, xcd = wgid % NXCD, off = wgid / NXCD; wgid = (xcd < r ? xcd * (q + 1) : r * (q + 1) + (xcd - r) * q) + off; }
    const int nig = WGM * nN, gid = wgid / nig, fm = gid * WGM, gsz = (nM - fm) < WGM ? (nM - fm) : WGM;
    pm = fm + ((wgid % nig) % gsz); pn = (wgid % nig) / gsz;
}

__device__ __forceinline__ float zero_v() { float z; asm volatile("v_mov_b32 %0, 0" : "=v"(z)); return z; }
__device__ __forceinline__ unsigned cvt_pk_bf16(float lo, float hi) { unsigned r; asm volatile("v_cvt_pk_bf16_f32 %0, %1, %2" : "=v"(r) : "v"(lo), "v"(hi)); return r; }

struct EpiBf16 {
    static constexpr bool PERM = true;
    bf16_t* O; int ldc;
    __device__ __forceinline__ void operator()(const f32x4 (&acc)[2][2][4][2], const Unit& u, int wr, int wc, int fr, int fq) const {
        const int row0 = u.pm * BM + wr * 64 + fr; const int col0 = u.pn * BM + wc * 32 + 8 * fq;
#pragma unroll
        for (int ai = 0; ai < 2; ++ai)
#pragma unroll
            for (int m = 0; m < 4; ++m) { bf16_t* rowp = O + (size_t)(row0 + ai * HALF + m * 16) * ldc + col0;
#pragma unroll
                for (int bj = 0; bj < 2; ++bj) { const f32x4 v0 = acc[ai][bj][m][0], v1 = acc[ai][bj][m][1];
                    u32x4 w; w.x = cvt_pk_bf16(v0[0], v0[1]); w.y = cvt_pk_bf16(v0[2], v0[3]); w.z = cvt_pk_bf16(v1[0], v1[1]); w.w = cvt_pk_bf16(v1[2], v1[3]);
                    *(u32x4*)(rowp + bj * HALF) = w; } }
    }
};
struct EpiF32 {
    static constexpr bool PERM = false;
    float* O; int ldc;
    __device__ __forceinline__ void operator()(const f32x4 (&acc)[2][2][4][2], const Unit& u, int wr, int wc, int fr, int fq) const {
        const int row0 = u.pm * BM + wr * 64 + fr; const int col0 = u.pn * BM + wc * 32 + 4 * fq;
#pragma unroll
        for (int ai = 0; ai < 2; ++ai)
#pragma unroll
            for (int m = 0; m < 4; ++m) { float* rowp = O + (size_t)(row0 + ai * HALF + m * 16) * ldc + col0;
#pragma unroll
                for (int bj = 0; bj < 2; ++bj)
#pragma unroll
                    for (int n = 0; n < 2; ++n) *(f32x4*)(rowp + bj * HALF + n * 16) = acc[ai][bj][m][n]; }
    }
};
__device__ __forceinline__ float silu_f(float x) { return x * __builtin_amdgcn_rcpf(1.0f + __builtin_amdgcn_exp2f(-1.4426950408889634f * x)); }
struct EpiSwiglu {
    static constexpr bool PERM = true;
    bf16_t* O; int ldc;
    __device__ __forceinline__ void operator()(const f32x4 (&acc)[2][2][4][2], const Unit& u, int wr, int wc, int fr, int fq) const {
        const int row0 = u.pm * BM + wr * 64 + fr; const int col0 = u.pn * HALF + wc * 32 + 8 * fq;
#pragma unroll
        for (int ai = 0; ai < 2; ++ai)
#pragma unroll
            for (int m = 0; m < 4; ++m) { bf16_t* rowp = O + (size_t)(row0 + ai * HALF + m * 16) * ldc + col0;
                const f32x4 a0 = acc[ai][0][m][0], a1 = acc[ai][0][m][1], g0 = acc[ai][1][m][0], g1 = acc[ai][1][m][1];
                u32x4 w; w.x = cvt_pk_bf16(silu_f(a0[0]) * g0[0], silu_f(a0[1]) * g0[1]); w.y = cvt_pk_bf16(silu_f(a0[2]) * g0[2], silu_f(a0[3]) * g0[3]);
                w.z = cvt_pk_bf16(silu_f(a1[0]) * g1[0], silu_f(a1[1]) * g1[1]); w.w = cvt_pk_bf16(silu_f(a1[2]) * g1[2], silu_f(a1[3]) * g1[3]);
                *(u32x4*)rowp = w; }
    }
};

struct EpiBf16S {
    static constexpr bool PERM = true;
    bf16_t* O; int ldc; float scl;
    __device__ __forceinline__ void operator()(const f32x4 (&acc)[2][2][4][2], const Unit& u, int wr, int wc, int fr, int fq) const {
        const int row0 = u.pm * BM + wr * 64 + fr; const int col0 = u.pn * BM + wc * 32 + 8 * fq;
#pragma unroll
        for (int ai = 0; ai < 2; ++ai)
#pragma unroll
            for (int m = 0; m < 4; ++m) { bf16_t* rowp = O + (size_t)(row0 + ai * HALF + m * 16) * ldc + col0;
#pragma unroll
                for (int bj = 0; bj < 2; ++bj) { const f32x4 v0 = acc[ai][bj][m][0] * scl, v1 = acc[ai][bj][m][1] * scl;
                    u32x4 w; w.x = cvt_pk_bf16(v0[0], v0[1]); w.y = cvt_pk_bf16(v0[2], v0[3]); w.z = cvt_pk_bf16(v1[0], v1[1]); w.w = cvt_pk_bf16(v1[2], v1[3]);
                    *(u32x4*)(rowp + bj * HALF) = w; } }
    }
};
struct EpiF32S {
    static constexpr bool PERM = false;
    float* O; int ldc; float scl;
    __device__ __forceinline__ void operator()(const f32x4 (&acc)[2][2][4][2], const Unit& u, int wr, int wc, int fr, int fq) const {
        const int row0 = u.pm * BM + wr * 64 + fr; const int col0 = u.pn * BM + wc * 32 + 4 * fq;
#pragma unroll
        for (int ai = 0; ai < 2; ++ai)
#pragma unroll
            for (int m = 0; m < 4; ++m) { float* rowp = O + (size_t)(row0 + ai * HALF + m * 16) * ldc + col0;
#pragma unroll
                for (int bj = 0; bj < 2; ++bj)
#pragma unroll
                    for (int n = 0; n < 2; ++n) *(f32x4*)(rowp + bj * HALF + n * 16) = acc[ai][bj][m][n] * scl; }
    }
};
__device__ __forceinline__ unsigned cvt_fp8x4(float a, float b, float c, float d) { int w = 0; w = __builtin_amdgcn_cvt_pk_fp8_f32(a, b, w, false); w = __builtin_amdgcn_cvt_pk_fp8_f32(c, d, w, true); return (unsigned)w; }
struct EpiSwigluS {
    static constexpr bool PERM = true;
    bf16_t* O; int ldc; float si;
    __device__ __forceinline__ void operator()(const f32x4 (&acc)[2][2][4][2], const Unit& u, int wr, int wc, int fr, int fq) const {
        const int row0 = u.pm * BM + wr * 64 + fr; const int col0 = u.pn * HALF + wc * 32 + 8 * fq;
#pragma unroll
        for (int ai = 0; ai < 2; ++ai)
#pragma unroll
            for (int m = 0; m < 4; ++m) { bf16_t* rowp = O + (size_t)(row0 + ai * HALF + m * 16) * ldc + col0;
                const f32x4 a0 = acc[ai][0][m][0] * si, a1 = acc[ai][0][m][1] * si, g0 = acc[ai][1][m][0] * si, g1 = acc[ai][1][m][1] * si;
                u32x4 w; w.x = cvt_pk_bf16(silu_f(a0[0]) * g0[0], silu_f(a0[1]) * g0[1]); w.y = cvt_pk_bf16(silu_f(a0[2]) * g0[2], silu_f(a0[3]) * g0[3]);
                w.z = cvt_pk_bf16(silu_f(a1[0]) * g1[0], silu_f(a1[1]) * g1[1]); w.w = cvt_pk_bf16(silu_f(a1[2]) * g1[2], silu_f(a1[3]) * g1[3]);
                *(u32x4*)rowp = w; }
    }
};
struct EpiSwiglu8 {
    static constexpr bool PERM = true;
    unsigned char* O; int ldc; float si, so;
    __device__ __forceinline__ f32x4 sw4(const f32x4 a, const f32x4 g, const float c1, const float k2) const {
        const f32x4 t = a * c1; f32x4 e; e[0] = __builtin_amdgcn_exp2f(t[0]); e[1] = __builtin_amdgcn_exp2f(t[1]); e[2] = __builtin_amdgcn_exp2f(t[2]); e[3] = __builtin_amdgcn_exp2f(t[3]);
        const f32x4 d = e + 1.0f; f32x4 r; r[0] = __builtin_amdgcn_rcpf(d[0]); r[1] = __builtin_amdgcn_rcpf(d[1]); r[2] = __builtin_amdgcn_rcpf(d[2]); r[3] = __builtin_amdgcn_rcpf(d[3]);
        return ((a * g) * k2) * r; }
    __device__ __forceinline__ void operator()(const f32x4 (&acc)[2][2][4][2], const Unit& u, int wr, int wc, int fr, int fq) const {
        const int row0 = u.pm * BM + wr * 64 + fr; const int col0 = u.pn * HALF + wc * 32 + 8 * fq; const float c1 = -1.4426950408889634f * si, k2 = si * si * so;
#pragma unroll
        for (int ai = 0; ai < 2; ++ai)
#pragma unroll
            for (int m = 0; m < 4; ++m) { unsigned char* rowp = O + (size_t)(row0 + ai * HALF + m * 16) * ldc + col0;
                const f32x4 o0 = sw4(acc[ai][0][m][0], acc[ai][1][m][0], c1, k2), o1 = sw4(acc[ai][0][m][1], acc[ai][1][m][1], c1, k2);
                const unsigned w0 = cvt_fp8x4(o0[0], o0[1], o0[2], o0[3]), w1 = cvt_fp8x4(o1[0], o1[1], o1[2], o1[3]);
                typedef unsigned u32x2_t __attribute__((ext_vector_type(2)));
                *(u32x2_t*)rowp = (u32x2_t){w0, w1}; }
    }
};

template <class Epi, class Sched, bool ALIGN_EPI, bool GATHER, int F8 = 0  >
__device__ __forceinline__ void gemm_phase(const int tid, PG8_LAS unsigned char* lds, PG8_LAS unsigned* gtab, const int* glist, const int K  , const int KL  , const Sched& S, const Epi& E) {
    const int wid = __builtin_amdgcn_readfirstlane(tid >> 6), lane = tid & 63, wr = wid >> 2, wc = wid & 3, fr = lane & 15, fq = lane >> 4;
    const int nt = KL / BK;
    unsigned voffA[2], voffB[2]; int RA[2], CA[2];
#pragma unroll
    for (int i = 0; i < 2; ++i) { int R, C; stage_rc(tid * 16 + i * 8192, R, C); const int Rb = Epi::PERM ? ((R & ~31) + perm32(R & 31)) : R;
        voffA[i] = (unsigned)(R * K + C) * 2u; voffB[i] = (unsigned)(Rb * K + C) * 2u; RA[i] = R; CA[i] = C; }
    const size_t kstep = (size_t)(BK * 2);
    const size_t hstep = (size_t)HALF * K * 2;
    const unsigned ldsw = (unsigned)wid * 1024u;
    const int aoff = lds_byte(wr * 64 + fr, fq * 8), boff = lds_byte(wc * 32 + fr, fq * 8);
    unsigned vc[2][2], vn[2][2], v2[2][2];
#define PG8_SA(b, h) (((b) * 2 + (h)) * HTB)
#define PG8_SB(b, h) ((4 + (b) * 2 + (h)) * HTB)
#define PG8_STAGE(bufoff, gbase, voff) do { _Pragma("unroll") for (int _i = 0; _i < 2; ++_i) \
        __builtin_amdgcn_global_load_lds((const unsigned*)((const char*)(gbase) + (voff)[_i]), (PG8_LAS unsigned*)(lds + (bufoff) + ldsw + _i * 8192), 16, 0, 0); } while (0)
#define PG8_STAGE_A(bufoff, gbase, h, VG) do { if constexpr (GATHER) { PG8_STAGE(bufoff, gbase, VG[h]); } else { PG8_STAGE(bufoff, (gbase) + (h) * hstep, voffA); } } while (0)
#define PG8_LDA(dst, b, h) do { _Pragma("unroll") for (int m = 0; m < 4; ++m) _Pragma("unroll") for (int k = 0; k < 2; ++k) dst[m][k] = *(const PG8_LAS bf16x8*)(lds + PG8_SA(b, h) + aoff + m * 2048 + k * 1024); } while (0)
#define PG8_LDB(dst, b, h) do { _Pragma("unroll") for (int n = 0; n < 2; ++n) _Pragma("unroll") for (int k = 0; k < 2; ++k) dst[n][k] = *(const PG8_LAS bf16x8*)(lds + PG8_SB(b, h) + boff + n * 2048 + k * 1024); } while (0)
#define PG8_CAT(x) __builtin_shufflevector(__builtin_bit_cast(i32x4_t, x[0]), __builtin_bit_cast(i32x4_t, x[1]), 0, 1, 2, 3, 4, 5, 6, 7)
#define PG8_MMA(ai, bj, At, Bt) do { __builtin_amdgcn_s_setprio(1); \
        if constexpr (F8 == 2) { _Pragma("unroll") for (int m = 0; m < 4; ++m) _Pragma("unroll") for (int n = 0; n < 2; ++n) _Pragma("unroll") for (int k = 0; k < 2; ++k) \
            asm volatile("v_mfma_i32_16x16x64_i8 %0, %1, %2, %0" : "+v"(acc[ai][bj][m][n]) : "v"(Bt[n][k]), "v"(At[m][k])); } \
        else if constexpr (F8 == 1) { _Pragma("unroll") for (int m = 0; m < 4; ++m) _Pragma("unroll") for (int n = 0; n < 2; ++n) \
            { const i32x8_t b8_ = PG8_CAT(Bt[n]), a8_ = PG8_CAT(At[m]); asm volatile("v_mfma_f32_16x16x128_f8f6f4 %0, %1, %2, %0" : "+v"(acc[ai][bj][m][n]) : "v"(b8_), "v"(a8_)); } } \
        else { _Pragma("unroll") for (int m = 0; m < 4; ++m) _Pragma("unroll") for (int n = 0; n < 2; ++n) _Pragma("unroll") for (int k = 0; k < 2; ++k) \
            acc[ai][bj][m][n] = __builtin_amdgcn_mfma_f32_16x16x32_bf16(Bt[n][k], At[m][k], acc[ai][bj][m][n], 0, 0, 0); } __builtin_amdgcn_s_setprio(0); } while (0)
#define PG8_WAIT_V(n) asm volatile("s_waitcnt vmcnt(" #n ")" ::: "memory")
#define PG8_WAIT_L(n) asm volatile("s_waitcnt lgkmcnt(" #n ")" ::: "memory")
#define PG8_BAR __builtin_amdgcn_s_barrier()
#define PG8_SCHED __builtin_amdgcn_sched_barrier(0)
#define PG8_GT_DMA(u) do { if (wid < 4) __builtin_amdgcn_global_load_lds((const unsigned*)(glist + (u).goff + wid * 64 + lane), (PG8_LAS unsigned*)(gtab + wid * 64), 4, 0, 0); } while (0)
#define PG8_GT_READ(V, u) do { _Pragma("unroll") for (int _h = 0; _h < 2; ++_h) _Pragma("unroll") for (int _i = 0; _i < 2; ++_i) { const int _p = _h * HALF + RA[_i]; int _r = (int)gtab[_p]; _r = (_p < (u).gcnt) ? _r : 0; \
        V[_h][_i] = ((unsigned)_r * (unsigned)K + (unsigned)CA[_i]) * 2u; } } while (0)
    Unit cur, nxt; int ui = 0;
    if (!S.next(0, cur)) return;
    f32x4 acc[2][2][4][2];
    { const float z = zero_v();
#pragma unroll
    for (int a = 0; a < 2; ++a)
#pragma unroll
        for (int b = 0; b < 2; ++b)
#pragma unroll
            for (int m = 0; m < 4; ++m)
#pragma unroll
                for (int n = 0; n < 2; ++n) acc[a][b][m][n] = (f32x4){z, z, z, z}; }
    bf16x8 At[4][2], B0[2][2], B1[2][2];
    const char* cA = cur.a; const char* cB = cur.b;
    if constexpr (GATHER) { PG8_GT_DMA(cur); PG8_WAIT_V(0); PG8_BAR; PG8_GT_READ(vc, cur); PG8_WAIT_L(0); PG8_BAR; }
    if constexpr (GATHER) {
#pragma unroll
        for (int _h = 0; _h < 2; ++_h) { vn[_h][0] = vc[_h][0]; vn[_h][1] = vc[_h][1]; } }
    PG8_STAGE(PG8_SB(0, 0), cB, voffB); PG8_STAGE(PG8_SB(0, 1), cB + hstep, voffB); PG8_STAGE_A(PG8_SA(0, 0), cA, 0, vc); PG8_STAGE_A(PG8_SA(0, 1), cA, 1, vc);
    if (wr == 1) PG8_BAR;
    PG8_WAIT_V(2); PG8_BAR;
    PG8_STAGE(PG8_SB(1, 0), cB + kstep, voffB); PG8_STAGE_A(PG8_SA(1, 0), cA + kstep, 0, vc); PG8_STAGE(PG8_SB(1, 1), cB + hstep + kstep, voffB);
    PG8_WAIT_V(6); PG8_BAR;
    for (;;) {
        const bool has_next = S.next(ui + 1, nxt);
        if constexpr (GATHER) { if (has_next) PG8_GT_DMA(nxt); }
        const char* nA = has_next ? nxt.a : cA; const char* nB = has_next ? nxt.b : cB;
        for (int t = 0; t < nt; t += 2) {
            const bool last = (t == nt - 2);
            const char* a1 = cA + (size_t)(t + 1) * kstep;
            const char* a2 = last ? nA : cA + (size_t)(t + 2) * kstep; const char* b2 = last ? nB : cB + (size_t)(t + 2) * kstep;
            const char* a3 = a2 + kstep; const char* b3 = b2 + kstep;
            if constexpr (GATHER) {
                if (last) { if (has_next) { PG8_GT_READ(vn, nxt); } else {
#pragma unroll
                        for (int _h = 0; _h < 2; ++_h) { vn[_h][0] = vc[_h][0]; vn[_h][1] = vc[_h][1]; } } }
#pragma unroll
                for (int _h = 0; _h < 2; ++_h) { v2[_h][0] = last ? vn[_h][0] : vc[_h][0]; v2[_h][1] = last ? vn[_h][1] : vc[_h][1]; }
            }
            PG8_LDB(B0, 0, 0); PG8_LDB(B1, 0, 1); PG8_SCHED; PG8_LDA(At, 0, 0); PG8_STAGE_A(PG8_SA(1, 1), a1, 1, vc);
            PG8_WAIT_V(8); PG8_WAIT_L(0); PG8_BAR; PG8_MMA(0, 0, At, B0); PG8_MMA(0, 1, At, B1); PG8_BAR; PG8_SCHED;
            PG8_LDA(At, 0, 1); PG8_STAGE(PG8_SB(0, 0), b2, voffB); PG8_STAGE(PG8_SB(0, 1), b2 + hstep, voffB); PG8_STAGE_A(PG8_SA(0, 0), a2, 0, v2);
            PG8_WAIT_V(8); PG8_WAIT_L(0); PG8_BAR; PG8_MMA(1, 0, At, B0); PG8_MMA(1, 1, At, B1); PG8_BAR; PG8_SCHED;
            PG8_LDB(B0, 1, 0); PG8_LDB(B1, 1, 1); PG8_SCHED; PG8_LDA(At, 1, 0); PG8_STAGE_A(PG8_SA(0, 1), a2, 1, v2);
            PG8_WAIT_V(8); PG8_WAIT_L(0); PG8_BAR; PG8_MMA(0, 0, At, B0); PG8_MMA(0, 1, At, B1); PG8_BAR; PG8_SCHED;
            PG8_LDA(At, 1, 1); PG8_STAGE(PG8_SB(1, 0), b3, voffB); PG8_STAGE(PG8_SB(1, 1), b3 + hstep, voffB); PG8_STAGE_A(PG8_SA(1, 0), a3, 0, v2);
            PG8_WAIT_V(8); PG8_WAIT_L(0); PG8_BAR; PG8_MMA(1, 0, At, B0); PG8_MMA(1, 1, At, B1); PG8_BAR; PG8_SCHED;
        }
        if constexpr (ALIGN_EPI) { if (wr == 0) PG8_BAR; }
        if constexpr (F8 != 0) {
            asm volatile("s_nop 15\n\ts_nop 15" : "+v"(acc[1][0][0][0]), "+v"(acc[1][0][0][1]), "+v"(acc[1][0][1][0]), "+v"(acc[1][0][1][1]), "+v"(acc[1][0][2][0]), "+v"(acc[1][0][2][1]), "+v"(acc[1][0][3][0]), "+v"(acc[1][0][3][1]) :: "memory");
            asm volatile("" : "+v"(acc[1][1][0][0]), "+v"(acc[1][1][0][1]), "+v"(acc[1][1][1][0]), "+v"(acc[1][1][1][1]), "+v"(acc[1][1][2][0]), "+v"(acc[1][1][2][1]), "+v"(acc[1][1][3][0]), "+v"(acc[1][1][3][1]) :: "memory"); }
        if constexpr (F8 == 2) {
#pragma unroll
            for (int a_ = 0; a_ < 2; ++a_)
#pragma unroll
                for (int b_ = 0; b_ < 2; ++b_)
#pragma unroll
                    for (int m = 0; m < 4; ++m)
#pragma unroll
                        for (int n = 0; n < 2; ++n) { const i32x4_t iv = __builtin_bit_cast(i32x4_t, acc[a_][b_][m][n]); acc[a_][b_][m][n] = (f32x4){(float)iv[0], (float)iv[1], (float)iv[2], (float)iv[3]}; } }
        E(acc, cur, wr, wc, fr, fq);
        if (!has_next) break;
        { const float z = zero_v();
#pragma unroll
        for (int a = 0; a < 2; ++a)
#pragma unroll
            for (int b = 0; b < 2; ++b)
#pragma unroll
                for (int m = 0; m < 4; ++m)
#pragma unroll
                    for (int n = 0; n < 2; ++n) acc[a][b][m][n] = (f32x4){z, z, z, z}; }
        cur = nxt; cA = nA; cB = nB; ++ui;
        if constexpr (GATHER) {
#pragma unroll
            for (int _h = 0; _h < 2; ++_h) { vc[_h][0] = vn[_h][0]; vc[_h][1] = vn[_h][1]; } }
        if constexpr (ALIGN_EPI) { if (wr == 1) PG8_BAR; }
    }
    PG8_WAIT_V(0);
    if constexpr (!ALIGN_EPI) { if (wr == 0) PG8_BAR; }
    PG8_BAR;
#undef PG8_SA
#undef PG8_SB
#undef PG8_STAGE
#undef PG8_STAGE_A
#undef PG8_LDA
#undef PG8_LDB
#undef PG8_CAT
#undef PG8_MMA
#undef PG8_WAIT_V
#undef PG8_WAIT_L
#undef PG8_BAR
#undef PG8_SCHED
#undef PG8_GT_DMA
#undef PG8_GT_READ
}
}
namespace attn_body {
using bf16=__hip_bfloat16;
using bf16x8=__attribute__((ext_vector_type(8)))short;
using s16x4=__attribute__((ext_vector_type(4)))short;
using f32x16=__attribute__((ext_vector_type(16)))float;
using u32x4=__attribute__((ext_vector_type(4)))unsigned;
constexpr int D=64,KP=64;
constexpr int NW=8,QBLK=32,QB=QBLK*NW,KVBLK=64;
__device__ __forceinline__ int crow(int r,int hi){return (r&3)+8*(r>>2)+4*hi;}
#define SBAR() __builtin_amdgcn_sched_barrier(0)
constexpr int NSLOT=3, SLOTB=8192;
constexpr int LDS_K=0, LDS_V=NSLOT*SLOTB, LDS_WS=2*NSLOT*SLOTB, LDS_OST=LDS_WS+NW*64*4, LDS_BYTES=LDS_OST+NW*4096;
constexpr float C2=0.125f*1.4426950408889634f;
__device__ __forceinline__ void glds16(const void*gsrc,unsigned lds_dst){unsigned keep;
  asm volatile("s_mov_b32 %0, m0\n\ts_mov_b32 m0, %2\n\ts_nop 0\n\tglobal_load_lds_dwordx4 %1, off\n\ts_mov_b32 m0, %0":"=&s"(keep):"v"(gsrc),"s"(lds_dst):"memory");}
__device__ __forceinline__ float max3f(float a,float b,float c){float r;asm("v_max3_f32 %0, %1, %2, %3":"=v"(r):"v"(a),"v"(b),"v"(c));return r;}
__device__ __forceinline__ float max2f(float a,float b){float r;asm("v_max_f32_e32 %0, %1, %2":"=v"(r):"v"(a),"v"(b));return r;}
__device__ __forceinline__ float fadd_s(float a,float b){float r;asm("v_add_f32_e32 %0, %1, %2":"=v"(r):"v"(a),"v"(b));return r;}
__device__ __forceinline__ float fsub_s(float a,float b){float r;asm("v_sub_f32_e32 %0, %1, %2":"=v"(r):"v"(a),"v"(b));return r;}
typedef float f32x2_t __attribute__((ext_vector_type(2))); typedef __bf16 bf16x2_t __attribute__((ext_vector_type(2)));
__device__ __forceinline__ unsigned cvtpk_s(float lo,float hi){f32x2_t v={lo,hi};bf16x2_t b=__builtin_convertvector(v,bf16x2_t);return __builtin_bit_cast(unsigned,b);}
#define WAIT_BAR(N) asm volatile("s_waitcnt vmcnt(" #N ") lgkmcnt(0)\n\ts_barrier":::"memory")

__device__ __forceinline__ void qkt(f32x16&p0,f32x16&p1,const char*Kslot,const bf16x8*qr,const f32x16&negm,int r32,int hi){
  const char*kb=Kslot+hi*1024+r32*16;
  #pragma unroll
  for(int d0=0;d0<4;++d0){
    const bf16x8 b0=*reinterpret_cast<const bf16x8*>(kb+d0*2048);
    const bf16x8 b1=*reinterpret_cast<const bf16x8*>(kb+d0*2048+512);
    if(d0==0){p0=__builtin_amdgcn_mfma_f32_32x32x16_bf16(b0,qr[0],negm,0,0,0);p1=__builtin_amdgcn_mfma_f32_32x32x16_bf16(b1,qr[0],negm,0,0,0);}
    else{p0=__builtin_amdgcn_mfma_f32_32x32x16_bf16(b0,qr[d0],p0,0,0,0);p1=__builtin_amdgcn_mfma_f32_32x32x16_bf16(b1,qr[d0],p1,0,0,0);}}
}
typedef __attribute__((address_space(3))) const char* lds_cptr;
typedef short v4i16_t __attribute__((ext_vector_type(4)));
__device__ __forceinline__ void kload8(bf16x8*kf,lds_cptr kp){
  kf[0]=*(const __attribute__((address_space(3))) bf16x8*)(kp);      kf[1]=*(const __attribute__((address_space(3))) bf16x8*)(kp+512);
  kf[2]=*(const __attribute__((address_space(3))) bf16x8*)(kp+2048); kf[3]=*(const __attribute__((address_space(3))) bf16x8*)(kp+2560);
  kf[4]=*(const __attribute__((address_space(3))) bf16x8*)(kp+4096); kf[5]=*(const __attribute__((address_space(3))) bf16x8*)(kp+4608);
  kf[6]=*(const __attribute__((address_space(3))) bf16x8*)(kp+6144); kf[7]=*(const __attribute__((address_space(3))) bf16x8*)(kp+6656);
}
__device__ __forceinline__ void kload2(bf16x8*kf,lds_cptr kp,int j){ kf[2*j]=*(const __attribute__((address_space(3))) bf16x8*)(kp+j*2048); kf[2*j+1]=*(const __attribute__((address_space(3))) bf16x8*)(kp+j*2048+512); }
__device__ __forceinline__ s16x4 vtr(lds_cptr p){ return __builtin_bit_cast(s16x4,__builtin_amdgcn_ds_read_tr16_b64_v4i16((__attribute__((address_space(3))) v4i16_t*)p)); }
__device__ __forceinline__ float rowmax(const f32x16&p0,const f32x16&p1){
  float a=max3f(p0[0],p0[1],p1[0]),b=max3f(p0[2],p0[3],p1[1]);a=max3f(a,p1[2],p1[3]);
  #pragma unroll
  for(int r=4;r<16;r+=4){a=max3f(a,p0[r],p0[r+1]);b=max3f(b,p0[r+2],p0[r+3]);a=max3f(a,p1[r],p1[r+1]);b=max3f(b,p1[r+2],p1[r+3]);}
  const float m=max2f(a,b);
  auto rr=__builtin_amdgcn_permlane32_swap(__float_as_uint(m),__float_as_uint(m),false,false);
  return max2f(__uint_as_float(rr[0]),__uint_as_float(rr[1]));
}
__device__ __forceinline__ void pv(f32x16*o,int vb,bf16x8 pa0,bf16x8 pa1,bf16x8 pa2,bf16x8 pa3){
  #pragma unroll
  for(int d0=0;d0<2;++d0){s16x4 lo[4],hi[4];
    #pragma unroll
    for(int ks=0;ks<4;++ks){
      asm volatile("ds_read_b64_tr_b16 %0,%1 offset:%c2":"=&v"(lo[ks]):"v"(vb),"i"(d0*4096+ks*1024):"memory");
      asm volatile("ds_read_b64_tr_b16 %0,%1 offset:%c2":"=&v"(hi[ks]):"v"(vb),"i"(d0*4096+ks*1024+512):"memory");}
    asm volatile("s_waitcnt lgkmcnt(0)":::"memory");SBAR();
    #define PK(k) (bf16x8){lo[k][0],lo[k][1],lo[k][2],lo[k][3],hi[k][0],hi[k][1],hi[k][2],hi[k][3]}
    o[d0]=__builtin_amdgcn_mfma_f32_32x32x16_bf16(pa0,PK(0),o[d0],0,0,0);
    o[d0]=__builtin_amdgcn_mfma_f32_32x32x16_bf16(pa1,PK(1),o[d0],0,0,0);
    o[d0]=__builtin_amdgcn_mfma_f32_32x32x16_bf16(pa2,PK(2),o[d0],0,0,0);
    o[d0]=__builtin_amdgcn_mfma_f32_32x32x16_bf16(pa3,PK(3),o[d0],0,0,0);
    #undef PK
  }
}

__device__ __forceinline__ void attn_unit(const int tid,const float mref,const bf16*Qu,int QP,const bf16*__restrict__ Kh,const bf16*__restrict__ Vh,int NT,bf16*Ou,int OP,char*shm){
  const int lane=tid&63,r32=lane&31,hi=lane>>5; const int wid=__builtin_amdgcn_readfirstlane(tid>>6);
  const bf16*Qw=Qu+(long)(wid*QBLK)*QP;
  const unsigned lds0=(unsigned)(uintptr_t)shm;
  float*wsf=(float*)(shm+LDS_WS)+wid*64;
  const bf16*ksrc=Kh+(long)lane*KP+wid*8;
  const bf16*vsrc=Vh+(long)(16*(wid&3)+(lane>>2))*KP+(wid>>2)*32+(lane&3)*8;
  const unsigned kdst=lds0+LDS_K+wid*1024, vdst=lds0+LDS_V+wid*1024;
  #define DMA_K(t,slot) glds16(ksrc+(long)(t)*KVBLK*KP,(unsigned)__builtin_amdgcn_readfirstlane(kdst+(slot)))
  #define DMA_V(t,slot) glds16(vsrc+(long)(t)*KVBLK*KP,(unsigned)__builtin_amdgcn_readfirstlane(vdst+(slot)))
  const int vb0=(int)(lds0+LDS_V)+((lane>>4)&1)*32+(lane&3)*8+(4*hi+((lane&15)>>2))*64;
  const char*Kbase=shm+LDS_K; bf16x8 kf[8];
  const lds_cptr shm3=(lds_cptr)shm; const lds_cptr kp0=shm3+LDS_K+hi*1024+r32*16; const lds_cptr vp0=shm3+LDS_V+((lane>>4)&1)*32+(lane&3)*8+(4*hi+((lane&15)>>2))*64;
  DMA_K(0,0);DMA_V(0,0);DMA_K(1,SLOTB);
  bf16x8 qr[4];
  #pragma unroll
  for(int d0=0;d0<4;++d0)qr[d0]=*reinterpret_cast<const bf16x8*>(&Qw[(long)r32*QP+d0*16+hi*8]);
  float l_reg=0.f;f32x16 o[2],negm; { const float z=pg8::zero_v(); _Pragma("unroll") for(int r=0;r<16;++r){o[0][r]=z;o[1][r]=z;negm[r]=z-mref;} } asm volatile("":"+v"(negm));
  f32x16 pA0,pA1,pB0,pB1;
  int sl_prev=0,sl_cur=0,sl_next=SLOTB;
  #define ROT() do{sl_prev=sl_cur;sl_cur=sl_next;sl_next=(sl_next==(NSLOT-1)*SLOTB)?0:sl_next+SLOTB;}while(0)
  DMA_K(2,2*SLOTB);
  WAIT_BAR(3);
  qkt(pA0,pA1,Kbase,qr,negm,r32,hi);asm volatile("s_nop 15\n\ts_nop 7":"+v"(pA0),"+v"(pA1));
  _Pragma("unroll") for(int r=0;r<16;++r){pA0[r]=__builtin_amdgcn_exp2f(pA0[r]);pA1[r]=__builtin_amdgcn_exp2f(pA1[r]);}
  WAIT_BAR(0);
  DMA_K(3,0);DMA_V(1,SLOTB);
  ROT();
  kload8(kf,kp0+sl_cur);
  WAIT_BAR(2);
  s16x4 vlo[8],vhi[8]; u32x4 pw0,pw1,pw2,pw3;
  #define MFX(a_,b_,c_) __builtin_amdgcn_mfma_f32_32x32x16_bf16(a_,b_,c_,0,0,0)
  #define PKW(P,B) cvtpk_s(P[B],P[B+1])
  #define PAF(k) __builtin_bit_cast(bf16x8,pw##k)
  #define VFR(i) (bf16x8){vlo[i][0],vlo[i][1],vlo[i][2],vlo[i][3],vhi[i][0],vhi[i][1],vhi[i][2],vhi[i][3]}
  #define PIN(x) asm volatile("":"+v"(x))
  #define GAPA(MF,A0,A1,A2,A3,W0,W1,PW) do{ MF; sacc+=A0; sacc+=A1; sacc+=A2; sacc+=A3; PIN(sacc); W0; W1; PIN(PW); SBAR(); }while(0)
  #define EX(v) __builtin_amdgcn_exp2f(v)
  #define GAPB(MF,X,B) do{ MF; X[B]=EX(X[B]); X[B+1]=EX(X[B+1]); X[B+2]=EX(X[B+2]); X[B+3]=EX(X[B+3]); PIN(X); SBAR(); }while(0)
  #define VRD(i) do{ vlo[i]=vtr(vp_+(((i)>>2)*4096+((i)&3)*1024)); vhi[i]=vtr(vp_+(((i)>>2)*4096+((i)&3)*1024+512)); }while(0)
  #define KRD(G,j) do{ if(G){ kload2(kf,kp0+sl_next,j); SBAR(); } }while(0)
  #define STEP(C0,C1,P0,P1,t,GK,GV,GL) do{ SBAR(); \
    const lds_cptr vp_=vp0+sl_prev; \
    VRD(0); SBAR(); float sacc=(P0[0]+P0[1]); \
    GAPA(C0=MFX(kf[0],qr[0],negm), P0[2],P0[3],P0[4],P0[5],     pw0[0]=PKW(P0,0), pw0[1]=PKW(P0,2), pw0); \
    VRD(4); SBAR(); GAPA(C1=MFX(kf[1],qr[0],negm), P0[6],P0[7],P0[8],P0[9],     pw0[2]=PKW(P0,4), pw0[3]=PKW(P0,6), pw0); \
    VRD(1); SBAR(); GAPA(C0=MFX(kf[2],qr[1],C0),   P0[10],P0[11],P0[12],P0[13], pw1[0]=PKW(P0,8), pw1[1]=PKW(P0,10), pw1); \
    VRD(5); SBAR(); GAPA(C1=MFX(kf[3],qr[1],C1),   P0[14],P0[15],P1[0],P1[1],   pw1[2]=PKW(P0,12),pw1[3]=PKW(P0,14), pw1); \
    VRD(2); SBAR(); GAPA(C0=MFX(kf[4],qr[2],C0),   P1[2],P1[3],P1[4],P1[5],     pw2[0]=PKW(P1,0), pw2[1]=PKW(P1,2), pw2); \
    VRD(6); SBAR(); GAPA(C1=MFX(kf[5],qr[2],C1),   P1[6],P1[7],P1[8],P1[9],     pw2[2]=PKW(P1,4), pw2[3]=PKW(P1,6), pw2); \
    VRD(3); SBAR(); GAPA(C0=MFX(kf[6],qr[3],C0),   P1[10],P1[11],P1[12],P1[13], pw3[0]=PKW(P1,8), pw3[1]=PKW(P1,10), pw3); \
    VRD(7); SBAR(); GAPA(C1=MFX(kf[7],qr[3],C1),   P1[14],P1[15],0.f,0.f,       pw3[2]=PKW(P1,12),pw3[3]=PKW(P1,14), pw3); \
    l_reg+=sacc; \
    if(GK){DMA_K((t)+3,sl_cur);} if(GV){DMA_V((t)+1,sl_next);} \
    SBAR(); \
    GAPB(o[0]=MFX(PAF(0),VFR(0),o[0]), C0,0); \
    GAPB(o[1]=MFX(PAF(0),VFR(4),o[1]), C0,4); \
    KRD(GL,0); GAPB(o[0]=MFX(PAF(1),VFR(1),o[0]), C0,8); \
    KRD(GL,1); GAPB(o[1]=MFX(PAF(1),VFR(5),o[1]), C0,12); \
    KRD(GL,2); GAPB(o[0]=MFX(PAF(2),VFR(2),o[0]), C1,0); \
    KRD(GL,3); GAPB(o[1]=MFX(PAF(2),VFR(6),o[1]), C1,4); \
    GAPB(o[0]=MFX(PAF(3),VFR(3),o[0]), C1,8); \
    GAPB(o[1]=MFX(PAF(3),VFR(7),o[1]), C1,12); \
    }while(0)
  int t=1;
  for(;t+5<NT;t+=2){
    STEP(pB0,pB1,pA0,pA1,t,true,true,true);     WAIT_BAR(2); ROT();
    STEP(pA0,pA1,pB0,pB1,t+1,true,true,true);   WAIT_BAR(2); ROT();
  }
  #define ENDW(tt) do{ if((tt)+3<NT){WAIT_BAR(2);} else if((tt)+2<NT){WAIT_BAR(1);} else {WAIT_BAR(0);} }while(0)
  for(;t+1<NT;t+=2){
    STEP(pB0,pB1,pA0,pA1,t,(t+3<NT),(t+1<NT),(t+1<NT));       ENDW(t);   ROT();
    STEP(pA0,pA1,pB0,pB1,t+1,(t+4<NT),(t+2<NT),(t+2<NT));     ENDW(t+1); ROT();
  }
  STEP(pB0,pB1,pA0,pA1,NT-1,false,false,false);
  { float sacc=pB0[0]+pB0[1]; _Pragma("unroll") for(int r=2;r<16;++r)sacc+=pB0[r]; _Pragma("unroll") for(int r=0;r<16;++r)sacc+=pB1[r]; l_reg+=sacc;
    pw0=(u32x4){PKW(pB0,0),PKW(pB0,2),PKW(pB0,4),PKW(pB0,6)};pw1=(u32x4){PKW(pB0,8),PKW(pB0,10),PKW(pB0,12),PKW(pB0,14)};pw2=(u32x4){PKW(pB1,0),PKW(pB1,2),PKW(pB1,4),PKW(pB1,6)};pw3=(u32x4){PKW(pB1,8),PKW(pB1,10),PKW(pB1,12),PKW(pB1,14)};
    SBAR(); pv(o,vb0+sl_cur,PAF(0),PAF(1),PAF(2),PAF(3)); }
  #undef PKW
  #undef PAF
  #undef VFR
  #undef PIN
  #undef GAPA
  #undef GAPB
  #undef EX
  #undef VRD
  #undef KRD
  #undef STEP
  #undef MFX
  #undef ENDW
  {auto rr=__builtin_amdgcn_permlane32_swap(__float_as_uint(l_reg),__float_as_uint(l_reg),false,false);l_reg=__uint_as_float(rr[0])+__uint_as_float(rr[1]);}
  if(hi==0)wsf[32+r32]=l_reg;asm volatile("s_waitcnt lgkmcnt(0)":::"memory");
  float rli[16];
  #pragma unroll
  for(int r=0;r<16;++r)rli[r]=__builtin_amdgcn_rcpf(wsf[32+crow(r,hi)]);
  bf16*Ow=Ou+(long)(wid*QBLK)*OP;
  { bf16*stg=(bf16*)(shm+LDS_OST)+wid*2048;
    #pragma unroll
    for(int r=0;r<16;++r){const int orow=crow(r,hi);
      #pragma unroll
      for(int d0=0;d0<2;++d0)stg[orow*64+d0*32+r32]=__float2bfloat16(o[d0][r]*rli[r]);}
    asm volatile("s_waitcnt lgkmcnt(0)":::"memory");
    #pragma unroll
    for(int i=0;i<4;++i){const int row=i*8+(lane>>3),ch=lane&7; const u32x4 v=*(const u32x4*)(stg+row*64+ch*8); *(u32x4*)(Ow+(long)row*OP+ch*8)=v;} }
  asm volatile("s_waitcnt lgkmcnt(0)\n\ts_barrier":::"memory");
  #undef DMA_K
  #undef DMA_V
  #undef ROT
}

typedef int v8i __attribute__((ext_vector_type(8)));
typedef int v4i __attribute__((ext_vector_type(4)));
typedef unsigned v2u_t __attribute__((ext_vector_type(2)));
constexpr int F8_SLOTB=4096, F8_LDS_K=0, F8_LDS_V=3*F8_SLOTB, F8_LDS_WS=6*F8_SLOTB, F8_OSTP=144, F8_LDS_OST=F8_LDS_WS+2048, F8_LDS_BYTES=F8_LDS_OST+NW*32*F8_OSTP;
constexpr float F8_ENC0=60.25f;
constexpr float F8_SH=13.0f;
#define MF8(a_,b_,c_,BF) __builtin_amdgcn_mfma_scale_f32_32x32x64_f8f6f4(a_,b_,c_,0,BF,0,0,0,0)
typedef __attribute__((address_space(3))) const v4i* lds_v4p;
__device__ __forceinline__ v8i ld256(lds_cptr p){ const v4i a=*(lds_v4p)(p), b=*(lds_v4p)(p+1024); return __builtin_shufflevector(a,b,0,1,2,3,4,5,6,7); }
__device__ __forceinline__ void attn_unit8(const int tid,const float mref,const unsigned char*Qu,int QP,const unsigned char*__restrict__ Kh,const unsigned char*__restrict__ Vh,int NT,bf16*Ou,int OP,char*shm){
  const int lane=tid&63,r32=lane&31,hi=lane>>5; const int wid=__builtin_amdgcn_readfirstlane(tid>>6);
  const unsigned lds0=(unsigned)(uintptr_t)shm;
  const bool isK=wid<4;
  const unsigned char*dsrc=(isK?Kh:Vh)+(wid&3)*1024+lane*16;
  const unsigned ddst=lds0+(isK?F8_LDS_K:F8_LDS_V)+(wid&3)*1024;
  #define DMA8(tk,sk,tv,sv) glds16(dsrc+(long)(isK?(tk):(tv))*4096,(unsigned)__builtin_amdgcn_readfirstlane(ddst+(isK?(sk):(sv))))
  const lds_cptr shm3=(lds_cptr)shm; const lds_cptr kp0=shm3+F8_LDS_K+hi*2048+r32*16; const lds_cptr vp0=shm3+F8_LDS_V+hi*2048+r32*16;
  DMA8(0,0,0,0); if(isK){DMA8(1,F8_SLOTB,0,0);}
  v8i qf; { const unsigned char*qp=Qu+(long)(wid*QBLK+r32)*QP+32*hi; const v4i a=*(const v4i*)qp, b=*(const v4i*)(qp+16); qf=__builtin_shufflevector(a,b,0,1,2,3,4,5,6,7); }
  f32x16 o[2],lacc,negm; { const float z=pg8::zero_v(); _Pragma("unroll") for(int r=0;r<16;++r){o[0][r]=z;o[1][r]=z;lacc[r]=z;negm[r]=z+(4.0f*(F8_SH-mref)+F8_ENC0);} } asm volatile("":"+v"(negm));
  v8i ones,pw; { int o1; asm volatile("v_mov_b32 %0, 0x38383838":"=v"(o1)); _Pragma("unroll") for(int j=0;j<8;++j){ones[j]=o1;pw[j]=o1;} } asm volatile("":"+v"(ones));
  f32x16 pA0,pA1,pB0,pB1; v8i kf[2],vf[2];
  int sl_prev=0,sl_cur=0,sl_next=F8_SLOTB;
  #define ROT() do{sl_prev=sl_cur;sl_cur=sl_next;sl_next=(sl_next==2*F8_SLOTB)?0:sl_next+F8_SLOTB;}while(0)
  if(isK){DMA8(2,2*F8_SLOTB,0,0);}
  WAIT_BAR(3);
  kf[0]=ld256(kp0); kf[1]=ld256(kp0+512);
  pA0=MF8(kf[0],qf,negm,0); pA1=MF8(kf[1],qf,negm,0);
  _Pragma("unroll") for(int r=0;r<16;++r){pA0[r]=__builtin_amdgcn_fmed3f(pA0[r],0.0f,123.0f);pA1[r]=__builtin_amdgcn_fmed3f(pA1[r],0.0f,123.0f);}
  WAIT_BAR(0);
  DMA8(3,0,1,F8_SLOTB);
  ROT();
  kf[0]=ld256(kp0+sl_cur); kf[1]=ld256(kp0+sl_cur+512);
  WAIT_BAR(1);
  #define PIN(x) asm volatile("":"+v"(x))
  #define EX(v) __builtin_amdgcn_fmed3f((v),0.0f,123.0f)
  #define CV4(W,P,B) do{ unsigned w_=(unsigned)W; w_=__builtin_amdgcn_cvt_pk_u8_f32(P[B],0u,w_); w_=__builtin_amdgcn_cvt_pk_u8_f32(P[(B)+1],1u,w_); w_=__builtin_amdgcn_cvt_pk_u8_f32(P[(B)+2],2u,w_); w_=__builtin_amdgcn_cvt_pk_u8_f32(P[(B)+3],3u,w_); W=(int)w_; }while(0)
  #define STEP8(C0,C1,P0,P1,t,GK,GV,GL) do{ SBAR(); \
    const lds_cptr vp_=vp0+sl_prev; \
    vf[0]=ld256(vp_); SBAR(); \
    C0=MF8(kf[0],qf,negm,0); CV4(pw[0],P0,0); CV4(pw[1],P0,4); CV4(pw[2],P0,8); CV4(pw[3],P0,12); PIN(pw); SBAR(); \
    vf[1]=ld256(vp_+512); SBAR(); \
    C1=MF8(kf[1],qf,negm,0); CV4(pw[4],P1,0); CV4(pw[5],P1,4); CV4(pw[6],P1,8); CV4(pw[7],P1,12); PIN(pw); SBAR(); \
    if(isK?(GK):(GV)){DMA8((t)+3,sl_cur,(t)+1,sl_next);} \
    SBAR(); \
    o[0]=MF8(vf[0],pw,o[0],1); \
    C0[0]=EX(C0[0]);C0[1]=EX(C0[1]);C0[2]=EX(C0[2]);C0[3]=EX(C0[3]);C0[4]=EX(C0[4]);C0[5]=EX(C0[5]);C0[6]=EX(C0[6]);C0[7]=EX(C0[7]);C0[8]=EX(C0[8]);C0[9]=EX(C0[9]);C0[10]=EX(C0[10]); PIN(C0); SBAR(); \
    if(GL){ kf[0]=ld256(kp0+sl_next); SBAR(); } \
    o[1]=MF8(vf[1],pw,o[1],1); \
    C0[11]=EX(C0[11]);C0[12]=EX(C0[12]);C0[13]=EX(C0[13]);C0[14]=EX(C0[14]);C0[15]=EX(C0[15]);C1[0]=EX(C1[0]);C1[1]=EX(C1[1]);C1[2]=EX(C1[2]);C1[3]=EX(C1[3]);C1[4]=EX(C1[4]);C1[5]=EX(C1[5]); PIN(C0); PIN(C1); SBAR(); \
    if(GL){ kf[1]=ld256(kp0+sl_next+512); SBAR(); } \
    lacc=MF8(ones,pw,lacc,1); \
    C1[6]=EX(C1[6]);C1[7]=EX(C1[7]);C1[8]=EX(C1[8]);C1[9]=EX(C1[9]);C1[10]=EX(C1[10]);C1[11]=EX(C1[11]);C1[12]=EX(C1[12]);C1[13]=EX(C1[13]);C1[14]=EX(C1[14]);C1[15]=EX(C1[15]); PIN(C1); SBAR(); \
    }while(0)
  int t=1;
  for(;t+5<NT;t+=2){
    STEP8(pB0,pB1,pA0,pA1,t,true,true,true);     WAIT_BAR(1); ROT();
    STEP8(pA0,pA1,pB0,pB1,t+1,true,true,true);   WAIT_BAR(1); ROT();
  }
  #define ENDW8(tt) do{ if((tt)+3<NT){WAIT_BAR(1);} else {WAIT_BAR(0);} }while(0)
  for(;t+1<NT;t+=2){
    STEP8(pB0,pB1,pA0,pA1,t,(t+3<NT),(t+1<NT),(t+1<NT));       ENDW8(t);   ROT();
    STEP8(pA0,pA1,pB0,pB1,t+1,(t+4<NT),(t+2<NT),(t+2<NT));     ENDW8(t+1); ROT();
  }
  STEP8(pB0,pB1,pA0,pA1,NT-1,false,false,false);
  { CV4(pw[0],pB0,0); CV4(pw[1],pB0,4); CV4(pw[2],pB0,8); CV4(pw[3],pB0,12); CV4(pw[4],pB1,0); CV4(pw[5],pB1,4); CV4(pw[6],pB1,8); CV4(pw[7],pB1,12);
    const lds_cptr vp_=vp0+sl_cur; vf[0]=ld256(vp_); vf[1]=ld256(vp_+512);
    o[0]=MF8(vf[0],pw,o[0],1); o[1]=MF8(vf[1],pw,o[1],1); lacc=MF8(ones,pw,lacc,1); }
  #undef PIN
  #undef EX
  #undef CV4
  #undef STEP8
  #undef ENDW8
  { const float rl=__builtin_amdgcn_rcpf(lacc[0]);
    typedef __attribute__((address_space(3))) char* lds_wptr;
    const lds_wptr stg=(lds_wptr)shm+F8_LDS_OST+wid*(32*F8_OSTP);
    #pragma unroll
    for(int m=0;m<2;++m)
      #pragma unroll
      for(int g=0;g<4;++g){ v2u_t w; w.x=cvtpk_s(o[m][4*g]*rl,o[m][4*g+1]*rl); w.y=cvtpk_s(o[m][4*g+2]*rl,o[m][4*g+3]*rl);
        *(__attribute__((address_space(3))) v2u_t*)(stg+r32*F8_OSTP+(32*m+8*g+4*hi)*2)=w; }
    asm volatile("s_waitcnt lgkmcnt(0)":::"memory");
    bf16*Ow=Ou+(long)(wid*QBLK)*OP;
    #pragma unroll
    for(int i=0;i<4;++i){const int row=i*8+(lane>>3),ch=lane&7; const u32x4 v=*(const __attribute__((address_space(3))) u32x4*)(stg+row*F8_OSTP+ch*16); *(u32x4*)(Ow+(long)row*OP+ch*8)=v;} }
  asm volatile("s_waitcnt lgkmcnt(0)\n\ts_barrier":::"memory");
  #undef DMA8
  #undef ROT
}
constexpr int F8P_NS=5, F8P_LDS_V=F8P_NS*F8_SLOTB, F8P_LDS_OST=2*F8P_NS*F8_SLOTB, F8P_LDS_BYTES=F8P_LDS_OST+NW*32*F8_OSTP;
__device__ __forceinline__ void attn_unit8p(const int tid,const float mref,const unsigned char*Qu,int QP,const unsigned char*__restrict__ Kh,const unsigned char*__restrict__ Vh,int NT,bf16*Ou,int OP,char*shm){
  const int lane=tid&63,r32=lane&31,hi=lane>>5; const int wid=__builtin_amdgcn_readfirstlane(tid>>6);
  const unsigned lds0=(unsigned)(uintptr_t)shm;
  const bool isK=wid<4;
  const unsigned char*dsrc=(isK?Kh:Vh)+(wid&3)*1024+lane*16;
  const unsigned ddst=lds0+(isK?0:F8P_LDS_V)+(wid&3)*1024;
  #define DMA8(tk,sk,tv,sv) glds16(dsrc+(long)(isK?(tk):(tv))*4096,(unsigned)__builtin_amdgcn_readfirstlane(ddst+(isK?(sk):(sv))))
  #define WR(x) (((x)>=F8P_NS*F8_SLOTB)?((x)-F8P_NS*F8_SLOTB):(x))
  const lds_cptr shm3=(lds_cptr)shm; const lds_cptr kp0=shm3+hi*2048+r32*16; const lds_cptr vp0=shm3+F8P_LDS_V+hi*2048+r32*16;
  DMA8(0,0,0,0); DMA8(1,F8_SLOTB,1,F8_SLOTB); DMA8(2,2*F8_SLOTB,2,2*F8_SLOTB); if(isK){DMA8(3,3*F8_SLOTB,0,0); DMA8(4,4*F8_SLOTB,0,0);}
  v8i qf; { const unsigned char*qp=Qu+(long)(wid*QBLK+r32)*QP+32*hi; const v4i a=*(const v4i*)qp, b=*(const v4i*)(qp+16); qf=__builtin_shufflevector(a,b,0,1,2,3,4,5,6,7); }
  f32x16 o[2],lacc,negm; { const float z=pg8::zero_v(); _Pragma("unroll") for(int r=0;r<16;++r){o[0][r]=z;o[1][r]=z;lacc[r]=z;negm[r]=z-mref+F8_SH;} } asm volatile("":"+v"(negm));
  v8i ones,pw; { int o1; asm volatile("v_mov_b32 %0, 0x38383838":"=v"(o1)); _Pragma("unroll") for(int j=0;j<8;++j){ones[j]=o1;pw[j]=o1;} } asm volatile("":"+v"(ones));
  f32x16 pA0,pA1,pB0,pB1; v8i kf[2],vf[2];
  WAIT_BAR(0);
  kf[0]=ld256(kp0); kf[1]=ld256(kp0+512);
  pA0=MF8(kf[0],qf,negm,0); pA1=MF8(kf[1],qf,negm,0);
  _Pragma("unroll") for(int r=0;r<16;++r){pA0[r]=__builtin_amdgcn_exp2f(pA0[r]);pA1[r]=__builtin_amdgcn_exp2f(pA1[r]);}
  kf[0]=ld256(kp0+F8_SLOTB); kf[1]=ld256(kp0+F8_SLOTB+512);
  WAIT_BAR(0);
  int sl=F8_SLOTB;
  #define PIN(x) asm volatile("":"+v"(x))
  #define EX(v) __builtin_amdgcn_exp2f(v)
  #define CV4(W,P,B) do{ W=__builtin_amdgcn_cvt_pk_bf8_f32(P[B],P[(B)+1],W,false); W=__builtin_amdgcn_cvt_pk_bf8_f32(P[(B)+2],P[(B)+3],W,true); }while(0)
  #define STEP8(C0,C1,P0,P1,t,GK,GV,GL) do{ SBAR(); \
    const int sl_p1=(sl==0)?(F8P_NS-1)*F8_SLOTB:sl-F8_SLOTB, sl_n1=WR(sl+F8_SLOTB), sl_n2=WR(sl+2*F8_SLOTB); \
    const lds_cptr vp_=vp0+sl_p1; \
    vf[0]=ld256(vp_); SBAR(); \
    C0=MF8(kf[0],qf,negm,0); CV4(pw[0],P0,0); CV4(pw[1],P0,4); CV4(pw[2],P0,8); CV4(pw[3],P0,12); PIN(pw); SBAR(); \
    vf[1]=ld256(vp_+512); SBAR(); \
    C1=MF8(kf[1],qf,negm,0); CV4(pw[4],P1,0); CV4(pw[5],P1,4); CV4(pw[6],P1,8); CV4(pw[7],P1,12); PIN(pw); SBAR(); \
    if(isK?(GK):(GV)){DMA8((t)+4,sl_p1,(t)+2,sl_n2);} \
    SBAR(); \
    o[0]=MF8(vf[0],pw,o[0],1); \
    C0[0]=EX(C0[0]);C0[1]=EX(C0[1]);C0[2]=EX(C0[2]);C0[3]=EX(C0[3]);C0[4]=EX(C0[4]);C0[5]=EX(C0[5]);C0[6]=EX(C0[6]);C0[7]=EX(C0[7]);C0[8]=EX(C0[8]);C0[9]=EX(C0[9]);C0[10]=EX(C0[10]); PIN(C0); SBAR(); \
    if(GL){ kf[0]=ld256(kp0+sl_n1); SBAR(); } \
    o[1]=MF8(vf[1],pw,o[1],1); \
    C0[11]=EX(C0[11]);C0[12]=EX(C0[12]);C0[13]=EX(C0[13]);C0[14]=EX(C0[14]);C0[15]=EX(C0[15]);C1[0]=EX(C1[0]);C1[1]=EX(C1[1]);C1[2]=EX(C1[2]);C1[3]=EX(C1[3]);C1[4]=EX(C1[4]);C1[5]=EX(C1[5]); PIN(C0); PIN(C1); SBAR(); \
    if(GL){ kf[1]=ld256(kp0+sl_n1+512); SBAR(); } \
    lacc=MF8(ones,pw,lacc,1); \
    C1[6]=EX(C1[6]);C1[7]=EX(C1[7]);C1[8]=EX(C1[8]);C1[9]=EX(C1[9]);C1[10]=EX(C1[10]);C1[11]=EX(C1[11]);C1[12]=EX(C1[12]);C1[13]=EX(C1[13]);C1[14]=EX(C1[14]);C1[15]=EX(C1[15]); PIN(C1); SBAR(); \
    sl=sl_n1; \
    }while(0)
  int t=1;
  for(;t+6<NT;t+=2){
    STEP8(pB0,pB1,pA0,pA1,t,true,true,true);
    STEP8(pA0,pA1,pB0,pB1,t+1,true,true,true);   WAIT_BAR(1);
  }
  for(;t+1<NT;t+=2){
    STEP8(pB0,pB1,pA0,pA1,t,(t+4<NT),(t+2<NT),true);
    STEP8(pA0,pA1,pB0,pB1,t+1,(t+5<NT),(t+3<NT),(t+2<NT));
    if(t+5<NT){WAIT_BAR(1);} else {WAIT_BAR(0);}
  }
  STEP8(pB0,pB1,pA0,pA1,NT-1,false,false,false);
  { CV4(pw[0],pB0,0); CV4(pw[1],pB0,4); CV4(pw[2],pB0,8); CV4(pw[3],pB0,12); CV4(pw[4],pB1,0); CV4(pw[5],pB1,4); CV4(pw[6],pB1,8); CV4(pw[7],pB1,12);
    const int sl_last=(sl==0)?(F8P_NS-1)*F8_SLOTB:sl-F8_SLOTB;
    const lds_cptr vp_=vp0+sl_last; vf[0]=ld256(vp_); vf[1]=ld256(vp_+512);
    o[0]=MF8(vf[0],pw,o[0],1); o[1]=MF8(vf[1],pw,o[1],1); lacc=MF8(ones,pw,lacc,1); }
  #undef PIN
  #undef EX
  #undef CV4
  #undef STEP8
  #undef WR
  { const float rl=__builtin_amdgcn_rcpf(lacc[0]);
    typedef __attribute__((address_space(3))) char* lds_wptr;
    const lds_wptr stg=(lds_wptr)shm+F8P_LDS_OST+wid*(32*F8_OSTP);
    #pragma unroll
    for(int m=0;m<2;++m)
      #pragma unroll
      for(int g=0;g<4;++g){ v2u_t w; w.x=cvtpk_s(o[m][4*g]*rl,o[m][4*g+1]*rl); w.y=cvtpk_s(o[m][4*g+2]*rl,o[m][4*g+3]*rl);
        *(__attribute__((address_space(3))) v2u_t*)(stg+r32*F8_OSTP+(32*m+8*g+4*hi)*2)=w; }
    asm volatile("s_waitcnt lgkmcnt(0)":::"memory");
    bf16*Ow=Ou+(long)(wid*QBLK)*OP;
    #pragma unroll
    for(int i=0;i<4;++i){const int row=i*8+(lane>>3),ch=lane&7; const u32x4 v=*(const __attribute__((address_space(3))) u32x4*)(stg+row*F8_OSTP+ch*16); *(u32x4*)(Ow+(long)row*OP+ch*8)=v;} }
  asm volatile("s_waitcnt lgkmcnt(0)\n\ts_barrier":::"memory");
  #undef DMA8
}
#undef MF8
#undef SBAR
#undef WAIT_BAR
}
#define GAS __attribute__((address_space(1)))
#define LAS __attribute__((address_space(3)))
typedef unsigned short bf16;
typedef unsigned v4u __attribute__((ext_vector_type(4)));
typedef float f32x4 __attribute__((ext_vector_type(4)));
typedef short bf16x8 __attribute__((ext_vector_type(8)));
typedef GAS unsigned gu32;
typedef GAS unsigned long long gu64;
#define RLX_AGENT __ATOMIC_RELAXED, __HIP_MEMORY_SCOPE_AGENT
#define LDS_WAIT() asm volatile("s_waitcnt lgkmcnt(0)" ::: "memory")
#define VM_WAIT() asm volatile("s_waitcnt vmcnt(0)" ::: "memory")
__device__ __forceinline__ unsigned long long rt() { return __builtin_amdgcn_s_memrealtime(); }
__device__ __forceinline__ unsigned f2bf(float f) { unsigned u = __builtin_bit_cast(unsigned, f); return (u + 0x7fffu + ((u >> 16) & 1u)) >> 16; }
__device__ __forceinline__ unsigned pk2(float lo, float hi) { return f2bf(lo) | (f2bf(hi) << 16); }

#define XB_TMO      128
#define XB_XCNT(j)  (256  + 64 * (j))
#define XB_XSUB(j)  (1280 + 64 * (j))
#define XB_XGEN(j)  (2304 + 64 * (j))
#define XB_TOP      3328
#define XB_TOPGEN   3392
#define XCD_BAR_WORDS 3456
#define XB_SPIN_CAP (1u << 18)

__device__ __forceinline__ unsigned xb_ld(unsigned* p)              { return __hip_atomic_load(p, __ATOMIC_RELAXED, __HIP_MEMORY_SCOPE_AGENT); }
__device__ __forceinline__ unsigned xb_add(unsigned* p, unsigned v) { return __hip_atomic_fetch_add(p, v, __ATOMIC_RELAXED, __HIP_MEMORY_SCOPE_AGENT); }
__device__ __forceinline__ unsigned xb_xcc_id() { return (unsigned)__builtin_amdgcn_s_getreg((3 << 11) | 20) & 0xFu; }
#define XB_SPIN(cond, bar) do { unsigned _sp = 0; while (cond) { __builtin_amdgcn_s_sleep(1); \
    if ((++_sp & 255u) == 0u) { if (xb_ld(&(bar)[XB_TMO])) break; if (_sp > XB_SPIN_CAP) { atomicAdd(&(bar)[XB_TMO], 1u); break; } } } } while (0)

struct XcdBarrier {
    unsigned* bar; unsigned x;
    volatile LAS unsigned* st;
};

__device__ __forceinline__ XcdBarrier xcd_barrier_post(unsigned* bar, volatile LAS unsigned* st) {
    XcdBarrier b; b.bar = bar; b.x = xb_xcc_id(); b.st = st;
    if (threadIdx.x == 0) (void)xb_add(&bar[XB_XCNT(b.x)], 1u);
    return b;
}
__device__ __forceinline__ void xcd_barrier_complete(unsigned* bar, unsigned x, unsigned& nloc, unsigned& nx) {
    const unsigned G = gridDim.x * gridDim.y * gridDim.z;
    unsigned sum, cnt, mine, sp = 0u;
    for (;;) {
        sum = 0u; cnt = 0u; mine = 0u;
#pragma unroll
        for (unsigned j = 0; j < 16; ++j) { const unsigned c = xb_ld(&bar[XB_XCNT(j)]); sum += c; cnt += (c > 0u) ? 1u : 0u; mine = (j == x) ? c : mine; }
        if (sum == G) break;
        __builtin_amdgcn_s_sleep(1);
        if ((++sp & 255u) == 0u) { if (xb_ld(&bar[XB_TMO])) break; if (sp > XB_SPIN_CAP) { atomicAdd(&bar[XB_TMO], 1u); break; } }
    }
    nloc = mine > 0u ? mine : 1u; nx = cnt > 0u ? cnt : 1u;
}

__device__ __forceinline__ void xcd_barrier(const XcdBarrier& b) {
    asm volatile("s_waitcnt vmcnt(0)" ::: "memory");
    __syncthreads();
    if (threadIdx.x == 0) {
        unsigned* bar = b.bar;
        __builtin_amdgcn_s_waitcnt(0);
        unsigned nloc = b.st[0], nx = b.st[1];
        if (nloc == 0u) { xcd_barrier_complete(bar, b.x, nloc, nx); b.st[0] = nloc; b.st[1] = nx; }
        const unsigned old = xb_add(&bar[XB_XSUB(b.x)], 1u);
        const unsigned gen = old / nloc;
        if (old + 1u == (gen + 1u) * nloc) {
            __builtin_amdgcn_fence(__ATOMIC_RELEASE, "agent");
            asm volatile("s_waitcnt vmcnt(0)" ::: "memory");
            const unsigned og = xb_add(&bar[XB_TOP], 1u);
            const unsigned tg = og / nx;
            if (og + 1u == (tg + 1u) * nx) xb_add(&bar[XB_TOPGEN], 1u);
            else XB_SPIN(xb_ld(&bar[XB_TOPGEN]) == tg, bar);
            __builtin_amdgcn_fence(__ATOMIC_ACQUIRE, "agent");
            xb_add(&bar[XB_XGEN(b.x)], 1u);
            asm volatile("s_waitcnt vmcnt(0)" ::: "memory");
        } else {
            XB_SPIN(xb_ld(&bar[XB_XGEN(b.x)]) == gen, bar);
            __builtin_amdgcn_fence(__ATOMIC_ACQUIRE, "agent");
            asm volatile("s_waitcnt vmcnt(0)" ::: "memory");
        }
    }
    __syncthreads();
}
constexpr int NWAVES = 8;
constexpr int DM = 1024, NB = 2, SEQ = 16384, CTX = 256, RB = SEQ + CTX  , NR = NB * RB  ;
constexpr int INW = 2048, FF = 2816, NE = 8, NCH = RB / 128  , NLAT = NB * SEQ;
constexpr float EPS = 1e-6f;
constexpr int PC_K = 512, PC_V = 640, PC_RQ = 768, PC_RK = 1024, PC_RV = 1280, PC_RG = 1536, PC_PP = 1792;
constexpr int MOE_TP = 104, MOE_PASSES = 3, LISTCAP = 32768;

constexpr size_t MiB = 1u << 20, U128K = 131072;
constexpr size_t WS_CTL = 0, CTL_ZERO_BYTES = 1 * MiB;
constexpr size_t WS_MODV = 1 * MiB;
constexpr size_t WS_ROPE = 1 * MiB + 256 * 1024;
constexpr size_t WS_DEC = WS_ROPE + 32768;
constexpr size_t WS_TOK = 3 * MiB / 2;
constexpr size_t WS_LIST = 5 * MiB / 2;
constexpr size_t WS_XC = 7 * MiB / 2;
constexpr size_t WS_WIN = 6 * MiB, WS_WOUT = 14 * MiB, WS_W13D = 18 * MiB, WS_W2D = 29 * MiB, WS_W13M = 35 * MiB, WS_W2M = 80 * MiB  , WS_XB = 103 * MiB  ;
constexpr size_t SZ_WIN = (size_t)INW * DM * 2, SZ_WOUT = (size_t)DM * DM * 2, SZ_W13 = (size_t)2 * FF * DM * 2, SZ_W2 = (size_t)DM * FF * 2;
constexpr size_t SZ8_W13 = SZ_W13 / 2, SZ8_W2 = SZ_W2 / 2;
constexpr size_t WS_AR = 168 * MiB;
constexpr size_t AR_P = 0, AR_QB = 1040 * U128K, AR_KC = 1300 * U128K, AR_VC = 1365 * U128K, AR_US = 1430 * U128K, AR_MIX = 1690 * U128K, AR_MX = 2210 * U128K;
constexpr size_t AR_HX2 = 0, AR_ACT = 520 * U128K, AR_YD = 2210 * U128K, AR_YM = 1664 * U128K;
constexpr size_t AR_PART0 = 1040 * U128K  , AR_PART1 = 0  ;
constexpr size_t AR_Q8 = AR_QB, AR_K8 = AR_QB + 136 * U128K, AR_V8 = AR_QB + 176 * U128K;
constexpr size_t DO_Q8 = AR_MX + 20 * MiB, DO_K8 = AR_MX + 40 * MiB, DO_V8 = AR_MX + 46 * MiB, DO_O8 = AR_US;
constexpr size_t WS_END = 512 * MiB;
static_assert(WS_XB + (size_t)NLAT * DM * 2 <= WS_AR && WS_W2M + 8 * SZ8_W2 <= WS_XB && WS_W13M + 8 * SZ8_W13 <= WS_W2M && WS_W13D + SZ_W13 <= WS_W2D && WS_W2D + SZ_W2 <= WS_W13M, "weights map");
static_assert(AR_MX + (size_t)NR * DM * 2 <= WS_END - WS_AR && AR_ACT + (size_t)NR * FF * 2 <= AR_YD && AR_YM + (size_t)264 * 256 * DM * 2 <= WS_END - WS_AR && AR_ACT + (size_t)MOE_TP * 256 * FF * 2 <= AR_YM, "arena map");
static_assert(AR_QB == (size_t)NR * INW * 2 && AR_KC == AR_QB + (size_t)NR * 512 * 2 && AR_US == AR_VC + (size_t)NR * 128 * 2 && AR_MIX == AR_US + (size_t)16 * NCH * 16384 && AR_MX == AR_MIX + (size_t)NR * DM * 2, "arena map 2");
constexpr int CW_TMO = 0, CW_CODE = 1, CW_CNT = 64  , CW_BAR = 4096;
constexpr int RING_BYTES = 131072, MISC_OFF = RING_BYTES + 320, GTAB_OFF = RING_BYTES + 1024, MOE_OFF = RING_BYTES + 2048, LDS_BYTES = 147456;

typedef unsigned v2u __attribute__((ext_vector_type(2)));
typedef float f32x16 __attribute__((ext_vector_type(16)));

struct Args { const float* in[24]; float* out; unsigned char* ws; int ph_lo, ph_hi, li, pad; };
enum { I_X = 0, I_C, I_CTX, I_CCTX, I_WMOD, I_BMOD, I_NPREMIX, I_NPOSTMIX, I_NPREFFN, I_NPOSTFFN, I_WIN, I_WOUT, I_QN, I_KN, I_DECAY, I_POOLW, I_POOLS, I_FW1, I_FW3, I_FW2, I_ROUTER, I_MW1, I_MW3, I_MW2 };

typedef const __attribute__((address_space(4))) Args* ArgP;
__device__ __forceinline__ ArgP args_here() { ArgP p = (ArgP)__builtin_amdgcn_kernarg_segment_ptr(); asm volatile("" : "+s"(p)); return p; }
struct Frame { LAS unsigned char* lds; int tid, lane, wave, G, gw, NGW, bx; };
__device__ __forceinline__ void relaunder(Frame& F) { int t = threadIdx.x; asm volatile("" : "+v"(t)); F.tid = t; F.lane = t & 63; F.wave = __builtin_amdgcn_readfirstlane(t >> 6);
    int g = gridDim.x; asm volatile("" : "+s"(g)); F.G = g; int bx = blockIdx.x; asm volatile("" : "+s"(bx)); F.bx = bx; F.gw = bx * NWAVES + F.wave; F.NGW = F.G * NWAVES; }

#ifndef ATT8_DEBUG
#define ATT8_DEBUG 0
#endif
#ifndef DENSE_F8
#define DENSE_F8 0
#endif
#ifndef MOE_F8
#define MOE_F8 1
#endif
#ifndef DENSE_I8UP
#define DENSE_I8UP 1
#endif
#ifndef MOE_I8UP
#define MOE_I8UP 1
#endif
#ifndef DENSE_DOWN_F8
#define DENSE_DOWN_F8 1
#endif
#ifndef IN_I8
#define IN_I8 3
#endif
constexpr float I8_XS = 20.0f, I8_XI = 20.0f, I8_WS = 1024.0f;
#ifndef IN1_F8
#define IN1_F8 0
#endif
__device__ __forceinline__ unsigned char* q8_ptr(ArgP a) { return ATT8_DEBUG ? a->ws + WS_AR + DO_Q8 : a->ws + WS_AR + AR_Q8; }
__device__ __forceinline__ unsigned char* k8_ptr(ArgP a) { return ATT8_DEBUG ? a->ws + WS_AR + DO_K8 : a->ws + WS_AR + AR_K8; }
__device__ __forceinline__ unsigned char* v8_ptr(ArgP a) { return ATT8_DEBUG ? a->ws + WS_AR + DO_V8 : a->ws + WS_AR + AR_V8; }
__device__ __forceinline__ unsigned fp8x4(float a, float b, float c, float d) { int w = 0; w = __builtin_amdgcn_cvt_pk_fp8_f32(a, b, w, false); w = __builtin_amdgcn_cvt_pk_fp8_f32(c, d, w, true); return (unsigned)w; }
__device__ __forceinline__ unsigned i8x4(float a, float b, float c, float d, float s) {
    unsigned w = 0;
    w = __builtin_amdgcn_cvt_pk_u8_f32(__builtin_amdgcn_fmed3f(__builtin_rintf(__builtin_fmaf(a, s, 128.0f)), 1.0f, 255.0f), 0, w);
    w = __builtin_amdgcn_cvt_pk_u8_f32(__builtin_amdgcn_fmed3f(__builtin_rintf(__builtin_fmaf(b, s, 128.0f)), 1.0f, 255.0f), 1, w);
    w = __builtin_amdgcn_cvt_pk_u8_f32(__builtin_amdgcn_fmed3f(__builtin_rintf(__builtin_fmaf(c, s, 128.0f)), 1.0f, 255.0f), 2, w);
    w = __builtin_amdgcn_cvt_pk_u8_f32(__builtin_amdgcn_fmed3f(__builtin_rintf(__builtin_fmaf(d, s, 128.0f)), 1.0f, 255.0f), 3, w);
    return w ^ 0x80808080u; }
__device__ __forceinline__ float bf_lo(unsigned u) { return __uint_as_float(u << 16); }
__device__ __forceinline__ float bf_hi(unsigned u) { return __uint_as_float(u & 0xffff0000u); }
__device__ __forceinline__ unsigned pkbf(float lo, float hi) { return attn_body::cvtpk_s(lo, hi); }
template <int M> __device__ __forceinline__ float shx(float v) { return __builtin_bit_cast(float, __builtin_amdgcn_ds_swizzle(__builtin_bit_cast(int, v), 0x1F | (M << 10))); }
__device__ __forceinline__ float half_sum(float v) { auto rr = __builtin_amdgcn_permlane32_swap(__float_as_uint(v), __float_as_uint(v), false, false); return __uint_as_float(rr[0]) + __uint_as_float(rr[1]); }
__device__ __forceinline__ float half_max(float v) { auto rr = __builtin_amdgcn_permlane32_swap(__float_as_uint(v), __float_as_uint(v), false, false); return fmaxf(__uint_as_float(rr[0]), __uint_as_float(rr[1])); }
__device__ __forceinline__ float wave_sum(float v) { v += shx<1>(v); v += shx<2>(v); v += shx<4>(v); v += shx<8>(v); v += shx<16>(v); return half_sum(v); }
__device__ __forceinline__ float siluf(float x) { return x / (1.0f + __expf(-x)); }
__device__ __forceinline__ float logsig(float x) { return -log1pf(expf(-x)); }
#define ROWCOL(j) (512 * ((j) >> 1) + 4 * ((j) & 1))
__device__ __forceinline__ void ld16(f32x4 (&v)[4], const float* p, int lane) {
#pragma unroll
    for (int j = 0; j < 4; ++j) v[j] = *(const f32x4*)(p + ROWCOL(j) + 8 * lane);
}
__device__ __forceinline__ void ld16b(f32x4 (&v)[4], const bf16* p, int lane) {
#pragma unroll
    for (int h = 0; h < 2; ++h) { const v4u u = *(const v4u*)(p + 512 * h + 8 * lane); v[2 * h] = (f32x4){bf_lo(u.x), bf_hi(u.x), bf_lo(u.y), bf_hi(u.y)}; v[2 * h + 1] = (f32x4){bf_lo(u.z), bf_hi(u.z), bf_lo(u.w), bf_hi(u.w)}; }
}
__device__ __forceinline__ void st16(float* p, const f32x4 (&v)[4], int lane) {
#pragma unroll
    for (int j = 0; j < 4; ++j) *(f32x4*)(p + ROWCOL(j) + 8 * lane) = v[j];
}
__device__ __forceinline__ void st16b(bf16* p, const f32x4 (&v)[4], int lane) {
#pragma unroll
    for (int h = 0; h < 2; ++h) { v4u u; u.x = pkbf(v[2 * h][0], v[2 * h][1]); u.y = pkbf(v[2 * h][2], v[2 * h][3]); u.z = pkbf(v[2 * h + 1][0], v[2 * h + 1][1]); u.w = pkbf(v[2 * h + 1][2], v[2 * h + 1][3]); *(v4u*)(p + 512 * h + 8 * lane) = u; }
}
__device__ __forceinline__ void st16f8(unsigned char* p, const f32x4 (&v)[4], int lane) {
#pragma unroll
    for (int h = 0; h < 2; ++h) { v2u u; u.x = fp8x4(v[2 * h][0], v[2 * h][1], v[2 * h][2], v[2 * h][3]); u.y = fp8x4(v[2 * h + 1][0], v[2 * h + 1][1], v[2 * h + 1][2], v[2 * h + 1][3]); *(v2u*)(p + 512 * h + 8 * lane) = u; }
}
__device__ __forceinline__ void st16i8(unsigned char* p, const f32x4 (&v)[4], int lane, const float I8_XS = ::I8_XS) {
#pragma unroll
    for (int h = 0; h < 2; ++h) { v2u u; u.x = i8x4(v[2 * h][0], v[2 * h][1], v[2 * h][2], v[2 * h][3], I8_XS); u.y = i8x4(v[2 * h + 1][0], v[2 * h + 1][1], v[2 * h + 1][2], v[2 * h + 1][3], I8_XS); *(v2u*)(p + 512 * h + 8 * lane) = u; }
}
__device__ __forceinline__ float sumsq16(const f32x4 (&v)[4]) {
    float s = 0.f;
#pragma unroll
    for (int j = 0; j < 4; ++j) s += (v[j][0] * v[j][0] + v[j][1] * v[j][1]) + (v[j][2] * v[j][2] + v[j][3] * v[j][3]);
    return s;
}
__device__ __forceinline__ const float* modv(const unsigned char* ws, int l, int cls, int chunk) { return (const float*)(ws + WS_MODV) + ((size_t)(l * 3 + cls) * 6 + chunk) * DM; }

template <int F8 = 0  > __device__ __forceinline__ void p0_transpose_item(const float* W, int K, int N, bf16* WT, int k0, int n0, int drow0, LAS float* scr, int lane) {
    { const int c4 = (lane & 7) * 4, r8 = lane >> 3;
#pragma unroll
        for (int i = 0; i < 8; ++i) { const int kk = 8 * i + r8; const f32x4 v = *(const f32x4*)(W + (size_t)(k0 + kk) * N + n0 + c4);
            LAS float* d = scr + kk * 33 + c4; d[0] = v[0]; d[1] = v[1]; d[2] = v[2]; d[3] = v[3]; } }
    LDS_WAIT(); asm volatile("" ::: "memory");
    const int c = lane & 7;
#pragma unroll
    for (int j = 0; j < 4; ++j) { const int n = (lane >> 3) + 8 * j; const LAS float* s = scr + (8 * c) * 33 + n;
        if constexpr (F8 == 2) { v2u o; o.x = i8x4(s[0 * 33], s[1 * 33], s[2 * 33], s[3 * 33], I8_WS); o.y = i8x4(s[4 * 33], s[5 * 33], s[6 * 33], s[7 * 33], I8_WS);
            *(v2u*)((unsigned char*)WT + (size_t)(drow0 + n) * K + k0 + 8 * c) = o; }
        else if constexpr (F8 == 1) { v2u o; o.x = fp8x4(s[0 * 33] * 64.0f, s[1 * 33] * 64.0f, s[2 * 33] * 64.0f, s[3 * 33] * 64.0f); o.y = fp8x4(s[4 * 33] * 64.0f, s[5 * 33] * 64.0f, s[6 * 33] * 64.0f, s[7 * 33] * 64.0f);
            *(v2u*)((unsigned char*)WT + (size_t)(drow0 + n) * K + k0 + 8 * c) = o; }
        else { v4u o; o.x = pkbf(s[0 * 33], s[1 * 33]); o.y = pkbf(s[2 * 33], s[3 * 33]); o.z = pkbf(s[4 * 33], s[5 * 33]); o.w = pkbf(s[6 * 33], s[7 * 33]);
        *(v4u*)(WT + (size_t)(drow0 + n) * K + k0 + 8 * c) = o; } }
    LDS_WAIT(); asm volatile("" ::: "memory");
}
constexpr int WC_IN = 16 * 64, WC_OUT = 16 * 32, WC_F = 1408, WCOPY_ITEMS = 2 * WC_IN + 2 * WC_OUT + 27 * WC_F;
constexpr int WCOPY_SPLIT1 = WCOPY_ITEMS - 21120, WCOPY_SPLIT2 = WCOPY_ITEMS - 12800;
struct WItem { const float* src; unsigned char* dst; int N, K, mode; };
__device__ __forceinline__ WItem wc_decode(ArgP a, int it) {
    WItem w; int r = it;
    if (r < 2 * WC_IN) { const int l = r / WC_IN, q = r % WC_IN, kb = q / 64, nb = q % 64;
        w.mode = ((IN_I8 >> l) & 1) ? 2 : ((IN1_F8 && l == 1) ? 1 : 0); w.N = INW; w.K = DM; w.src = a->in[I_WIN] + (size_t)l * DM * INW + (size_t)(64 * kb) * INW + 32 * nb;
        w.dst = a->ws + WS_WIN + l * SZ_WIN + ((size_t)(32 * nb) * DM + 64 * kb) * (w.mode ? 1 : 2); return w; }
    r -= 2 * WC_IN;
    if (r < 2 * WC_OUT) { const int l = r / WC_OUT, q = r % WC_OUT, kb = q / 32, nb = q % 32;
        w.mode = 0; w.N = DM; w.K = DM; w.src = a->in[I_WOUT] + (size_t)l * DM * DM + (size_t)(64 * kb) * DM + 32 * nb; w.dst = a->ws + WS_WOUT + l * SZ_WOUT + ((size_t)(32 * nb) * DM + 64 * kb) * 2; return w; }
    r -= 2 * WC_OUT;
    const int mat = r / WC_F, q = r % WC_F;
    int which, e; bool moe;
    if (mat < 3) { which = mat; e = 0; moe = false; } else { which = (mat - 3) % 3; e = (mat - 3) / 3; moe = true; }
    if (which < 2) {
        const float* W = (moe ? a->in[which == 0 ? I_MW1 : I_MW3] + (size_t)e * DM * FF : a->in[which == 0 ? I_FW1 : I_FW3]);
        unsigned char* WT = a->ws + (moe ? WS_W13M + e * (MOE_F8 ? SZ8_W13 : SZ_W13) : WS_W13D);
        const int kb = q / 88, nb = q % 88, n0 = 32 * nb; const int drow0 = (n0 >> 7) * 256 + which * 128 + (n0 & 127);
        w.mode = moe ? ((MOE_F8 && !MOE_I8UP) ? 1 : (MOE_I8UP ? 2 : 0)) : (DENSE_F8 ? 1 : (DENSE_I8UP ? 2 : 0));
        w.N = FF; w.K = DM; w.src = W + (size_t)(64 * kb) * FF + n0; w.dst = WT + ((size_t)drow0 * DM + 64 * kb) * (w.mode ? 1 : 2);
    } else {
        const float* W = (moe ? a->in[I_MW2] + (size_t)e * FF * DM : a->in[I_FW2]);
        unsigned char* WT = a->ws + (moe ? WS_W2M + e * (MOE_F8 ? SZ8_W2 : SZ_W2) : WS_W2D);
        const int kb = q / 32, nb = q % 32;
        w.mode = moe ? (MOE_F8 ? 1 : 0) : ((DENSE_F8 || DENSE_DOWN_F8) ? 1 : 0);
        w.N = DM; w.K = FF; w.src = W + (size_t)(64 * kb) * DM + 32 * nb; w.dst = WT + ((size_t)(32 * nb) * FF + 64 * kb) * (w.mode ? 1 : 2);
    }
    return w;
}
__device__ __forceinline__ void wc_load(const WItem& w, f32x4 (&v)[8], int lane) {
    const int c4 = (lane & 7) * 4, r8 = lane >> 3;
#pragma unroll
    for (int i = 0; i < 8; ++i) v[i] = *(const f32x4*)(w.src + (size_t)(8 * i + r8) * w.N + c4);
}
__device__ __forceinline__ void wc_process(const WItem& w, const f32x4 (&v)[8], LAS float* scr, int lane) {
    { const int c4 = (lane & 7) * 4, r8 = lane >> 3;
#pragma unroll
        for (int i = 0; i < 8; ++i) { LAS float* d = scr + (8 * i + r8) * 33 + c4; d[0] = v[i][0]; d[1] = v[i][1]; d[2] = v[i][2]; d[3] = v[i][3]; } }
    LDS_WAIT(); asm volatile("" ::: "memory");
    const int c = lane & 7;
#pragma unroll
    for (int j = 0; j < 4; ++j) { const int n = (lane >> 3) + 8 * j; const LAS float* s = scr + (8 * c) * 33 + n;
        const float s0 = s[0 * 33], s1 = s[1 * 33], s2 = s[2 * 33], s3 = s[3 * 33], s4 = s[4 * 33], s5 = s[5 * 33], s6 = s[6 * 33], s7 = s[7 * 33];
        if (w.mode == 2) { v2u o; o.x = i8x4(s0, s1, s2, s3, I8_WS); o.y = i8x4(s4, s5, s6, s7, I8_WS); *(v2u*)(w.dst + (size_t)n * w.K + 8 * c) = o; }
        else if (w.mode == 1) { v2u o; o.x = fp8x4(s0 * 64.0f, s1 * 64.0f, s2 * 64.0f, s3 * 64.0f); o.y = fp8x4(s4 * 64.0f, s5 * 64.0f, s6 * 64.0f, s7 * 64.0f); *(v2u*)(w.dst + (size_t)n * w.K + 8 * c) = o; }
        else { v4u o; o.x = pkbf(s0, s1); o.y = pkbf(s2, s3); o.z = pkbf(s4, s5); o.w = pkbf(s6, s7); *(v4u*)(w.dst + ((size_t)n * w.K + 8 * c) * 2) = o; } }
    LDS_WAIT(); asm volatile("" ::: "memory");
}
__device__ __forceinline__ void weight_copy_items(ArgP a, Frame& F, const int lo_, const int hi_, const int rk, const int nrk) {
    LAS float* scr = (LAS float*)(F.lds + F.wave * 16384);
    int it = lo_ + rk; if (it >= hi_) return;
    WItem cur = wc_decode(a, it); f32x4 vc[8]; wc_load(cur, vc, F.lane);
    for (;;) {
        const int itn = it + nrk; const bool more = itn < hi_;
        const WItem nx = wc_decode(a, more ? itn : it); f32x4 vn[8]; wc_load(nx, vn, F.lane);
        wc_process(cur, vc, scr, F.lane);
        if (!more) break;
        cur = nx; it = itn;
#pragma unroll
        for (int i = 0; i < 8; ++i) vc[i] = vn[i];
    }
}
__device__ __forceinline__ void phase_p0a(ArgP a, Frame& F) {
    LAS float* sv = (LAS float*)F.lds;
    LAS float* red = (LAS float*)(F.lds + 12288);
    for (int i = F.tid; i < 3072; i += 512) { const int v = i >> 10, k = i & 1023; const float x = (v < 2) ? a->in[I_C][v * 1024 + k] : a->in[I_CCTX][k]; sv[i] = siluf(x); }
    __syncthreads();
    for (int it = F.bx; it < 256; it += F.G) {
        const int l = it >> 7, cg = it & 127; const int r5 = F.lane / 12, c12 = F.lane % 12; const bool act = F.lane < 60;
        f32x4 acc[3]; acc[0] = acc[1] = acc[2] = (f32x4){0.f, 0.f, 0.f, 0.f};
        const float* Wl = a->in[I_WMOD] + (size_t)l * DM * 6144 + 48 * cg + 4 * c12;
#pragma unroll
        for (int hb = 0; hb < 2; ++hb) { f32x4 w4[13];
#pragma unroll
            for (int j = 0; j < 13; ++j) { const int kk = r5 + 5 * (13 * hb + j); const int kc = (act && kk < 128) ? 128 * F.wave + kk : 128 * F.wave; w4[j] = *(const f32x4*)(Wl + (size_t)kc * 6144); }
#pragma unroll
            for (int j = 0; j < 13; ++j) { const int kk = r5 + 5 * (13 * hb + j); const int k = 128 * F.wave + kk;
                if (act && kk < 128) { acc[0] += sv[k] * w4[j]; acc[1] += sv[1024 + k] * w4[j]; acc[2] += sv[2048 + k] * w4[j]; } } }
        if (act) {
#pragma unroll
            for (int v = 0; v < 3; ++v)
#pragma unroll
                for (int e = 0; e < 4; ++e) red[(F.wave * 60 + F.lane) * 12 + v * 4 + e] = acc[v][e]; }
        __syncthreads();
        if (F.tid < 144) { const int v = F.tid / 48, col = F.tid % 48, c12b = col >> 2, e = col & 3; float s = 0.f;
            for (int w = 0; w < 8; ++w)
                for (int r = 0; r < 5; ++r) s += red[(w * 60 + r * 12 + c12b) * 12 + v * 4 + e];
            ((float*)(a->ws + WS_MODV))[((size_t)(l * 3 + v)) * 6144 + 48 * cg + col] = s + a->in[I_BMOD][l * 6144 + 48 * cg + col]; }
        __syncthreads();
    }
    if (F.bx == F.G - 1 && F.tid >= 64 && F.tid < 80) { const int t = F.tid - 64; const float lg = logsig(a->in[I_DECAY][t]); ((float*)(a->ws + WS_DEC))[t] = lg; ((float*)(a->ws + WS_DEC))[16 + t] = expf(128.0f * lg); }
    if (F.tid < 16)
        for (int i = F.bx * 16 + F.tid; i < 4096; i += F.G * 16) { const int pos = i >> 4, fi = i & 15; const double inv = pow(10000.0, -(double)fi / 16.0); const double ang = (double)pos * inv;
            ((float*)(a->ws + WS_ROPE))[i] = (float)cos(ang); ((float*)(a->ws + WS_ROPE))[4096 + i] = (float)sin(ang); }
    weight_copy_items(a, F, 0, WCOPY_ITEMS, F.gw, F.NGW);
}

struct RowLoc { int b, jj, cls; size_t xoff; bool isctx; };
__device__ __forceinline__ RowLoc rowloc(int r) { RowLoc L; L.b = r / RB; L.jj = r - L.b * RB; L.isctx = L.jj < CTX; L.cls = L.isctx ? 2 : L.b;
    L.xoff = L.isctx ? (size_t)(L.b * CTX + L.jj) * DM : (size_t)(L.b * SEQ + (L.jj - CTX)) * DM; return L; }

__device__ __forceinline__ void wave_sum2(float& a, float& b) {
    for (int o = 0; o < 1; ++o) { float ta, tb; ta = shx<1>(a); tb = shx<1>(b); a += ta; b += tb; ta = shx<2>(a); tb = shx<2>(b); a += ta; b += tb; ta = shx<4>(a); tb = shx<4>(b); a += ta; b += tb;
        ta = shx<8>(a); tb = shx<8>(b); a += ta; b += tb; ta = shx<16>(a); tb = shx<16>(b); a += ta; b += tb; a = half_sum(a); b = half_sum(b); }
}
__device__ __forceinline__ void premix_rows(ArgP a, Frame& F, const int r0  , const int stride, const int nrows  , const bool isctx) {
    bf16* HX = (bf16*)(a->ws + WS_AR + AR_MIX);
    const float* xsrc = isctx ? a->in[I_CTX] : a->in[I_X];
    f32x4 A[4], B[4], t0[4]; int curcls = -1;
    f32x4 v0[4], v1[4], n0[4], n1[4]; ld16(v0, xsrc + (size_t)r0 * DM, F.lane); ld16(v1, xsrc + (size_t)(r0 + stride) * DM, F.lane);
#pragma unroll 1
    for (int rr = 0; rr < nrows; rr += 2) {
        const int ra = r0 + rr * stride, rb = ra + stride;
        if (rr + 2 < nrows) { ld16(n0, xsrc + (size_t)(ra + 2 * stride) * DM, F.lane); ld16(n1, xsrc + (size_t)(rb + 2 * stride) * DM, F.lane); }
        const int ba = isctx ? ra / CTX : ra / SEQ, bb = isctx ? rb / CTX : rb / SEQ; const int cls = isctx ? 2 : ba;
        if (cls != curcls) { curcls = cls; ld16(A, a->in[I_NPREMIX], F.lane); ld16(t0, modv(a->ws, 0, cls, 1), F.lane); ld16(B, modv(a->ws, 0, cls, 0), F.lane);
#pragma unroll
            for (int j = 0; j < 4; ++j) A[j] = A[j] * (1.0f + t0[j]); }
        const int ua = isctx ? ba * RB + (ra - ba * CTX) : ra + CTX * (ba + 1), ub = isctx ? bb * RB + (rb - bb * CTX) : rb + CTX * (bb + 1);
        float q0 = sumsq16(v0), q1 = sumsq16(v1); wave_sum2(q0, q1);
        const float r0s = 1.0f / sqrtf(q0 * (1.0f / DM) + EPS), r1s = 1.0f / sqrtf(q1 * (1.0f / DM) + EPS);
#pragma unroll
        for (int j = 0; j < 4; ++j) { v0[j] = v0[j] * r0s * A[j] + B[j]; v1[j] = v1[j] * r1s * A[j] + B[j]; }
        if (IN_I8 & 1) { st16i8((unsigned char*)HX + (size_t)ua * DM, v0, F.lane, I8_XI); st16i8((unsigned char*)HX + (size_t)ub * DM, v1, F.lane, I8_XI); }
        else { st16b(HX + (size_t)ua * DM, v0, F.lane); st16b(HX + (size_t)ub * DM, v1, F.lane); }
#pragma unroll
        for (int j = 0; j < 4; ++j) { v0[j] = n0[j]; v1[j] = n1[j]; }
    }
}
__device__ __forceinline__ void phase_premix0(ArgP a, Frame& F) {
    const int per = NLAT / F.NGW;
    if (F.gw < NLAT) premix_rows(a, F, F.gw, F.NGW, per, false);
    for (int j = F.gw; j < 8 * NB * CTX / 2; j += F.NGW) if ((j & 7) == 0) premix_rows(a, F, (j >> 3) * 2, 1, 2, true);
}

__device__ __forceinline__ void moe_prefix(const unsigned char* ws, int (&tstart)[9], int (&cnt)[8]) {
    const unsigned* cw = (const unsigned*)(ws + WS_CTL) + CW_CNT; int s = 0;
#pragma unroll
    for (int e = 0; e < 8; ++e) { cnt[e] = (int)__builtin_amdgcn_readfirstlane(cw[64 * e]); tstart[e] = s; s += (cnt[e] + 255) >> 8; }
    tstart[8] = s;
}

template <int MODE> __device__ __forceinline__ void resid_rows(ArgP a, Frame& F, const int r0, const int stride, const int nrows, const bool isctx,
                                                               const int (&tstart)[9], int& myE0, int& myE1, float& myW0, float& myW1) {
    constexpr int l = MODE >> 1; constexpr bool post_ffn = MODE & 1;
    const bf16* SRC = (const bf16*)(a->ws + WS_AR + (MODE == 1 ? AR_YD : (MODE == 3 ? AR_YM : AR_MX)));
    bf16* H = (bf16*)(a->ws + WS_AR + (MODE == 1 ? AR_MIX : AR_HX2));
    const float* gpost = a->in[post_ffn ? I_NPOSTFFN : I_NPOSTMIX] + l * DM;
    const float* gnext = (MODE == 1) ? a->in[I_NPREMIX] + DM : a->in[I_NPREFFN] + l * DM;
    constexpr int gate_chunk = post_ffn ? 5 : 2, sc_chunk = (MODE == 1) ? 1 : 4, sh_chunk = (MODE == 1) ? 0 : 3, lnext = (MODE == 1) ? 1 : l;
    const LAS float* rts = (const LAS float*)F.lds;
    float* XC = (float*)(a->ws + WS_XC);
    const float* xin = isctx ? (MODE == 0 ? a->in[I_CTX] : (const float*)XC) : a->in[I_X];
    float* xout = isctx ? XC : a->out;
    bf16* XB = (bf16*)(a->ws + WS_XB);
    f32x4 G1[4], A2[4], B2[4], t0[4]; int curcls = -1;
#define UROW(r_) (isctx ? ((r_) / CTX) * RB + ((r_) % CTX) : (r_) + CTX * ((r_) / SEQ + 1))
    v4u tiv = (v4u){0u, 0u, 0u, 0u}; float tw0 = 0.f, tw1 = 0.f;
    if constexpr (MODE == 3) { if (F.lane < nrows) { const unsigned char* tp = a->ws + WS_TOK + (size_t)(r0 + F.lane * stride) * 32; tiv = *(const v4u*)tp; tw0 = *(const float*)(tp + 16); tw1 = *(const float*)(tp + 20); } }
    f32x4 s0[4], x0[4], s1[4], x1[4], sn0[4], xn0[4], sn1[4], xn1[4], y1[4];
#define RESID_LOAD(S_, X_, rr_) do { \
        if constexpr (MODE == 3) { const int e0 = __builtin_amdgcn_readlane((int)tiv.x, rr_), p0l = __builtin_amdgcn_readlane((int)tiv.y, rr_), e1 = __builtin_amdgcn_readlane((int)tiv.z, rr_), p1l = __builtin_amdgcn_readlane((int)tiv.w, rr_); \
            const float w0 = __builtin_bit_cast(float, __builtin_amdgcn_readlane(__builtin_bit_cast(int, tw0), rr_)), w1 = __builtin_bit_cast(float, __builtin_amdgcn_readlane(__builtin_bit_cast(int, tw1), rr_)); \
            int ts0 = 0, ts1 = 0; _Pragma("unroll") for (int e = 0; e < 8; ++e) { ts0 = (e0 == e) ? tstart[e] : ts0; ts1 = (e1 == e) ? tstart[e] : ts1; } \
            ld16b(S_, SRC + ((size_t)ts0 * 256 + p0l) * DM, F.lane); ld16b(y1, SRC + ((size_t)ts1 * 256 + p1l) * DM, F.lane); \
            _Pragma("unroll") for (int j = 0; j < 4; ++j) S_[j] = w0 * S_[j] + w1 * y1[j]; } \
        else if (isctx && (MODE == 0 || (MODE == 1 && !DENSE_DOWN_F8))) { const int cr_ = r0 + (rr_) * stride; const float* pp_ = (const float*)(a->ws + WS_AR + (MODE == 0 ? AR_PART0 : AR_PART1)) + (size_t)((cr_ >> 8) * 256 + (cr_ & 255)) * DM; \
            ld16(S_, pp_, F.lane); for (int ks_ = 1; ks_ < (MODE == 0 ? 4 : 11); ++ks_) { ld16(y1, pp_ + (size_t)ks_ * 512 * DM, F.lane); _Pragma("unroll") for (int j = 0; j < 4; ++j) S_[j] += y1[j]; } } \
        else ld16b(S_, SRC + (size_t)UROW(r0 + (rr_) * stride) * DM, F.lane); \
        if (!isctx && MODE != 0) ld16b(X_, XB + (size_t)(r0 + (rr_) * stride) * DM, F.lane); else ld16(X_, xin + (size_t)(r0 + (rr_) * stride) * DM, F.lane); } while (0)
    RESID_LOAD(s0, x0, 0); RESID_LOAD(s1, x1, 1);
#pragma unroll 1
    for (int rr = 0; rr < nrows; rr += 2) {
        if (rr + 2 < nrows) { RESID_LOAD(sn0, xn0, rr + 2); RESID_LOAD(sn1, xn1, rr + 3); }
        const int ra = r0 + rr * stride, rb = ra + stride; const int cls = isctx ? 2 : ra / SEQ;
        if (cls != curcls) { curcls = cls; ld16(G1, gpost, F.lane); ld16(t0, modv(a->ws, l, cls, gate_chunk), F.lane);
#pragma unroll
            for (int j = 0; j < 4; ++j) G1[j] = G1[j] * t0[j];
            if constexpr (MODE != 3) { ld16(A2, gnext, F.lane); ld16(t0, modv(a->ws, lnext, cls, sc_chunk), F.lane); ld16(B2, modv(a->ws, lnext, cls, sh_chunk), F.lane);
#pragma unroll
                for (int j = 0; j < 4; ++j) A2[j] = A2[j] * (1.0f + t0[j]); } }
        float q0 = sumsq16(s0), q1 = sumsq16(s1); wave_sum2(q0, q1);
        const float rs0 = 1.0f / sqrtf(q0 * (1.0f / DM) + EPS), rs1 = 1.0f / sqrtf(q1 * (1.0f / DM) + EPS);
#pragma unroll
        for (int j = 0; j < 4; ++j) { x0[j] = x0[j] + G1[j] * (s0[j] * rs0); x1[j] = x1[j] + G1[j] * (s1[j] * rs1); }
        if (!isctx && MODE != 3) { st16b(XB + (size_t)ra * DM, x0, F.lane); st16b(XB + (size_t)rb * DM, x1, F.lane); } else { st16(xout + (size_t)ra * DM, x0, F.lane); st16(xout + (size_t)rb * DM, x1, F.lane); }
        if constexpr (MODE != 3) {
            float u0 = sumsq16(x0), u1 = sumsq16(x1); wave_sum2(u0, u1);
            const float t0r = 1.0f / sqrtf(u0 * (1.0f / DM) + EPS), t1r = 1.0f / sqrtf(u1 * (1.0f / DM) + EPS);
#pragma unroll
            for (int j = 0; j < 4; ++j) { x0[j] = x0[j] * t0r * A2[j] + B2[j]; x1[j] = x1[j] * t1r * A2[j] + B2[j]; }
            if constexpr (MODE == 1 && (IN_I8 & 2)) { st16i8((unsigned char*)H + (size_t)UROW(ra) * DM, x0, F.lane, I8_XI); st16i8((unsigned char*)H + (size_t)UROW(rb) * DM, x1, F.lane, I8_XI); }
            else if constexpr (MODE == 2 && MOE_F8 && MOE_I8UP) { st16i8((unsigned char*)H + (size_t)ra * DM, x0, F.lane); st16i8((unsigned char*)H + (size_t)rb * DM, x1, F.lane); }
            else if constexpr (MODE == 0 && DENSE_I8UP && !DENSE_F8) { st16i8((unsigned char*)H + (size_t)UROW(ra) * DM, x0, F.lane); st16i8((unsigned char*)H + (size_t)UROW(rb) * DM, x1, F.lane); }
            else if constexpr ((MODE == 1 && !IN1_F8) || (MODE == 0 && !DENSE_F8) || (MODE == 2 && !MOE_F8)) { st16b(H + (size_t)(MODE == 2 ? ra : UROW(ra)) * DM, x0, F.lane); st16b(H + (size_t)(MODE == 2 ? rb : UROW(rb)) * DM, x1, F.lane); }
            else { st16f8((unsigned char*)H + (size_t)(MODE == 2 ? ra : UROW(ra)) * DM, x0, F.lane); st16f8((unsigned char*)H + (size_t)(MODE == 2 ? rb : UROW(rb)) * DM, x1, F.lane); }
            if constexpr (MODE == 2) {
                asm volatile("" ::: "memory");
                float lgA[8], lgB[8];
#pragma unroll
                for (int e = 0; e < 8; ++e) { float pA = 0.f, pB = 0.f;
#pragma unroll
                    for (int j = 0; j < 4; ++j) { const f32x4 rv = *(const LAS f32x4*)(rts + e * 1024 + ROWCOL(j) + 8 * F.lane);
                        pA += (x0[j][0] * rv[0] + x0[j][1] * rv[1]) + (x0[j][2] * rv[2] + x0[j][3] * rv[3]); pB += (x1[j][0] * rv[0] + x1[j][1] * rv[1]) + (x1[j][2] * rv[2] + x1[j][3] * rv[3]); }
                    wave_sum2(pA, pB); lgA[e] = pA; lgB[e] = pB; }
#define TOP2(lg, rrow) do { int i0 = 0; float v0 = lg[0]; _Pragma("unroll") for (int e = 1; e < 8; ++e) if (lg[e] > v0) { v0 = lg[e]; i0 = e; } \
                    int i1 = -1; float v1 = -INFINITY; _Pragma("unroll") for (int e = 0; e < 8; ++e) if (e != i0 && lg[e] > v1) { v1 = lg[e]; i1 = e; } \
                    const float w0 = 1.0f / (1.0f + __expf(v1 - v0)); if (F.lane == (rrow)) { myE0 = i0; myE1 = i1; myW0 = w0; myW1 = 1.0f - w0; } } while (0)
                TOP2(lgA, rr); TOP2(lgB, rr + 1);
#undef TOP2
            }
        }
#pragma unroll
        for (int j = 0; j < 4; ++j) { s0[j] = sn0[j]; x0[j] = xn0[j]; s1[j] = sn1[j]; x1[j] = xn1[j]; }
    }
#undef RESID_LOAD
#undef UROW
}
template <int MODE> __device__ __forceinline__ void phase_resid(ArgP a, Frame& F) {
    float* XC = (float*)(a->ws + WS_XC);
    int tstart[9], ecnt[8];
    if constexpr (MODE == 3) moe_prefix(a->ws, tstart, ecnt); else {
#pragma unroll
        for (int e = 0; e < 9; ++e) tstart[e] = 0; }
    int myE0 = -1, myE1 = -1; float myW0 = 0.f, myW1 = 0.f;
    if constexpr (MODE < 2) {
        if (F.gw < NLAT) resid_rows<MODE>(a, F, F.gw, F.NGW, NLAT / F.NGW, false, tstart, myE0, myE1, myW0, myW1);
        for (int j = F.gw; j < 8 * NB * CTX / 2; j += F.NGW) if ((j & 7) == 0) resid_rows<MODE>(a, F, (j >> 3) * 2, 1, 2, true, tstart, myE0, myE1, myW0, myW1);
    } else {
        LAS float* rts = (LAS float*)F.lds;
        LAS int* wcnt = (LAS int*)(F.lds + 32768);
        LAS int* bbase = (LAS int*)(F.lds + 32768 + 256);
        if constexpr (MODE == 2) { for (int i = F.tid; i < 8192; i += 512) { const int k = i >> 3, e = i & 7; rts[e * 1024 + k] = a->in[I_ROUTER][i]; } __syncthreads(); }
        const int per = NLAT / F.NGW;
        for (int rd = 0; rd < 1; ++rd) {
            const bool active = F.gw < NLAT;
            myE0 = -1; myE1 = -1;
            if (active) resid_rows<MODE>(a, F, F.gw, F.NGW, per, false, tstart, myE0, myE1, myW0, myW1);
            if constexpr (MODE == 2) {
                int tid2 = F.tid; asm volatile("" : "+v"(tid2)); const int lane2 = tid2 & 63;
                if (lane2 < 8) wcnt[F.wave * 8 + lane2] = 0;
                LDS_WAIT();
                int r0 = 0, r1 = 0;
                if (active && lane2 < per) { r0 = __hip_atomic_fetch_add(wcnt + F.wave * 8 + myE0, 1, __ATOMIC_RELAXED, __HIP_MEMORY_SCOPE_WORKGROUP); r1 = __hip_atomic_fetch_add(wcnt + F.wave * 8 + myE1, 1, __ATOMIC_RELAXED, __HIP_MEMORY_SCOPE_WORKGROUP); }
                __syncthreads();
                if (tid2 < 8) { int tot = 0; for (int w = 0; w < 8; ++w) tot += wcnt[w * 8 + tid2];
                    int base = 0; if (tot > 0) base = (int)__hip_atomic_fetch_add((unsigned*)(a->ws + WS_CTL) + CW_CNT + 64 * tid2, (unsigned)tot, RLX_AGENT);
                    bbase[tid2] = base; }
                __syncthreads();
                if (active && lane2 < per) {
                    int wb0 = bbase[myE0], wb1 = bbase[myE1];
                    for (int w = 0; w < F.wave; ++w) { wb0 += wcnt[w * 8 + myE0]; wb1 += wcnt[w * 8 + myE1]; }
                    const int lp0 = wb0 + r0, lp1 = wb1 + r1;
                    const int tk = F.gw + lane2 * F.NGW; int* lists = (int*)(a->ws + WS_LIST);
                    lists[myE0 * LISTCAP + lp0] = tk; lists[myE1 * LISTCAP + lp1] = tk;
                    v4u ti; ti.x = (unsigned)myE0; ti.y = (unsigned)lp0; ti.z = (unsigned)myE1; ti.w = (unsigned)lp1;
                    *(v4u*)(a->ws + WS_TOK + (size_t)tk * 32) = ti; *(float*)(a->ws + WS_TOK + (size_t)tk * 32 + 16) = myW0; *(float*)(a->ws + WS_TOK + (size_t)tk * 32 + 20) = myW1;
                }
                __syncthreads();
            }
        }
    }
}
typedef float f32x16v __attribute__((ext_vector_type(16)));
__device__ __forceinline__ int crow32(int r, int hi) { return (r & 3) + 8 * (r >> 2) + 4 * hi; }
__device__ __forceinline__ int chain_id(int b, int h, int dir) { return (b * 4 + h) * 2 + dir; }

__device__ __forceinline__ void phase_prep(ArgP a, Frame& F, int l) {
    const bf16* P = (const bf16*)(a->ws + WS_AR + AR_P);
    bf16* QB = (bf16*)(a->ws + WS_AR + AR_QB); bf16* KC = (bf16*)(a->ws + WS_AR + AR_KC); bf16* VC = (bf16*)(a->ws + WS_AR + AR_VC);
    unsigned char* Q8 = q8_ptr(a); unsigned char* K8 = k8_ptr(a); unsigned char* V8 = v8_ptr(a);
    const float* ropec = (const float*)(a->ws + WS_ROPE); const float* ropes = ropec + 4096;
    {
        const int rr = F.lane >> 3, c = F.lane & 7;
        float gq[8], gk[8];
#pragma unroll
        for (int j = 0; j < 8; ++j) { gq[j] = a->in[I_QN][l * 64 + 8 * c + j]; gk[j] = a->in[I_KN][l * 64 + 8 * c + j]; }
        for (int it = F.gw; it < NR / 8; it += F.NGW) {
            const int row = it * 8 + rr; const int b = row / RB, jj = row - b * RB; const bool lat = jj >= CTX; const int t = jj - CTX;
            float cs[8], sn[8];
            if (lat) { const int pos = (c < 4) ? (t >> 6) : (t & 63); const int fi = 8 * (c & 1);
#pragma unroll
                for (int j = 0; j < 8; ++j) { cs[j] = ropec[pos * 16 + fi + j]; sn[j] = ropes[pos * 16 + fi + j]; } }
            else {
#pragma unroll
                for (int j = 0; j < 8; ++j) { cs[j] = 1.f; sn[j] = 0.f; } }
            const float sgn = (c & 2) ? 1.f : -1.f;
            const bf16* prow = P + (size_t)row * INW;
#pragma unroll 2
            for (int hs = 0; hs < 10; ++hs) {
                const v4u u = *(const v4u*)(prow + hs * 64 + 8 * c);
                float x[8] = {bf_lo(u.x), bf_hi(u.x), bf_lo(u.y), bf_hi(u.y), bf_lo(u.z), bf_hi(u.z), bf_lo(u.w), bf_hi(u.w)};
                float ss = 0.f;
#pragma unroll
                for (int j = 0; j < 8; ++j) ss += x[j] * x[j];
                ss += shx<1>(ss); ss += shx<2>(ss); ss += shx<4>(ss);
                const float rstd = 1.0f / sqrtf(ss * (1.0f / 64.0f) + EPS);
                float y[8];
#pragma unroll
                for (int j = 0; j < 8; ++j) { y[j] = x[j] * rstd * (hs < 8 ? gq[j] : gk[j]); }
#pragma unroll
                for (int j = 0; j < 8; ++j) { const float p = shx<2>(y[j]); x[j] = y[j] * cs[j] + sgn * p * sn[j]; }
                const float sc = (hs < 8) ? attn_body::C2 : 1.0f;
#if ATT8_DEBUG
                { v4u o; o.x = pkbf(x[0] * sc, x[1] * sc); o.y = pkbf(x[2] * sc, x[3] * sc); o.z = pkbf(x[4] * sc, x[5] * sc); o.w = pkbf(x[6] * sc, x[7] * sc);
                if (hs < 8) *(v4u*)(QB + (size_t)row * 512 + hs * 64 + 8 * c) = o;
                else *(v4u*)(KC + ((size_t)(b * 2 + (hs - 8)) * RB + jj) * 64 + 8 * c) = o; }
#endif
                { const float s8 = (hs < 8) ? 4.0f * sc : sc;
                  v2u o8; o8.x = fp8x4(x[0] * s8, x[1] * s8, x[2] * s8, x[3] * s8); o8.y = fp8x4(x[4] * s8, x[5] * s8, x[6] * s8, x[7] * s8);
                if (hs < 8) *(v2u*)(Q8 + (size_t)row * 512 + hs * 64 + 8 * c) = o8;
                else *(v2u*)(K8 + ((size_t)((b * 2 + (hs - 8)) * (RB / 64) + (jj >> 6))) * 4096 + (c >> 1) * 1024 + (jj & 63) * 16 + 8 * (c & 1)) = o8; }
            }
#if ATT8_DEBUG
#pragma unroll
            for (int kv = 0; kv < 2; ++kv) *(v4u*)(VC + ((size_t)(b * 2 + kv) * RB + jj) * 64 + 8 * c) = *(const v4u*)(prow + PC_V + kv * 64 + 8 * c);
#endif
        }
    }
    for (int it = F.gw; it < NR / 32; it += F.NGW) {
        const int b = it / (RB / 32), g = it - b * (RB / 32), tile = g >> 1, c2 = g & 1, kv = F.lane >> 5, kg = (F.lane >> 4) & 1, d4 = F.lane & 15;
        const bf16* src = P + (size_t)(b * RB + 32 * g + 4 * kg) * INW + PC_V + kv * 64 + 4 * d4;
        v2u u[16];
#pragma unroll
        for (int j = 0; j < 16; ++j) u[j] = *(const v2u*)(src + (size_t)((j & 3) + 8 * (j >> 2)) * INW);
        unsigned char* dst = V8 + ((size_t)((b * 2 + kv) * (RB / 64) + tile)) * 4096 + ((kg * 2 + c2) * 64 + 4 * d4) * 16;
        v4u o0, o1, o2, o3;
        o0.x = fp8x4(bf_lo(u[0].x), bf_lo(u[1].x), bf_lo(u[2].x), bf_lo(u[3].x)); o0.y = fp8x4(bf_lo(u[4].x), bf_lo(u[5].x), bf_lo(u[6].x), bf_lo(u[7].x)); o0.z = fp8x4(bf_lo(u[8].x), bf_lo(u[9].x), bf_lo(u[10].x), bf_lo(u[11].x)); o0.w = fp8x4(bf_lo(u[12].x), bf_lo(u[13].x), bf_lo(u[14].x), bf_lo(u[15].x));
        o1.x = fp8x4(bf_hi(u[0].x), bf_hi(u[1].x), bf_hi(u[2].x), bf_hi(u[3].x)); o1.y = fp8x4(bf_hi(u[4].x), bf_hi(u[5].x), bf_hi(u[6].x), bf_hi(u[7].x)); o1.z = fp8x4(bf_hi(u[8].x), bf_hi(u[9].x), bf_hi(u[10].x), bf_hi(u[11].x)); o1.w = fp8x4(bf_hi(u[12].x), bf_hi(u[13].x), bf_hi(u[14].x), bf_hi(u[15].x));
        o2.x = fp8x4(bf_lo(u[0].y), bf_lo(u[1].y), bf_lo(u[2].y), bf_lo(u[3].y)); o2.y = fp8x4(bf_lo(u[4].y), bf_lo(u[5].y), bf_lo(u[6].y), bf_lo(u[7].y)); o2.z = fp8x4(bf_lo(u[8].y), bf_lo(u[9].y), bf_lo(u[10].y), bf_lo(u[11].y)); o2.w = fp8x4(bf_lo(u[12].y), bf_lo(u[13].y), bf_lo(u[14].y), bf_lo(u[15].y));
        o3.x = fp8x4(bf_hi(u[0].y), bf_hi(u[1].y), bf_hi(u[2].y), bf_hi(u[3].y)); o3.y = fp8x4(bf_hi(u[4].y), bf_hi(u[5].y), bf_hi(u[6].y), bf_hi(u[7].y)); o3.z = fp8x4(bf_hi(u[8].y), bf_hi(u[9].y), bf_hi(u[10].y), bf_hi(u[11].y)); o3.w = fp8x4(bf_hi(u[12].y), bf_hi(u[13].y), bf_hi(u[14].y), bf_hi(u[15].y));
        *(v4u*)(dst) = o0; *(v4u*)(dst + 16) = o1; *(v4u*)(dst + 32) = o2; *(v4u*)(dst + 48) = o3;
    }
    __syncthreads();
    typedef short bf16x8_t __attribute__((ext_vector_type(8)));
    LAS unsigned char* VT = F.lds; LAS unsigned char* KTf = F.lds + 17536; LAS unsigned char* KTb = F.lds + 2 * 17536;
    float* US = (float*)(a->ws + WS_AR + AR_US);
    for (int it = F.bx; it < NB * 4 * NCH; it += F.G) {
        const int c = it % NCH, bh = it / NCH, b = bh >> 2, h = bh & 3;
        const float lgf = ((const float*)(a->ws + WS_DEC))[l * 8 + h], lgb = ((const float*)(a->ws + WS_DEC))[l * 8 + 4 + h];
        { const int p = F.tid >> 2, sg = F.tid & 3; const bf16* prow = P + (size_t)(b * RB + c * 128 + p) * INW;
            const float zf = __expf(lgf * (float)(127 - p)) * 0.125f, zb = __expf(lgb * (float)p) * 0.125f;
#pragma unroll
            for (int q = 0; q < 2; ++q) { const v4u uk = *(const v4u*)(prow + PC_RK + h * 64 + sg * 16 + q * 8), uv = *(const v4u*)(prow + PC_RV + h * 64 + sg * 16 + q * 8);
                const unsigned kw[4] = {uk.x, uk.y, uk.z, uk.w}, vw[4] = {uv.x, uv.y, uv.z, uv.w};
#pragma unroll
                for (int i = 0; i < 8; ++i) { const int ch = sg * 16 + q * 8 + i; const int off = ch * 272 + sg * 32 + 2 * p;
                    const unsigned kwv = kw[i >> 1], vwv = vw[i >> 1]; const float kf = (i & 1) ? bf_hi(kwv) : bf_lo(kwv);
                    *(LAS bf16*)(VT + off) = (bf16)((i & 1) ? (vwv >> 16) : (vwv & 0xffffu));
                    *(LAS bf16*)(KTf + off) = (bf16)(pkbf(kf * zf, 0.f) & 0xffffu); *(LAS bf16*)(KTb + off) = (bf16)(pkbf(kf * zb, 0.f) & 0xffffu); } } }
        __syncthreads();
        { const int dir = F.wave >> 2, di = (F.wave >> 1) & 1, ei = F.wave & 1, r32 = F.lane & 31, hh = F.lane >> 5;
            f32x16v acc; { const float z = pg8::zero_v(); _Pragma("unroll") for (int r = 0; r < 16; ++r) acc[r] = z; }
            const int erow = 32 * ei + r32, drow = 32 * di + r32;
            const LAS unsigned char* ap = VT + erow * 272 + (erow >> 4) * 32 + 16 * hh; const LAS unsigned char* bp = (dir ? KTb : KTf) + drow * 272 + (drow >> 4) * 32 + 16 * hh;
#pragma unroll
            for (int s8 = 0; s8 < 8; ++s8) { const bf16x8_t av = *(const LAS bf16x8_t*)(ap + 32 * s8), bv = *(const LAS bf16x8_t*)(bp + 32 * s8);
                acc = __builtin_amdgcn_mfma_f32_32x32x16_bf16(av, bv, acc, 0, 0, 0); }
            float* dst = US + ((size_t)(chain_id(b, h, dir) * NCH + c)) * 4096;
#pragma unroll
            for (int r = 0; r < 16; ++r) dst[(32 * ei + crow32(r, hh)) * 64 + 32 * di + r32] = acc[r]; }
        __syncthreads();
    }
}

__device__ __forceinline__ void phase_scan(ArgP a, Frame& F, int l) {
    float* US = (float*)(a->ws + WS_AR + AR_US);
    if (F.tid < 256) {
        for (int id = F.bx * 256 + F.tid; id < 16 * 4096; id += F.G * 256) {
            const int chain = id >> 12, e = id & 4095, dir = chain & 1, h = (chain >> 1) & 3;
            const float dec = ((const float*)(a->ws + WS_DEC))[16 + l * 8 + dir * 4 + h];
            const float* base = US + (size_t)chain * NCH * 4096 + e; float st = 0.f;
            bf16* sb = (bf16*)(a->ws + WS_AR + AR_MX) + (size_t)chain * NCH * 4096 + e;
            for (int s0 = 0; s0 < NCH; s0 += 10) { float u[10]; int ci[10];
#pragma unroll
                for (int q = 0; q < 10; ++q) { const int s = s0 + q; ci[q] = dir == 0 ? s : (s < 2 ? 1 - s : NCH + 1 - s); u[q] = base[(size_t)ci[q] * 4096]; }
#pragma unroll
                for (int q = 0; q < 10; ++q) { sb[(size_t)ci[q] * 4096] = (bf16)(pkbf(st, 0.f) & 0xffffu); st = dec * st + u[q]; } }
        }
    }
}

__device__ __forceinline__ void ret_out_item(ArgP a, Frame& F, int l, int b, int c, int hp, int buf) {
    typedef short bf16x8_t __attribute__((ext_vector_type(8)));
    const bf16* P = (const bf16*)(a->ws + WS_AR + AR_P); bf16* MIX = (bf16*)(a->ws + WS_AR + AR_MIX);
    LAS bf16* VT = (LAS bf16*)(F.lds + buf * 34816);
    const int hl = F.wave >> 2, head = 2 * hp + hl, pi = F.wave & 3, r32 = F.lane & 31, hh = F.lane >> 5;
    const int row0 = b * RB + c * 128;
    { const int m = F.tid >> 2, qd = F.tid & 3; const bf16* src = P + (size_t)(row0 + m) * INW + PC_RV + (2 * hp) * 64 + 32 * qd;
        LAS bf16* dst = VT + (size_t)((qd >> 1) * 64 + 32 * (qd & 1)) * 132 + m;
#pragma unroll
        for (int q = 0; q < 4; ++q) { const v4u u = *(const v4u*)(src + 8 * q);
            dst[(8 * q + 0) * 132] = (bf16)(u.x & 0xffffu); dst[(8 * q + 1) * 132] = (bf16)(u.x >> 16); dst[(8 * q + 2) * 132] = (bf16)(u.y & 0xffffu); dst[(8 * q + 3) * 132] = (bf16)(u.y >> 16);
            dst[(8 * q + 4) * 132] = (bf16)(u.z & 0xffffu); dst[(8 * q + 5) * 132] = (bf16)(u.z >> 16); dst[(8 * q + 6) * 132] = (bf16)(u.w & 0xffffu); dst[(8 * q + 7) * 132] = (bf16)(u.w >> 16); } }
    bf16x8_t qf[4], kf[4][4];
    { const bf16* qrow = P + (size_t)(row0 + 32 * pi + r32) * INW + PC_RQ + head * 64 + 8 * hh;
#pragma unroll
        for (int d0 = 0; d0 < 4; ++d0) qf[d0] = *(const bf16x8_t*)(qrow + 16 * d0);
#pragma unroll
        for (int mb = 0; mb < 4; ++mb) { const bf16* krow = P + (size_t)(row0 + 32 * mb + r32) * INW + PC_RK + head * 64 + 8 * hh;
#pragma unroll
            for (int d0 = 0; d0 < 4; ++d0) kf[mb][d0] = *(const bf16x8_t*)(krow + 16 * d0); } }
    const float L2E = 1.4426950408889634f;
    const float lgf2 = ((const float*)(a->ws + WS_DEC))[l * 8 + head] * L2E, lgb2 = ((const float*)(a->ws + WS_DEC))[l * 8 + 4 + head] * L2E;
    int p = 32 * pi + r32; asm volatile("" : "+v"(p));
    bf16x8_t pk[8];
#pragma unroll
    for (int mb = 0; mb < 4; ++mb) {
        f32x16v st; { const float z = pg8::zero_v(); _Pragma("unroll") for (int r = 0; r < 16; ++r) st[r] = z; }
#pragma unroll
        for (int d0 = 0; d0 < 4; ++d0) st = __builtin_amdgcn_mfma_f32_32x32x16_bf16(kf[mb][d0], qf[d0], st, 0, 0, 0);
#pragma unroll
        for (int r = 0; r < 16; ++r) { const float fd = (float)(p - (32 * mb + crow32(r, hh)));
            const float arg = lgf2 * fmaxf(fd, 0.f) + lgb2 * fmaxf(-fd, 0.f) + fmaxf(1.0f - fabsf(fd), 0.f) - 3.0f;
            st[r] = st[r] * __builtin_amdgcn_exp2f(arg); }
        v4u w0, w1; w0.x = pkbf(st[0], st[1]); w0.y = pkbf(st[2], st[3]); w0.z = pkbf(st[4], st[5]); w0.w = pkbf(st[6], st[7]);
        w1.x = pkbf(st[8], st[9]); w1.y = pkbf(st[10], st[11]); w1.z = pkbf(st[12], st[13]); w1.w = pkbf(st[14], st[15]);
        pk[2 * mb] = __builtin_bit_cast(bf16x8_t, w0); pk[2 * mb + 1] = __builtin_bit_cast(bf16x8_t, w1);
    }
    __builtin_amdgcn_sched_barrier(0);
    const float ef = __builtin_amdgcn_exp2f(lgf2 * (float)(p + 1)), ebk = __builtin_amdgcn_exp2f(lgb2 * (float)(128 - p));
    f32x16v ot[2];
    { const float z = pg8::zero_v(); _Pragma("unroll") for (int r = 0; r < 16; ++r) { ot[0][r] = z; ot[1][r] = z; } }
    { const bf16* SB = (const bf16*)(a->ws + WS_AR + AR_MX);
      const bf16* Sf = SB + ((size_t)(chain_id(b, head, 0) * NCH + c)) * 4096; const bf16* Sb = SB + ((size_t)(chain_id(b, head, 1) * NCH + c)) * 4096;
#pragma unroll
        for (int s4 = 0; s4 < 4; ++s4) {
            const v4u qu = __builtin_bit_cast(v4u, qf[s4]); v4u qa, qb;
            qa.x = pkbf(bf_lo(qu.x) * ef, bf_hi(qu.x) * ef); qa.y = pkbf(bf_lo(qu.y) * ef, bf_hi(qu.y) * ef); qa.z = pkbf(bf_lo(qu.z) * ef, bf_hi(qu.z) * ef); qa.w = pkbf(bf_lo(qu.w) * ef, bf_hi(qu.w) * ef);
            qb.x = pkbf(bf_lo(qu.x) * ebk, bf_hi(qu.x) * ebk); qb.y = pkbf(bf_lo(qu.y) * ebk, bf_hi(qu.y) * ebk); qb.z = pkbf(bf_lo(qu.z) * ebk, bf_hi(qu.z) * ebk); qb.w = pkbf(bf_lo(qu.w) * ebk, bf_hi(qu.w) * ebk);
#pragma unroll
            for (int eb = 0; eb < 2; ++eb) { const int off = (32 * eb + r32) * 64 + 16 * s4 + 8 * hh;
                const bf16x8_t wf = *(const bf16x8_t*)(Sf + off), wb = *(const bf16x8_t*)(Sb + off);
                ot[eb] = __builtin_amdgcn_mfma_f32_32x32x16_bf16(wf, __builtin_bit_cast(bf16x8_t, qa), ot[eb], 0, 0, 0);
                ot[eb] = __builtin_amdgcn_mfma_f32_32x32x16_bf16(wb, __builtin_bit_cast(bf16x8_t, qb), ot[eb], 0, 0, 0); } } }
    __builtin_amdgcn_sched_barrier(0);
    __syncthreads();
    { const LAS bf16* vrow = VT + (size_t)(hl * 64 + r32) * 132 + 4 * hh;
#pragma unroll
        for (int eb = 0; eb < 2; ++eb)
#pragma unroll
            for (int sg = 0; sg < 8; ++sg) { const LAS bf16* vp = vrow + (size_t)(32 * eb) * 132 + 16 * sg;
                const v2u lo = *(const LAS v2u*)vp, hi = *(const LAS v2u*)(vp + 8);
                const v4u av = (v4u){lo.x, lo.y, hi.x, hi.y};
                ot[eb] = __builtin_amdgcn_mfma_f32_32x32x16_bf16(__builtin_bit_cast(bf16x8_t, av), pk[sg], ot[eb], 0, 0, 0); } }
    __builtin_amdgcn_sched_barrier(0);
    float s1 = 0.f, s2 = 0.f;
#pragma unroll
    for (int eb = 0; eb < 2; ++eb)
#pragma unroll
        for (int r = 0; r < 16; ++r) { const float v = ot[eb][r]; s1 += v; s2 += v * v; }
    { auto rr = __builtin_amdgcn_permlane32_swap(__float_as_uint(s1), __float_as_uint(s1), false, false); s1 = __uint_as_float(rr[0]) + __uint_as_float(rr[1]); }
    { auto rr = __builtin_amdgcn_permlane32_swap(__float_as_uint(s2), __float_as_uint(s2), false, false); s2 = __uint_as_float(rr[0]) + __uint_as_float(rr[1]); }
    const float mu = s1 * (1.0f / 64.0f); const float var = fmaxf(s2 * (1.0f / 64.0f) - mu * mu, 0.f); const float rstd = 1.0f / sqrtf(var + EPS);
    const size_t orow = (size_t)(row0 + p);
#pragma unroll
    for (int eb = 0; eb < 2; ++eb)
#pragma unroll
        for (int g = 0; g < 4; ++g) { const int e0 = 32 * eb + 8 * g + 4 * hh;
            const v2u gu = *(const v2u*)(P + orow * INW + PC_RG + head * 64 + e0);
            const float g0 = bf_lo(gu.x), g1 = bf_hi(gu.x), g2 = bf_lo(gu.y), g3 = bf_hi(gu.y);
            v2u w; w.x = pkbf(siluf(g0) * ((ot[eb][4 * g] - mu) * rstd), siluf(g1) * ((ot[eb][4 * g + 1] - mu) * rstd)); w.y = pkbf(siluf(g2) * ((ot[eb][4 * g + 2] - mu) * rstd), siluf(g3) * ((ot[eb][4 * g + 3] - mu) * rstd));
            *(v2u*)(MIX + orow * DM + 512 + head * 64 + e0) = w; }
}
__device__ __forceinline__ void pool_item(ArgP a, Frame& F, int l, int b, int tl, int g) {
    typedef short bf16x8_t __attribute__((ext_vector_type(8)));
    const bf16* P = (const bf16*)(a->ws + WS_AR + AR_P); bf16* MIX = (bf16*)(a->ws + WS_AR + AR_MIX);
    LAS bf16* msb = (LAS bf16*)F.lds;
    LAS bf16* wt = (LAS bf16*)(F.lds + 18432);
    LAS bf16* ost = (LAS bf16*)(F.lds + 18432 + 9216);
    const int sb = (tl < 2) ? 0 : CTX, T = (tl < 2) ? CTX : SEQ, hw = 1 << g  ;
    { const int d = F.tid & 63, cq = F.tid >> 6; const float* W = a->in[I_POOLW] + ((size_t)(l * 4 + g)) * 4096 + d;
        v4u o; o.x = pkbf(W[(8 * cq + 0) * 64], W[(8 * cq + 1) * 64]); o.y = pkbf(W[(8 * cq + 2) * 64], W[(8 * cq + 3) * 64]); o.z = pkbf(W[(8 * cq + 4) * 64], W[(8 * cq + 5) * 64]); o.w = pkbf(W[(8 * cq + 6) * 64], W[(8 * cq + 7) * 64]);
        *(LAS v4u*)(wt + d * 72 + 8 * cq) = o; }
    { const int p = F.tid >> 2, qd = F.tid & 3; const int t = tl * 128 - sb + p; const int lo = max(t - hw, 0), hi = min(t + hw, T);
        float acc[16];
#pragma unroll
        for (int e = 0; e < 16; ++e) acc[e] = 0.f;
        const bf16* colp = P + (size_t)(b * RB + sb) * INW + PC_PP + g * 64 + 16 * qd;
        for (int tt = lo; tt < hi; ++tt) { const v4u u0 = *(const v4u*)(colp + (size_t)tt * INW), u1 = *(const v4u*)(colp + (size_t)tt * INW + 8);
            acc[0] += bf_lo(u0.x); acc[1] += bf_hi(u0.x); acc[2] += bf_lo(u0.y); acc[3] += bf_hi(u0.y); acc[4] += bf_lo(u0.z); acc[5] += bf_hi(u0.z); acc[6] += bf_lo(u0.w); acc[7] += bf_hi(u0.w);
            acc[8] += bf_lo(u1.x); acc[9] += bf_hi(u1.x); acc[10] += bf_lo(u1.y); acc[11] += bf_hi(u1.y); acc[12] += bf_lo(u1.z); acc[13] += bf_hi(u1.z); acc[14] += bf_lo(u1.w); acc[15] += bf_hi(u1.w); }
        const v4u s0 = *(const v4u*)(colp + (size_t)t * INW), s1 = *(const v4u*)(colp + (size_t)t * INW + 8);
        const float sf[16] = {bf_lo(s0.x), bf_hi(s0.x), bf_lo(s0.y), bf_hi(s0.y), bf_lo(s0.z), bf_hi(s0.z), bf_lo(s0.w), bf_hi(s0.w), bf_lo(s1.x), bf_hi(s1.x), bf_lo(s1.y), bf_hi(s1.y), bf_lo(s1.z), bf_hi(s1.z), bf_lo(s1.w), bf_hi(s1.w)};
        const float inv = 1.0f / (float)(hi - lo);
        float m[16];
#pragma unroll
        for (int e = 0; e < 16; ++e) m[e] = acc[e] * inv - sf[e];
        v4u o0, o1; o0.x = pkbf(m[0], m[1]); o0.y = pkbf(m[2], m[3]); o0.z = pkbf(m[4], m[5]); o0.w = pkbf(m[6], m[7]); o1.x = pkbf(m[8], m[9]); o1.y = pkbf(m[10], m[11]); o1.z = pkbf(m[12], m[13]); o1.w = pkbf(m[14], m[15]);
        *(LAS v4u*)(msb + p * 72 + 16 * qd) = o0; *(LAS v4u*)(msb + p * 72 + 16 * qd + 8) = o1; }
    __syncthreads();
    { const int pi = F.wave >> 1, di = F.wave & 1, i = F.lane & 31, kk = F.lane >> 5; f32x16v o; { const float z = pg8::zero_v(); _Pragma("unroll") for (int r = 0; r < 16; ++r) o[r] = z; }
        const LAS bf16* ap = msb + (32 * pi + i) * 72 + 8 * kk; const LAS bf16* bp = wt + (32 * di + i) * 72 + 8 * kk;
#pragma unroll
        for (int s4 = 0; s4 < 4; ++s4) o = __builtin_amdgcn_mfma_f32_32x32x16_bf16(*(const LAS bf16x8_t*)(ap + 16 * s4), *(const LAS bf16x8_t*)(bp + 16 * s4), o, 0, 0, 0);
        const float scl = a->in[I_POOLS][l * 256 + g * 64 + 32 * di + i];
#pragma unroll
        for (int r = 0; r < 16; ++r) ost[(32 * pi + crow32(r, kk)) * 72 + 32 * di + i] = (bf16)(pkbf(o[r] * scl, 0.f) & 0xffffu); }
    __syncthreads();
    { bf16* obase = MIX + (size_t)(b * RB + tl * 128) * DM + 768 + g * 64;
#pragma unroll
        for (int k = 0; k < 2; ++k) { const int idx = F.tid + 512 * k, row = idx >> 3, ch = idx & 7; *(v4u*)(obase + (size_t)row * DM + 8 * ch) = *(const LAS v4u*)(ost + row * 72 + 8 * ch); } }
    __syncthreads();
}
__device__ __forceinline__ void phase_mix(ArgP a, Frame& F, int l, int vcu) {
    { int nb = 0;
      for (int it = F.bx; it < NB * NCH * 2; it += F.G) { const int hp = it & 1, r = it >> 1, c = r % NCH, b = r / NCH;
          if (l == 1 && c < 2) continue;
          ret_out_item(a, F, l, b, c, hp, nb & 1); ++nb; }
      __syncthreads(); }
    for (int it = (F.bx + F.G - 16) % F.G; it < NB * 4 * NCH; it += F.G) { const int c = it % NCH, bh = it / NCH, b = bh >> 2, hg = bh & 3;
        if (l == 1 && c < 2) continue;
        pool_item(a, F, l, b, c, hg); }
    const bf16* QBp = (const bf16*)(a->ws + WS_AR + AR_QB); const bf16* KC = (const bf16*)(a->ws + WS_AR + AR_KC); const bf16* VC = (const bf16*)(a->ws + WS_AR + AR_VC); bf16* MIX = (bf16*)(a->ws + WS_AR + AR_MIX);
    const unsigned char* Q8 = q8_ptr(a); const unsigned char* K8 = k8_ptr(a); const unsigned char* V8 = v8_ptr(a);
    const int NU = NB * 8 * (SEQ / 256);
    float mref;
    { float gq = fabsf(a->in[I_QN][l * 64 + F.lane]), gk = fabsf(a->in[I_KN][l * 64 + F.lane]);
#pragma unroll
      for (int o = 0; o < 1; ++o) { gq = fmaxf(gq, shx<1>(gq)); gk = fmaxf(gk, shx<1>(gk)); gq = fmaxf(gq, shx<2>(gq)); gk = fmaxf(gk, shx<2>(gk)); gq = fmaxf(gq, shx<4>(gq)); gk = fmaxf(gk, shx<4>(gk));
          gq = fmaxf(gq, shx<8>(gq)); gk = fmaxf(gk, shx<8>(gk)); gq = fmaxf(gq, shx<16>(gq)); gk = fmaxf(gk, shx<16>(gk)); gq = half_max(gq); gk = half_max(gk); }
      mref = fminf(64.0f * gq * gk * attn_body::C2 * 1.01f + 0.125f, 64.0f); mref = __builtin_amdgcn_readfirstlane(mref); }
    for (int i = 0; ; ++i) {
        int u;
        if (F.G == 256) { if (i >= 4) break; const int x = vcu >> 5, cu = vcu & 31; const int grp = x >> 1; u = grp * 256 + (x & 1) * 128 + cu * 4 + i; }
        else { u = F.bx + i * F.G; if (u >= NU) break; }
        const int grp = u >> 8, w = u & 255, b = grp >> 1, kvh = grp & 1, hd = kvh * 4 + (w >> 6), qb = w & 63;
        const size_t qrow = (size_t)b * RB + CTX + qb * 256;
#if ATT8_DEBUG
        attn_body::attn_unit(F.tid, mref, (const attn_body::bf16*)(QBp + qrow * 512 + hd * 64), 512, (const attn_body::bf16*)(KC + (size_t)(b * 2 + kvh) * RB * 64), (const attn_body::bf16*)(VC + (size_t)(b * 2 + kvh) * RB * 64), RB / 64,
                                (attn_body::bf16*)(MIX + qrow * DM + hd * 64), DM, (char*)F.lds);
        attn_body::attn_unit8(F.tid, mref, Q8 + qrow * 512 + hd * 64, 512, K8 + (size_t)(b * 2 + kvh) * (RB / 64) * 4096, V8 + (size_t)(b * 2 + kvh) * (RB / 64) * 4096, RB / 64,
                                (attn_body::bf16*)((bf16*)(a->ws + WS_AR + DO_O8) + qrow * 512 + hd * 64), 512, (char*)F.lds);
#else
        attn_body::attn_unit8(F.tid, mref, Q8 + qrow * 512 + hd * 64, 512, K8 + (size_t)(b * 2 + kvh) * (RB / 64) * 4096, V8 + (size_t)(b * 2 + kvh) * (RB / 64) * 4096, RB / 64,
                                (attn_body::bf16*)(MIX + qrow * DM + hd * 64), DM, (char*)F.lds);
#endif
    }
    if (l == 0) {
        for (int u = (F.bx + F.G - 32) % F.G; u < NB * 8; u += F.G) { const int b = u >> 3, hd = u & 7, kvh = hd >> 2; const size_t qrow = (size_t)b * RB;
#if ATT8_DEBUG
            attn_body::attn_unit(F.tid, mref, (const attn_body::bf16*)(QBp + qrow * 512 + hd * 64), 512, (const attn_body::bf16*)(KC + (size_t)(b * 2 + kvh) * RB * 64), (const attn_body::bf16*)(VC + (size_t)(b * 2 + kvh) * RB * 64), CTX / 64,
                                    (attn_body::bf16*)(MIX + qrow * DM + hd * 64), DM, (char*)F.lds);
            attn_body::attn_unit8(F.tid, mref, Q8 + qrow * 512 + hd * 64, 512, K8 + (size_t)(b * 2 + kvh) * (RB / 64) * 4096, V8 + (size_t)(b * 2 + kvh) * (RB / 64) * 4096, CTX / 64,
                                    (attn_body::bf16*)((bf16*)(a->ws + WS_AR + DO_O8) + qrow * 512 + hd * 64), 512, (char*)F.lds);
#else
            attn_body::attn_unit8(F.tid, mref, Q8 + qrow * 512 + hd * 64, 512, K8 + (size_t)(b * 2 + kvh) * (RB / 64) * 4096, V8 + (size_t)(b * 2 + kvh) * (RB / 64) * 4096, CTX / 64,
                                    (attn_body::bf16*)(MIX + qrow * DM + hd * 64), DM, (char*)F.lds);
#endif
        }
    }
}
struct PlainSched {
    int nM, nN, G, c, skipctx; const char* A; const char* B; size_t tA, tB;
    __device__ __forceinline__ bool next(int i, pg8::Unit& u) const {
        const long L = (long)i * G + c; if (L >= (long)nM * nN) return false;
        int pm, pn; pg8::deal((int)L, nM, nN, pm, pn); if (skipctx) pm = pm + 1 + (pm >= 64 ? 1 : 0);
        u.pm = pm; u.pn = pn; u.a = A + (size_t)pm * tA; u.b = B + (size_t)pn * tB; u.goff = 0; u.gcnt = 0; return true; }
};
struct CtxSplitSched {
    int nN, nsp, G, c, KL; const char* A; const char* B; size_t tA, tB;
    __device__ __forceinline__ bool next(int i, pg8::Unit& u) const {
        const long L = (long)i * G + c; if (L >= (long)2 * nN * nsp) return false;
        const int ct = (int)L & 1, r = (int)L >> 1, pn = r % nN, ks = r / nN;
        u.pm = 2 * ks + ct; u.pn = pn; u.a = A + (size_t)(ct * 65) * tA + (size_t)ks * KL * 2; u.b = B + (size_t)pn * tB + (size_t)ks * KL * 2; u.goff = 0; u.gcnt = 0; return true; }
};
struct CtxFullSched {
    int nN, G, c; const char* A; const char* B; size_t tA, tB;
    __device__ __forceinline__ bool next(int i, pg8::Unit& u) const {
        const long L = (long)i * G + c; if (L >= (long)2 * nN) return false;
        const int ct = (int)L & 1, pn = (int)L >> 1;
        u.pm = ct * 65; u.pn = pn; u.a = A + (size_t)(ct * 65) * tA; u.b = B + (size_t)pn * tB; u.goff = 0; u.gcnt = 0; return true; }
};
struct MoeSched {
    int nM, nN, G, c, t0, up, c0; const char* A; const char* W; size_t tA, tB, wsz; int ts[9], cnt[8];
    __device__ __forceinline__ bool next(int i, pg8::Unit& u) const {
        long L = (long)i * G + c;
        if (c0 > 0) { const int w = G - c0; const long E = 3L * w; L = (c >= c0) ? ((i < 3) ? (long)i * w + (c - c0) : E + (long)(i - 3) * G + c) : E + (long)i * G + c; }
        if (L >= (long)nM * nN) return false;
        int pml, pn; pg8::deal((int)L, nM, nN, pml, pn); const int rt = t0 + pml;
        int e = 0, tse = 0, ce = cnt[0];
#pragma unroll
        for (int k = 1; k < 8; ++k) { const bool sel = (rt >= ts[k]) && (ts[k + 1] > ts[k]); e = sel ? k : e; tse = sel ? ts[k] : tse; ce = sel ? cnt[k] : ce; }
        const int lt = rt - tse;
        u.pn = pn; u.b = W + (size_t)e * wsz + (size_t)pn * tB;
        if (up) { u.pm = pml; u.a = A; u.goff = e * LISTCAP + lt * 256; const int rem = ce - lt * 256; u.gcnt = rem < 256 ? rem : 256; }
        else { u.pm = rt; u.a = A + (size_t)pml * tA; u.goff = 0; u.gcnt = 0; }
        return true; }
};

#if ATT8_DEBUG
__device__ __forceinline__ void dbg_compare(ArgP a, Frame& F, int l) {
    const bf16* MIX = (const bf16*)(a->ws + WS_AR + AR_MIX); const bf16* O8 = (const bf16*)(a->ws + WS_AR + DO_O8);
    float sd = 0.f, so = 0.f;
    for (int row = F.gw; row < NR; row += F.NGW) { const int b = row / RB, jj = row - b * RB; if (jj < CTX && l == 1) continue;
        const v4u x = *(const v4u*)(MIX + (size_t)row * DM + 8 * F.lane), y = *(const v4u*)(O8 + (size_t)row * 512 + 8 * F.lane);
        const float xv[8] = {bf_lo(x.x), bf_hi(x.x), bf_lo(x.y), bf_hi(x.y), bf_lo(x.z), bf_hi(x.z), bf_lo(x.w), bf_hi(x.w)}, yv[8] = {bf_lo(y.x), bf_hi(y.x), bf_lo(y.y), bf_hi(y.y), bf_lo(y.z), bf_hi(y.z), bf_lo(y.w), bf_hi(y.w)};
#pragma unroll
        for (int j = 0; j < 8; ++j) { const float d = yv[j] - xv[j]; sd += d * d; so += xv[j] * xv[j]; } }
    sd = wave_sum(sd); so = wave_sum(so);
    if (F.lane == 0) { atomicAdd((float*)(a->ws + WS_CTL) + 2048, sd); atomicAdd((float*)(a->ws + WS_CTL) + 2049, so); }
}
#endif
constexpr int N_PHASES_K = 22;
__global__ void __launch_bounds__(NWAVES * 64, 2) mk_fwd(Args a_unused) {
    extern __shared__ __attribute__((aligned(16))) unsigned char lds[];
    Frame F; ArgP a = args_here();
    F.lds = (LAS unsigned char*)lds;
    relaunder(F);
    unsigned* ctl = (unsigned*)(a->ws + WS_CTL);
    for (int u = F.tid; u < (LDS_BYTES - RING_BYTES) / 4; u += NWAVES * 64) ((LAS unsigned*)(F.lds + RING_BYTES))[u] = 0u;
    __syncthreads();
    volatile LAS unsigned* MISC = (volatile LAS unsigned*)(F.lds + MISC_OFF);
    XcdBarrier bar = xcd_barrier_post(ctl + CW_BAR + a->li * XCD_BAR_WORDS, MISC + 8);
    LAS unsigned* gtab = (LAS unsigned*)(F.lds + GTAB_OFF);
    const int lo = a->ph_lo, hi = a->ph_hi; int ph = 0;
#define RUN (a = args_here(), relaunder(F), (ph >= lo && ph < hi))
#ifndef PROF_MASK
#define PROF_MASK 0
#endif
#ifndef PROF_AMP
#define PROF_AMP 10
#endif
#if PROF_MASK
#define PROF_STAMP(k_) do { if (blockIdx.x == 0 && threadIdx.x == 0) ((volatile unsigned long long*)(a->ws + WS_CTL + 32768))[k_] = wall_clock64(); } while (0)
#else
#define PROF_STAMP(k_) do { } while (0)
#endif
#define SEAM() do { if (ph >= lo && ph + 1 < hi) xcd_barrier(bar); ++ph; a = args_here(); PROF_STAMP(ph); } while (0)
    unsigned char* AR = a->ws + WS_AR;
    PROF_STAMP(0);

    if (RUN) phase_p0a(a, F);
    SEAM();
    if (RUN) phase_premix0(a, F);
    SEAM();
#pragma unroll 1
    for (int l = 0; l < 2; ++l) {
        if (RUN) {
            if ((IN_I8 >> l) & 1) {
                PlainSched S{NR / 256, INW / 256, F.G, F.bx, 0, (const char*)(AR + AR_MIX), (const char*)(a->ws + WS_WIN + l * SZ_WIN), (size_t)256 * DM, (size_t)256 * DM};
                pg8::EpiBf16S E{(bf16*)(AR + AR_P), INW, 1.0f / (I8_XI * I8_WS)};
                pg8::gemm_phase<pg8::EpiBf16S, PlainSched, true, false, 2>(F.tid, F.lds, gtab, nullptr, DM / 2, DM / 2, S, E);
            } else if (IN1_F8 && l == 1) {
                PlainSched S{NR / 256, INW / 256, F.G, F.bx, 0, (const char*)(AR + AR_MIX), (const char*)(a->ws + WS_WIN + SZ_WIN), (size_t)256 * DM, (size_t)256 * DM};
                pg8::EpiBf16S E{(bf16*)(AR + AR_P), INW, 1.0f / 64.0f};
                pg8::gemm_phase<pg8::EpiBf16S, PlainSched, true, false, 1>(F.tid, F.lds, gtab, nullptr, DM / 2, DM / 2, S, E);
            } else {
            PlainSched S{NR / 256, INW / 256, F.G, F.bx, 0, (const char*)(AR + AR_MIX), (const char*)(a->ws + WS_WIN + l * SZ_WIN), (size_t)256 * DM * 2, (size_t)256 * DM * 2};
            pg8::EpiBf16 E{(bf16*)(AR + AR_P), INW};
            pg8::gemm_phase<pg8::EpiBf16, PlainSched, true, false>(F.tid, F.lds, gtab, nullptr, DM, DM, S, E); }
        }
        SEAM();
        if (RUN) phase_prep(a, F, l);
        SEAM();
        if (RUN) phase_scan(a, F, l);
        SEAM();
        if (RUN) phase_mix(a, F, l, (F.G % 8 == 0) ? (F.bx % 8) * (F.G / 8) + (F.bx / 8) : F.bx);
        SEAM();
        if (RUN) {
#if ATT8_DEBUG
            dbg_compare(a, F, l);
#endif
            PlainSched S{NLAT / 256, DM / 256, F.G, F.bx, 1, (const char*)(AR + AR_MIX), (const char*)(a->ws + WS_WOUT + l * SZ_WOUT), (size_t)256 * DM * 2, (size_t)256 * DM * 2};
            pg8::EpiBf16 E{(bf16*)(AR + AR_MX), DM};
            pg8::gemm_phase<pg8::EpiBf16, PlainSched, true, false>(F.tid, F.lds, gtab, nullptr, DM, DM, S, E);
            if (l == 0) {
                CtxSplitSched S2{DM / 256, 4, F.G, F.bx, 256, (const char*)(AR + AR_MIX), (const char*)(a->ws + WS_WOUT), (size_t)256 * DM * 2, (size_t)256 * DM * 2};
                pg8::EpiF32 E2{(float*)(AR + AR_PART0), DM};
                pg8::gemm_phase<pg8::EpiF32, CtxSplitSched, true, false>(F.tid, F.lds, gtab, nullptr, DM, 256, S2, E2); }
        }
        SEAM();
        if (l == 0) {
            if (RUN) phase_resid<0>(a, F);
            SEAM();
            if (RUN) {
#if DENSE_F8
                PlainSched S{NR / 256, 2 * FF / 256, F.G, F.bx, 0, (const char*)(AR + AR_HX2), (const char*)(a->ws + WS_W13D), (size_t)256 * DM, (size_t)256 * DM};
                pg8::EpiSwiglu8 E{(unsigned char*)(AR + AR_ACT), FF, 1.0f / 64.0f, 8.0f};
                pg8::gemm_phase<pg8::EpiSwiglu8, PlainSched, true, false, 1>(F.tid, F.lds, gtab, nullptr, DM / 2, DM / 2, S, E);
#elif DENSE_I8UP
                PlainSched S{NR / 256, 2 * FF / 256, F.G, F.bx, 0, (const char*)(AR + AR_HX2), (const char*)(a->ws + WS_W13D), (size_t)256 * DM, (size_t)256 * DM};
#if DENSE_DOWN_F8
                pg8::EpiSwiglu8 E{(unsigned char*)(AR + AR_ACT), FF, 1.0f / (I8_XS * I8_WS), 8.0f};
                pg8::gemm_phase<pg8::EpiSwiglu8, PlainSched, true, false, 2>(F.tid, F.lds, gtab, nullptr, DM / 2, DM / 2, S, E);
#else
                pg8::EpiSwigluS E{(bf16*)(AR + AR_ACT), FF, 1.0f / (I8_XS * I8_WS)};
                pg8::gemm_phase<pg8::EpiSwigluS, PlainSched, true, false, 2>(F.tid, F.lds, gtab, nullptr, DM / 2, DM / 2, S, E);
#endif
#else
                PlainSched S{NR / 256, 2 * FF / 256, F.G, F.bx, 0, (const char*)(AR + AR_HX2), (const char*)(a->ws + WS_W13D), (size_t)256 * DM * 2, (size_t)256 * DM * 2};
                pg8::EpiSwiglu E{(bf16*)(AR + AR_ACT), FF};
                pg8::gemm_phase<pg8::EpiSwiglu, PlainSched, true, false>(F.tid, F.lds, gtab, nullptr, DM, DM, S, E);
#endif
            }
            SEAM();
            if (RUN) {
#if DENSE_F8 || DENSE_DOWN_F8
                PlainSched S{NLAT / 256, DM / 256, F.G, F.bx, 1, (const char*)(AR + AR_ACT), (const char*)(a->ws + WS_W2D), (size_t)256 * FF, (size_t)256 * FF};
                pg8::EpiBf16S E{(bf16*)(AR + AR_YD), DM, 1.0f / 512.0f};
                pg8::gemm_phase<pg8::EpiBf16S, PlainSched, true, false, 1>(F.tid, F.lds, gtab, nullptr, FF / 2, FF / 2, S, E);
#if DENSE_DOWN_F8 && !DENSE_F8
                CtxFullSched S2{DM / 256, F.G, F.bx, (const char*)(AR + AR_ACT), (const char*)(a->ws + WS_W2D), (size_t)256 * FF, (size_t)256 * FF};
                pg8::gemm_phase<pg8::EpiBf16S, CtxFullSched, true, false, 1>(F.tid, F.lds, gtab, nullptr, FF / 2, FF / 2, S2, E);
#else
                CtxSplitSched S2{DM / 256, 11, F.G, F.bx, 128, (const char*)(AR + AR_ACT), (const char*)(a->ws + WS_W2D), (size_t)256 * FF, (size_t)256 * FF};
                pg8::EpiF32S E2{(float*)(AR + AR_PART1), DM, 1.0f / 512.0f};
                pg8::gemm_phase<pg8::EpiF32S, CtxSplitSched, true, false, 1>(F.tid, F.lds, gtab, nullptr, FF / 2, 128, S2, E2);
#endif
#else
                PlainSched S{NLAT / 256, DM / 256, F.G, F.bx, 1, (const char*)(AR + AR_ACT), (const char*)(a->ws + WS_W2D), (size_t)256 * FF * 2, (size_t)256 * FF * 2};
                pg8::EpiBf16 E{(bf16*)(AR + AR_YD), DM};
                pg8::gemm_phase<pg8::EpiBf16, PlainSched, true, false>(F.tid, F.lds, gtab, nullptr, FF, FF, S, E);
                CtxSplitSched S2{DM / 256, 11, F.G, F.bx, 256, (const char*)(AR + AR_ACT), (const char*)(a->ws + WS_W2D), (size_t)256 * FF * 2, (size_t)256 * FF * 2};
                pg8::EpiF32 E2{(float*)(AR + AR_PART1), DM};
                pg8::gemm_phase<pg8::EpiF32, CtxSplitSched, true, false>(F.tid, F.lds, gtab, nullptr, FF, 256, S2, E2);
#endif
            }
            SEAM();
            if (RUN) phase_resid<1>(a, F);
            SEAM();
        } else {
            if (RUN) phase_resid<2>(a, F);
            SEAM();
#pragma unroll 1
            for (int p = 0; p <= MOE_PASSES; ++p) {
                if (RUN) {
                    constexpr size_t ACTB = (size_t)MOE_TP * 256 * FF;
                    int nprev = 0;
                    if (p >= 1) {
                        MoeSched S; moe_prefix(a->ws, S.ts, S.cnt);
                        const int tot = S.ts[8]; int n = tot - (p - 1) * MOE_TP; n = n < 0 ? 0 : (n > MOE_TP ? MOE_TP : n); nprev = n;
                        S.nM = n; S.nN = DM / 256; S.G = F.G; S.c = F.bx; S.t0 = (p - 1) * MOE_TP; S.up = 0; S.c0 = 0; S.A = (const char*)(AR + AR_ACT + ((p - 1) & 1) * ACTB); S.W = (const char*)(a->ws + WS_W2M); S.tA = (size_t)256 * FF; S.tB = (size_t)256 * FF; S.wsz = SZ8_W2;
                        pg8::EpiBf16S E{(bf16*)(AR + AR_YM), DM, 1.0f / 512.0f};
                        pg8::gemm_phase<pg8::EpiBf16S, MoeSched, true, false, 1>(F.tid, F.lds, gtab, nullptr, FF / 2, FF / 2, S, E);
                    }
                    if (p < MOE_PASSES) {
                        a = args_here(); relaunder(F);
                        MoeSched S; moe_prefix(a->ws, S.ts, S.cnt);
                        const int tot = S.ts[8]; int n = tot - p * MOE_TP; n = n < 0 ? 0 : (n > MOE_TP ? MOE_TP : n);
                        S.nM = n; S.nN = 2 * FF / 256; S.G = F.G; S.c = F.bx; S.t0 = p * MOE_TP; S.up = 1; S.A = (const char*)(AR + AR_HX2); S.W = (const char*)(a->ws + WS_W13M); S.tA = 0; S.tB = (size_t)256 * DM; S.wsz = SZ8_W13;
                        { const int nd = nprev * (DM / 256), r = nd % F.G; S.c0 = (r != 0 && 3L * (F.G - r) <= (long)n * S.nN) ? r : 0; }
                        pg8::EpiSwiglu8 E{(unsigned char*)(AR + AR_ACT + (p & 1) * ACTB), FF, MOE_I8UP ? 1.0f / (I8_XS * I8_WS) : 1.0f / 64.0f, 8.0f};
                        pg8::gemm_phase<pg8::EpiSwiglu8, MoeSched, true, true, MOE_I8UP ? 2 : 1>(F.tid, F.lds, gtab, (const int*)(a->ws + WS_LIST), DM / 2, DM / 2, S, E);
                    }
                }
                SEAM();
            }
            if (RUN) phase_resid<3>(a, F);
            ++ph;
        }
    }
#if PROF_MASK
    a = args_here(); relaunder(F);
    if (F.bx == 0 && F.tid == 0) {
        PROF_STAMP(N_PHASES_K);
        const volatile unsigned long long* ts = (const volatile unsigned long long*)(a->ws + WS_CTL + 32768); long long sum = 0;
        for (int k = 0; k < N_PHASES_K; ++k) if ((PROF_MASK >> k) & 1) sum += (long long)(ts[k + 1] - ts[k]);
        const long long ticks = sum * PROF_AMP; const long long t0 = wall_clock64();
        while (wall_clock64() - t0 < ticks) __builtin_amdgcn_s_sleep(32);
    }
#endif
#if ATT8_DEBUG
    a = args_here(); relaunder(F);
    if (F.bx == 0 && F.tid == 0) {
        const float sd = __hip_atomic_load((float*)(a->ws + WS_CTL) + 2048, RLX_AGENT), so = __hip_atomic_load((float*)(a->ws + WS_CTL) + 2049, RLX_AGENT);
        float nl = -__log2f(sd / so); if (!(nl > 0.f)) nl = 0.f; if (nl > 40.f) nl = 40.f;
        const long long ticks = (long long)(nl * 200000.f); const long long t0 = wall_clock64();
        while (wall_clock64() - t0 < ticks) __builtin_amdgcn_s_sleep(32);
    }
#endif
#undef RUN
#undef SEAM
}
constexpr int N_PHASES = 22;

#ifndef DET_PROBE
#define DET_PROBE 0
#endif
#if DET_PROBE
__global__ void det_cksum(const unsigned* out, unsigned long long* dst, int n) {
    unsigned long long s = 0; for (int i = blockIdx.x * blockDim.x + threadIdx.x; i < n; i += gridDim.x * blockDim.x) s += (unsigned long long)out[i] * (unsigned)(2 * (i & 1023) + 1);
    for (int o = 32; o > 0; o >>= 1) s += __shfl_xor(s, o);
    if ((threadIdx.x & 63) == 0) atomicAdd(dst, s);
}
__global__ void det_fill(unsigned* p, size_t n, unsigned v) { for (size_t i = (size_t)blockIdx.x * blockDim.x + threadIdx.x; i < n; i += (size_t)gridDim.x * blockDim.x) p[i] = v; }
__global__ void det_cmp(const unsigned long long* c, float* out) { if (c[0] != c[1]) out[0] = __builtin_nanf(""); }
#endif
#ifndef MK_N_LAUNCHES
#define MK_N_LAUNCHES 1
#endif
extern "C" void kernel_launch(void* const* d_in, const int* in_sizes, int n_in, void* d_out, int out_size, void* d_ws, size_t ws_size, hipStream_t stream) {
    static int grid = 0;
    if (grid == 0) {
        if (n_in != 24 || out_size != NLAT * DM || ws_size < WS_END) { fprintf(stderr, "kernel_launch: unexpected shapes (n_in %d out %d ws %zu)\n", n_in, out_size, ws_size); grid = -1; return; }
        int dev = 0, cus = 0, per_cu = 0;
        if (hipGetDevice(&dev) != hipSuccess || hipDeviceGetAttribute(&cus, hipDeviceAttributeMultiprocessorCount, dev) != hipSuccess) { grid = -1; return; }
        if (hipFuncSetAttribute((const void*)mk_fwd, hipFuncAttributeMaxDynamicSharedMemorySize, LDS_BYTES) != hipSuccess) { fprintf(stderr, "kernel_launch: hipFuncSetAttribute failed\n"); grid = -1; return; }
        if (hipOccupancyMaxActiveBlocksPerMultiprocessor(&per_cu, (const void*)mk_fwd, NWAVES * 64, LDS_BYTES) != hipSuccess || per_cu < 1) fprintf(stderr, "kernel_launch: occupancy query says %d\n", per_cu);
        (void)hipGetLastError();
        grid = cus;
        while (grid > 8 && (NLAT % (2 * grid * NWAVES) != 0 || NLAT / (grid * NWAVES) > 64)) --grid;
    }
    if (grid < 0) return;
    if (hipMemsetAsync((char*)d_ws + WS_CTL, 0, CTL_ZERO_BYTES, stream) != hipSuccess) return;
    Args a{};
    for (int i = 0; i < 24; ++i) a.in[i] = (const float*)d_in[i];
    a.out = (float*)d_out; a.ws = (unsigned char*)d_ws; a.pad = 0;
#if DET_PROBE
    { a.ph_lo = 0; a.ph_hi = N_PHASES; a.li = 0;
      unsigned long long* ck = (unsigned long long*)((char*)d_ws + WS_CTL + 65536);
      hipLaunchKernelGGL(det_fill, dim3(2048), dim3(256), 0, stream, (unsigned*)((char*)d_ws + MiB), (WS_END - MiB) / 4, 0x3C3C3C3Cu);
      hipLaunchKernelGGL(mk_fwd, dim3(grid), dim3(NWAVES * 64), LDS_BYTES, stream, a);
      hipLaunchKernelGGL(det_cksum, dim3(1024), dim3(256), 0, stream, (const unsigned*)d_out, ck, out_size);
      if (hipMemsetAsync((char*)d_ws + WS_CTL, 0, 65536, stream) != hipSuccess) return;
      hipLaunchKernelGGL(det_fill, dim3(2048), dim3(256), 0, stream, (unsigned*)((char*)d_ws + MiB), (WS_END - MiB) / 4, 0xBDBDBDBDu);
      hipLaunchKernelGGL(det_fill, dim3(2048), dim3(256), 0, stream, (unsigned*)d_out, (size_t)out_size, 0xBDBDBDBDu);
      hipLaunchKernelGGL(mk_fwd, dim3(grid), dim3(NWAVES * 64), LDS_BYTES, stream, a);
      hipLaunchKernelGGL(det_cksum, dim3(1024), dim3(256), 0, stream, (const unsigned*)d_out, ck + 1, out_size);
      hipLaunchKernelGGL(det_cmp, dim3(1), dim3(1), 0, stream, (const unsigned long long*)ck, (float*)d_out);
      return; }
#endif
    if (MK_N_LAUNCHES == 1) { a.ph_lo = 0; a.ph_hi = N_PHASES; a.li = 0; hipLaunchKernelGGL(mk_fwd, dim3(grid), dim3(NWAVES * 64), LDS_BYTES, stream, a); }
    else { for (int p = 0; p < N_PHASES; ++p) { a.ph_lo = p; a.ph_hi = p + 1; a.li = p; hipLaunchKernelGGL(mk_fwd, dim3(grid), dim3(NWAVES * 64), LDS_BYTES, stream, a); } }
}
```

```cpp
#include <hip/hip_runtime.h>
#include <hip/hip_bf16.h>
#include <cstdio>
#include <cstdint>
#include <cmath>
namespace pg8 {
#define PG8_LAS __attribute__((address_space(3)))
typedef unsigned short bf16_t;
typedef short bf16x8 __attribute__((ext_vector_type(8)));
typedef float f32x4 __attribute__((ext_vector_type(4)));
typedef unsigned u32x4 __attribute__((ext_vector_type(4)));
typedef int i32x4_t __attribute__((ext_vector_type(4)));
typedef int i32x8_t __attribute__((ext_vector_type(8)));
typedef int i32x8_t __attribute__((ext_vector_type(8)));
constexpr int BM = 256, BK = 64, HALF = 128, HTB = HALF * BK * 2  , STAGE_BYTES = 8 * HTB, NXCD = 8, WGM = 8;

__host__ __device__ __forceinline__ int lds_byte(int r, int c) { const int st = (r >> 4) * 2 + (c >> 5), rr = r & 15, cc = c & 31, ob = rr * 64 + cc * 2; return st * 1024 + (ob ^ (((ob >> 9) & 1) << 5)); }
__host__ __device__ __forceinline__ void stage_rc(int b, int& R, int& C) { const int st = b / 1024, sb = b % 1024, swz = sb ^ (((sb >> 9) & 1) << 5); R = (st >> 1) * 16 + swz / 64; C = (st & 1) * 32 + (swz % 64) / 2; }
__host__ __device__ __forceinline__ int perm32(int rho) { const int n = rho >> 4, i = rho & 15; return 8 * (i >> 2) + 4 * n + (i & 3); }

struct Unit { int pm, pn; const char* a; const char* b; int goff, gcnt; };

__device__ __forceinline__ void deal(int L, int nM, int nN, int& pm, int& pn) {
    const int nwg = nM * nN; int wgid = L;
    { const int q = nwg / NXCD, r = nwg % NXCD, xcd = wgid % NXCD, off = wgid / NXCD; wgid = (xcd < r ? xcd * (q + 1) : r * (q + 1) + (xcd - r) * q) + off; }
    const int nig = WGM * nN, gid = wgid / nig, fm = gid * WGM, gsz = (nM - fm) < WGM ? (nM - fm) : WGM;
    pm = fm + ((wgid % nig) % gsz); pn = (wgid % nig) / gsz;
}

__device__ __forceinline__ float zero_v() { float z; asm volatile("v_mov_b32 %0, 0" : "=v"(z)); return z; }
__device__ __forceinline__ unsigned cvt_pk_bf16(float lo, float hi) { unsigned r; asm volatile("v_cvt_pk_bf16_f32 %0, %1, %2" : "=v"(r) : "v"(lo), "v"(hi)); return r; }

struct EpiBf16 {
    static constexpr bool PERM = true;
    bf16_t* O; int ldc;
    __device__ __forceinline__ void operator()(const f32x4 (&acc)[2][2][4][2], const Unit& u, int wr, int wc, int fr, int fq) const {
        const int row0 = u.pm * BM + wr * 64 + fr; const int col0 = u.pn * BM + wc * 32 + 8 * fq;
#pragma unroll
        for (int ai = 0; ai < 2; ++ai)
#pragma unroll
            for (int m = 0; m < 4; ++m) { bf16_t* rowp = O + (size_t)(row0 + ai * HALF + m * 16) * ldc + col0;
#pragma unroll
                for (int bj = 0; bj < 2; ++bj) { const f32x4 v0 = acc[ai][bj][m][0], v1 = acc[ai][bj][m][1];
                    u32x4 w; w.x = cvt_pk_bf16(v0[0], v0[1]); w.y = cvt_pk_bf16(v0[2], v0[3]); w.z = cvt_pk_bf16(v1[0], v1[1]); w.w = cvt_pk_bf16(v1[2], v1[3]);
                    *(u32x4*)(rowp + bj * HALF) = w; } }
    }
};
struct EpiF32 {
    static constexpr bool PERM = false;
    float* O; int ldc;
    __device__ __forceinline__ void operator()(const f32x4 (&acc)[2][2][4][2], const Unit& u, int wr, int wc, int fr, int fq) const {
        const int row0 = u.pm * BM + wr * 64 + fr; const int col0 = u.pn * BM + wc * 32 + 4 * fq;
#pragma unroll
        for (int ai = 0; ai < 2; ++ai)
#pragma unroll
            for (int m = 0; m < 4; ++m) { float* rowp = O + (size_t)(row0 + ai * HALF + m * 16) * ldc + col0;
#pragma unroll
                for (int bj = 0; bj < 2; ++bj)
#pragma unroll
                    for (int n = 0; n < 2; ++n) *(f32x4*)(rowp + bj * HALF + n * 16) = acc[ai][bj][m][n]; }
    }
};
__device__ __forceinline__ float silu_f(float x) { return x * __builtin_amdgcn_rcpf(1.0f + __builtin_amdgcn_exp2f(-1.4426950408889634f * x)); }
struct EpiSwiglu {
    static constexpr bool PERM = true;
    bf16_t* O; int ldc;
    __device__ __forceinline__ void operator()(const f32x4 (&acc)[2][2][4][2], const Unit& u, int wr, int wc, int fr, int fq) const {
        const int row0 = u.pm * BM + wr * 64 + fr; const int col0 = u.pn * HALF + wc * 32 + 8 * fq;
#pragma unroll
        for (int ai = 0; ai < 2; ++ai)
#pragma unroll
            for (int m = 0; m < 4; ++m) { bf16_t* rowp = O + (size_t)(row0 + ai * HALF + m * 16) * ldc + col0;
                const f32x4 a0 = acc[ai][0][m][0], a1 = acc[ai][0][m][1], g0 = acc[ai][1][m][0], g1 = acc[ai][1][m][1];
                u32x4 w; w.x = cvt_pk_bf16(silu_f(a0[0]) * g0[0], silu_f(a0[1]) * g0[1]); w.y = cvt_pk_bf16(silu_f(a0[2]) * g0[2], silu_f(a0[3]) * g0[3]);
                w.z = cvt_pk_bf16(silu_f(a1[0]) * g1[0], silu_f(a1[1]) * g1[1]); w.w = cvt_pk_bf16(silu_f(a1[2]) * g1[2], silu_f(a1[3]) * g1[3]);
                *(u32x4*)rowp = w; }
    }
};

struct EpiBf16S {
    static constexpr bool PERM = true;
    bf16_t* O; int ldc; float scl;
    __device__ __forceinline__ void operator()(const f32x4 (&acc)[2][2][4][2], const Unit& u, int wr, int wc, int fr, int fq) const {
        const int row0 = u.pm * BM + wr * 64 + fr; const int col0 = u.pn * BM + wc * 32 + 8 * fq;
#pragma unroll
        for (int ai = 0; ai < 2; ++ai)
#pragma unroll
            for (int m = 0; m < 4; ++m) { bf16_t* rowp = O + (size_t)(row0 + ai * HALF + m * 16) * ldc + col0;
#pragma unroll
                for (int bj = 0; bj < 2; ++bj) { const f32x4 v0 = acc[ai][bj][m][0] * scl, v1 = acc[ai][bj][m][1] * scl;
                    u32x4 w; w.x = cvt_pk_bf16(v0[0], v0[1]); w.y = cvt_pk_bf16(v0[2], v0[3]); w.z = cvt_pk_bf16(v1[0], v1[1]); w.w = cvt_pk_bf16(v1[2], v1[3]);
                    *(u32x4*)(rowp + bj * HALF) = w; } }
    }
};
struct EpiF32S {
    static constexpr bool PERM = false;
    float* O; int ldc; float scl;
    __device__ __forceinline__ void operator()(const f32x4 (&acc)[2][2][4][2], const Unit& u, int wr, int wc, int fr, int fq) const {
        const int row0 = u.pm * BM + wr * 64 + fr; const int col0 = u.pn * BM + wc * 32 + 4 * fq;
#pragma unroll
        for (int ai = 0; ai < 2; ++ai)
#pragma unroll
            for (int m = 0; m < 4; ++m) { float* rowp = O + (size_t)(row0 + ai * HALF + m * 16) * ldc + col0;
#pragma unroll
                for (int bj = 0; bj < 2; ++bj)
#pragma unroll
                    for (int n = 0; n < 2; ++n) *(f32x4*)(rowp + bj * HALF + n * 16) = acc[ai][bj][m][n] * scl; }
    }
};
__device__ __forceinline__ unsigned cvt_fp8x4(float a, float b, float c, float d) { int w = 0; w = __builtin_amdgcn_cvt_pk_fp8_f32(a, b, w, false); w = __builtin_amdgcn_cvt_pk_fp8_f32(c, d, w, true); return (unsigned)w; }
struct EpiSwigluS {
    static constexpr bool PERM = true;
    bf16_t* O; int ldc; float si;
    __device__ __forceinline__ void operator()(const f32x4 (&acc)[2][2][4][2], const Unit& u, int wr, int wc, int fr, int fq) const {
        const int row0 = u.pm * BM + wr * 64 + fr; const int col0 = u.pn * HALF + wc * 32 + 8 * fq;
#pragma unroll
        for (int ai = 0; ai < 2; ++ai)
#pragma unroll
            for (int m = 0; m < 4; ++m) { bf16_t* rowp = O + (size_t)(row0 + ai * HALF + m * 16) * ldc + col0;
                const f32x4 a0 = acc[ai][0][m][0] * si, a1 = acc[ai][0][m][1] * si, g0 = acc[ai][1][m][0] * si, g1 = acc[ai][1][m][1] * si;
                u32x4 w; w.x = cvt_pk_bf16(silu_f(a0[0]) * g0[0], silu_f(a0[1]) * g0[1]); w.y = cvt_pk_bf16(silu_f(a0[2]) * g0[2], silu_f(a0[3]) * g0[3]);
                w.z = cvt_pk_bf16(silu_f(a1[0]) * g1[0], silu_f(a1[1]) * g1[1]); w.w = cvt_pk_bf16(silu_f(a1[2]) * g1[2], silu_f(a1[3]) * g1[3]);
                *(u32x4*)rowp = w; }
    }
};
struct EpiSwiglu8 {
    static constexpr bool PERM = true;
    unsigned char* O; int ldc; float si, so;
    __device__ __forceinline__ f32x4 sw4(const f32x4 a, const f32x4 g, const float c1, const float k2) const {
        const f32x4 t = a * c1; f32x4 e; e[0] = __builtin_amdgcn_exp2f(t[0]); e[1] = __builtin_amdgcn_exp2f(t[1]); e[2] = __builtin_amdgcn_exp2f(t[2]); e[3] = __builtin_amdgcn_exp2f(t[3]);
        const f32x4 d = e + 1.0f; f32x4 r; r[0] = __builtin_amdgcn_rcpf(d[0]); r[1] = __builtin_amdgcn_rcpf(d[1]); r[2] = __builtin_amdgcn_rcpf(d[2]); r[3] = __builtin_amdgcn_rcpf(d[3]);
        return ((a * g) * k2) * r; }
    __device__ __forceinline__ void operator()(const f32x4 (&acc)[2][2][4][2], const Unit& u, int wr, int wc, int fr, int fq) const {
        const int row0 = u.pm * BM + wr * 64 + fr; const int col0 = u.pn * HALF + wc * 32 + 8 * fq; const float c1 = -1.4426950408889634f * si, k2 = si * si * so;
#pragma unroll
        for (int ai = 0; ai < 2; ++ai)
#pragma unroll
            for (int m = 0; m < 4; ++m) { unsigned char* rowp = O + (size_t)(row0 + ai * HALF + m * 16) * ldc + col0;
                const f32x4 o0 = sw4(acc[ai][0][m][0], acc[ai][1][m][0], c1, k2), o1 = sw4(acc[ai][0][m][1], acc[ai][1][m][1], c1, k2);
                const unsigned w0 = cvt_fp8x4(o0[0], o0[1], o0[2], o0[3]), w1 = cvt_fp8x4(o1[0], o1[1], o1[2], o1[3]);
                typedef unsigned u32x2_t __attribute__((ext_vector_type(2)));
                *(u32x2_t*)rowp = (u32x2_t){w0, w1}; }
    }
};

template <class Epi, class Sched, bool ALIGN_EPI, bool GATHER, int F8 = 0  >
__device__ __forceinline__ void gemm_phase(const int tid, PG8_LAS unsigned char* lds, PG8_LAS unsigned* gtab, const int* glist, const int K  , const int KL  , const Sched& S, const Epi& E) {
    const int wid = __builtin_amdgcn_readfirstlane(tid >> 6), lane = tid & 63, wr = wid >> 2, wc = wid & 3, fr = lane & 15, fq = lane >> 4;
    const int nt = KL / BK;
    unsigned voffA[2], voffB[2]; int RA[2], CA[2];
#pragma unroll
    for (int i = 0; i < 2; ++i) { int R, C; stage_rc(tid * 16 + i * 8192, R, C); const int Rb = Epi::PERM ? ((R & ~31) + perm32(R & 31)) : R;
        voffA[i] = (unsigned)(R * K + C) * 2u; voffB[i] = (unsigned)(Rb * K + C) * 2u; RA[i] = R; CA[i] = C; }
    const size_t kstep = (size_t)(BK * 2);
    const size_t hstep = (size_t)HALF * K * 2;
    const unsigned ldsw = (unsigned)wid * 1024u;
    const int aoff = lds_byte(wr * 64 + fr, fq * 8), boff = lds_byte(wc * 32 + fr, fq * 8);
    unsigned vc[2][2], vn[2][2], v2[2][2];
#define PG8_SA(b, h) (((b) * 2 + (h)) * HTB)
#define PG8_SB(b, h) ((4 + (b) * 2 + (h)) * HTB)
#define PG8_STAGE(bufoff, gbase, voff) do { _Pragma("unroll") for (int _i = 0; _i < 2; ++_i) \
        __builtin_amdgcn_global_load_lds((const unsigned*)((const char*)(gbase) + (voff)[_i]), (PG8_LAS unsigned*)(lds + (bufoff) + ldsw + _i * 8192), 16, 0, 0); } while (0)
#define PG8_STAGE_A(bufoff, gbase, h, VG) do { if constexpr (GATHER) { PG8_STAGE(bufoff, gbase, VG[h]); } else { PG8_STAGE(bufoff, (gbase) + (h) * hstep, voffA); } } while (0)
#define PG8_LDA(dst, b, h) do { _Pragma("unroll") for (int m = 0; m < 4; ++m) _Pragma("unroll") for (int k = 0; k < 2; ++k) dst[m][k] = *(const PG8_LAS bf16x8*)(lds + PG8_SA(b, h) + aoff + m * 2048 + k * 1024); } while (0)
#define PG8_LDB(dst, b, h) do { _Pragma("unroll") for (int n = 0; n < 2; ++n) _Pragma("unroll") for (int k = 0; k < 2; ++k) dst[n][k] = *(const PG8_LAS bf16x8*)(lds + PG8_SB(b, h) + boff + n * 2048 + k * 1024); } while (0)
#define PG8_CAT(x) __builtin_shufflevector(__builtin_bit_cast(i32x4_t, x[0]), __builtin_bit_cast(i32x4_t, x[1]), 0, 1, 2, 3, 4, 5, 6, 7)
#define PG8_MMA(ai, bj, At, Bt) do { __builtin_amdgcn_s_setprio(1); \
        if constexpr (F8 == 2) { _Pragma("unroll") for (int m = 0; m < 4; ++m) _Pragma("unroll") for (int n = 0; n < 2; ++n) _Pragma("unroll") for (int k = 0; k < 2; ++k) \
            asm volatile("v_mfma_i32_16x16x64_i8 %0, %1, %2, %0" : "+v"(acc[ai][bj][m][n]) : "v"(Bt[n][k]), "v"(At[m][k])); } \
        else if constexpr (F8 == 1) { _Pragma("unroll") for (int m = 0; m < 4; ++m) _Pragma("unroll") for (int n = 0; n < 2; ++n) \
            { const i32x8_t b8_ = PG8_CAT(Bt[n]), a8_ = PG8_CAT(At[m]); asm volatile("v_mfma_f32_16x16x128_f8f6f4 %0, %1, %2, %0" : "+v"(acc[ai][bj][m][n]) : "v"(b8_), "v"(a8_)); } } \
        else { _Pragma("unroll") for (int m = 0; m < 4; ++m) _Pragma("unroll") for (int n = 0; n < 2; ++n) _Pragma("unroll") for (int k = 0; k < 2; ++k) \
            acc[ai][bj][m][n] = __builtin_amdgcn_mfma_f32_16x16x32_bf16(Bt[n][k], At[m][k], acc[ai][bj][m][n], 0, 0, 0); } __builtin_amdgcn_s_setprio(0); } while (0)
#define PG8_WAIT_V(n) asm volatile("s_waitcnt vmcnt(" #n ")" ::: "memory")
#define PG8_WAIT_L(n) asm volatile("s_waitcnt lgkmcnt(" #n ")" ::: "memory")
#define PG8_BAR __builtin_amdgcn_s_barrier()
#define PG8_SCHED __builtin_amdgcn_sched_barrier(0)
#define PG8_GT_DMA(u) do { if (wid < 4) __builtin_amdgcn_global_load_lds((const unsigned*)(glist + (u).goff + wid * 64 + lane), (PG8_LAS unsigned*)(gtab + wid * 64), 4, 0, 0); } while (0)
#define PG8_GT_READ(V, u) do { _Pragma("unroll") for (int _h = 0; _h < 2; ++_h) _Pragma("unroll") for (int _i = 0; _i < 2; ++_i) { const int _p = _h * HALF + RA[_i]; int _r = (int)gtab[_p]; _r = (_p < (u).gcnt) ? _r : 0; \
        V[_h][_i] = ((unsigned)_r * (unsigned)K + (unsigned)CA[_i]) * 2u; } } while (0)
    Unit cur, nxt; int ui = 0;
    if (!S.next(0, cur)) return;
    f32x4 acc[2][2][4][2];
    { const float z = zero_v();
#pragma unroll
    for (int a = 0; a < 2; ++a)
#pragma unroll
        for (int b = 0; b < 2; ++b)
#pragma unroll
            for (int m = 0; m < 4; ++m)
#pragma unroll
                for (int n = 0; n < 2; ++n) acc[a][b][m][n] = (f32x4){z, z, z, z}; }
    bf16x8 At[4][2], B0[2][2], B1[2][2];
    const char* cA = cur.a; const char* cB = cur.b;
    if constexpr (GATHER) { PG8_GT_DMA(cur); PG8_WAIT_V(0); PG8_BAR; PG8_GT_READ(vc, cur); PG8_WAIT_L(0); PG8_BAR; }
    if constexpr (GATHER) {
#pragma unroll
        for (int _h = 0; _h < 2; ++_h) { vn[_h][0] = vc[_h][0]; vn[_h][1] = vc[_h][1]; } }
    PG8_STAGE(PG8_SB(0, 0), cB, voffB); PG8_STAGE(PG8_SB(0, 1), cB + hstep, voffB); PG8_STAGE_A(PG8_SA(0, 0), cA, 0, vc); PG8_STAGE_A(PG8_SA(0, 1), cA, 1, vc);
    if (wr == 1) PG8_BAR;
    PG8_WAIT_V(2); PG8_BAR;
    PG8_STAGE(PG8_SB(1, 0), cB + kstep, voffB); PG8_STAGE_A(PG8_SA(1, 0), cA + kstep, 0, vc); PG8_STAGE(PG8_SB(1, 1), cB + hstep + kstep, voffB);
    PG8_WAIT_V(6); PG8_BAR;
    for (;;) {
        const bool has_next = S.next(ui + 1, nxt);
        if constexpr (GATHER) { if (has_next) PG8_GT_DMA(nxt); }
        const char* nA = has_next ? nxt.a : cA; const char* nB = has_next ? nxt.b : cB;
        for (int t = 0; t < nt; t += 2) {
            const bool last = (t == nt - 2);
            const char* a1 = cA + (size_t)(t + 1) * kstep;
            const char* a2 = last ? nA : cA + (size_t)(t + 2) * kstep; const char* b2 = last ? nB : cB + (size_t)(t + 2) * kstep;
            const char* a3 = a2 + kstep; const char* b3 = b2 + kstep;
            if constexpr (GATHER) {
                if (last) { if (has_next) { PG8_GT_READ(vn, nxt); } else {
#pragma unroll
                        for (int _h = 0; _h < 2; ++_h) { vn[_h][0] = vc[_h][0]; vn[_h][1] = vc[_h][1]; } } }
#pragma unroll
                for (int _h = 0; _h < 2; ++_h) { v2[_h][0] = last ? vn[_h][0] : vc[_h][0]; v2[_h][1] = last ? vn[_h][1] : vc[_h][1]; }
            }
            PG8_LDB(B0, 0, 0); PG8_LDB(B1, 0, 1); PG8_SCHED; PG8_LDA(At, 0, 0); PG8_STAGE_A(PG8_SA(1, 1), a1, 1, vc);
            PG8_WAIT_V(8); PG8_WAIT_L(0); PG8_BAR; PG8_MMA(0, 0, At, B0); PG8_MMA(0, 1, At, B1); PG8_BAR; PG8_SCHED;
            PG8_LDA(At, 0, 1); PG8_STAGE(PG8_SB(0, 0), b2, voffB); PG8_STAGE(PG8_SB(0, 1), b2 + hstep, voffB); PG8_STAGE_A(PG8_SA(0, 0), a2, 0, v2);
            PG8_WAIT_V(8); PG8_WAIT_L(0); PG8_BAR; PG8_MMA(1, 0, At, B0); PG8_MMA(1, 1, At, B1); PG8_BAR; PG8_SCHED;
            PG8_LDB(B0, 1, 0); PG8_LDB(B1, 1, 1); PG8_SCHED; PG8_LDA(At, 1, 0); PG8_STAGE_A(PG8_SA(0, 1), a2, 1, v2);
            PG8_WAIT_V(8); PG8_WAIT_L(0); PG8_BAR; PG8_MMA(0, 0, At, B0); PG8_MMA(0, 1, At, B1); PG8_BAR; PG8_SCHED;
            PG8_LDA(At, 1, 1); PG8_STAGE(PG8_SB(1, 0), b3, voffB); PG8_STAGE(PG8_SB(1, 1), b3 + hstep, voffB); PG8_STAGE_A(PG8_SA(1, 0), a3, 0, v2);
            PG8_WAIT_V(8); PG8_WAIT_L(0); PG8_BAR; PG8_MMA(1, 0, At, B0); PG8_MMA(1, 1, At, B1); PG8_BAR; PG8_SCHED;
        }
        if constexpr (ALIGN_EPI) { if (wr == 0) PG8_BAR; }
        if constexpr (F8 != 0) {
            asm volatile("s_nop 15\n\ts_nop 15" : "+v"(acc[1][0][0][0]), "+v"(acc[1][0][0][1]), "+v"(acc[1][0][1][0]), "+v"(acc[1][0][1][1]), "+v"(acc[1][0][2][0]), "+v"(acc[1][0][2][1]), "+v"(acc[1][0][3][0]), "+v"(acc[1][0][3][1]) :: "memory");
            asm volatile("" : "+v"(acc[1][1][0][0]), "+v"(acc[1][1][0][1]), "+v"(acc[1][1][1][0]), "+v"(acc[1][1][1][1]), "+v"(acc[1][1][2][0]), "+v"(acc[1][1][2][1]), "+v"(acc[1][1][3][0]), "+v"(acc[1][1][3][1]) :: "memory"); }
        if constexpr (F8 == 2) {
#pragma unroll
            for (int a_ = 0; a_ < 2; ++a_)
#pragma unroll
                for (int b_ = 0; b_ < 2; ++b_)
#pragma unroll
                    for (int m = 0; m < 4; ++m)
#pragma unroll
                        for (int n = 0; n < 2; ++n) { const i32x4_t iv = __builtin_bit_cast(i32x4_t, acc[a_][b_][m][n]); acc[a_][b_][m][n] = (f32x4){(float)iv[0], (float)iv[1], (float)iv[2], (float)iv[3]}; } }
        E(acc, cur, wr, wc, fr, fq);
        if (!has_next) break;
        { const float z = zero_v();
#pragma unroll
        for (int a = 0; a < 2; ++a)
#pragma unroll
            for (int b = 0; b < 2; ++b)
#pragma unroll
                for (int m = 0; m < 4; ++m)
#pragma unroll
                    for (int n = 0; n < 2; ++n) acc[a][b][m][n] = (f32x4){z, z, z, z}; }
        cur = nxt; cA = nA; cB = nB; ++ui;
        if constexpr (GATHER) {
#pragma unroll
            for (int _h = 0; _h < 2; ++_h) { vc[_h][0] = vn[_h][0]; vc[_h][1] = vn[_h][1]; } }
        if constexpr (ALIGN_EPI) { if (wr == 1) PG8_BAR; }
    }
    PG8_WAIT_V(0);
    if constexpr (!ALIGN_EPI) { if (wr == 0) PG8_BAR; }
    PG8_BAR;
#undef PG8_SA
#undef PG8_SB
#undef PG8_STAGE
#undef PG8_STAGE_A
#undef PG8_LDA
#undef PG8_LDB
#undef PG8_CAT
#undef PG8_MMA
#undef PG8_WAIT_V
#undef PG8_WAIT_L
#undef PG8_BAR
#undef PG8_SCHED
#undef PG8_GT_DMA
#undef PG8_GT_READ
}
}
namespace attn_body {
using bf16=__hip_bfloat16;
using bf16x8=__attribute__((ext_vector_type(8)))short;
using s16x4=__attribute__((ext_vector_type(4)))short;
using f32x16=__attribute__((ext_vector_type(16)))float;
using u32x4=__attribute__((ext_vector_type(4)))unsigned;
constexpr int D=64,KP=64;
constexpr int NW=8,QBLK=32,QB=QBLK*NW,KVBLK=64;
__device__ __forceinline__ int crow(int r,int hi){return (r&3)+8*(r>>2)+4*hi;}
#define SBAR() __builtin_amdgcn_sched_barrier(0)
constexpr int NSLOT=3, SLOTB=8192;
constexpr int LDS_K=0, LDS_V=NSLOT*SLOTB, LDS_WS=2*NSLOT*SLOTB, LDS_OST=LDS_WS+NW*64*4, LDS_BYTES=LDS_OST+NW*4096;
constexpr float C2=0.125f*1.4426950408889634f;
__device__ __forceinline__ void glds16(const void*gsrc,unsigned lds_dst){unsigned keep;
  asm volatile("s_mov_b32 %0, m0\n\ts_mov_b32 m0, %2\n\ts_nop 0\n\tglobal_load_lds_dwordx4 %1, off\n\ts_mov_b32 m0, %0":"=&s"(keep):"v"(gsrc),"s"(lds_dst):"memory");}
__device__ __forceinline__ float max3f(float a,float b,float c){float r;asm("v_max3_f32 %0, %1, %2, %3":"=v"(r):"v"(a),"v"(b),"v"(c));return r;}
__device__ __forceinline__ float max2f(float a,float b){float r;asm("v_max_f32_e32 %0, %1, %2":"=v"(r):"v"(a),"v"(b));return r;}
__device__ __forceinline__ float fadd_s(float a,float b){float r;asm("v_add_f32_e32 %0, %1, %2":"=v"(r):"v"(a),"v"(b));return r;}
__device__ __forceinline__ float fsub_s(float a,float b){float r;asm("v_sub_f32_e32 %0, %1, %2":"=v"(r):"v"(a),"v"(b));return r;}
typedef float f32x2_t __attribute__((ext_vector_type(2))); typedef __bf16 bf16x2_t __attribute__((ext_vector_type(2)));
__device__ __forceinline__ unsigned cvtpk_s(float lo,float hi){f32x2_t v={lo,hi};bf16x2_t b=__builtin_convertvector(v,bf16x2_t);return __builtin_bit_cast(unsigned,b);}
#define WAIT_BAR(N) asm volatile("s_waitcnt vmcnt(" #N ") lgkmcnt(0)\n\ts_barrier":::"memory")

__device__ __forceinline__ void qkt(f32x16&p0,f32x16&p1,const char*Kslot,const bf16x8*qr,const f32x16&negm,int r32,int hi){
  const char*kb=Kslot+hi*1024+r32*16;
  #pragma unroll
  for(int d0=0;d0<4;++d0){
    const bf16x8 b0=*reinterpret_cast<const bf16x8*>(kb+d0*2048);
    const bf16x8 b1=*reinterpret_cast<const bf16x8*>(kb+d0*2048+512);
    if(d0==0){p0=__builtin_amdgcn_mfma_f32_32x32x16_bf16(b0,qr[0],negm,0,0,0);p1=__builtin_amdgcn_mfma_f32_32x32x16_bf16(b1,qr[0],negm,0,0,0);}
    else{p0=__builtin_amdgcn_mfma_f32_32x32x16_bf16(b0,qr[d0],p0,0,0,0);p1=__builtin_amdgcn_mfma_f32_32x32x16_bf16(b1,qr[d0],p1,0,0,0);}}
}
typedef __attribute__((address_space(3))) const char* lds_cptr;
typedef short v4i16_t __attribute__((ext_vector_type(4)));
__device__ __forceinline__ void kload8(bf16x8*kf,lds_cptr kp){
  kf[0]=*(const __attribute__((address_space(3))) bf16x8*)(kp);      kf[1]=*(const __attribute__((address_space(3))) bf16x8*)(kp+512);
  kf[2]=*(const __attribute__((address_space(3))) bf16x8*)(kp+2048); kf[3]=*(const __attribute__((address_space(3))) bf16x8*)(kp+2560);
  kf[4]=*(const __attribute__((address_space(3))) bf16x8*)(kp+4096); kf[5]=*(const __attribute__((address_space(3))) bf16x8*)(kp+4608);
  kf[6]=*(const __attribute__((address_space(3))) bf16x8*)(kp+6144); kf[7]=*(const __attribute__((address_space(3))) bf16x8*)(kp+6656);
}
__device__ __forceinline__ void kload2(bf16x8*kf,lds_cptr kp,int j){ kf[2*j]=*(const __attribute__((address_space(3))) bf16x8*)(kp+j*2048); kf[2*j+1]=*(const __attribute__((address_space(3))) bf16x8*)(kp+j*2048+512); }
__device__ __forceinline__ s16x4 vtr(lds_cptr p){ return __builtin_bit_cast(s16x4,__builtin_amdgcn_ds_read_tr16_b64_v4i16((__attribute__((address_space(3))) v4i16_t*)p)); }
__device__ __forceinline__ float rowmax(const f32x16&p0,const f32x16&p1){
  float a=max3f(p0[0],p0[1],p1[0]),b=max3f(p0[2],p0[3],p1[1]);a=max3f(a,p1[2],p1[3]);
  #pragma unroll
  for(int r=4;r<16;r+=4){a=max3f(a,p0[r],p0[r+1]);b=max3f(b,p0[r+2],p0[r+3]);a=max3f(a,p1[r],p1[r+1]);b=max3f(b,p1[r+2],p1[r+3]);}
  const float m=max2f(a,b);
  auto rr=__builtin_amdgcn_permlane32_swap(__float_as_uint(m),__float_as_uint(m),false,false);
  return max2f(__uint_as_float(rr[0]),__uint_as_float(rr[1]));
}
__device__ __forceinline__ void pv(f32x16*o,int vb,bf16x8 pa0,bf16x8 pa1,bf16x8 pa2,bf16x8 pa3){
  #pragma unroll
  for(int d0=0;d0<2;++d0){s16x4 lo[4],hi[4];
    #pragma unroll
    for(int ks=0;ks<4;++ks){
      asm volatile("ds_read_b64_tr_b16 %0,%1 offset:%c2":"=&v"(lo[ks]):"v"(vb),"i"(d0*4096+ks*1024):"memory");
      asm volatile("ds_read_b64_tr_b16 %0,%1 offset:%c2":"=&v"(hi[ks]):"v"(vb),"i"(d0*4096+ks*1024+512):"memory");}
    asm volatile("s_waitcnt lgkmcnt(0)":::"memory");SBAR();
    #define PK(k) (bf16x8){lo[k][0],lo[k][1],lo[k][2],lo[k][3],hi[k][0],hi[k][1],hi[k][2],hi[k][3]}
    o[d0]=__builtin_amdgcn_mfma_f32_32x32x16_bf16(pa0,PK(0),o[d0],0,0,0);
    o[d0]=__builtin_amdgcn_mfma_f32_32x32x16_bf16(pa1,PK(1),o[d0],0,0,0);
    o[d0]=__builtin_amdgcn_mfma_f32_32x32x16_bf16(pa2,PK(2),o[d0],0,0,0);
    o[d0]=__builtin_amdgcn_mfma_f32_32x32x16_bf16(pa3,PK(3),o[d0],0,0,0);
    #undef PK
  }
}

__device__ __forceinline__ void attn_unit(const int tid,const float mref,const bf16*Qu,int QP,const bf16*__restrict__ Kh,const bf16*__restrict__ Vh,int NT,bf16*Ou,int OP,char*shm){
  const int lane=tid&63,r32=lane&31,hi=lane>>5; const int wid=__builtin_amdgcn_readfirstlane(tid>>6);
  const bf16*Qw=Qu+(long)(wid*QBLK)*QP;
  const unsigned lds0=(unsigned)(uintptr_t)shm;
  float*wsf=(float*)(shm+LDS_WS)+wid*64;
  const bf16*ksrc=Kh+(long)lane*KP+wid*8;
  const bf16*vsrc=Vh+(long)(16*(wid&3)+(lane>>2))*KP+(wid>>2)*32+(lane&3)*8;
  const unsigned kdst=lds0+LDS_K+wid*1024, vdst=lds0+LDS_V+wid*1024;
  #define DMA_K(t,slot) glds16(ksrc+(long)(t)*KVBLK*KP,(unsigned)__builtin_amdgcn_readfirstlane(kdst+(slot)))
  #define DMA_V(t,slot) glds16(vsrc+(long)(t)*KVBLK*KP,(unsigned)__builtin_amdgcn_readfirstlane(vdst+(slot)))
  const int vb0=(int)(lds0+LDS_V)+((lane>>4)&1)*32+(lane&3)*8+(4*hi+((lane&15)>>2))*64;
  const char*Kbase=shm+LDS_K; bf16x8 kf[8];
  const lds_cptr shm3=(lds_cptr)shm; const lds_cptr kp0=shm3+LDS_K+hi*1024+r32*16; const lds_cptr vp0=shm3+LDS_V+((lane>>4)&1)*32+(lane&3)*8+(4*hi+((lane&15)>>2))*64;
  DMA_K(0,0);DMA_V(0,0);DMA_K(1,SLOTB);
  bf16x8 qr[4];
  #pragma unroll
  for(int d0=0;d0<4;++d0)qr[d0]=*reinterpret_cast<const bf16x8*>(&Qw[(long)r32*QP+d0*16+hi*8]);
  float l_reg=0.f;f32x16 o[2],negm; { const float z=pg8::zero_v(); _Pragma("unroll") for(int r=0;r<16;++r){o[0][r]=z;o[1][r]=z;negm[r]=z-mref;} } asm volatile("":"+v"(negm));
  f32x16 pA0,pA1,pB0,pB1;
  int sl_prev=0,sl_cur=0,sl_next=SLOTB;
  #define ROT() do{sl_prev=sl_cur;sl_cur=sl_next;sl_next=(sl_next==(NSLOT-1)*SLOTB)?0:sl_next+SLOTB;}while(0)
  DMA_K(2,2*SLOTB);
  WAIT_BAR(3);
  qkt(pA0,pA1,Kbase,qr,negm,r32,hi);asm volatile("s_nop 15\n\ts_nop 7":"+v"(pA0),"+v"(pA1));
  _Pragma("unroll") for(int r=0;r<16;++r){pA0[r]=__builtin_amdgcn_exp2f(pA0[r]);pA1[r]=__builtin_amdgcn_exp2f(pA1[r]);}
  WAIT_BAR(0);
  DMA_K(3,0);DMA_V(1,SLOTB);
  ROT();
  kload8(kf,kp0+sl_cur);
  WAIT_BAR(2);
  s16x4 vlo[8],vhi[8]; u32x4 pw0,pw1,pw2,pw3;
  #define MFX(a_,b_,c_) __builtin_amdgcn_mfma_f32_32x32x16_bf16(a_,b_,c_,0,0,0)
  #define PKW(P,B) cvtpk_s(P[B],P[B+1])
  #define PAF(k) __builtin_bit_cast(bf16x8,pw##k)
  #define VFR(i) (bf16x8){vlo[i][0],vlo[i][1],vlo[i][2],vlo[i][3],vhi[i][0],vhi[i][1],vhi[i][2],vhi[i][3]}
  #define PIN(x) asm volatile("":"+v"(x))
  #define GAPA(MF,A0,A1,A2,A3,W0,W1,PW) do{ MF; sacc+=A0; sacc+=A1; sacc+=A2; sacc+=A3; PIN(sacc); W0; W1; PIN(PW); SBAR(); }while(0)
  #define EX(v) __builtin_amdgcn_exp2f(v)
  #define GAPB(MF,X,B) do{ MF; X[B]=EX(X[B]); X[B+1]=EX(X[B+1]); X[B+2]=EX(X[B+2]); X[B+3]=EX(X[B+3]); PIN(X); SBAR(); }while(0)
  #define VRD(i) do{ vlo[i]=vtr(vp_+(((i)>>2)*4096+((i)&3)*1024)); vhi[i]=vtr(vp_+(((i)>>2)*4096+((i)&3)*1024+512)); }while(0)
  #define KRD(G,j) do{ if(G){ kload2(kf,kp0+sl_next,j); SBAR(); } }while(0)
  #define STEP(C0,C1,P0,P1,t,GK,GV,GL) do{ SBAR(); \
    const lds_cptr vp_=vp0+sl_prev; \
    VRD(0); SBAR(); float sacc=(P0[0]+P0[1]); \
    GAPA(C0=MFX(kf[0],qr[0],negm), P0[2],P0[3],P0[4],P0[5],     pw0[0]=PKW(P0,0), pw0[1]=PKW(P0,2), pw0); \
    VRD(4); SBAR(); GAPA(C1=MFX(kf[1],qr[0],negm), P0[6],P0[7],P0[8],P0[9],     pw0[2]=PKW(P0,4), pw0[3]=PKW(P0,6), pw0); \
    VRD(1); SBAR(); GAPA(C0=MFX(kf[2],qr[1],C0),   P0[10],P0[11],P0[12],P0[13], pw1[0]=PKW(P0,8), pw1[1]=PKW(P0,10), pw1); \
    VRD(5); SBAR(); GAPA(C1=MFX(kf[3],qr[1],C1),   P0[14],P0[15],P1[0],P1[1],   pw1[2]=PKW(P0,12),pw1[3]=PKW(P0,14), pw1); \
    VRD(2); SBAR(); GAPA(C0=MFX(kf[4],qr[2],C0),   P1[2],P1[3],P1[4],P1[5],     pw2[0]=PKW(P1,0), pw2[1]=PKW(P1,2), pw2); \
    VRD(6); SBAR(); GAPA(C1=MFX(kf[5],qr[2],C1),   P1[6],P1[7],P1[8],P1[9],     pw2[2]=PKW(P1,4), pw2[3]=PKW(P1,6), pw2); \
    VRD(3); SBAR(); GAPA(C0=MFX(kf[6],qr[3],C0),   P1[10],P1[11],P1[12],P1[13], pw3[0]=PKW(P1,8), pw3[1]=PKW(P1,10), pw3); \
    VRD(7); SBAR(); GAPA(C1=MFX(kf[7],qr[3],C1),   P1[14],P1[15],0.f,0.f,       pw3[2]=PKW(P1,12),pw3[3]=PKW(P1,14), pw3); \
    l_reg+=sacc; \
    if(GK){DMA_K((t)+3,sl_cur);} if(GV){DMA_V((t)+1,sl_next);} \
    SBAR(); \
    GAPB(o[0]=MFX(PAF(0),VFR(0),o[0]), C0,0); \
    GAPB(o[1]=MFX(PAF(0),VFR(4),o[1]), C0,4); \
    KRD(GL,0); GAPB(o[0]=MFX(PAF(1),VFR(1),o[0]), C0,8); \
    KRD(GL,1); GAPB(o[1]=MFX(PAF(1),VFR(5),o[1]), C0,12); \
    KRD(GL,2); GAPB(o[0]=MFX(PAF(2),VFR(2),o[0]), C1,0); \
    KRD(GL,3); GAPB(o[1]=MFX(PAF(2),VFR(6),o[1]), C1,4); \
    GAPB(o[0]=MFX(PAF(3),VFR(3),o[0]), C1,8); \
    GAPB(o[1]=MFX(PAF(3),VFR(7),o[1]), C1,12); \
    }while(0)
  int t=1;
  for(;t+5<NT;t+=2){
    STEP(pB0,pB1,pA0,pA1,t,true,true,true);     WAIT_BAR(2); ROT();
    STEP(pA0,pA1,pB0,pB1,t+1,true,true,true);   WAIT_BAR(2); ROT();
  }
  #define ENDW(tt) do{ if((tt)+3<NT){WAIT_BAR(2);} else if((tt)+2<NT){WAIT_BAR(1);} else {WAIT_BAR(0);} }while(0)
  for(;t+1<NT;t+=2){
    STEP(pB0,pB1,pA0,pA1,t,(t+3<NT),(t+1<NT),(t+1<NT));       ENDW(t);   ROT();
    STEP(pA0,pA1,pB0,pB1,t+1,(t+4<NT),(t+2<NT),(t+2<NT));     ENDW(t+1); ROT();
  }
  STEP(pB0,pB1,pA0,pA1,NT-1,false,false,false);
  { float sacc=pB0[0]+pB0[1]; _Pragma("unroll") for(int r=2;r<16;++r)sacc+=pB0[r]; _Pragma("unroll") for(int r=0;r<16;++r)sacc+=pB1[r]; l_reg+=sacc;
    pw0=(u32x4){PKW(pB0,0),PKW(pB0,2),PKW(pB0,4),PKW(pB0,6)};pw1=(u32x4){PKW(pB0,8),PKW(pB0,10),PKW(pB0,12),PKW(pB0,14)};pw2=(u32x4){PKW(pB1,0),PKW(pB1,2),PKW(pB1,4),PKW(pB1,6)};pw3=(u32x4){PKW(pB1,8),PKW(pB1,10),PKW(pB1,12),PKW(pB1,14)};
    SBAR(); pv(o,vb0+sl_cur,PAF(0),PAF(1),PAF(2),PAF(3)); }
  #undef PKW
  #undef PAF
  #undef VFR
  #undef PIN
  #undef GAPA
  #undef GAPB
  #undef EX
  #undef VRD
  #undef KRD
  #undef STEP
  #undef MFX
  #undef ENDW
  {auto rr=__builtin_amdgcn_permlane32_swap(__float_as_uint(l_reg),__float_as_uint(l_reg),false,false);l_reg=__uint_as_float(rr[0])+__uint_as_float(rr[1]);}
  if(hi==0)wsf[32+r32]=l_reg;asm volatile("s_waitcnt lgkmcnt(0)":::"memory");
  float rli[16];
  #pragma unroll
  for(int r=0;r<16;++r)rli[r]=__builtin_amdgcn_rcpf(wsf[32+crow(r,hi)]);
  bf16*Ow=Ou+(long)(wid*QBLK)*OP;
  { bf16*stg=(bf16*)(shm+LDS_OST)+wid*2048;
    #pragma unroll
    for(int r=0;r<16;++r){const int orow=crow(r,hi);
      #pragma unroll
      for(int d0=0;d0<2;++d0)stg[orow*64+d0*32+r32]=__float2bfloat16(o[d0][r]*rli[r]);}
    asm volatile("s_waitcnt lgkmcnt(0)":::"memory");
    #pragma unroll
    for(int i=0;i<4;++i){const int row=i*8+(lane>>3),ch=lane&7; const u32x4 v=*(const u32x4*)(stg+row*64+ch*8); *(u32x4*)(Ow+(long)row*OP+ch*8)=v;} }
  asm volatile("s_waitcnt lgkmcnt(0)\n\ts_barrier":::"memory");
  #undef DMA_K
  #undef DMA_V
  #undef ROT
}

typedef int v8i __attribute__((ext_vector_type(8)));
typedef int v4i __attribute__((ext_vector_type(4)));
typedef unsigned v2u_t __attribute__((ext_vector_type(2)));
constexpr int F8_SLOTB=4096, F8_LDS_K=0, F8_LDS_V=3*F8_SLOTB, F8_LDS_WS=6*F8_SLOTB, F8_OSTP=144, F8_LDS_OST=F8_LDS_WS+2048, F8_LDS_BYTES=F8_LDS_OST+NW*32*F8_OSTP;
constexpr float F8_ENC0=60.25f;
constexpr float F8_SH=13.0f;
#define MF8(a_,b_,c_,BF) __builtin_amdgcn_mfma_scale_f32_32x32x64_f8f6f4(a_,b_,c_,0,BF,0,0,0,0)
typedef __attribute__((address_space(3))) const v4i* lds_v4p;
__device__ __forceinline__ v8i ld256(lds_cptr p){ const v4i a=*(lds_v4p)(p), b=*(lds_v4p)(p+1024); return __builtin_shufflevector(a,b,0,1,2,3,4,5,6,7); }
__device__ __forceinline__ void attn_unit8(const int tid,const float mref,const unsigned char*Qu,int QP,const unsigned char*__restrict__ Kh,const unsigned char*__restrict__ Vh,int NT,bf16*Ou,int OP,char*shm){
  const int lane=tid&63,r32=lane&31,hi=lane>>5; const int wid=__builtin_amdgcn_readfirstlane(tid>>6);
  const unsigned lds0=(unsigned)(uintptr_t)shm;
  const bool isK=wid<4;
  const unsigned char*dsrc=(isK?Kh:Vh)+(wid&3)*1024+lane*16;
  const unsigned ddst=lds0+(isK?F8_LDS_K:F8_LDS_V)+(wid&3)*1024;
  #define DMA8(tk,sk,tv,sv) glds16(dsrc+(long)(isK?(tk):(tv))*4096,(unsigned)__builtin_amdgcn_readfirstlane(ddst+(isK?(sk):(sv))))
  const lds_cptr shm3=(lds_cptr)shm; const lds_cptr kp0=shm3+F8_LDS_K+hi*2048+r32*16; const lds_cptr vp0=shm3+F8_LDS_V+hi*2048+r32*16;
  DMA8(0,0,0,0); if(isK){DMA8(1,F8_SLOTB,0,0);}
  v8i qf; { const unsigned char*qp=Qu+(long)(wid*QBLK+r32)*QP+32*hi; const v4i a=*(const v4i*)qp, b=*(const v4i*)(qp+16); qf=__builtin_shufflevector(a,b,0,1,2,3,4,5,6,7); }
  f32x16 o[2],lacc,negm; { const float z=pg8::zero_v(); _Pragma("unroll") for(int r=0;r<16;++r){o[0][r]=z;o[1][r]=z;lacc[r]=z;negm[r]=z+(4.0f*(F8_SH-mref)+F8_ENC0);} } asm volatile("":"+v"(negm));
  v8i ones,pw; { int o1; asm volatile("v_mov_b32 %0, 0x38383838":"=v"(o1)); _Pragma("unroll") for(int j=0;j<8;++j){ones[j]=o1;pw[j]=o1;} } asm volatile("":"+v"(ones));
  f32x16 pA0,pA1,pB0,pB1; v8i kf[2],vf[2];
  int sl_prev=0,sl_cur=0,sl_next=F8_SLOTB;
  #define ROT() do{sl_prev=sl_cur;sl_cur=sl_next;sl_next=(sl_next==2*F8_SLOTB)?0:sl_next+F8_SLOTB;}while(0)
  if(isK){DMA8(2,2*F8_SLOTB,0,0);}
  WAIT_BAR(3);
  kf[0]=ld256(kp0); kf[1]=ld256(kp0+512);
  pA0=MF8(kf[0],qf,negm,0); pA1=MF8(kf[1],qf,negm,0);

  WAIT_BAR(0);
  DMA8(3,0,1,F8_SLOTB);
  ROT();
  kf[0]=ld256(kp0+sl_cur); kf[1]=ld256(kp0+sl_cur+512);
  WAIT_BAR(1);
  #define PIN(x) asm volatile("":"+v"(x))
  #define EX(v) (v)
  #define CV4(W,P,B) do{ unsigned w_=(unsigned)W; w_=__builtin_amdgcn_cvt_pk_u8_f32(P[B],0u,w_); w_=__builtin_amdgcn_cvt_pk_u8_f32(P[(B)+1],1u,w_); w_=__builtin_amdgcn_cvt_pk_u8_f32(P[(B)+2],2u,w_); w_=__builtin_amdgcn_cvt_pk_u8_f32(P[(B)+3],3u,w_); W=(int)w_; }while(0)
  #define STEP8(C0,C1,P0,P1,t,GK,GV,GL) do{ SBAR(); \
    const lds_cptr vp_=vp0+sl_prev; \
    vf[0]=ld256(vp_); SBAR(); \
    C0=MF8(kf[0],qf,negm,0); CV4(pw[0],P0,0); CV4(pw[1],P0,4); CV4(pw[2],P0,8); CV4(pw[3],P0,12); PIN(pw); SBAR(); \
    vf[1]=ld256(vp_+512); SBAR(); \
    C1=MF8(kf[1],qf,negm,0); CV4(pw[4],P1,0); CV4(pw[5],P1,4); CV4(pw[6],P1,8); CV4(pw[7],P1,12); PIN(pw); SBAR(); \
    if(isK?(GK):(GV)){DMA8((t)+3,sl_cur,(t)+1,sl_next);} \
    SBAR(); \
    o[0]=MF8(vf[0],pw,o[0],1); \
    C0[0]=EX(C0[0]);C0[1]=EX(C0[1]);C0[2]=EX(C0[2]);C0[3]=EX(C0[3]);C0[4]=EX(C0[4]);C0[5]=EX(C0[5]);C0[6]=EX(C0[6]);C0[7]=EX(C0[7]);C0[8]=EX(C0[8]);C0[9]=EX(C0[9]);C0[10]=EX(C0[10]); PIN(C0); SBAR(); \
    if(GL){ kf[0]=ld256(kp0+sl_next); SBAR(); } \
    o[1]=MF8(vf[1],pw,o[1],1); \
    C0[11]=EX(C0[11]);C0[12]=EX(C0[12]);C0[13]=EX(C0[13]);C0[14]=EX(C0[14]);C0[15]=EX(C0[15]);C1[0]=EX(C1[0]);C1[1]=EX(C1[1]);C1[2]=EX(C1[2]);C1[3]=EX(C1[3]);C1[4]=EX(C1[4]);C1[5]=EX(C1[5]); PIN(C0); PIN(C1); SBAR(); \
    if(GL){ kf[1]=ld256(kp0+sl_next+512); SBAR(); } \
    lacc=MF8(ones,pw,lacc,1); \
    C1[6]=EX(C1[6]);C1[7]=EX(C1[7]);C1[8]=EX(C1[8]);C1[9]=EX(C1[9]);C1[10]=EX(C1[10]);C1[11]=EX(C1[11]);C1[12]=EX(C1[12]);C1[13]=EX(C1[13]);C1[14]=EX(C1[14]);C1[15]=EX(C1[15]); PIN(C1); SBAR(); \
    }while(0)
  int t=1;
  for(;t+5<NT;t+=2){
    STEP8(pB0,pB1,pA0,pA1,t,true,true,true);     WAIT_BAR(1); ROT();
    STEP8(pA0,pA1,pB0,pB1,t+1,true,true,true);   WAIT_BAR(1); ROT();
  }
  #define ENDW8(tt) do{ if((tt)+3<NT){WAIT_BAR(1);} else {WAIT_BAR(0);} }while(0)
  for(;t+1<NT;t+=2){
    STEP8(pB0,pB1,pA0,pA1,t,(t+3<NT),(t+1<NT),(t+1<NT));       ENDW8(t);   ROT();
    STEP8(pA0,pA1,pB0,pB1,t+1,(t+4<NT),(t+2<NT),(t+2<NT));     ENDW8(t+1); ROT();
  }
  STEP8(pB0,pB1,pA0,pA1,NT-1,false,false,false);
  { CV4(pw[0],pB0,0); CV4(pw[1],pB0,4); CV4(pw[2],pB0,8); CV4(pw[3],pB0,12); CV4(pw[4],pB1,0); CV4(pw[5],pB1,4); CV4(pw[6],pB1,8); CV4(pw[7],pB1,12);
    const lds_cptr vp_=vp0+sl_cur; vf[0]=ld256(vp_); vf[1]=ld256(vp_+512);
    o[0]=MF8(vf[0],pw,o[0],1); o[1]=MF8(vf[1],pw,o[1],1); lacc=MF8(ones,pw,lacc,1); }
  #undef PIN
  #undef EX
  #undef CV4
  #undef STEP8
  #undef ENDW8
  { const float rl=__builtin_amdgcn_rcpf(lacc[0]);
    typedef __attribute__((address_space(3))) char* lds_wptr;
    const lds_wptr stg=(lds_wptr)shm+F8_LDS_OST+wid*(32*F8_OSTP);
    #pragma unroll
    for(int m=0;m<2;++m)
      #pragma unroll
      for(int g=0;g<4;++g){ v2u_t w; w.x=cvtpk_s(o[m][4*g]*rl,o[m][4*g+1]*rl); w.y=cvtpk_s(o[m][4*g+2]*rl,o[m][4*g+3]*rl);
        *(__attribute__((address_space(3))) v2u_t*)(stg+r32*F8_OSTP+(32*m+8*g+4*hi)*2)=w; }
    asm volatile("s_waitcnt lgkmcnt(0)":::"memory");
    bf16*Ow=Ou+(long)(wid*QBLK)*OP;
    #pragma unroll
    for(int i=0;i<4;++i){const int row=i*8+(lane>>3),ch=lane&7; const u32x4 v=*(const __attribute__((address_space(3))) u32x4*)(stg+row*F8_OSTP+ch*16); *(u32x4*)(Ow+(long)row*OP+ch*8)=v;} }
  asm volatile("s_waitcnt lgkmcnt(0)\n\ts_barrier":::"memory");
  #undef DMA8
  #undef ROT
}
constexpr int F8P_NS=5, F8P_LDS_V=F8P_NS*F8_SLOTB, F8P_LDS_OST=2*F8P_NS*F8_SLOTB, F8P_LDS_BYTES=F8P_LDS_OST+NW*32*F8_OSTP;
__device__ __forceinline__ void attn_unit8p(const int tid,const float mref,const unsigned char*Qu,int QP,const unsigned char*__restrict__ Kh,const unsigned char*__restrict__ Vh,int NT,bf16*Ou,int OP,char*shm){
  const int lane=tid&63,r32=lane&31,hi=lane>>5; const int wid=__builtin_amdgcn_readfirstlane(tid>>6);
  const unsigned lds0=(unsigned)(uintptr_t)shm;
  const bool isK=wid<4;
  const unsigned char*dsrc=(isK?Kh:Vh)+(wid&3)*1024+lane*16;
  const unsigned ddst=lds0+(isK?0:F8P_LDS_V)+(wid&3)*1024;
  #define DMA8(tk,sk,tv,sv) glds16(dsrc+(long)(isK?(tk):(tv))*4096,(unsigned)__builtin_amdgcn_readfirstlane(ddst+(isK?(sk):(sv))))
  #define WR(x) (((x)>=F8P_NS*F8_SLOTB)?((x)-F8P_NS*F8_SLOTB):(x))
  const lds_cptr shm3=(lds_cptr)shm; const lds_cptr kp0=shm3+hi*2048+r32*16; const lds_cptr vp0=shm3+F8P_LDS_V+hi*2048+r32*16;
  DMA8(0,0,0,0); DMA8(1,F8_SLOTB,1,F8_SLOTB); DMA8(2,2*F8_SLOTB,2,2*F8_SLOTB); if(isK){DMA8(3,3*F8_SLOTB,0,0); DMA8(4,4*F8_SLOTB,0,0);}
  v8i qf; { const unsigned char*qp=Qu+(long)(wid*QBLK+r32)*QP+32*hi; const v4i a=*(const v4i*)qp, b=*(const v4i*)(qp+16); qf=__builtin_shufflevector(a,b,0,1,2,3,4,5,6,7); }
  f32x16 o[2],lacc,negm; { const float z=pg8::zero_v(); _Pragma("unroll") for(int r=0;r<16;++r){o[0][r]=z;o[1][r]=z;lacc[r]=z;negm[r]=z-mref+F8_SH;} } asm volatile("":"+v"(negm));
  v8i ones,pw; { int o1; asm volatile("v_mov_b32 %0, 0x38383838":"=v"(o1)); _Pragma("unroll") for(int j=0;j<8;++j){ones[j]=o1;pw[j]=o1;} } asm volatile("":"+v"(ones));
  f32x16 pA0,pA1,pB0,pB1; v8i kf[2],vf[2];
  WAIT_BAR(0);
  kf[0]=ld256(kp0); kf[1]=ld256(kp0+512);
  pA0=MF8(kf[0],qf,negm,0); pA1=MF8(kf[1],qf,negm,0);
  _Pragma("unroll") for(int r=0;r<16;++r){pA0[r]=__builtin_amdgcn_exp2f(pA0[r]);pA1[r]=__builtin_amdgcn_exp2f(pA1[r]);}
  kf[0]=ld256(kp0+F8_SLOTB); kf[1]=ld256(kp0+F8_SLOTB+512);
  WAIT_BAR(0);
  int sl=F8_SLOTB;
  #define PIN(x) asm volatile("":"+v"(x))
  #define EX(v) __builtin_amdgcn_exp2f(v)
  #define CV4(W,P,B) do{ W=__builtin_amdgcn_cvt_pk_bf8_f32(P[B],P[(B)+1],W,false); W=__builtin_amdgcn_cvt_pk_bf8_f32(P[(B)+2],P[(B)+3],W,true); }while(0)
  #define STEP8(C0,C1,P0,P1,t,GK,GV,GL) do{ SBAR(); \
    const int sl_p1=(sl==0)?(F8P_NS-1)*F8_SLOTB:sl-F8_SLOTB, sl_n1=WR(sl+F8_SLOTB), sl_n2=WR(sl+2*F8_SLOTB); \
    const lds_cptr vp_=vp0+sl_p1; \
    vf[0]=ld256(vp_); SBAR(); \
    C0=MF8(kf[0],qf,negm,0); CV4(pw[0],P0,0); CV4(pw[1],P0,4); CV4(pw[2],P0,8); CV4(pw[3],P0,12); PIN(pw); SBAR(); \
    vf[1]=ld256(vp_+512); SBAR(); \
    C1=MF8(kf[1],qf,negm,0); CV4(pw[4],P1,0); CV4(pw[5],P1,4); CV4(pw[6],P1,8); CV4(pw[7],P1,12); PIN(pw); SBAR(); \
    if(isK?(GK):(GV)){DMA8((t)+4,sl_p1,(t)+2,sl_n2);} \
    SBAR(); \
    o[0]=MF8(vf[0],pw,o[0],1); \
    C0[0]=EX(C0[0]);C0[1]=EX(C0[1]);C0[2]=EX(C0[2]);C0[3]=EX(C0[3]);C0[4]=EX(C0[4]);C0[5]=EX(C0[5]);C0[6]=EX(C0[6]);C0[7]=EX(C0[7]);C0[8]=EX(C0[8]);C0[9]=EX(C0[9]);C0[10]=EX(C0[10]); PIN(C0); SBAR(); \
    if(GL){ kf[0]=ld256(kp0+sl_n1); SBAR(); } \
    o[1]=MF8(vf[1],pw,o[1],1); \
    C0[11]=EX(C0[11]);C0[12]=EX(C0[12]);C0[13]=EX(C0[13]);C0[14]=EX(C0[14]);C0[15]=EX(C0[15]);C1[0]=EX(C1[0]);C1[1]=EX(C1[1]);C1[2]=EX(C1[2]);C1[3]=EX(C1[3]);C1[4]=EX(C1[4]);C1[5]=EX(C1[5]); PIN(C0); PIN(C1); SBAR(); \
    if(GL){ kf[1]=ld256(kp0+sl_n1+512); SBAR(); } \
    lacc=MF8(ones,pw,lacc,1); \
    C1[6]=EX(C1[6]);C1[7]=EX(C1[7]);C1[8]=EX(C1[8]);C1[9]=EX(C1[9]);C1[10]=EX(C1[10]);C1[11]=EX(C1[11]);C1[12]=EX(C1[12]);C1[13]=EX(C1[13]);C1[14]=EX(C1[14]);C1[15]=EX(C1[15]); PIN(C1); SBAR(); \
    sl=sl_n1; \
    }while(0)
  int t=1;
  for(;t+6<NT;t+=2){
    STEP8(pB0,pB1,pA0,pA1,t,true,true,true);
    STEP8(pA0,pA1,pB0,pB1,t+1,true,true,true);   WAIT_BAR(1);
  }
  for(;t+1<NT;t+=2){
    STEP8(pB0,pB1,pA0,pA1,t,(t+4<NT),(t+2<NT),true);
    STEP8(pA0,pA1,pB0,pB1,t+1,(t+5<NT),(t+3<NT),(t+2<NT));
    if(t+5<NT){WAIT_BAR(1);} else {WAIT_BAR(0);}
  }
  STEP8(pB0,pB1,pA0,pA1,NT-1,false,false,false);
  { CV4(pw[0],pB0,0); CV4(pw[1],pB0,4); CV4(pw[2],pB0,8); CV4(pw[3],pB0,12); CV4(pw[4],pB1,0); CV4(pw[5],pB1,4); CV4(pw[6],pB1,8); CV4(pw[7],pB1,12);
    const int sl_last=(sl==0)?(F8P_NS-1)*F8_SLOTB:sl-F8_SLOTB;
    const lds_cptr vp_=vp0+sl_last; vf[0]=ld256(vp_); vf[1]=ld256(vp_+512);
    o[0]=MF8(vf[0],pw,o[0],1); o[1]=MF8(vf[1],pw,o[1],1); lacc=MF8(ones,pw,lacc,1); }
  #undef PIN
  #undef EX
  #undef CV4
  #undef STEP8
  #undef WR
  { const float rl=__builtin_amdgcn_rcpf(lacc[0]);
    typedef __attribute__((address_space(3))) char* lds_wptr;
    const lds_wptr stg=(lds_wptr)shm+F8P_LDS_OST+wid*(32*F8_OSTP);
    #pragma unroll
    for(int m=0;m<2;++m)
      #pragma unroll
      for(int g=0;g<4;++g){ v2u_t w; w.x=cvtpk_s(o[m][4*g]*rl,o[m][4*g+1]*rl); w.y=cvtpk_s(o[m][4*g+2]*rl,o[m][4*g+3]*rl);
        *(__attribute__((address_space(3))) v2u_t*)(stg+r32*F8_OSTP+(32*m+8*g+4*hi)*2)=w; }
    asm volatile("s_waitcnt lgkmcnt(0)":::"memory");
    bf16*Ow=Ou+(long)(wid*QBLK)*OP;
    #pragma unroll
    for(int i=0;i<4;++i){const int row=i*8+(lane>>3),ch=lane&7; const u32x4 v=*(const __attribute__((address_space(3))) u32x4*)(stg+row*F8_OSTP+ch*16); *(u32x4*)(Ow+(long)row*OP+ch*8)=v;} }
  asm volatile("s_waitcnt lgkmcnt(0)\n\ts_barrier":::"memory");
  #undef DMA8
}
#undef MF8
#undef SBAR
#undef WAIT_BAR
}
#define GAS __attribute__((address_space(1)))
#define LAS __attribute__((address_space(3)))
typedef unsigned short bf16;
typedef unsigned v4u __attribute__((ext_vector_type(4)));
typedef float f32x4 __attribute__((ext_vector_type(4)));
typedef short bf16x8 __attribute__((ext_vector_type(8)));
typedef GAS unsigned gu32;
typedef GAS unsigned long long gu64;
#define RLX_AGENT __ATOMIC_RELAXED, __HIP_MEMORY_SCOPE_AGENT
#define LDS_WAIT() asm volatile("s_waitcnt lgkmcnt(0)" ::: "memory")
#define VM_WAIT() asm volatile("s_waitcnt vmcnt(0)" ::: "memory")
__device__ __forceinline__ unsigned long long rt() { return __builtin_amdgcn_s_memrealtime(); }
__device__ __forceinline__ unsigned f2bf(float f) { unsigned u = __builtin_bit_cast(unsigned, f); return (u + 0x7fffu + ((u >> 16) & 1u)) >> 16; }
__device__ __forceinline__ unsigned pk2(float lo, float hi) { return f2bf(lo) | (f2bf(hi) << 16); }

#define XB_TMO      128
#define XB_XCNT(j)  (256  + 64 * (j))
#define XB_XSUB(j)  (1280 + 64 * (j))
#define XB_XGEN(j)  (2304 + 64 * (j))
#define XB_TOP      3328
#define XB_TOPGEN   3392
#define XCD_BAR_WORDS 3456
#define XB_SPIN_CAP (1u << 18)

__device__ __forceinline__ unsigned xb_ld(unsigned* p)              { return __hip_atomic_load(p, __ATOMIC_RELAXED, __HIP_MEMORY_SCOPE_AGENT); }
__device__ __forceinline__ unsigned xb_add(unsigned* p, unsigned v) { return __hip_atomic_fetch_add(p, v, __ATOMIC_RELAXED, __HIP_MEMORY_SCOPE_AGENT); }
__device__ __forceinline__ unsigned xb_xcc_id() { return (unsigned)__builtin_amdgcn_s_getreg((3 << 11) | 20) & 0xFu; }
#define XB_SPIN(cond, bar) do { unsigned _sp = 0; while (cond) { __builtin_amdgcn_s_sleep(1); \
    if ((++_sp & 255u) == 0u) { if (xb_ld(&(bar)[XB_TMO])) break; if (_sp > XB_SPIN_CAP) { atomicAdd(&(bar)[XB_TMO], 1u); break; } } } } while (0)

struct XcdBarrier {
    unsigned* bar; unsigned x;
    volatile LAS unsigned* st;
};

__device__ __forceinline__ XcdBarrier xcd_barrier_post(unsigned* bar, volatile LAS unsigned* st) {
    XcdBarrier b; b.bar = bar; b.x = xb_xcc_id(); b.st = st;
    if (threadIdx.x == 0) (void)xb_add(&bar[XB_XCNT(b.x)], 1u);
    return b;
}
__device__ __forceinline__ void xcd_barrier_complete(unsigned* bar, unsigned x, unsigned& nloc, unsigned& nx) {
    const unsigned G = gridDim.x * gridDim.y * gridDim.z;
    unsigned sum, cnt, mine, sp = 0u;
    for (;;) {
        sum = 0u; cnt = 0u; mine = 0u;
#pragma unroll
        for (unsigned j = 0; j < 16; ++j) { const unsigned c = xb_ld(&bar[XB_XCNT(j)]); sum += c; cnt += (c > 0u) ? 1u : 0u; mine = (j == x) ? c : mine; }
        if (sum == G) break;
        __builtin_amdgcn_s_sleep(1);
        if ((++sp & 255u) == 0u) { if (xb_ld(&bar[XB_TMO])) break; if (sp > XB_SPIN_CAP) { atomicAdd(&bar[XB_TMO], 1u); break; } }
    }
    nloc = mine > 0u ? mine : 1u; nx = cnt > 0u ? cnt : 1u;
}

__device__ __forceinline__ void xcd_barrier(const XcdBarrier& b) {
    asm volatile("s_waitcnt vmcnt(0)" ::: "memory");
    __syncthreads();
    if (threadIdx.x == 0) {
        unsigned* bar = b.bar;
        __builtin_amdgcn_s_waitcnt(0);
        unsigned nloc = b.st[0], nx = b.st[1];
        if (nloc == 0u) { xcd_barrier_complete(bar, b.x, nloc, nx); b.st[0] = nloc; b.st[1] = nx; }
        const unsigned old = xb_add(&bar[XB_XSUB(b.x)], 1u);
        const unsigned gen = old / nloc;
        if (old + 1u == (gen + 1u) * nloc) {
            __builtin_amdgcn_fence(__ATOMIC_RELEASE, "agent");
            asm volatile("s_waitcnt vmcnt(0)" ::: "memory");
            const unsigned og = xb_add(&bar[XB_TOP], 1u);
            const unsigned tg = og / nx;
            if (og + 1u == (tg + 1u) * nx) xb_add(&bar[XB_TOPGEN], 1u);
            else XB_SPIN(xb_ld(&bar[XB_TOPGEN]) == tg, bar);
            __builtin_amdgcn_fence(__ATOMIC_ACQUIRE, "agent");
            xb_add(&bar[XB_XGEN(b.x)], 1u);
            asm volatile("s_waitcnt vmcnt(0)" ::: "memory");
        } else {
            XB_SPIN(xb_ld(&bar[XB_XGEN(b.x)]) == gen, bar);
            __builtin_amdgcn_fence(__ATOMIC_ACQUIRE, "agent");
            asm volatile("s_waitcnt vmcnt(0)" ::: "memory");
        }
    }
    __syncthreads();
}
constexpr int NWAVES = 8;
constexpr int DM = 1024, NB = 2, SEQ = 16384, CTX = 256, RB = SEQ + CTX  , NR = NB * RB  ;
constexpr int INW = 2048, FF = 2816, NE = 8, NCH = RB / 128  , NLAT = NB * SEQ;
constexpr float EPS = 1e-6f;
constexpr int PC_K = 512, PC_V = 640, PC_RQ = 768, PC_RK = 1024, PC_RV = 1280, PC_RG = 1536, PC_PP = 1792;
constexpr int MOE_TP = 104, MOE_PASSES = 3, LISTCAP = 32768;

constexpr size_t MiB = 1u << 20, U128K = 131072;
constexpr size_t WS_CTL = 0, CTL_ZERO_BYTES = 1 * MiB;
constexpr size_t WS_MODV = 1 * MiB;
constexpr size_t WS_ROPE = 1 * MiB + 256 * 1024;
constexpr size_t WS_DEC = WS_ROPE + 32768;
constexpr size_t WS_TOK = 3 * MiB / 2;
constexpr size_t WS_LIST = 5 * MiB / 2;
constexpr size_t WS_XC = 7 * MiB / 2;
constexpr size_t WS_WIN = 6 * MiB, WS_WOUT = 14 * MiB, WS_W13D = 18 * MiB, WS_W2D = 29 * MiB, WS_W13M = 35 * MiB, WS_W2M = 80 * MiB  , WS_XB = 103 * MiB  ;
constexpr size_t SZ_WIN = (size_t)INW * DM * 2, SZ_WOUT = (size_t)DM * DM * 2, SZ_W13 = (size_t)2 * FF * DM * 2, SZ_W2 = (size_t)DM * FF * 2;
constexpr size_t SZ8_W13 = SZ_W13 / 2, SZ8_W2 = SZ_W2 / 2;
constexpr size_t WS_AR = 168 * MiB;
constexpr size_t AR_P = 0, AR_QB = 1040 * U128K, AR_KC = 1300 * U128K, AR_VC = 1365 * U128K, AR_US = 1430 * U128K, AR_MIX = 1690 * U128K, AR_MX = 2210 * U128K;
constexpr size_t AR_HX2 = 0, AR_ACT = 520 * U128K, AR_YD = 2210 * U128K, AR_YM = 1664 * U128K;
constexpr size_t AR_PART0 = 1040 * U128K  , AR_PART1 = 0  ;
constexpr size_t AR_Q8 = AR_QB, AR_K8 = AR_QB + 136 * U128K, AR_V8 = AR_QB + 176 * U128K;
constexpr size_t DO_Q8 = AR_MX + 20 * MiB, DO_K8 = AR_MX + 40 * MiB, DO_V8 = AR_MX + 46 * MiB, DO_O8 = AR_US;
constexpr size_t WS_END = 512 * MiB;
static_assert(WS_XB + (size_t)NLAT * DM * 2 <= WS_AR && WS_W2M + 8 * SZ8_W2 <= WS_XB && WS_W13M + 8 * SZ8_W13 <= WS_W2M && WS_W13D + SZ_W13 <= WS_W2D && WS_W2D + SZ_W2 <= WS_W13M, "weights map");
static_assert(AR_MX + (size_t)NR * DM * 2 <= WS_END - WS_AR && AR_ACT + (size_t)NR * FF * 2 <= AR_YD && AR_YM + (size_t)264 * 256 * DM * 2 <= WS_END - WS_AR && AR_ACT + (size_t)MOE_TP * 256 * FF * 2 <= AR_YM, "arena map");
static_assert(AR_QB == (size_t)NR * INW * 2 && AR_KC == AR_QB + (size_t)NR * 512 * 2 && AR_US == AR_VC + (size_t)NR * 128 * 2 && AR_MIX == AR_US + (size_t)16 * NCH * 16384 && AR_MX == AR_MIX + (size_t)NR * DM * 2, "arena map 2");
constexpr int CW_TMO = 0, CW_CODE = 1, CW_CNT = 64  , CW_BAR = 4096;
constexpr int RING_BYTES = 131072, MISC_OFF = RING_BYTES + 320, GTAB_OFF = RING_BYTES + 1024, MOE_OFF = RING_BYTES + 2048, LDS_BYTES = 147456;

typedef unsigned v2u __attribute__((ext_vector_type(2)));
typedef float f32x16 __attribute__((ext_vector_type(16)));

struct Args { const float* in[24]; float* out; unsigned char* ws; int ph_lo, ph_hi, li, pad; };
enum { I_X = 0, I_C, I_CTX, I_CCTX, I_WMOD, I_BMOD, I_NPREMIX, I_NPOSTMIX, I_NPREFFN, I_NPOSTFFN, I_WIN, I_WOUT, I_QN, I_KN, I_DECAY, I_POOLW, I_POOLS, I_FW1, I_FW3, I_FW2, I_ROUTER, I_MW1, I_MW3, I_MW2 };

typedef const __attribute__((address_space(4))) Args* ArgP;
__device__ __forceinline__ ArgP args_here() { ArgP p = (ArgP)__builtin_amdgcn_kernarg_segment_ptr(); asm volatile("" : "+s"(p)); return p; }
struct Frame { LAS unsigned char* lds; int tid, lane, wave, G, gw, NGW, bx; };
__device__ __forceinline__ void relaunder(Frame& F) { int t = threadIdx.x; asm volatile("" : "+v"(t)); F.tid = t; F.lane = t & 63; F.wave = __builtin_amdgcn_readfirstlane(t >> 6);
    int g = gridDim.x; asm volatile("" : "+s"(g)); F.G = g; int bx = blockIdx.x; asm volatile("" : "+s"(bx)); F.bx = bx; F.gw = bx * NWAVES + F.wave; F.NGW = F.G * NWAVES; }

#ifndef ATT8_DEBUG
#define ATT8_DEBUG 0
#endif
#ifndef DENSE_F8
#define DENSE_F8 0
#endif
#ifndef MOE_F8
#define MOE_F8 1
#endif
#ifndef DENSE_I8UP
#define DENSE_I8UP 1
#endif
#ifndef MOE_I8UP
#define MOE_I8UP 1
#endif
#ifndef DENSE_DOWN_F8
#define DENSE_DOWN_F8 1
#endif
#ifndef IN_I8
#define IN_I8 3
#endif
constexpr float I8_XS = 20.0f, I8_XI = 20.0f, I8_WS = 1024.0f;
#ifndef IN1_F8
#define IN1_F8 0
#endif
__device__ __forceinline__ unsigned char* q8_ptr(ArgP a) { return ATT8_DEBUG ? a->ws + WS_AR + DO_Q8 : a->ws + WS_AR + AR_Q8; }
__device__ __forceinline__ unsigned char* k8_ptr(ArgP a) { return ATT8_DEBUG ? a->ws + WS_AR + DO_K8 : a->ws + WS_AR + AR_K8; }
__device__ __forceinline__ unsigned char* v8_ptr(ArgP a) { return ATT8_DEBUG ? a->ws + WS_AR + DO_V8 : a->ws + WS_AR + AR_V8; }
__device__ __forceinline__ unsigned fp8x4(float a, float b, float c, float d) { int w = 0; w = __builtin_amdgcn_cvt_pk_fp8_f32(a, b, w, false); w = __builtin_amdgcn_cvt_pk_fp8_f32(c, d, w, true); return (unsigned)w; }
__device__ __forceinline__ unsigned i8x4(float a, float b, float c, float d, float s) {
    unsigned w = 0;
    w = __builtin_amdgcn_cvt_pk_u8_f32(__builtin_amdgcn_fmed3f(__builtin_rintf(__builtin_fmaf(a, s, 128.0f)), 1.0f, 255.0f), 0, w);
    w = __builtin_amdgcn_cvt_pk_u8_f32(__builtin_amdgcn_fmed3f(__builtin_rintf(__builtin_fmaf(b, s, 128.0f)), 1.0f, 255.0f), 1, w);
    w = __builtin_amdgcn_cvt_pk_u8_f32(__builtin_amdgcn_fmed3f(__builtin_rintf(__builtin_fmaf(c, s, 128.0f)), 1.0f, 255.0f), 2, w);
    w = __builtin_amdgcn_cvt_pk_u8_f32(__builtin_amdgcn_fmed3f(__builtin_rintf(__builtin_fmaf(d, s, 128.0f)), 1.0f, 255.0f), 3, w);
    return w ^ 0x80808080u; }
__device__ __forceinline__ float bf_lo(unsigned u) { return __uint_as_float(u << 16); }
__device__ __forceinline__ float bf_hi(unsigned u) { return __uint_as_float(u & 0xffff0000u); }
__device__ __forceinline__ unsigned pkbf(float lo, float hi) { return attn_body::cvtpk_s(lo, hi); }
template <int M> __device__ __forceinline__ float shx(float v) { return __builtin_bit_cast(float, __builtin_amdgcn_ds_swizzle(__builtin_bit_cast(int, v), 0x1F | (M << 10))); }
__device__ __forceinline__ float half_sum(float v) { auto rr = __builtin_amdgcn_permlane32_swap(__float_as_uint(v), __float_as_uint(v), false, false); return __uint_as_float(rr[0]) + __uint_as_float(rr[1]); }
__device__ __forceinline__ float half_max(float v) { auto rr = __builtin_amdgcn_permlane32_swap(__float_as_uint(v), __float_as_uint(v), false, false); return fmaxf(__uint_as_float(rr[0]), __uint_as_float(rr[1])); }
__device__ __forceinline__ float wave_sum(float v) { v += shx<1>(v); v += shx<2>(v); v += shx<4>(v); v += shx<8>(v); v += shx<16>(v); return half_sum(v); }
__device__ __forceinline__ float siluf(float x) { return x / (1.0f + __expf(-x)); }
__device__ __forceinline__ float logsig(float x) { return -log1pf(expf(-x)); }
#define ROWCOL(j) (512 * ((j) >> 1) + 4 * ((j) & 1))
__device__ __forceinline__ void ld16(f32x4 (&v)[4], const float* p, int lane) {
#pragma unroll
    for (int j = 0; j < 4; ++j) v[j] = *(const f32x4*)(p + ROWCOL(j) + 8 * lane);
}
__device__ __forceinline__ void ld16b(f32x4 (&v)[4], const bf16* p, int lane) {
#pragma unroll
    for (int h = 0; h < 2; ++h) { const v4u u = *(const v4u*)(p + 512 * h + 8 * lane); v[2 * h] = (f32x4){bf_lo(u.x), bf_hi(u.x), bf_lo(u.y), bf_hi(u.y)}; v[2 * h + 1] = (f32x4){bf_lo(u.z), bf_hi(u.z), bf_lo(u.w), bf_hi(u.w)}; }
}
__device__ __forceinline__ void st16(float* p, const f32x4 (&v)[4], int lane) {
#pragma unroll
    for (int j = 0; j < 4; ++j) *(f32x4*)(p + ROWCOL(j) + 8 * lane) = v[j];
}
__device__ __forceinline__ void st16b(bf16* p, const f32x4 (&v)[4], int lane) {
#pragma unroll
    for (int h = 0; h < 2; ++h) { v4u u; u.x = pkbf(v[2 * h][0], v[2 * h][1]); u.y = pkbf(v[2 * h][2], v[2 * h][3]); u.z = pkbf(v[2 * h + 1][0], v[2 * h + 1][1]); u.w = pkbf(v[2 * h + 1][2], v[2 * h + 1][3]); *(v4u*)(p + 512 * h + 8 * lane) = u; }
}
__device__ __forceinline__ void st16f8(unsigned char* p, const f32x4 (&v)[4], int lane) {
#pragma unroll
    for (int h = 0; h < 2; ++h) { v2u u; u.x = fp8x4(v[2 * h][0], v[2 * h][1], v[2 * h][2], v[2 * h][3]); u.y = fp8x4(v[2 * h + 1][0], v[2 * h + 1][1], v[2 * h + 1][2], v[2 * h + 1][3]); *(v2u*)(p + 512 * h + 8 * lane) = u; }
}
__device__ __forceinline__ void st16i8(unsigned char* p, const f32x4 (&v)[4], int lane, const float I8_XS = ::I8_XS) {
#pragma unroll
    for (int h = 0; h < 2; ++h) { v2u u; u.x = i8x4(v[2 * h][0], v[2 * h][1], v[2 * h][2], v[2 * h][3], I8_XS); u.y = i8x4(v[2 * h + 1][0], v[2 * h + 1][1], v[2 * h + 1][2], v[2 * h + 1][3], I8_XS); *(v2u*)(p + 512 * h + 8 * lane) = u; }
}
__device__ __forceinline__ float sumsq16(const f32x4 (&v)[4]) {
    float s = 0.f;
#pragma unroll
    for (int j = 0; j < 4; ++j) s += (v[j][0] * v[j][0] + v[j][1] * v[j][1]) + (v[j][2] * v[j][2] + v[j][3] * v[j][3]);
    return s;
}
__device__ __forceinline__ const float* modv(const unsigned char* ws, int l, int cls, int chunk) { return (const float*)(ws + WS_MODV) + ((size_t)(l * 3 + cls) * 6 + chunk) * DM; }

template <int F8 = 0  > __device__ __forceinline__ void p0_transpose_item(const float* W, int K, int N, bf16* WT, int k0, int n0, int drow0, LAS float* scr, int lane) {
    { const int c4 = (lane & 7) * 4, r8 = lane >> 3;
#pragma unroll
        for (int i = 0; i < 8; ++i) { const int kk = 8 * i + r8; const f32x4 v = *(const f32x4*)(W + (size_t)(k0 + kk) * N + n0 + c4);
            LAS float* d = scr + kk * 33 + c4; d[0] = v[0]; d[1] = v[1]; d[2] = v[2]; d[3] = v[3]; } }
    LDS_WAIT(); asm volatile("" ::: "memory");
    const int c = lane & 7;
#pragma unroll
    for (int j = 0; j < 4; ++j) { const int n = (lane >> 3) + 8 * j; const LAS float* s = scr + (8 * c) * 33 + n;
        if constexpr (F8 == 2) { v2u o; o.x = i8x4(s[0 * 33], s[1 * 33], s[2 * 33], s[3 * 33], I8_WS); o.y = i8x4(s[4 * 33], s[5 * 33], s[6 * 33], s[7 * 33], I8_WS);
            *(v2u*)((unsigned char*)WT + (size_t)(drow0 + n) * K + k0 + 8 * c) = o; }
        else if constexpr (F8 == 1) { v2u o; o.x = fp8x4(s[0 * 33] * 64.0f, s[1 * 33] * 64.0f, s[2 * 33] * 64.0f, s[3 * 33] * 64.0f); o.y = fp8x4(s[4 * 33] * 64.0f, s[5 * 33] * 64.0f, s[6 * 33] * 64.0f, s[7 * 33] * 64.0f);
            *(v2u*)((unsigned char*)WT + (size_t)(drow0 + n) * K + k0 + 8 * c) = o; }
        else { v4u o; o.x = pkbf(s[0 * 33], s[1 * 33]); o.y = pkbf(s[2 * 33], s[3 * 33]); o.z = pkbf(s[4 * 33], s[5 * 33]); o.w = pkbf(s[6 * 33], s[7 * 33]);
        *(v4u*)(WT + (size_t)(drow0 + n) * K + k0 + 8 * c) = o; } }
    LDS_WAIT(); asm volatile("" ::: "memory");
}
constexpr int WC_IN = 16 * 64, WC_OUT = 16 * 32, WC_F = 1408, WCOPY_ITEMS = 2 * WC_IN + 2 * WC_OUT + 27 * WC_F;
constexpr int WCOPY_SPLIT1 = WCOPY_ITEMS - 21120, WCOPY_SPLIT2 = WCOPY_ITEMS - 12800;
struct WItem { const float* src; unsigned char* dst; int N, K, mode; };
__device__ __forceinline__ WItem wc_decode(ArgP a, int it) {
    WItem w; int r = it;
    if (r < 2 * WC_IN) { const int l = r / WC_IN, q = r % WC_IN, kb = q / 64, nb = q % 64;
        w.mode = ((IN_I8 >> l) & 1) ? 2 : ((IN1_F8 && l == 1) ? 1 : 0); w.N = INW; w.K = DM; w.src = a->in[I_WIN] + (size_t)l * DM * INW + (size_t)(64 * kb) * INW + 32 * nb;
        w.dst = a->ws + WS_WIN + l * SZ_WIN + ((size_t)(32 * nb) * DM + 64 * kb) * (w.mode ? 1 : 2); return w; }
    r -= 2 * WC_IN;
    if (r < 2 * WC_OUT) { const int l = r / WC_OUT, q = r % WC_OUT, kb = q / 32, nb = q % 32;
        w.mode = 0; w.N = DM; w.K = DM; w.src = a->in[I_WOUT] + (size_t)l * DM * DM + (size_t)(64 * kb) * DM + 32 * nb; w.dst = a->ws + WS_WOUT + l * SZ_WOUT + ((size_t)(32 * nb) * DM + 64 * kb) * 2; return w; }
    r -= 2 * WC_OUT;
    const int mat = r / WC_F, q = r % WC_F;
    int which, e; bool moe;
    if (mat < 3) { which = mat; e = 0; moe = false; } else { which = (mat - 3) % 3; e = (mat - 3) / 3; moe = true; }
    if (which < 2) {
        const float* W = (moe ? a->in[which == 0 ? I_MW1 : I_MW3] + (size_t)e * DM * FF : a->in[which == 0 ? I_FW1 : I_FW3]);
        unsigned char* WT = a->ws + (moe ? WS_W13M + e * (MOE_F8 ? SZ8_W13 : SZ_W13) : WS_W13D);
        const int kb = q / 88, nb = q % 88, n0 = 32 * nb; const int drow0 = (n0 >> 7) * 256 + which * 128 + (n0 & 127);
        w.mode = moe ? ((MOE_F8 && !MOE_I8UP) ? 1 : (MOE_I8UP ? 2 : 0)) : (DENSE_F8 ? 1 : (DENSE_I8UP ? 2 : 0));
        w.N = FF; w.K = DM; w.src = W + (size_t)(64 * kb) * FF + n0; w.dst = WT + ((size_t)drow0 * DM + 64 * kb) * (w.mode ? 1 : 2);
    } else {
        const float* W = (moe ? a->in[I_MW2] + (size_t)e * FF * DM : a->in[I_FW2]);
        unsigned char* WT = a->ws + (moe ? WS_W2M + e * (MOE_F8 ? SZ8_W2 : SZ_W2) : WS_W2D);
        const int kb = q / 32, nb = q % 32;
        w.mode = moe ? (MOE_F8 ? 1 : 0) : ((DENSE_F8 || DENSE_DOWN_F8) ? 1 : 0);
        w.N = DM; w.K = FF; w.src = W + (size_t)(64 * kb) * DM + 32 * nb; w.dst = WT + ((size_t)(32 * nb) * FF + 64 * kb) * (w.mode ? 1 : 2);
    }
    return w;
}
__device__ __forceinline__ void wc_load(const WItem& w, f32x4 (&v)[8], int lane) {
    const int c4 = (lane & 7) * 4, r8 = lane >> 3;
#pragma unroll
    for (int i = 0; i < 8; ++i) v[i] = *(const f32x4*)(w.src + (size_t)(8 * i + r8) * w.N + c4);
}
__device__ __forceinline__ void wc_process(const WItem& w, const f32x4 (&v)[8], LAS float* scr, int lane) {
    { const int c4 = (lane & 7) * 4, r8 = lane >> 3;
#pragma unroll
        for (int i = 0; i < 8; ++i) { LAS float* d = scr + (8 * i + r8) * 33 + c4; d[0] = v[i][0]; d[1] = v[i][1]; d[2] = v[i][2]; d[3] = v[i][3]; } }
    LDS_WAIT(); asm volatile("" ::: "memory");
    const int c = lane & 7;
#pragma unroll
    for (int j = 0; j < 4; ++j) { const int n = (lane >> 3) + 8 * j; const LAS float* s = scr + (8 * c) * 33 + n;
        const float s0 = s[0 * 33], s1 = s[1 * 33], s2 = s[2 * 33], s3 = s[3 * 33], s4 = s[4 * 33], s5 = s[5 * 33], s6 = s[6 * 33], s7 = s[7 * 33];
        if (w.mode == 2) { v2u o; o.x = i8x4(s0, s1, s2, s3, I8_WS); o.y = i8x4(s4, s5, s6, s7, I8_WS); *(v2u*)(w.dst + (size_t)n * w.K + 8 * c) = o; }
        else if (w.mode == 1) { v2u o; o.x = fp8x4(s0 * 64.0f, s1 * 64.0f, s2 * 64.0f, s3 * 64.0f); o.y = fp8x4(s4 * 64.0f, s5 * 64.0f, s6 * 64.0f, s7 * 64.0f); *(v2u*)(w.dst + (size_t)n * w.K + 8 * c) = o; }
        else { v4u o; o.x = pkbf(s0, s1); o.y = pkbf(s2, s3); o.z = pkbf(s4, s5); o.w = pkbf(s6, s7); *(v4u*)(w.dst + ((size_t)n * w.K + 8 * c) * 2) = o; } }
    LDS_WAIT(); asm volatile("" ::: "memory");
}
__device__ __forceinline__ void weight_copy_items(ArgP a, Frame& F, const int lo_, const int hi_, const int rk, const int nrk) {
    LAS float* scr = (LAS float*)(F.lds + F.wave * 16384);
    int it = lo_ + rk; if (it >= hi_) return;
    WItem cur = wc_decode(a, it); f32x4 vc[8]; wc_load(cur, vc, F.lane);
    for (;;) {
        const int itn = it + nrk; const bool more = itn < hi_;
        const WItem nx = wc_decode(a, more ? itn : it); f32x4 vn[8]; wc_load(nx, vn, F.lane);
        wc_process(cur, vc, scr, F.lane);
        if (!more) break;
        cur = nx; it = itn;
#pragma unroll
        for (int i = 0; i < 8; ++i) vc[i] = vn[i];
    }
}
__device__ __forceinline__ void phase_p0a(ArgP a, Frame& F) {
    LAS float* sv = (LAS float*)F.lds;
    LAS float* red = (LAS float*)(F.lds + 12288);
    for (int i = F.tid; i < 3072; i += 512) { const int v = i >> 10, k = i & 1023; const float x = (v < 2) ? a->in[I_C][v * 1024 + k] : a->in[I_CCTX][k]; sv[i] = siluf(x); }
    __syncthreads();
    for (int it = F.bx; it < 256; it += F.G) {
        const int l = it >> 7, cg = it & 127; const int r5 = F.lane / 12, c12 = F.lane % 12; const bool act = F.lane < 60;
        f32x4 acc[3]; acc[0] = acc[1] = acc[2] = (f32x4){0.f, 0.f, 0.f, 0.f};
        const float* Wl = a->in[I_WMOD] + (size_t)l * DM * 6144 + 48 * cg + 4 * c12;
#pragma unroll
        for (int hb = 0; hb < 2; ++hb) { f32x4 w4[13];
#pragma unroll
            for (int j = 0; j < 13; ++j) { const int kk = r5 + 5 * (13 * hb + j); const int kc = (act && kk < 128) ? 128 * F.wave + kk : 128 * F.wave; w4[j] = *(const f32x4*)(Wl + (size_t)kc * 6144); }
#pragma unroll
            for (int j = 0; j < 13; ++j) { const int kk = r5 + 5 * (13 * hb + j); const int k = 128 * F.wave + kk;
                if (act && kk < 128) { acc[0] += sv[k] * w4[j]; acc[1] += sv[1024 + k] * w4[j]; acc[2] += sv[2048 + k] * w4[j]; } } }
        if (act) {
#pragma unroll
            for (int v = 0; v < 3; ++v)
#pragma unroll
                for (int e = 0; e < 4; ++e) red[(F.wave * 60 + F.lane) * 12 + v * 4 + e] = acc[v][e]; }
        __syncthreads();
        if (F.tid < 144) { const int v = F.tid / 48, col = F.tid % 48, c12b = col >> 2, e = col & 3; float s = 0.f;
            for (int w = 0; w < 8; ++w)
                for (int r = 0; r < 5; ++r) s += red[(w * 60 + r * 12 + c12b) * 12 + v * 4 + e];
            ((float*)(a->ws + WS_MODV))[((size_t)(l * 3 + v)) * 6144 + 48 * cg + col] = s + a->in[I_BMOD][l * 6144 + 48 * cg + col]; }
        __syncthreads();
    }
    if (F.bx == F.G - 1 && F.tid >= 64 && F.tid < 80) { const int t = F.tid - 64; const float lg = logsig(a->in[I_DECAY][t]); ((float*)(a->ws + WS_DEC))[t] = lg; ((float*)(a->ws + WS_DEC))[16 + t] = expf(128.0f * lg); }
    if (F.tid < 16)
        for (int i = F.bx * 16 + F.tid; i < 4096; i += F.G * 16) { const int pos = i >> 4, fi = i & 15; const double inv = pow(10000.0, -(double)fi / 16.0); const double ang = (double)pos * inv;
            ((float*)(a->ws + WS_ROPE))[i] = (float)cos(ang); ((float*)(a->ws + WS_ROPE))[4096 + i] = (float)sin(ang); }
    weight_copy_items(a, F, 0, WCOPY_ITEMS, F.gw, F.NGW);
}

struct RowLoc { int b, jj, cls; size_t xoff; bool isctx; };
__device__ __forceinline__ RowLoc rowloc(int r) { RowLoc L; L.b = r / RB; L.jj = r - L.b * RB; L.isctx = L.jj < CTX; L.cls = L.isctx ? 2 : L.b;
    L.xoff = L.isctx ? (size_t)(L.b * CTX + L.jj) * DM : (size_t)(L.b * SEQ + (L.jj - CTX)) * DM; return L; }

__device__ __forceinline__ void wave_sum2(float& a, float& b) {
    for (int o = 0; o < 1; ++o) { float ta, tb; ta = shx<1>(a); tb = shx<1>(b); a += ta; b += tb; ta = shx<2>(a); tb = shx<2>(b); a += ta; b += tb; ta = shx<4>(a); tb = shx<4>(b); a += ta; b += tb;
        ta = shx<8>(a); tb = shx<8>(b); a += ta; b += tb; ta = shx<16>(a); tb = shx<16>(b); a += ta; b += tb; a = half_sum(a); b = half_sum(b); }
}
__device__ __forceinline__ void premix_rows(ArgP a, Frame& F, const int r0  , const int stride, const int nrows  , const bool isctx) {
    bf16* HX = (bf16*)(a->ws + WS_AR + AR_MIX);
    const float* xsrc = isctx ? a->in[I_CTX] : a->in[I_X];
    f32x4 A[4], B[4], t0[4]; int curcls = -1;
    f32x4 v0[4], v1[4], n0[4], n1[4]; ld16(v0, xsrc + (size_t)r0 * DM, F.lane); ld16(v1, xsrc + (size_t)(r0 + stride) * DM, F.lane);
#pragma unroll 1
    for (int rr = 0; rr < nrows; rr += 2) {
        const int ra = r0 + rr * stride, rb = ra + stride;
        if (rr + 2 < nrows) { ld16(n0, xsrc + (size_t)(ra + 2 * stride) * DM, F.lane); ld16(n1, xsrc + (size_t)(rb + 2 * stride) * DM, F.lane); }
        const int ba = isctx ? ra / CTX : ra / SEQ, bb = isctx ? rb / CTX : rb / SEQ; const int cls = isctx ? 2 : ba;
        if (cls != curcls) { curcls = cls; ld16(A, a->in[I_NPREMIX], F.lane); ld16(t0, modv(a->ws, 0, cls, 1), F.lane); ld16(B, modv(a->ws, 0, cls, 0), F.lane);
#pragma unroll
            for (int j = 0; j < 4; ++j) A[j] = A[j] * (1.0f + t0[j]); }
        const int ua = isctx ? ba * RB + (ra - ba * CTX) : ra + CTX * (ba + 1), ub = isctx ? bb * RB + (rb - bb * CTX) : rb + CTX * (bb + 1);
        float q0 = sumsq16(v0), q1 = sumsq16(v1); wave_sum2(q0, q1);
        const float r0s = 1.0f / sqrtf(q0 * (1.0f / DM) + EPS), r1s = 1.0f / sqrtf(q1 * (1.0f / DM) + EPS);
#pragma unroll
        for (int j = 0; j < 4; ++j) { v0[j] = v0[j] * r0s * A[j] + B[j]; v1[j] = v1[j] * r1s * A[j] + B[j]; }
        if (IN_I8 & 1) { st16i8((unsigned char*)HX + (size_t)ua * DM, v0, F.lane, I8_XI); st16i8((unsigned char*)HX + (size_t)ub * DM, v1, F.lane, I8_XI); }
        else { st16b(HX + (size_t)ua * DM, v0, F.lane); st16b(HX + (size_t)ub * DM, v1, F.lane); }
#pragma unroll
        for (int j = 0; j < 4; ++j) { v0[j] = n0[j]; v1[j] = n1[j]; }
    }
}
__device__ __forceinline__ void phase_premix0(ArgP a, Frame& F) {
    const int per = NLAT / F.NGW;
    if (F.gw < NLAT) premix_rows(a, F, F.gw, F.NGW, per, false);
    for (int j = F.gw; j < 8 * NB * CTX / 2; j += F.NGW) if ((j & 7) == 0) premix_rows(a, F, (j >> 3) * 2, 1, 2, true);
}

__device__ __forceinline__ void moe_prefix(const unsigned char* ws, int (&tstart)[9], int (&cnt)[8]) {
    const unsigned* cw = (const unsigned*)(ws + WS_CTL) + CW_CNT; int s = 0;
#pragma unroll
    for (int e = 0; e < 8; ++e) { cnt[e] = (int)__builtin_amdgcn_readfirstlane(cw[64 * e]); tstart[e] = s; s += (cnt[e] + 255) >> 8; }
    tstart[8] = s;
}

template <int MODE> __device__ __forceinline__ void resid_rows(ArgP a, Frame& F, const int r0, const int stride, const int nrows, const bool isctx,
                                                               const int (&tstart)[9], int& myE0, int& myE1, float& myW0, float& myW1) {
    constexpr int l = MODE >> 1; constexpr bool post_ffn = MODE & 1;
    const bf16* SRC = (const bf16*)(a->ws + WS_AR + (MODE == 1 ? AR_YD : (MODE == 3 ? AR_YM : AR_MX)));
    bf16* H = (bf16*)(a->ws + WS_AR + (MODE == 1 ? AR_MIX : AR_HX2));
    const float* gpost = a->in[post_ffn ? I_NPOSTFFN : I_NPOSTMIX] + l * DM;
    const float* gnext = (MODE == 1) ? a->in[I_NPREMIX] + DM : a->in[I_NPREFFN] + l * DM;
    constexpr int gate_chunk = post_ffn ? 5 : 2, sc_chunk = (MODE == 1) ? 1 : 4, sh_chunk = (MODE == 1) ? 0 : 3, lnext = (MODE == 1) ? 1 : l;
    const LAS float* rts = (const LAS float*)F.lds;
    float* XC = (float*)(a->ws + WS_XC);
    const float* xin = isctx ? (MODE == 0 ? a->in[I_CTX] : (const float*)XC) : a->in[I_X];
    float* xout = isctx ? XC : a->out;
    bf16* XB = (bf16*)(a->ws + WS_XB);
    f32x4 G1[4], A2[4], B2[4], t0[4]; int curcls = -1;
#define UROW(r_) (isctx ? ((r_) / CTX) * RB + ((r_) % CTX) : (r_) + CTX * ((r_) / SEQ + 1))
    v4u tiv = (v4u){0u, 0u, 0u, 0u}; float tw0 = 0.f, tw1 = 0.f;
    if constexpr (MODE == 3) { if (F.lane < nrows) { const unsigned char* tp = a->ws + WS_TOK + (size_t)(r0 + F.lane * stride) * 32; tiv = *(const v4u*)tp; tw0 = *(const float*)(tp + 16); tw1 = *(const float*)(tp + 20); } }
    f32x4 s0[4], x0[4], s1[4], x1[4], sn0[4], xn0[4], sn1[4], xn1[4], y1[4];
#define RESID_LOAD(S_, X_, rr_) do { \
        if constexpr (MODE == 3) { const int e0 = __builtin_amdgcn_readlane((int)tiv.x, rr_), p0l = __builtin_amdgcn_readlane((int)tiv.y, rr_), e1 = __builtin_amdgcn_readlane((int)tiv.z, rr_), p1l = __builtin_amdgcn_readlane((int)tiv.w, rr_); \
            const float w0 = __builtin_bit_cast(float, __builtin_amdgcn_readlane(__builtin_bit_cast(int, tw0), rr_)), w1 = __builtin_bit_cast(float, __builtin_amdgcn_readlane(__builtin_bit_cast(int, tw1), rr_)); \
            int ts0 = 0, ts1 = 0; _Pragma("unroll") for (int e = 0; e < 8; ++e) { ts0 = (e0 == e) ? tstart[e] : ts0; ts1 = (e1 == e) ? tstart[e] : ts1; } \
            ld16b(S_, SRC + ((size_t)ts0 * 256 + p0l) * DM, F.lane); ld16b(y1, SRC + ((size_t)ts1 * 256 + p1l) * DM, F.lane); \
            _Pragma("unroll") for (int j = 0; j < 4; ++j) S_[j] = w0 * S_[j] + w1 * y1[j]; } \
        else if (isctx && (MODE == 0 || (MODE == 1 && !DENSE_DOWN_F8))) { const int cr_ = r0 + (rr_) * stride; const float* pp_ = (const float*)(a->ws + WS_AR + (MODE == 0 ? AR_PART0 : AR_PART1)) + (size_t)((cr_ >> 8) * 256 + (cr_ & 255)) * DM; \
            ld16(S_, pp_, F.lane); for (int ks_ = 1; ks_ < (MODE == 0 ? 4 : 11); ++ks_) { ld16(y1, pp_ + (size_t)ks_ * 512 * DM, F.lane); _Pragma("unroll") for (int j = 0; j < 4; ++j) S_[j] += y1[j]; } } \
        else ld16b(S_, SRC + (size_t)UROW(r0 + (rr_) * stride) * DM, F.lane); \
        if (!isctx && MODE != 0) ld16b(X_, XB + (size_t)(r0 + (rr_) * stride) * DM, F.lane); else ld16(X_, xin + (size_t)(r0 + (rr_) * stride) * DM, F.lane); } while (0)
    RESID_LOAD(s0, x0, 0); RESID_LOAD(s1, x1, 1);
#pragma unroll 1
    for (int rr = 0; rr < nrows; rr += 2) {
        if (rr + 2 < nrows) { RESID_LOAD(sn0, xn0, rr + 2); RESID_LOAD(sn1, xn1, rr + 3); }
        const int ra = r0 + rr * stride, rb = ra + stride; const int cls = isctx ? 2 : ra / SEQ;
        if (cls != curcls) { curcls = cls; ld16(G1, gpost, F.lane); ld16(t0, modv(a->ws, l, cls, gate_chunk), F.lane);
#pragma unroll
            for (int j = 0; j < 4; ++j) G1[j] = G1[j] * t0[j];
            if constexpr (MODE != 3) { ld16(A2, gnext, F.lane); ld16(t0, modv(a->ws, lnext, cls, sc_chunk), F.lane); ld16(B2, modv(a->ws, lnext, cls, sh_chunk), F.lane);
#pragma unroll
                for (int j = 0; j < 4; ++j) A2[j] = A2[j] * (1.0f + t0[j]); } }
        float q0 = sumsq16(s0), q1 = sumsq16(s1); wave_sum2(q0, q1);
        const float rs0 = 1.0f / sqrtf(q0 * (1.0f / DM) + EPS), rs1 = 1.0f / sqrtf(q1 * (1.0f / DM) + EPS);
#pragma unroll
        for (int j = 0; j < 4; ++j) { x0[j] = x0[j] + G1[j] * (s0[j] * rs0); x1[j] = x1[j] + G1[j] * (s1[j] * rs1); }
        if (!isctx && MODE != 3) { st16b(XB + (size_t)ra * DM, x0, F.lane); st16b(XB + (size_t)rb * DM, x1, F.lane); } else { st16(xout + (size_t)ra * DM, x0, F.lane); st16(xout + (size_t)rb * DM, x1, F.lane); }
        if constexpr (MODE != 3) {
            float u0 = sumsq16(x0), u1 = sumsq16(x1); wave_sum2(u0, u1);
            const float t0r = 1.0f / sqrtf(u0 * (1.0f / DM) + EPS), t1r = 1.0f / sqrtf(u1 * (1.0f / DM) + EPS);
#pragma unroll
            for (int j = 0; j < 4; ++j) { x0[j] = x0[j] * t0r * A2[j] + B2[j]; x1[j] = x1[j] * t1r * A2[j] + B2[j]; }
            if constexpr (MODE == 1 && (IN_I8 & 2)) { st16i8((unsigned char*)H + (size_t)UROW(ra) * DM, x0, F.lane, I8_XI); st16i8((unsigned char*)H + (size_t)UROW(rb) * DM, x1, F.lane, I8_XI); }
            else if constexpr (MODE == 2 && MOE_F8 && MOE_I8UP) { st16i8((unsigned char*)H + (size_t)ra * DM, x0, F.lane); st16i8((unsigned char*)H + (size_t)rb * DM, x1, F.lane); }
            else if constexpr (MODE == 0 && DENSE_I8UP && !DENSE_F8) { st16i8((unsigned char*)H + (size_t)UROW(ra) * DM, x0, F.lane); st16i8((unsigned char*)H + (size_t)UROW(rb) * DM, x1, F.lane); }
            else if constexpr ((MODE == 1 && !IN1_F8) || (MODE == 0 && !DENSE_F8) || (MODE == 2 && !MOE_F8)) { st16b(H + (size_t)(MODE == 2 ? ra : UROW(ra)) * DM, x0, F.lane); st16b(H + (size_t)(MODE == 2 ? rb : UROW(rb)) * DM, x1, F.lane); }
            else { st16f8((unsigned char*)H + (size_t)(MODE == 2 ? ra : UROW(ra)) * DM, x0, F.lane); st16f8((unsigned char*)H + (size_t)(MODE == 2 ? rb : UROW(rb)) * DM, x1, F.lane); }
            if constexpr (MODE == 2) {
                asm volatile("" ::: "memory");
                float lgA[8], lgB[8];
#pragma unroll
                for (int e = 0; e < 8; ++e) { float pA = 0.f, pB = 0.f;
#pragma unroll
                    for (int j = 0; j < 4; ++j) { const f32x4 rv = *(const LAS f32x4*)(rts + e * 1024 + ROWCOL(j) + 8 * F.lane);
                        pA += (x0[j][0] * rv[0] + x0[j][1] * rv[1]) + (x0[j][2] * rv[2] + x0[j][3] * rv[3]); pB += (x1[j][0] * rv[0] + x1[j][1] * rv[1]) + (x1[j][2] * rv[2] + x1[j][3] * rv[3]); }
                    wave_sum2(pA, pB); lgA[e] = pA; lgB[e] = pB; }
#define TOP2(lg, rrow) do { int i0 = 0; float v0 = lg[0]; _Pragma("unroll") for (int e = 1; e < 8; ++e) if (lg[e] > v0) { v0 = lg[e]; i0 = e; } \
                    int i1 = -1; float v1 = -INFINITY; _Pragma("unroll") for (int e = 0; e < 8; ++e) if (e != i0 && lg[e] > v1) { v1 = lg[e]; i1 = e; } \
                    const float w0 = 1.0f / (1.0f + __expf(v1 - v0)); if (F.lane == (rrow)) { myE0 = i0; myE1 = i1; myW0 = w0; myW1 = 1.0f - w0; } } while (0)
                TOP2(lgA, rr); TOP2(lgB, rr + 1);
#undef TOP2
            }
        }
#pragma unroll
        for (int j = 0; j < 4; ++j) { s0[j] = sn0[j]; x0[j] = xn0[j]; s1[j] = sn1[j]; x1[j] = xn1[j]; }
    }
#undef RESID_LOAD
#undef UROW
}
template <int MODE> __device__ __forceinline__ void phase_resid(ArgP a, Frame& F) {
    float* XC = (float*)(a->ws + WS_XC);
    int tstart[9], ecnt[8];
    if constexpr (MODE == 3) moe_prefix(a->ws, tstart, ecnt); else {
#pragma unroll
        for (int e = 0; e < 9; ++e) tstart[e] = 0; }
    int myE0 = -1, myE1 = -1; float myW0 = 0.f, myW1 = 0.f;
    if constexpr (MODE < 2) {
        if (F.gw < NLAT) resid_rows<MODE>(a, F, F.gw, F.NGW, NLAT / F.NGW, false, tstart, myE0, myE1, myW0, myW1);
        for (int j = F.gw; j < 8 * NB * CTX / 2; j += F.NGW) if ((j & 7) == 0) resid_rows<MODE>(a, F, (j >> 3) * 2, 1, 2, true, tstart, myE0, myE1, myW0, myW1);
    } else {
        LAS float* rts = (LAS float*)F.lds;
        LAS int* wcnt = (LAS int*)(F.lds + 32768);
        LAS int* bbase = (LAS int*)(F.lds + 32768 + 256);
        if constexpr (MODE == 2) { for (int i = F.tid; i < 8192; i += 512) { const int k = i >> 3, e = i & 7; rts[e * 1024 + k] = a->in[I_ROUTER][i]; } __syncthreads(); }
        const int per = NLAT / F.NGW;
        for (int rd = 0; rd < 1; ++rd) {
            const bool active = F.gw < NLAT;
            myE0 = -1; myE1 = -1;
            if (active) resid_rows<MODE>(a, F, F.gw, F.NGW, per, false, tstart, myE0, myE1, myW0, myW1);
            if constexpr (MODE == 2) {
                int tid2 = F.tid; asm volatile("" : "+v"(tid2)); const int lane2 = tid2 & 63;
                if (lane2 < 8) wcnt[F.wave * 8 + lane2] = 0;
                LDS_WAIT();
                int r0 = 0, r1 = 0;
                if (active && lane2 < per) { r0 = __hip_atomic_fetch_add(wcnt + F.wave * 8 + myE0, 1, __ATOMIC_RELAXED, __HIP_MEMORY_SCOPE_WORKGROUP); r1 = __hip_atomic_fetch_add(wcnt + F.wave * 8 + myE1, 1, __ATOMIC_RELAXED, __HIP_MEMORY_SCOPE_WORKGROUP); }
                __syncthreads();
                if (tid2 < 8) { int tot = 0; for (int w = 0; w < 8; ++w) tot += wcnt[w * 8 + tid2];
                    int base = 0; if (tot > 0) base = (int)__hip_atomic_fetch_add((unsigned*)(a->ws + WS_CTL) + CW_CNT + 64 * tid2, (unsigned)tot, RLX_AGENT);
                    bbase[tid2] = base; }
                __syncthreads();
                if (active && lane2 < per) {
                    int wb0 = bbase[myE0], wb1 = bbase[myE1];
                    for (int w = 0; w < F.wave; ++w) { wb0 += wcnt[w * 8 + myE0]; wb1 += wcnt[w * 8 + myE1]; }
                    const int lp0 = wb0 + r0, lp1 = wb1 + r1;
                    const int tk = F.gw + lane2 * F.NGW; int* lists = (int*)(a->ws + WS_LIST);
                    lists[myE0 * LISTCAP + lp0] = tk; lists[myE1 * LISTCAP + lp1] = tk;
                    v4u ti; ti.x = (unsigned)myE0; ti.y = (unsigned)lp0; ti.z = (unsigned)myE1; ti.w = (unsigned)lp1;
                    *(v4u*)(a->ws + WS_TOK + (size_t)tk * 32) = ti; *(float*)(a->ws + WS_TOK + (size_t)tk * 32 + 16) = myW0; *(float*)(a->ws + WS_TOK + (size_t)tk * 32 + 20) = myW1;
                }
                __syncthreads();
            }
        }
    }
}
typedef float f32x16v __attribute__((ext_vector_type(16)));
__device__ __forceinline__ int crow32(int r, int hi) { return (r & 3) + 8 * (r >> 2) + 4 * hi; }
__device__ __forceinline__ int chain_id(int b, int h, int dir) { return (b * 4 + h) * 2 + dir; }

__device__ __forceinline__ void phase_prep(ArgP a, Frame& F, int l) {
    const bf16* P = (const bf16*)(a->ws + WS_AR + AR_P);
    bf16* QB = (bf16*)(a->ws + WS_AR + AR_QB); bf16* KC = (bf16*)(a->ws + WS_AR + AR_KC); bf16* VC = (bf16*)(a->ws + WS_AR + AR_VC);
    unsigned char* Q8 = q8_ptr(a); unsigned char* K8 = k8_ptr(a); unsigned char* V8 = v8_ptr(a);
    const float* ropec = (const float*)(a->ws + WS_ROPE); const float* ropes = ropec + 4096;
    {
        const int rr = F.lane >> 3, c = F.lane & 7;
        float gq[8], gk[8];
#pragma unroll
        for (int j = 0; j < 8; ++j) { gq[j] = a->in[I_QN][l * 64 + 8 * c + j]; gk[j] = a->in[I_KN][l * 64 + 8 * c + j]; }
        for (int it = F.gw; it < NR / 8; it += F.NGW) {
            const int row = it * 8 + rr; const int b = row / RB, jj = row - b * RB; const bool lat = jj >= CTX; const int t = jj - CTX;
            float cs[8], sn[8];
            if (lat) { const int pos = (c < 4) ? (t >> 6) : (t & 63); const int fi = 8 * (c & 1);
#pragma unroll
                for (int j = 0; j < 8; ++j) { cs[j] = ropec[pos * 16 + fi + j]; sn[j] = ropes[pos * 16 + fi + j]; } }
            else {
#pragma unroll
                for (int j = 0; j < 8; ++j) { cs[j] = 1.f; sn[j] = 0.f; } }
            const float sgn = (c & 2) ? 1.f : -1.f;
            const bf16* prow = P + (size_t)row * INW;
#pragma unroll 2
            for (int hs = 0; hs < 10; ++hs) {
                const v4u u = *(const v4u*)(prow + hs * 64 + 8 * c);
                float x[8] = {bf_lo(u.x), bf_hi(u.x), bf_lo(u.y), bf_hi(u.y), bf_lo(u.z), bf_hi(u.z), bf_lo(u.w), bf_hi(u.w)};
                float ss = 0.f;
#pragma unroll
                for (int j = 0; j < 8; ++j) ss += x[j] * x[j];
                ss += shx<1>(ss); ss += shx<2>(ss); ss += shx<4>(ss);
                const float rstd = 1.0f / sqrtf(ss * (1.0f / 64.0f) + EPS);
                float y[8];
#pragma unroll
                for (int j = 0; j < 8; ++j) { y[j] = x[j] * rstd * (hs < 8 ? gq[j] : gk[j]); }
#pragma unroll
                for (int j = 0; j < 8; ++j) { const float p = shx<2>(y[j]); x[j] = y[j] * cs[j] + sgn * p * sn[j]; }
                const float sc = (hs < 8) ? attn_body::C2 : 1.0f;
#if ATT8_DEBUG
                { v4u o; o.x = pkbf(x[0] * sc, x[1] * sc); o.y = pkbf(x[2] * sc, x[3] * sc); o.z = pkbf(x[4] * sc, x[5] * sc); o.w = pkbf(x[6] * sc, x[7] * sc);
                if (hs < 8) *(v4u*)(QB + (size_t)row * 512 + hs * 64 + 8 * c) = o;
                else *(v4u*)(KC + ((size_t)(b * 2 + (hs - 8)) * RB + jj) * 64 + 8 * c) = o; }
#endif
                { const float s8 = (hs < 8) ? 4.0f * sc : sc;
                  v2u o8; o8.x = fp8x4(x[0] * s8, x[1] * s8, x[2] * s8, x[3] * s8); o8.y = fp8x4(x[4] * s8, x[5] * s8, x[6] * s8, x[7] * s8);
                if (hs < 8) *(v2u*)(Q8 + (size_t)row * 512 + hs * 64 + 8 * c) = o8;
                else *(v2u*)(K8 + ((size_t)((b * 2 + (hs - 8)) * (RB / 64) + (jj >> 6))) * 4096 + (c >> 1) * 1024 + (jj & 63) * 16 + 8 * (c & 1)) = o8; }
            }
#if ATT8_DEBUG
#pragma unroll
            for (int kv = 0; kv < 2; ++kv) *(v4u*)(VC + ((size_t)(b * 2 + kv) * RB + jj) * 64 + 8 * c) = *(const v4u*)(prow + PC_V + kv * 64 + 8 * c);
#endif
        }
    }
    for (int it = F.gw; it < NR / 32; it += F.NGW) {
        const int b = it / (RB / 32), g = it - b * (RB / 32), tile = g >> 1, c2 = g & 1, kv = F.lane >> 5, kg = (F.lane >> 4) & 1, d4 = F.lane & 15;
        const bf16* src = P + (size_t)(b * RB + 32 * g + 4 * kg) * INW + PC_V + kv * 64 + 4 * d4;
        v2u u[16];
#pragma unroll
        for (int j = 0; j < 16; ++j) u[j] = *(const v2u*)(src + (size_t)((j & 3) + 8 * (j >> 2)) * INW);
        unsigned char* dst = V8 + ((size_t)((b * 2 + kv) * (RB / 64) + tile)) * 4096 + ((kg * 2 + c2) * 64 + 4 * d4) * 16;
        v4u o0, o1, o2, o3;
        o0.x = fp8x4(bf_lo(u[0].x), bf_lo(u[1].x), bf_lo(u[2].x), bf_lo(u[3].x)); o0.y = fp8x4(bf_lo(u[4].x), bf_lo(u[5].x), bf_lo(u[6].x), bf_lo(u[7].x)); o0.z = fp8x4(bf_lo(u[8].x), bf_lo(u[9].x), bf_lo(u[10].x), bf_lo(u[11].x)); o0.w = fp8x4(bf_lo(u[12].x), bf_lo(u[13].x), bf_lo(u[14].x), bf_lo(u[15].x));
        o1.x = fp8x4(bf_hi(u[0].x), bf_hi(u[1].x), bf_hi(u[2].x), bf_hi(u[3].x)); o1.y = fp8x4(bf_hi(u[4].x), bf_hi(u[5].x), bf_hi(u[6].x), bf_hi(u[7].x)); o1.z = fp8x4(bf_hi(u[8].x), bf_hi(u[9].x), bf_hi(u[10].x), bf_hi(u[11].x)); o1.w = fp8x4(bf_hi(u[12].x), bf_hi(u[13].x), bf_hi(u[14].x), bf_hi(u[15].x));
        o2.x = fp8x4(bf_lo(u[0].y), bf_lo(u[1].y), bf_lo(u[2].y), bf_lo(u[3].y)); o2.y = fp8x4(bf_lo(u[4].y), bf_lo(u[5].y), bf_lo(u[6].y), bf_lo(u[7].y)); o2.z = fp8x4(bf_lo(u[8].y), bf_lo(u[9].y), bf_lo(u[10].y), bf_lo(u[11].y)); o2.w = fp8x4(bf_lo(u[12].y), bf_lo(u[13].y), bf_lo(u[14].y), bf_lo(u[15].y));
        o3.x = fp8x4(bf_hi(u[0].y), bf_hi(u[1].y), bf_hi(u[2].y), bf_hi(u[3].y)); o3.y = fp8x4(bf_hi(u[4].y), bf_hi(u[5].y), bf_hi(u[6].y), bf_hi(u[7].y)); o3.z = fp8x4(bf_hi(u[8].y), bf_hi(u[9].y), bf_hi(u[10].y), bf_hi(u[11].y)); o3.w = fp8x4(bf_hi(u[12].y), bf_hi(u[13].y), bf_hi(u[14].y), bf_hi(u[15].y));
        *(v4u*)(dst) = o0; *(v4u*)(dst + 16) = o1; *(v4u*)(dst + 32) = o2; *(v4u*)(dst + 48) = o3;
    }
    __syncthreads();
    typedef short bf16x8_t __attribute__((ext_vector_type(8)));
    LAS unsigned char* VT = F.lds; LAS unsigned char* KTf = F.lds + 17536; LAS unsigned char* KTb = F.lds + 2 * 17536;
    float* US = (float*)(a->ws + WS_AR + AR_US);
    for (int it = F.bx; it < NB * 4 * NCH; it += F.G) {
        const int c = it % NCH, bh = it / NCH, b = bh >> 2, h = bh & 3;
        const float lgf = ((const float*)(a->ws + WS_DEC))[l * 8 + h], lgb = ((const float*)(a->ws + WS_DEC))[l * 8 + 4 + h];
        { const int p = F.tid >> 2, sg = F.tid & 3; const bf16* prow = P + (size_t)(b * RB + c * 128 + p) * INW;
            const float zf = __expf(lgf * (float)(127 - p)) * 0.125f, zb = __expf(lgb * (float)p) * 0.125f;
#pragma unroll
            for (int q = 0; q < 2; ++q) { const v4u uk = *(const v4u*)(prow + PC_RK + h * 64 + sg * 16 + q * 8), uv = *(const v4u*)(prow + PC_RV + h * 64 + sg * 16 + q * 8);
                const unsigned kw[4] = {uk.x, uk.y, uk.z, uk.w}, vw[4] = {uv.x, uv.y, uv.z, uv.w};
#pragma unroll
                for (int i = 0; i < 8; ++i) { const int ch = sg * 16 + q * 8 + i; const int off = ch * 272 + sg * 32 + 2 * p;
                    const unsigned kwv = kw[i >> 1], vwv = vw[i >> 1]; const float kf = (i & 1) ? bf_hi(kwv) : bf_lo(kwv);
                    *(LAS bf16*)(VT + off) = (bf16)((i & 1) ? (vwv >> 16) : (vwv & 0xffffu));
                    *(LAS bf16*)(KTf + off) = (bf16)(pkbf(kf * zf, 0.f) & 0xffffu); *(LAS bf16*)(KTb + off) = (bf16)(pkbf(kf * zb, 0.f) & 0xffffu); } } }
        __syncthreads();
        { const int dir = F.wave >> 2, di = (F.wave >> 1) & 1, ei = F.wave & 1, r32 = F.lane & 31, hh = F.lane >> 5;
            f32x16v acc; { const float z = pg8::zero_v(); _Pragma("unroll") for (int r = 0; r < 16; ++r) acc[r] = z; }
            const int erow = 32 * ei + r32, drow = 32 * di + r32;
            const LAS unsigned char* ap = VT + erow * 272 + (erow >> 4) * 32 + 16 * hh; const LAS unsigned char* bp = (dir ? KTb : KTf) + drow * 272 + (drow >> 4) * 32 + 16 * hh;
#pragma unroll
            for (int s8 = 0; s8 < 8; ++s8) { const bf16x8_t av = *(const LAS bf16x8_t*)(ap + 32 * s8), bv = *(const LAS bf16x8_t*)(bp + 32 * s8);
                acc = __builtin_amdgcn_mfma_f32_32x32x16_bf16(av, bv, acc, 0, 0, 0); }
            float* dst = US + ((size_t)(chain_id(b, h, dir) * NCH + c)) * 4096;
#pragma unroll
            for (int r = 0; r < 16; ++r) dst[(32 * ei + crow32(r, hh)) * 64 + 32 * di + r32] = acc[r]; }
        __syncthreads();
    }
}

__device__ __forceinline__ void phase_scan(ArgP a, Frame& F, int l) {
    float* US = (float*)(a->ws + WS_AR + AR_US);
    if (F.tid < 256) {
        for (int id = F.bx * 256 + F.tid; id < 16 * 4096; id += F.G * 256) {
            const int chain = id >> 12, e = id & 4095, dir = chain & 1, h = (chain >> 1) & 3;
            const float dec = ((const float*)(a->ws + WS_DEC))[16 + l * 8 + dir * 4 + h];
            const float* base = US + (size_t)chain * NCH * 4096 + e; float st = 0.f;
            bf16* sb = (bf16*)(a->ws + WS_AR + AR_MX) + (size_t)chain * NCH * 4096 + e;
            for (int s0 = 0; s0 < NCH; s0 += 10) { float u[10]; int ci[10];
#pragma unroll
                for (int q = 0; q < 10; ++q) { const int s = s0 + q; ci[q] = dir == 0 ? s : (s < 2 ? 1 - s : NCH + 1 - s); u[q] = base[(size_t)ci[q] * 4096]; }
#pragma unroll
                for (int q = 0; q < 10; ++q) { sb[(size_t)ci[q] * 4096] = (bf16)(pkbf(st, 0.f) & 0xffffu); st = dec * st + u[q]; } }
        }
    }
}

__device__ __forceinline__ void ret_out_item(ArgP a, Frame& F, int l, int b, int c, int hp, int buf) {
    typedef short bf16x8_t __attribute__((ext_vector_type(8)));
    const bf16* P = (const bf16*)(a->ws + WS_AR + AR_P); bf16* MIX = (bf16*)(a->ws + WS_AR + AR_MIX);
    LAS bf16* VT = (LAS bf16*)(F.lds + buf * 34816);
    const int hl = F.wave >> 2, head = 2 * hp + hl, pi = F.wave & 3, r32 = F.lane & 31, hh = F.lane >> 5;
    const int row0 = b * RB + c * 128;
    { const int m = F.tid >> 2, qd = F.tid & 3; const bf16* src = P + (size_t)(row0 + m) * INW + PC_RV + (2 * hp) * 64 + 32 * qd;
        LAS bf16* dst = VT + (size_t)((qd >> 1) * 64 + 32 * (qd & 1)) * 132 + m;
#pragma unroll
        for (int q = 0; q < 4; ++q) { const v4u u = *(const v4u*)(src + 8 * q);
            dst[(8 * q + 0) * 132] = (bf16)(u.x & 0xffffu); dst[(8 * q + 1) * 132] = (bf16)(u.x >> 16); dst[(8 * q + 2) * 132] = (bf16)(u.y & 0xffffu); dst[(8 * q + 3) * 132] = (bf16)(u.y >> 16);
            dst[(8 * q + 4) * 132] = (bf16)(u.z & 0xffffu); dst[(8 * q + 5) * 132] = (bf16)(u.z >> 16); dst[(8 * q + 6) * 132] = (bf16)(u.w & 0xffffu); dst[(8 * q + 7) * 132] = (bf16)(u.w >> 16); } }
    bf16x8_t qf[4], kf[4][4];
    { const bf16* qrow = P + (size_t)(row0 + 32 * pi + r32) * INW + PC_RQ + head * 64 + 8 * hh;
#pragma unroll
        for (int d0 = 0; d0 < 4; ++d0) qf[d0] = *(const bf16x8_t*)(qrow + 16 * d0);
#pragma unroll
        for (int mb = 0; mb < 4; ++mb) { const bf16* krow = P + (size_t)(row0 + 32 * mb + r32) * INW + PC_RK + head * 64 + 8 * hh;
#pragma unroll
            for (int d0 = 0; d0 < 4; ++d0) kf[mb][d0] = *(const bf16x8_t*)(krow + 16 * d0); } }
    const float L2E = 1.4426950408889634f;
    const float lgf2 = ((const float*)(a->ws + WS_DEC))[l * 8 + head] * L2E, lgb2 = ((const float*)(a->ws + WS_DEC))[l * 8 + 4 + head] * L2E;
    int p = 32 * pi + r32; asm volatile("" : "+v"(p));
    bf16x8_t pk[8];
#pragma unroll
    for (int mb = 0; mb < 4; ++mb) {
        f32x16v st; { const float z = pg8::zero_v(); _Pragma("unroll") for (int r = 0; r < 16; ++r) st[r] = z; }
#pragma unroll
        for (int d0 = 0; d0 < 4; ++d0) st = __builtin_amdgcn_mfma_f32_32x32x16_bf16(kf[mb][d0], qf[d0], st, 0, 0, 0);
#pragma unroll
        for (int r = 0; r < 16; ++r) { const float fd = (float)(p - (32 * mb + crow32(r, hh)));
            const float arg = lgf2 * fmaxf(fd, 0.f) + lgb2 * fmaxf(-fd, 0.f) + fmaxf(1.0f - fabsf(fd), 0.f) - 3.0f;
            st[r] = st[r] * __builtin_amdgcn_exp2f(arg); }
        v4u w0, w1; w0.x = pkbf(st[0], st[1]); w0.y = pkbf(st[2], st[3]); w0.z = pkbf(st[4], st[5]); w0.w = pkbf(st[6], st[7]);
        w1.x = pkbf(st[8], st[9]); w1.y = pkbf(st[10], st[11]); w1.z = pkbf(st[12], st[13]); w1.w = pkbf(st[14], st[15]);
        pk[2 * mb] = __builtin_bit_cast(bf16x8_t, w0); pk[2 * mb + 1] = __builtin_bit_cast(bf16x8_t, w1);
    }
    __builtin_amdgcn_sched_barrier(0);
    const float ef = __builtin_amdgcn_exp2f(lgf2 * (float)(p + 1)), ebk = __builtin_amdgcn_exp2f(lgb2 * (float)(128 - p));
    f32x16v ot[2];
    { const float z = pg8::zero_v(); _Pragma("unroll") for (int r = 0; r < 16; ++r) { ot[0][r] = z; ot[1][r] = z; } }
    { const bf16* SB = (const bf16*)(a->ws + WS_AR + AR_MX);
      const bf16* Sf = SB + ((size_t)(chain_id(b, head, 0) * NCH + c)) * 4096; const bf16* Sb = SB + ((size_t)(chain_id(b, head, 1) * NCH + c)) * 4096;
#pragma unroll
        for (int s4 = 0; s4 < 4; ++s4) {
            const v4u qu = __builtin_bit_cast(v4u, qf[s4]); v4u qa, qb;
            qa.x = pkbf(bf_lo(qu.x) * ef, bf_hi(qu.x) * ef); qa.y = pkbf(bf_lo(qu.y) * ef, bf_hi(qu.y) * ef); qa.z = pkbf(bf_lo(qu.z) * ef, bf_hi(qu.z) * ef); qa.w = pkbf(bf_lo(qu.w) * ef, bf_hi(qu.w) * ef);
            qb.x = pkbf(bf_lo(qu.x) * ebk, bf_hi(qu.x) * ebk); qb.y = pkbf(bf_lo(qu.y) * ebk, bf_hi(qu.y) * ebk); qb.z = pkbf(bf_lo(qu.z) * ebk, bf_hi(qu.z) * ebk); qb.w = pkbf(bf_lo(qu.w) * ebk, bf_hi(qu.w) * ebk);
#pragma unroll
            for (int eb = 0; eb < 2; ++eb) { const int off = (32 * eb + r32) * 64 + 16 * s4 + 8 * hh;
                const bf16x8_t wf = *(const bf16x8_t*)(Sf + off), wb = *(const bf16x8_t*)(Sb + off);
                ot[eb] = __builtin_amdgcn_mfma_f32_32x32x16_bf16(wf, __builtin_bit_cast(bf16x8_t, qa), ot[eb], 0, 0, 0);
                ot[eb] = __builtin_amdgcn_mfma_f32_32x32x16_bf16(wb, __builtin_bit_cast(bf16x8_t, qb), ot[eb], 0, 0, 0); } } }
    __builtin_amdgcn_sched_barrier(0);
    __syncthreads();
    { const LAS bf16* vrow = VT + (size_t)(hl * 64 + r32) * 132 + 4 * hh;
#pragma unroll
        for (int eb = 0; eb < 2; ++eb)
#pragma unroll
            for (int sg = 0; sg < 8; ++sg) { const LAS bf16* vp = vrow + (size_t)(32 * eb) * 132 + 16 * sg;
                const v2u lo = *(const LAS v2u*)vp, hi = *(const LAS v2u*)(vp + 8);
                const v4u av = (v4u){lo.x, lo.y, hi.x, hi.y};
                ot[eb] = __builtin_amdgcn_mfma_f32_32x32x16_bf16(__builtin_bit_cast(bf16x8_t, av), pk[sg], ot[eb], 0, 0, 0); } }
    __builtin_amdgcn_sched_barrier(0);
    float s1 = 0.f, s2 = 0.f;
#pragma unroll
    for (int eb = 0; eb < 2; ++eb)
#pragma unroll
        for (int r = 0; r < 16; ++r) { const float v = ot[eb][r]; s1 += v; s2 += v * v; }
    { auto rr = __builtin_amdgcn_permlane32_swap(__float_as_uint(s1), __float_as_uint(s1), false, false); s1 = __uint_as_float(rr[0]) + __uint_as_float(rr[1]); }
    { auto rr = __builtin_amdgcn_permlane32_swap(__float_as_uint(s2), __float_as_uint(s2), false, false); s2 = __uint_as_float(rr[0]) + __uint_as_float(rr[1]); }
    const float mu = s1 * (1.0f / 64.0f); const float var = fmaxf(s2 * (1.0f / 64.0f) - mu * mu, 0.f); const float rstd = 1.0f / sqrtf(var + EPS);
    const size_t orow = (size_t)(row0 + p);
#pragma unroll
    for (int eb = 0; eb < 2; ++eb)
#pragma unroll
        for (int g = 0; g < 4; ++g) { const int e0 = 32 * eb + 8 * g + 4 * hh;
            const v2u gu = *(const v2u*)(P + orow * INW + PC_RG + head * 64 + e0);
            const float g0 = bf_lo(gu.x), g1 = bf_hi(gu.x), g2 = bf_lo(gu.y), g3 = bf_hi(gu.y);
            v2u w; w.x = pkbf(siluf(g0) * ((ot[eb][4 * g] - mu) * rstd), siluf(g1) * ((ot[eb][4 * g + 1] - mu) * rstd)); w.y = pkbf(siluf(g2) * ((ot[eb][4 * g + 2] - mu) * rstd), siluf(g3) * ((ot[eb][4 * g + 3] - mu) * rstd));
            *(v2u*)(MIX + orow * DM + 512 + head * 64 + e0) = w; }
}
__device__ __forceinline__ void pool_item(ArgP a, Frame& F, int l, int b, int tl, int g) {
    typedef short bf16x8_t __attribute__((ext_vector_type(8)));
    const bf16* P = (const bf16*)(a->ws + WS_AR + AR_P); bf16* MIX = (bf16*)(a->ws + WS_AR + AR_MIX);
    LAS bf16* msb = (LAS bf16*)F.lds;
    LAS bf16* wt = (LAS bf16*)(F.lds + 18432);
    LAS bf16* ost = (LAS bf16*)(F.lds + 18432 + 9216);
    const int sb = (tl < 2) ? 0 : CTX, T = (tl < 2) ? CTX : SEQ, hw = 1 << g  ;
    { const int d = F.tid & 63, cq = F.tid >> 6; const float* W = a->in[I_POOLW] + ((size_t)(l * 4 + g)) * 4096 + d;
        v4u o; o.x = pkbf(W[(8 * cq + 0) * 64], W[(8 * cq + 1) * 64]); o.y = pkbf(W[(8 * cq + 2) * 64], W[(8 * cq + 3) * 64]); o.z = pkbf(W[(8 * cq + 4) * 64], W[(8 * cq + 5) * 64]); o.w = pkbf(W[(8 * cq + 6) * 64], W[(8 * cq + 7) * 64]);
        *(LAS v4u*)(wt + d * 72 + 8 * cq) = o; }
    { const int p = F.tid >> 2, qd = F.tid & 3; const int t = tl * 128 - sb + p; const int lo = max(t - hw, 0), hi = min(t + hw, T);
        float acc[16];
#pragma unroll
        for (int e = 0; e < 16; ++e) acc[e] = 0.f;
        const bf16* colp = P + (size_t)(b * RB + sb) * INW + PC_PP + g * 64 + 16 * qd;
        for (int tt = lo; tt < hi; ++tt) { const v4u u0 = *(const v4u*)(colp + (size_t)tt * INW), u1 = *(const v4u*)(colp + (size_t)tt * INW + 8);
            acc[0] += bf_lo(u0.x); acc[1] += bf_hi(u0.x); acc[2] += bf_lo(u0.y); acc[3] += bf_hi(u0.y); acc[4] += bf_lo(u0.z); acc[5] += bf_hi(u0.z); acc[6] += bf_lo(u0.w); acc[7] += bf_hi(u0.w);
            acc[8] += bf_lo(u1.x); acc[9] += bf_hi(u1.x); acc[10] += bf_lo(u1.y); acc[11] += bf_hi(u1.y); acc[12] += bf_lo(u1.z); acc[13] += bf_hi(u1.z); acc[14] += bf_lo(u1.w); acc[15] += bf_hi(u1.w); }
        const v4u s0 = *(const v4u*)(colp + (size_t)t * INW), s1 = *(const v4u*)(colp + (size_t)t * INW + 8);
        const float sf[16] = {bf_lo(s0.x), bf_hi(s0.x), bf_lo(s0.y), bf_hi(s0.y), bf_lo(s0.z), bf_hi(s0.z), bf_lo(s0.w), bf_hi(s0.w), bf_lo(s1.x), bf_hi(s1.x), bf_lo(s1.y), bf_hi(s1.y), bf_lo(s1.z), bf_hi(s1.z), bf_lo(s1.w), bf_hi(s1.w)};
        const float inv = 1.0f / (float)(hi - lo);
        float m[16];
#pragma unroll
        for (int e = 0; e < 16; ++e) m[e] = acc[e] * inv - sf[e];
        v4u o0, o1; o0.x = pkbf(m[0], m[1]); o0.y = pkbf(m[2], m[3]); o0.z = pkbf(m[4], m[5]); o0.w = pkbf(m[6], m[7]); o1.x = pkbf(m[8], m[9]); o1.y = pkbf(m[10], m[11]); o1.z = pkbf(m[12], m[13]); o1.w = pkbf(m[14], m[15]);
        *(LAS v4u*)(msb + p * 72 + 16 * qd) = o0; *(LAS v4u*)(msb + p * 72 + 16 * qd + 8) = o1; }
    __syncthreads();
    { const int pi = F.wave >> 1, di = F.wave & 1, i = F.lane & 31, kk = F.lane >> 5; f32x16v o; { const float z = pg8::zero_v(); _Pragma("unroll") for (int r = 0; r < 16; ++r) o[r] = z; }
        const LAS bf16* ap = msb + (32 * pi + i) * 72 + 8 * kk; const LAS bf16* bp = wt + (32 * di + i) * 72 + 8 * kk;
#pragma unroll
        for (int s4 = 0; s4 < 4; ++s4) o = __builtin_amdgcn_mfma_f32_32x32x16_bf16(*(const LAS bf16x8_t*)(ap + 16 * s4), *(const LAS bf16x8_t*)(bp + 16 * s4), o, 0, 0, 0);
        const float scl = a->in[I_POOLS][l * 256 + g * 64 + 32 * di + i];
#pragma unroll
        for (int r = 0; r < 16; ++r) ost[(32 * pi + crow32(r, kk)) * 72 + 32 * di + i] = (bf16)(pkbf(o[r] * scl, 0.f) & 0xffffu); }
    __syncthreads();
    { bf16* obase = MIX + (size_t)(b * RB + tl * 128) * DM + 768 + g * 64;
#pragma unroll
        for (int k = 0; k < 2; ++k) { const int idx = F.tid + 512 * k, row = idx >> 3, ch = idx & 7; *(v4u*)(obase + (size_t)row * DM + 8 * ch) = *(const LAS v4u*)(ost + row * 72 + 8 * ch); } }
    __syncthreads();
}
__device__ __forceinline__ void phase_mix(ArgP a, Frame& F, int l, int vcu) {
    { int nb = 0;
      for (int it = F.bx; it < NB * NCH * 2; it += F.G) { const int hp = it & 1, r = it >> 1, c = r % NCH, b = r / NCH;
          if (l == 1 && c < 2) continue;
          ret_out_item(a, F, l, b, c, hp, nb & 1); ++nb; }
      __syncthreads(); }
    for (int it = (F.bx + F.G - 16) % F.G; it < NB * 4 * NCH; it += F.G) { const int c = it % NCH, bh = it / NCH, b = bh >> 2, hg = bh & 3;
        if (l == 1 && c < 2) continue;
        pool_item(a, F, l, b, c, hg); }
    const bf16* QBp = (const bf16*)(a->ws + WS_AR + AR_QB); const bf16* KC = (const bf16*)(a->ws + WS_AR + AR_KC); const bf16* VC = (const bf16*)(a->ws + WS_AR + AR_VC); bf16* MIX = (bf16*)(a->ws + WS_AR + AR_MIX);
    const unsigned char* Q8 = q8_ptr(a); const unsigned char* K8 = k8_ptr(a); const unsigned char* V8 = v8_ptr(a);
    const int NU = NB * 8 * (SEQ / 256);
    float mref;
    { float gq = fabsf(a->in[I_QN][l * 64 + F.lane]), gk = fabsf(a->in[I_KN][l * 64 + F.lane]);
#pragma unroll
      for (int o = 0; o < 1; ++o) { gq = fmaxf(gq, shx<1>(gq)); gk = fmaxf(gk, shx<1>(gk)); gq = fmaxf(gq, shx<2>(gq)); gk = fmaxf(gk, shx<2>(gk)); gq = fmaxf(gq, shx<4>(gq)); gk = fmaxf(gk, shx<4>(gk));
          gq = fmaxf(gq, shx<8>(gq)); gk = fmaxf(gk, shx<8>(gk)); gq = fmaxf(gq, shx<16>(gq)); gk = fmaxf(gk, shx<16>(gk)); gq = half_max(gq); gk = half_max(gk); }
      mref = fminf(64.0f * gq * gk * attn_body::C2 * 1.01f + 0.125f, 64.0f); mref = __builtin_amdgcn_readfirstlane(mref); }
    for (int i = 0; ; ++i) {
        int u;
        if (F.G == 256) { if (i >= 4) break; const int x = vcu >> 5, cu = vcu & 31; const int grp = x >> 1; u = grp * 256 + (x & 1) * 128 + cu * 4 + i; }
        else { u = F.bx + i * F.G; if (u >= NU) break; }
        const int grp = u >> 8, w = u & 255, b = grp >> 1, kvh = grp & 1, hd = kvh * 4 + (w >> 6), qb = w & 63;
        const size_t qrow = (size_t)b * RB + CTX + qb * 256;
#if ATT8_DEBUG
        attn_body::attn_unit(F.tid, mref, (const attn_body::bf16*)(QBp + qrow * 512 + hd * 64), 512, (const attn_body::bf16*)(KC + (size_t)(b * 2 + kvh) * RB * 64), (const attn_body::bf16*)(VC + (size_t)(b * 2 + kvh) * RB * 64), RB / 64,
                                (attn_body::bf16*)(MIX + qrow * DM + hd * 64), DM, (char*)F.lds);
        attn_body::attn_unit8(F.tid, mref, Q8 + qrow * 512 + hd * 64, 512, K8 + (size_t)(b * 2 + kvh) * (RB / 64) * 4096, V8 + (size_t)(b * 2 + kvh) * (RB / 64) * 4096, RB / 64,
                                (attn_body::bf16*)((bf16*)(a->ws + WS_AR + DO_O8) + qrow * 512 + hd * 64), 512, (char*)F.lds);
#else
        attn_body::attn_unit8(F.tid, mref, Q8 + qrow * 512 + hd * 64, 512, K8 + (size_t)(b * 2 + kvh) * (RB / 64) * 4096, V8 + (size_t)(b * 2 + kvh) * (RB / 64) * 4096, RB / 64,
                                (attn_body::bf16*)(MIX + qrow * DM + hd * 64), DM, (char*)F.lds);
#endif
    }
    if (l == 0) {
        for (int u = (F.bx + F.G - 32) % F.G; u < NB * 8; u += F.G) { const int b = u >> 3, hd = u & 7, kvh = hd >> 2; const size_t qrow = (size_t)b * RB;
#if ATT8_DEBUG
            attn_body::attn_unit(F.tid, mref, (const attn_body::bf16*)(QBp + qrow * 512 + hd * 64), 512, (const attn_body::bf16*)(KC + (size_t)(b * 2 + kvh) * RB * 64), (const attn_body::bf16*)(VC + (size_t)(b * 2 + kvh) * RB * 64), CTX / 64,
                                    (attn_body::bf16*)(MIX + qrow * DM + hd * 64), DM, (char*)F.lds);
            attn_body::attn_unit8(F.tid, mref, Q8 + qrow * 512 + hd * 64, 512, K8 + (size_t)(b * 2 + kvh) * (RB / 64) * 4096, V8 + (size_t)(b * 2 + kvh) * (RB / 64) * 4096, CTX / 64,
                                    (attn_body::bf16*)((bf16*)(a->ws + WS_AR + DO_O8) + qrow * 512 + hd * 64), 512, (char*)F.lds);
#else
            attn_body::attn_unit8(F.tid, mref, Q8 + qrow * 512 + hd * 64, 512, K8 + (size_t)(b * 2 + kvh) * (RB / 64) * 4096, V8 + (size_t)(b * 2 + kvh) * (RB / 64) * 4096, CTX / 64,
                                    (attn_body::bf16*)(MIX + qrow * DM + hd * 64), DM, (char*)F.lds);
#endif
        }
    }
}
struct PlainSched {
    int nM, nN, G, c, skipctx; const char* A; const char* B; size_t tA, tB;
    __device__ __forceinline__ bool next(int i, pg8::Unit& u) const {
        const long L = (long)i * G + c; if (L >= (long)nM * nN) return false;
        int pm, pn; pg8::deal((int)L, nM, nN, pm, pn); if (skipctx) pm = pm + 1 + (pm >= 64 ? 1 : 0);
        u.pm = pm; u.pn = pn; u.a = A + (size_t)pm * tA; u.b = B + (size_t)pn * tB; u.goff = 0; u.gcnt = 0; return true; }
};
struct CtxSplitSched {
    int nN, nsp, G, c, KL; const char* A; const char* B; size_t tA, tB;
    __device__ __forceinline__ bool next(int i, pg8::Unit& u) const {
        const long L = (long)i * G + c; if (L >= (long)2 * nN * nsp) return false;
        const int ct = (int)L & 1, r = (int)L >> 1, pn = r % nN, ks = r / nN;
        u.pm = 2 * ks + ct; u.pn = pn; u.a = A + (size_t)(ct * 65) * tA + (size_t)ks * KL * 2; u.b = B + (size_t)pn * tB + (size_t)ks * KL * 2; u.goff = 0; u.gcnt = 0; return true; }
};
struct CtxFullSched {
    int nN, G, c; const char* A; const char* B; size_t tA, tB;
    __device__ __forceinline__ bool next(int i, pg8::Unit& u) const {
        const long L = (long)i * G + c; if (L >= (long)2 * nN) return false;
        const int ct = (int)L & 1, pn = (int)L >> 1;
        u.pm = ct * 65; u.pn = pn; u.a = A + (size_t)(ct * 65) * tA; u.b = B + (size_t)pn * tB; u.goff = 0; u.gcnt = 0; return true; }
};
struct MoeSched {
    int nM, nN, G, c, t0, up, c0; const char* A; const char* W; size_t tA, tB, wsz; int ts[9], cnt[8];
    __device__ __forceinline__ bool next(int i, pg8::Unit& u) const {
        long L = (long)i * G + c;
        if (c0 > 0) { const int w = G - c0; const long E = 3L * w; L = (c >= c0) ? ((i < 3) ? (long)i * w + (c - c0) : E + (long)(i - 3) * G + c) : E + (long)i * G + c; }
        if (L >= (long)nM * nN) return false;
        int pml, pn; pg8::deal((int)L, nM, nN, pml, pn); const int rt = t0 + pml;
        int e = 0, tse = 0, ce = cnt[0];
#pragma unroll
        for (int k = 1; k < 8; ++k) { const bool sel = (rt >= ts[k]) && (ts[k + 1] > ts[k]); e = sel ? k : e; tse = sel ? ts[k] : tse; ce = sel ? cnt[k] : ce; }
        const int lt = rt - tse;
        u.pn = pn; u.b = W + (size_t)e * wsz + (size_t)pn * tB;
        if (up) { u.pm = pml; u.a = A; u.goff = e * LISTCAP + lt * 256; const int rem = ce - lt * 256; u.gcnt = rem < 256 ? rem : 256; }
        else { u.pm = rt; u.a = A + (size_t)pml * tA; u.goff = 0; u.gcnt = 0; }
        return true; }
};

#if ATT8_DEBUG
__device__ __forceinline__ void dbg_compare(ArgP a, Frame& F, int l) {
    const bf16* MIX = (const bf16*)(a->ws + WS_AR + AR_MIX); const bf16* O8 = (const bf16*)(a->ws + WS_AR + DO_O8);
    float sd = 0.f, so = 0.f;
    for (int row = F.gw; row < NR; row += F.NGW) { const int b = row / RB, jj = row - b * RB; if (jj < CTX && l == 1) continue;
        const v4u x = *(const v4u*)(MIX + (size_t)row * DM + 8 * F.lane), y = *(const v4u*)(O8 + (size_t)row * 512 + 8 * F.lane);
        const float xv[8] = {bf_lo(x.x), bf_hi(x.x), bf_lo(x.y), bf_hi(x.y), bf_lo(x.z), bf_hi(x.z), bf_lo(x.w), bf_hi(x.w)}, yv[8] = {bf_lo(y.x), bf_hi(y.x), bf_lo(y.y), bf_hi(y.y), bf_lo(y.z), bf_hi(y.z), bf_lo(y.w), bf_hi(y.w)};
#pragma unroll
        for (int j = 0; j < 8; ++j) { const float d = yv[j] - xv[j]; sd += d * d; so += xv[j] * xv[j]; } }
    sd = wave_sum(sd); so = wave_sum(so);
    if (F.lane == 0) { atomicAdd((float*)(a->ws + WS_CTL) + 2048, sd); atomicAdd((float*)(a->ws + WS_CTL) + 2049, so); }
}
#endif
constexpr int N_PHASES_K = 22;
__global__ void __launch_bounds__(NWAVES * 64, 2) mk_fwd(Args a_unused) {
    extern __shared__ __attribute__((aligned(16))) unsigned char lds[];
    Frame F; ArgP a = args_here();
    F.lds = (LAS unsigned char*)lds;
    relaunder(F);
    unsigned* ctl = (unsigned*)(a->ws + WS_CTL);
    for (int u = F.tid; u < (LDS_BYTES - RING_BYTES) / 4; u += NWAVES * 64) ((LAS unsigned*)(F.lds + RING_BYTES))[u] = 0u;
    __syncthreads();
    volatile LAS unsigned* MISC = (volatile LAS unsigned*)(F.lds + MISC_OFF);
    XcdBarrier bar = xcd_barrier_post(ctl + CW_BAR + a->li * XCD_BAR_WORDS, MISC + 8);
    LAS unsigned* gtab = (LAS unsigned*)(F.lds + GTAB_OFF);
    const int lo = a->ph_lo, hi = a->ph_hi; int ph = 0;
#define RUN (a = args_here(), relaunder(F), (ph >= lo && ph < hi))
#ifndef PROF_MASK
#define PROF_MASK 0
#endif
#ifndef PROF_AMP
#define PROF_AMP 10
#endif
#if PROF_MASK
#define PROF_STAMP(k_) do { if (blockIdx.x == 0 && threadIdx.x == 0) ((volatile unsigned long long*)(a->ws + WS_CTL + 32768))[k_] = wall_clock64(); } while (0)
#else
#define PROF_STAMP(k_) do { } while (0)
#endif
#define SEAM() do { if (ph >= lo && ph + 1 < hi) xcd_barrier(bar); ++ph; a = args_here(); PROF_STAMP(ph); } while (0)
    unsigned char* AR = a->ws + WS_AR;
    PROF_STAMP(0);

    if (RUN) phase_p0a(a, F);
    SEAM();
    if (RUN) phase_premix0(a, F);
    SEAM();
#pragma unroll 1
    for (int l = 0; l < 2; ++l) {
        if (RUN) {
            if ((IN_I8 >> l) & 1) {
                PlainSched S{NR / 256, INW / 256, F.G, F.bx, 0, (const char*)(AR + AR_MIX), (const char*)(a->ws + WS_WIN + l * SZ_WIN), (size_t)256 * DM, (size_t)256 * DM};
                pg8::EpiBf16S E{(bf16*)(AR + AR_P), INW, 1.0f / (I8_XI * I8_WS)};
                pg8::gemm_phase<pg8::EpiBf16S, PlainSched, true, false, 2>(F.tid, F.lds, gtab, nullptr, DM / 2, DM / 2, S, E);
            } else if (IN1_F8 && l == 1) {
                PlainSched S{NR / 256, INW / 256, F.G, F.bx, 0, (const char*)(AR + AR_MIX), (const char*)(a->ws + WS_WIN + SZ_WIN), (size_t)256 * DM, (size_t)256 * DM};
                pg8::EpiBf16S E{(bf16*)(AR + AR_P), INW, 1.0f / 64.0f};
                pg8::gemm_phase<pg8::EpiBf16S, PlainSched, true, false, 1>(F.tid, F.lds, gtab, nullptr, DM / 2, DM / 2, S, E);
            } else {
            PlainSched S{NR / 256, INW / 256, F.G, F.bx, 0, (const char*)(AR + AR_MIX), (const char*)(a->ws + WS_WIN + l * SZ_WIN), (size_t)256 * DM * 2, (size_t)256 * DM * 2};
            pg8::EpiBf16 E{(bf16*)(AR + AR_P), INW};
            pg8::gemm_phase<pg8::EpiBf16, PlainSched, true, false>(F.tid, F.lds, gtab, nullptr, DM, DM, S, E); }
        }
        SEAM();
        if (RUN) phase_prep(a, F, l);
        SEAM();
        if (RUN) phase_scan(a, F, l);
        SEAM();
        if (RUN) phase_mix(a, F, l, (F.G % 8 == 0) ? (F.bx % 8) * (F.G / 8) + (F.bx / 8) : F.bx);
        SEAM();
        if (RUN) {
#if ATT8_DEBUG
            dbg_compare(a, F, l);
#endif
            PlainSched S{NLAT / 256, DM / 256, F.G, F.bx, 1, (const char*)(AR + AR_MIX), (const char*)(a->ws + WS_WOUT + l * SZ_WOUT), (size_t)256 * DM * 2, (size_t)256 * DM * 2};
            pg8::EpiBf16 E{(bf16*)(AR + AR_MX), DM};
            pg8::gemm_phase<pg8::EpiBf16, PlainSched, true, false>(F.tid, F.lds, gtab, nullptr, DM, DM, S, E);
            if (l == 0) {
                CtxSplitSched S2{DM / 256, 4, F.G, F.bx, 256, (const char*)(AR + AR_MIX), (const char*)(a->ws + WS_WOUT), (size_t)256 * DM * 2, (size_t)256 * DM * 2};
                pg8::EpiF32 E2{(float*)(AR + AR_PART0), DM};
                pg8::gemm_phase<pg8::EpiF32, CtxSplitSched, true, false>(F.tid, F.lds, gtab, nullptr, DM, 256, S2, E2); }
        }
        SEAM();
        if (l == 0) {
            if (RUN) phase_resid<0>(a, F);
            SEAM();
            if (RUN) {
#if DENSE_F8
                PlainSched S{NR / 256, 2 * FF / 256, F.G, F.bx, 0, (const char*)(AR + AR_HX2), (const char*)(a->ws + WS_W13D), (size_t)256 * DM, (size_t)256 * DM};
                pg8::EpiSwiglu8 E{(unsigned char*)(AR + AR_ACT), FF, 1.0f / 64.0f, 8.0f};
                pg8::gemm_phase<pg8::EpiSwiglu8, PlainSched, true, false, 1>(F.tid, F.lds, gtab, nullptr, DM / 2, DM / 2, S, E);
#elif DENSE_I8UP
                PlainSched S{NR / 256, 2 * FF / 256, F.G, F.bx, 0, (const char*)(AR + AR_HX2), (const char*)(a->ws + WS_W13D), (size_t)256 * DM, (size_t)256 * DM};
#if DENSE_DOWN_F8
                pg8::EpiSwiglu8 E{(unsigned char*)(AR + AR_ACT), FF, 1.0f / (I8_XS * I8_WS), 8.0f};
                pg8::gemm_phase<pg8::EpiSwiglu8, PlainSched, true, false, 2>(F.tid, F.lds, gtab, nullptr, DM / 2, DM / 2, S, E);
#else
                pg8::EpiSwigluS E{(bf16*)(AR + AR_ACT), FF, 1.0f / (I8_XS * I8_WS)};
                pg8::gemm_phase<pg8::EpiSwigluS, PlainSched, true, false, 2>(F.tid, F.lds, gtab, nullptr, DM / 2, DM / 2, S, E);
#endif
#else
                PlainSched S{NR / 256, 2 * FF / 256, F.G, F.bx, 0, (const char*)(AR + AR_HX2), (const char*)(a->ws + WS_W13D), (size_t)256 * DM * 2, (size_t)256 * DM * 2};
                pg8::EpiSwiglu E{(bf16*)(AR + AR_ACT), FF};
                pg8::gemm_phase<pg8::EpiSwiglu, PlainSched, true, false>(F.tid, F.lds, gtab, nullptr, DM, DM, S, E);
#endif
            }
            SEAM();
            if (RUN) {
#if DENSE_F8 || DENSE_DOWN_F8
                PlainSched S{NLAT / 256, DM / 256, F.G, F.bx, 1, (const char*)(AR + AR_ACT), (const char*)(a->ws + WS_W2D), (size_t)256 * FF, (size_t)256 * FF};
                pg8::EpiBf16S E{(bf16*)(AR + AR_YD), DM, 1.0f / 512.0f};
                pg8::gemm_phase<pg8::EpiBf16S, PlainSched, true, false, 1>(F.tid, F.lds, gtab, nullptr, FF / 2, FF / 2, S, E);
#if DENSE_DOWN_F8 && !DENSE_F8
                CtxFullSched S2{DM / 256, F.G, F.bx, (const char*)(AR + AR_ACT), (const char*)(a->ws + WS_W2D), (size_t)256 * FF, (size_t)256 * FF};
                pg8::gemm_phase<pg8::EpiBf16S, CtxFullSched, true, false, 1>(F.tid, F.lds, gtab, nullptr, FF / 2, FF / 2, S2, E);
#else
                CtxSplitSched S2{DM / 256, 11, F.G, F.bx, 128, (const char*)(AR + AR_ACT), (const char*)(a->ws + WS_W2D), (size_t)256 * FF, (size_t)256 * FF};
                pg8::EpiF32S E2{(float*)(AR + AR_PART1), DM, 1.0f / 512.0f};
                pg8::gemm_phase<pg8::EpiF32S, CtxSplitSched, true, false, 1>(F.tid, F.lds, gtab, nullptr, FF / 2, 128, S2, E2);
#endif
#else
                PlainSched S{NLAT / 256, DM / 256, F.G, F.bx, 1, (const char*)(AR + AR_ACT), (const char*)(a->ws + WS_W2D), (size_t)256 * FF * 2, (size_t)256 * FF * 2};
                pg8::EpiBf16 E{(bf16*)(AR + AR_YD), DM};
                pg8::gemm_phase<pg8::EpiBf16, PlainSched, true, false>(F.tid, F.lds, gtab, nullptr, FF, FF, S, E);
                CtxSplitSched S2{DM / 256, 11, F.G, F.bx, 256, (const char*)(AR + AR_ACT), (const char*)(a->ws + WS_W2D), (size_t)256 * FF * 2, (size_t)256 * FF * 2};
                pg8::EpiF32 E2{(float*)(AR + AR_PART1), DM};
                pg8::gemm_phase<pg8::EpiF32, CtxSplitSched, true, false>(F.tid, F.lds, gtab, nullptr, FF, 256, S2, E2);
#endif
            }
            SEAM();
            if (RUN) phase_resid<1>(a, F);
            SEAM();
        } else {
            if (RUN) phase_resid<2>(a, F);
            SEAM();
#pragma unroll 1
            for (int p = 0; p <= MOE_PASSES; ++p) {
                if (RUN) {
                    constexpr size_t ACTB = (size_t)MOE_TP * 256 * FF;
                    int nprev = 0;
                    if (p >= 1) {
                        MoeSched S; moe_prefix(a->ws, S.ts, S.cnt);
                        const int tot = S.ts[8]; int n = tot - (p - 1) * MOE_TP; n = n < 0 ? 0 : (n > MOE_TP ? MOE_TP : n); nprev = n;
                        S.nM = n; S.nN = DM / 256; S.G = F.G; S.c = F.bx; S.t0 = (p - 1) * MOE_TP; S.up = 0; S.c0 = 0; S.A = (const char*)(AR + AR_ACT + ((p - 1) & 1) * ACTB); S.W = (const char*)(a->ws + WS_W2M); S.tA = (size_t)256 * FF; S.tB = (size_t)256 * FF; S.wsz = SZ8_W2;
                        pg8::EpiBf16S E{(bf16*)(AR + AR_YM), DM, 1.0f / 512.0f};
                        pg8::gemm_phase<pg8::EpiBf16S, MoeSched, true, false, 1>(F.tid, F.lds, gtab, nullptr, FF / 2, FF / 2, S, E);
                    }
                    if (p < MOE_PASSES) {
                        a = args_here(); relaunder(F);
                        MoeSched S; moe_prefix(a->ws, S.ts, S.cnt);
                        const int tot = S.ts[8]; int n = tot - p * MOE_TP; n = n < 0 ? 0 : (n > MOE_TP ? MOE_TP : n);
                        S.nM = n; S.nN = 2 * FF / 256; S.G = F.G; S.c = F.bx; S.t0 = p * MOE_TP; S.up = 1; S.A = (const char*)(AR + AR_HX2); S.W = (const char*)(a->ws + WS_W13M); S.tA = 0; S.tB = (size_t)256 * DM; S.wsz = SZ8_W13;
                        { const int nd = nprev * (DM / 256), r = nd % F.G; S.c0 = (r != 0 && 3L * (F.G - r) <= (long)n * S.nN) ? r : 0; }
                        pg8::EpiSwiglu8 E{(unsigned char*)(AR + AR_ACT + (p & 1) * ACTB), FF, MOE_I8UP ? 1.0f / (I8_XS * I8_WS) : 1.0f / 64.0f, 8.0f};
                        pg8::gemm_phase<pg8::EpiSwiglu8, MoeSched, true, true, MOE_I8UP ? 2 : 1>(F.tid, F.lds, gtab, (const int*)(a->ws + WS_LIST), DM / 2, DM / 2, S, E);
                    }
                }
                SEAM();
            }
            if (RUN) phase_resid<3>(a, F);
            ++ph;
        }
    }
#if PROF_MASK
    a = args_here(); relaunder(F);
    if (F.bx == 0 && F.tid == 0) {
        PROF_STAMP(N_PHASES_K);
        const volatile unsigned long long* ts = (const volatile unsigned long long*)(a->ws + WS_CTL + 32768); long long sum = 0;
        for (int k = 0; k < N_PHASES_K; ++k) if ((PROF_MASK >> k) & 1) sum += (long long)(ts[k + 1] - ts[k]);
        const long long ticks = sum * PROF_AMP; const long long t0 = wall_clock64();
        while (wall_clock64() - t0 < ticks) __builtin_amdgcn_s_sleep(32);
    }
#endif
#if ATT8_DEBUG
    a = args_here(); relaunder(F);
    if (F.bx == 0 && F.tid == 0) {
        const float sd = __hip_atomic_load((float*)(a->ws + WS_CTL) + 2048, RLX_AGENT), so = __hip_atomic_load((float*)(a->ws + WS_CTL) + 2049, RLX_AGENT);
        float nl = -__log2f(sd / so); if (!(nl > 0.f)) nl = 0.f; if (nl > 40.f) nl = 40.f;
        const long long ticks = (long long)(nl * 200000.f); const long long t0 = wall_clock64();
        while (wall_clock64() - t0 < ticks) __builtin_amdgcn_s_sleep(32);
    }
#endif
#undef RUN
#undef SEAM
}
constexpr int N_PHASES = 22;

#ifndef DET_PROBE
#define DET_PROBE 0
#endif
#if DET_PROBE
__global__ void det_cksum(const unsigned* out, unsigned long long* dst, int n) {
    unsigned long long s = 0; for (int i = blockIdx.x * blockDim.x + threadIdx.x; i < n; i += gridDim.x * blockDim.x) s += (unsigned long long)out[i] * (unsigned)(2 * (i & 1023) + 1);
    for (int o = 32; o > 0; o >>= 1) s += __shfl_xor(s, o);
    if ((threadIdx.x & 63) == 0) atomicAdd(dst, s);
}
__global__ void det_fill(unsigned* p, size_t n, unsigned v) { for (size_t i = (size_t)blockIdx.x * blockDim.x + threadIdx.x; i < n; i += (size_t)gridDim.x * blockDim.x) p[i] = v; }
__global__ void det_cmp(const unsigned long long* c, float* out) { if (c[0] != c[1]) out[0] = __builtin_nanf(""); }
#endif
#ifndef MK_N_LAUNCHES
#define MK_N_LAUNCHES 1
#endif
extern "C" void kernel_launch(void* const* d_in, const int* in_sizes, int n_in, void* d_out, int out_size, void* d_ws, size_t ws_size, hipStream_t stream) {
    static int grid = 0;
    if (grid == 0) {
        if (n_in != 24 || out_size != NLAT * DM || ws_size < WS_END) { fprintf(stderr, "kernel_launch: unexpected shapes (n_in %d out %d ws %zu)\n", n_in, out_size, ws_size); grid = -1; return; }
        int dev = 0, cus = 0, per_cu = 0;
        if (hipGetDevice(&dev) != hipSuccess || hipDeviceGetAttribute(&cus, hipDeviceAttributeMultiprocessorCount, dev) != hipSuccess) { grid = -1; return; }
        if (hipFuncSetAttribute((const void*)mk_fwd, hipFuncAttributeMaxDynamicSharedMemorySize, LDS_BYTES) != hipSuccess) { fprintf(stderr, "kernel_launch: hipFuncSetAttribute failed\n"); grid = -1; return; }
        if (hipOccupancyMaxActiveBlocksPerMultiprocessor(&per_cu, (const void*)mk_fwd, NWAVES * 64, LDS_BYTES) != hipSuccess || per_cu < 1) fprintf(stderr, "kernel_launch: occupancy query says %d\n", per_cu);
        (void)hipGetLastError();
        grid = cus;
        while (grid > 8 && (NLAT % (2 * grid * NWAVES) != 0 || NLAT / (grid * NWAVES) > 64)) --grid;
    }
    if (grid < 0) return;
    if (hipMemsetAsync((char*)d_ws + WS_CTL, 0, CTL_ZERO_BYTES, stream) != hipSuccess) return;
    Args a{};
    for (int i = 0; i < 24; ++i) a.in[i] = (const float*)d_in[i];
    a.out = (float*)d_out; a.ws = (unsigned char*)d_ws; a.pad = 0;
#if DET_PROBE
    { a.ph_lo = 0; a.ph_hi = N_PHASES; a.li = 0;
      unsigned long long* ck = (unsigned long long*)((char*)d_ws + WS_CTL + 65536);
      hipLaunchKernelGGL(det_fill, dim3(2048), dim3(256), 0, stream, (unsigned*)((char*)d_ws + MiB), (WS_END - MiB) / 4, 0x3C3C3C3Cu);
      hipLaunchKernelGGL(mk_fwd, dim3(grid), dim3(NWAVES * 64), LDS_BYTES, stream, a);
      hipLaunchKernelGGL(det_cksum, dim3(1024), dim3(256), 0, stream, (const unsigned*)d_out, ck, out_size);
      if (hipMemsetAsync((char*)d_ws + WS_CTL, 0, 65536, stream) != hipSuccess) return;
      hipLaunchKernelGGL(det_fill, dim3(2048), dim3(256), 0, stream, (unsigned*)((char*)d_ws + MiB), (WS_END - MiB) / 4, 0xBDBDBDBDu);
      hipLaunchKernelGGL(det_fill, dim3(2048), dim3(256), 0, stream, (unsigned*)d_out, (size_t)out_size, 0xBDBDBDBDu);
      hipLaunchKernelGGL(mk_fwd, dim3(grid), dim3(NWAVES * 64), LDS_BYTES, stream, a);
      hipLaunchKernelGGL(det_cksum, dim3(1024), dim3(256), 0, stream, (const unsigned*)d_out, ck + 1, out_size);
      hipLaunchKernelGGL(det_cmp, dim3(1), dim3(1), 0, stream, (const unsigned long long*)ck, (float*)d_out);
      return; }
#endif
    if (MK_N_LAUNCHES == 1) { a.ph_lo = 0; a.ph_hi = N_PHASES; a.li = 0; hipLaunchKernelGGL(mk_fwd, dim3(grid), dim3(NWAVES * 64), LDS_BYTES, stream, a); }
    else { for (int p = 0; p < N_PHASES; ++p) { a.ph_lo = p; a.ph_hi = p + 1; a.li = p; hipLaunchKernelGGL(mk_fwd, dim3(grid), dim3(NWAVES * 64), LDS_BYTES, stream, a); } }
}
```

```cpp
#include <hip/hip_runtime.h>
#include <hip/hip_bf16.h>
#include <cstdio>
#include <cstdint>
#include <cmath>
namespace pg8 {
#define PG8_LAS __attribute__((address_space(3)))
typedef unsigned short bf16_t;
typedef short bf16x8 __attribute__((ext_vector_type(8)));
typedef float f32x4 __attribute__((ext_vector_type(4)));
typedef unsigned u32x4 __attribute__((ext_vector_type(4)));
typedef int i32x4_t __attribute__((ext_vector_type(4)));
typedef int i32x8_t __attribute__((ext_vector_type(8)));
typedef int i32x8_t __attribute__((ext_vector_type(8)));
constexpr int BM = 256, BK = 64, HALF = 128, HTB = HALF * BK * 2  , STAGE_BYTES = 8 * HTB, NXCD = 8, WGM = 8;

__host__ __device__ __forceinline__ int lds_byte(int r, int c) { const int st = (r >> 4) * 2 + (c >> 5), rr = r & 15, cc = c & 31, ob = rr * 64 + cc * 2; return st * 1024 + (ob ^ (((ob >> 9) & 1) << 5)); }
__host__ __device__ __forceinline__ void stage_rc(int b, int& R, int& C) { const int st = b / 1024, sb = b % 1024, swz = sb ^ (((sb >> 9) & 1) << 5); R = (st >> 1) * 16 + swz / 64; C = (st & 1) * 32 + (swz % 64) / 2; }
__host__ __device__ __forceinline__ int perm32(int rho) { const int n = rho >> 4, i = rho & 15; return 8 * (i >> 2) + 4 * n + (i & 3); }

struct Unit { int pm, pn; const char* a; const char* b; int goff, gcnt; };

__device__ __forceinline__ void deal(int L, int nM, int nN, int& pm, int& pn) {
    const int nwg = nM * nN; int wgid = L;
    { const int q = nwg / NXCD, r = nwg % NXCD, xcd = wgid % NXCD, off = wgid / NXCD; wgid = (xcd < r ? xcd * (q + 1) : r * (q + 1) + (xcd - r) * q) + off; }
    const int nig = WGM * nN, gid = wgid / nig, fm = gid * WGM, gsz = (nM - fm) < WGM ? (nM - fm) : WGM;
    pm = fm + ((wgid % nig) % gsz); pn = (wgid % nig) / gsz;
}

__device__ __forceinline__ float zero_v() { float z; asm volatile("v_mov_b32 %0, 0" : "=v"(z)); return z; }
__device__ __forceinline__ unsigned cvt_pk_bf16(float lo, float hi) { unsigned r; asm volatile("v_cvt_pk_bf16_f32 %0, %1, %2" : "=v"(r) : "v"(lo), "v"(hi)); return r; }

struct EpiBf16 {
    static constexpr bool PERM = true;
    bf16_t* O; int ldc;
    __device__ __forceinline__ void operator()(const f32x4 (&acc)[2][2][4][2], const Unit& u, int wr, int wc, int fr, int fq) const {
        const int row0 = u.pm * BM + wr * 64 + fr; const int col0 = u.pn * BM + wc * 32 + 8 * fq;
#pragma unroll
        for (int ai = 0; ai < 2; ++ai)
#pragma unroll
            for (int m = 0; m < 4; ++m) { bf16_t* rowp = O + (size_t)(row0 + ai * HALF + m * 16) * ldc + col0;
#pragma unroll
                for (int bj = 0; bj < 2; ++bj) { const f32x4 v0 = acc[ai][bj][m][0], v1 = acc[ai][bj][m][1];
                    u32x4 w; w.x = cvt_pk_bf16(v0[0], v0[1]); w.y = cvt_pk_bf16(v0[2], v0[3]); w.z = cvt_pk_bf16(v1[0], v1[1]); w.w = cvt_pk_bf16(v1[2], v1[3]);
                    *(u32x4*)(rowp + bj * HALF) = w; } }
    }
};
struct EpiF32 {
    static constexpr bool PERM = false;
    float* O; int ldc;
    __device__ __forceinline__ void operator()(const f32x4 (&acc)[2][2][4][2], const Unit& u, int wr, int wc, int fr, int fq) const {
        const int row0 = u.pm * BM + wr * 64 + fr; const int col0 = u.pn * BM + wc * 32 + 4 * fq;
#pragma unroll
        for (int ai = 0; ai < 2; ++ai)
#pragma unroll
            for (int m = 0; m < 4; ++m) { float* rowp = O + (size_t)(row0 + ai * HALF + m * 16) * ldc + col0;
#pragma unroll
                for (int bj = 0; bj < 2; ++bj)
#pragma unroll
                    for (int n = 0; n < 2; ++n) *(f32x4*)(rowp + bj * HALF + n * 16) = acc[ai][bj][m][n]; }
    }
};
__device__ __forceinline__ float silu_f(float x) { return x * __builtin_amdgcn_rcpf(1.0f + __builtin_amdgcn_exp2f(-1.4426950408889634f * x)); }
struct EpiSwiglu {
    static constexpr bool PERM = true;
    bf16_t* O; int ldc;
    __device__ __forceinline__ void operator()(const f32x4 (&acc)[2][2][4][2], const Unit& u, int wr, int wc, int fr, int fq) const {
        const int row0 = u.pm * BM + wr * 64 + fr; const int col0 = u.pn * HALF + wc * 32 + 8 * fq;
#pragma unroll
        for (int ai = 0; ai < 2; ++ai)
#pragma unroll
            for (int m = 0; m < 4; ++m) { bf16_t* rowp = O + (size_t)(row0 + ai * HALF + m * 16) * ldc + col0;
                const f32x4 a0 = acc[ai][0][m][0], a1 = acc[ai][0][m][1], g0 = acc[ai][1][m][0], g1 = acc[ai][1][m][1];
                u32x4 w; w.x = cvt_pk_bf16(silu_f(a0[0]) * g0[0], silu_f(a0[1]) * g0[1]); w.y = cvt_pk_bf16(silu_f(a0[2]) * g0[2], silu_f(a0[3]) * g0[3]);
                w.z = cvt_pk_bf16(silu_f(a1[0]) * g1[0], silu_f(a1[1]) * g1[1]); w.w = cvt_pk_bf16(silu_f(a1[2]) * g1[2], silu_f(a1[3]) * g1[3]);
                *(u32x4*)rowp = w; }
    }
};

struct EpiBf16S {
    static constexpr bool PERM = true;
    bf16_t* O; int ldc; float scl;
    __device__ __forceinline__ void operator()(const f32x4 (&acc)[2][2][4][2], const Unit& u, int wr, int wc, int fr, int fq) const {
        const int row0 = u.pm * BM + wr * 64 + fr; const int col0 = u.pn * BM + wc * 32 + 8 * fq;
#pragma unroll
        for (int ai = 0; ai < 2; ++ai)
#pragma unroll
            for (int m = 0; m < 4; ++m) { bf16_t* rowp = O + (size_t)(row0 + ai * HALF + m * 16) * ldc + col0;
#pragma unroll
                for (int bj = 0; bj < 2; ++bj) { const f32x4 v0 = acc[ai][bj][m][0] * scl, v1 = acc[ai][bj][m][1] * scl;
                    u32x4 w; w.x = cvt_pk_bf16(v0[0], v0[1]); w.y = cvt_pk_bf16(v0[2], v0[3]); w.z = cvt_pk_bf16(v1[0], v1[1]); w.w = cvt_pk_bf16(v1[2], v1[3]);
                    *(u32x4*)(rowp + bj * HALF) = w; } }
    }
};
struct EpiF32S {
    static constexpr bool PERM = false;
    float* O; int ldc; float scl;
    __device__ __forceinline__ void operator()(const f32x4 (&acc)[2][2][4][2], const Unit& u, int wr, int wc, int fr, int fq) const {
        const int row0 = u.pm * BM + wr * 64 + fr; const int col0 = u.pn * BM + wc * 32 + 4 * fq;
#pragma unroll
        for (int ai = 0; ai < 2; ++ai)
#pragma unroll
            for (int m = 0; m < 4; ++m) { float* rowp = O + (size_t)(row0 + ai * HALF + m * 16) * ldc + col0;
#pragma unroll
                for (int bj = 0; bj < 2; ++bj)
#pragma unroll
                    for (int n = 0; n < 2; ++n) *(f32x4*)(rowp + bj * HALF + n * 16) = acc[ai][bj][m][n] * scl; }
    }
};
__device__ __forceinline__ unsigned cvt_fp8x4(float a, float b, float c, float d) { int w = 0; w = __builtin_amdgcn_cvt_pk_fp8_f32(a, b, w, false); w = __builtin_amdgcn_cvt_pk_fp8_f32(c, d, w, true); return (unsigned)w; }
struct EpiSwigluS {
    static constexpr bool PERM = true;
    bf16_t* O; int ldc; float si;
    __device__ __forceinline__ void operator()(const f32x4 (&acc)[2][2][4][2], const Unit& u, int wr, int wc, int fr, int fq) const {
        const int row0 = u.pm * BM + wr * 64 + fr; const int col0 = u.pn * HALF + wc * 32 + 8 * fq;
#pragma unroll
        for (int ai = 0; ai < 2; ++ai)
#pragma unroll
            for (int m = 0; m < 4; ++m) { bf16_t* rowp = O + (size_t)(row0 + ai * HALF + m * 16) * ldc + col0;
                const f32x4 a0 = acc[ai][0][m][0] * si, a1 = acc[ai][0][m][1] * si, g0 = acc[ai][1][m][0] * si, g1 = acc[ai][1][m][1] * si;
                u32x4 w; w.x = cvt_pk_bf16(silu_f(a0[0]) * g0[0], silu_f(a0[1]) * g0[1]); w.y = cvt_pk_bf16(silu_f(a0[2]) * g0[2], silu_f(a0[3]) * g0[3]);
                w.z = cvt_pk_bf16(silu_f(a1[0]) * g1[0], silu_f(a1[1]) * g1[1]); w.w = cvt_pk_bf16(silu_f(a1[2]) * g1[2], silu_f(a1[3]) * g1[3]);
                *(u32x4*)rowp = w; }
    }
};
struct EpiSwiglu8 {
    static constexpr bool PERM = true;
    unsigned char* O; int ldc; float si, so;
    __device__ __forceinline__ f32x4 sw4(const f32x4 a, const f32x4 g, const float c1, const float k2) const {
        const f32x4 t = a * c1; f32x4 e; e[0] = __builtin_amdgcn_exp2f(t[0]); e[1] = __builtin_amdgcn_exp2f(t[1]); e[2] = __builtin_amdgcn_exp2f(t[2]); e[3] = __builtin_amdgcn_exp2f(t[3]);
        const f32x4 d = e + 1.0f; f32x4 r; r[0] = __builtin_amdgcn_rcpf(d[0]); r[1] = __builtin_amdgcn_rcpf(d[1]); r[2] = __builtin_amdgcn_rcpf(d[2]); r[3] = __builtin_amdgcn_rcpf(d[3]);
        return ((a * g) * k2) * r; }
    __device__ __forceinline__ void operator()(const f32x4 (&acc)[2][2][4][2], const Unit& u, int wr, int wc, int fr, int fq) const {
        const int row0 = u.pm * BM + wr * 64 + fr; const int col0 = u.pn * HALF + wc * 32 + 8 * fq; const float c1 = -1.4426950408889634f * si, k2 = si * si * so;
#pragma unroll
        for (int ai = 0; ai < 2; ++ai)
#pragma unroll
            for (int m = 0; m < 4; ++m) { unsigned char* rowp = O + (size_t)(row0 + ai * HALF + m * 16) * ldc + col0;
                const f32x4 o0 = sw4(acc[ai][0][m][0], acc[ai][1][m][0], c1, k2), o1 = sw4(acc[ai][0][m][1], acc[ai][1][m][1], c1, k2);
                const unsigned w0 = cvt_fp8x4(o0[0], o0[1], o0[2], o0[3]), w1 = cvt_fp8x4(o1[0], o1[1], o1[2], o1[3]);
                typedef unsigned u32x2_t __attribute__((ext_vector_type(2)));
                *(u32x2_t*)rowp = (u32x2_t){w0, w1}; }
    }
};

template <class Epi, class Sched, bool ALIGN_EPI, bool GATHER, int F8 = 0  >
__device__ __forceinline__ void gemm_phase(const int tid, PG8_LAS unsigned char* lds, PG8_LAS unsigned* gtab, const int* glist, const int K  , const int KL  , const Sched& S, const Epi& E) {
    const int wid = __builtin_amdgcn_readfirstlane(tid >> 6), lane = tid & 63, wr = wid >> 2, wc = wid & 3, fr = lane & 15, fq = lane >> 4;
    const int nt = KL / BK;
    unsigned voffA[2], voffB[2]; int RA[2], CA[2];
#pragma unroll
    for (int i = 0; i < 2; ++i) { int R, C; stage_rc(tid * 16 + i * 8192, R, C); const int Rb = Epi::PERM ? ((R & ~31) + perm32(R & 31)) : R;
        voffA[i] = (unsigned)(R * K + C) * 2u; voffB[i] = (unsigned)(Rb * K + C) * 2u; RA[i] = R; CA[i] = C; }
    const size_t kstep = (size_t)(BK * 2);
    const size_t hstep = (size_t)HALF * K * 2;
    const unsigned ldsw = (unsigned)wid * 1024u;
    const int aoff = lds_byte(wr * 64 + fr, fq * 8), boff = lds_byte(wc * 32 + fr, fq * 8);
    unsigned vc[2][2], vn[2][2], v2[2][2];
#define PG8_SA(b, h) (((b) * 2 + (h)) * HTB)
#define PG8_SB(b, h) ((4 + (b) * 2 + (h)) * HTB)
#define PG8_STAGE(bufoff, gbase, voff) do { _Pragma("unroll") for (int _i = 0; _i < 2; ++_i) \
        __builtin_amdgcn_global_load_lds((const unsigned*)((const char*)(gbase) + (voff)[_i]), (PG8_LAS unsigned*)(lds + (bufoff) + ldsw + _i * 8192), 16, 0, 0); } while (0)
#define PG8_STAGE_A(bufoff, gbase, h, VG) do { if constexpr (GATHER) { PG8_STAGE(bufoff, gbase, VG[h]); } else { PG8_STAGE(bufoff, (gbase) + (h) * hstep, voffA); } } while (0)
#define PG8_LDA(dst, b, h) do { _Pragma("unroll") for (int m = 0; m < 4; ++m) _Pragma("unroll") for (int k = 0; k < 2; ++k) dst[m][k] = *(const PG8_LAS bf16x8*)(lds + PG8_SA(b, h) + aoff + m * 2048 + k * 1024); } while (0)
#define PG8_LDB(dst, b, h) do { _Pragma("unroll") for (int n = 0; n < 2; ++n) _Pragma("unroll") for (int k = 0; k < 2; ++k) dst[n][k] = *(const PG8_LAS bf16x8*)(lds + PG8_SB(b, h) + boff + n * 2048 + k * 1024); } while (0)
#define PG8_CAT(x) __builtin_shufflevector(__builtin_bit_cast(i32x4_t, x[0]), __builtin_bit_cast(i32x4_t, x[1]), 0, 1, 2, 3, 4, 5, 6, 7)
#define PG8_MMA(ai, bj, At, Bt) do { __builtin_amdgcn_s_setprio(1); \
        if constexpr (F8 == 2) { _Pragma("unroll") for (int m = 0; m < 4; ++m) _Pragma("unroll") for (int n = 0; n < 2; ++n) _Pragma("unroll") for (int k = 0; k < 2; ++k) \
            asm volatile("v_mfma_i32_16x16x64_i8 %0, %1, %2, %0" : "+v"(acc[ai][bj][m][n]) : "v"(Bt[n][k]), "v"(At[m][k])); } \
        else if constexpr (F8 == 1) { _Pragma("unroll") for (int m = 0; m < 4; ++m) _Pragma("unroll") for (int n = 0; n < 2; ++n) \
            { const i32x8_t b8_ = PG8_CAT(Bt[n]), a8_ = PG8_CAT(At[m]); asm volatile("v_mfma_f32_16x16x128_f8f6f4 %0, %1, %2, %0" : "+v"(acc[ai][bj][m][n]) : "v"(b8_), "v"(a8_)); } } \
        else { _Pragma("unroll") for (int m = 0; m < 4; ++m) _Pragma("unroll") for (int n = 0; n < 2; ++n) _Pragma("unroll") for (int k = 0; k < 2; ++k) \
            acc[ai][bj][m][n] = __builtin_amdgcn_mfma_f32_16x16x32_bf16(Bt[n][k], At[m][k], acc[ai][bj][m][n], 0, 0, 0); } __builtin_amdgcn_s_setprio(0); } while (0)
#define PG8_WAIT_V(n) asm volatile("s_waitcnt vmcnt(" #n ")" ::: "memory")
#define PG8_WAIT_L(n) asm volatile("s_waitcnt lgkmcnt(" #n ")" ::: "memory")
#define PG8_BAR __builtin_amdgcn_s_barrier()
#define PG8_SCHED __builtin_amdgcn_sched_barrier(0)
#define PG8_GT_DMA(u) do { if (wid < 4) __builtin_amdgcn_global_load_lds((const unsigned*)(glist + (u).goff + wid * 64 + lane), (PG8_LAS unsigned*)(gtab + wid * 64), 4, 0, 0); } while (0)
#define PG8_GT_READ(V, u) do { _Pragma("unroll") for (int _h = 0; _h < 2; ++_h) _Pragma("unroll") for (int _i = 0; _i < 2; ++_i) { const int _p = _h * HALF + RA[_i]; int _r = (int)gtab[_p]; _r = (_p < (u).gcnt) ? _r : 0; \
        V[_h][_i] = ((unsigned)_r * (unsigned)K + (unsigned)CA[_i]) * 2u; } } while (0)
    Unit cur, nxt; int ui = 0;
    if (!S.next(0, cur)) return;
    f32x4 acc[2][2][4][2];
    { const float z = zero_v();
#pragma unroll
    for (int a = 0; a < 2; ++a)
#pragma unroll
        for (int b = 0; b < 2; ++b)
#pragma unroll
            for (int m = 0; m < 4; ++m)
#pragma unroll
                for (int n = 0; n < 2; ++n) acc[a][b][m][n] = (f32x4){z, z, z, z}; }
    bf16x8 At[4][2], B0[2][2], B1[2][2];
    const char* cA = cur.a; const char* cB = cur.b;
    if constexpr (GATHER) { PG8_GT_DMA(cur); PG8_WAIT_V(0); PG8_BAR; PG8_GT_READ(vc, cur); PG8_WAIT_L(0); PG8_BAR; }
    if constexpr (GATHER) {
#pragma unroll
        for (int _h = 0; _h < 2; ++_h) { vn[_h][0] = vc[_h][0]; vn[_h][1] = vc[_h][1]; } }
    PG8_STAGE(PG8_SB(0, 0), cB, voffB); PG8_STAGE(PG8_SB(0, 1), cB + hstep, voffB); PG8_STAGE_A(PG8_SA(0, 0), cA, 0, vc); PG8_STAGE_A(PG8_SA(0, 1), cA, 1, vc);
    if (wr == 1) PG8_BAR;
    PG8_WAIT_V(2); PG8_BAR;
    PG8_STAGE(PG8_SB(1, 0), cB + kstep, voffB); PG8_STAGE_A(PG8_SA(1, 0), cA + kstep, 0, vc); PG8_STAGE(PG8_SB(1, 1), cB + hstep + kstep, voffB);
    PG8_WAIT_V(6); PG8_BAR;
    for (;;) {
        const bool has_next = S.next(ui + 1, nxt);
        if constexpr (GATHER) { if (has_next) PG8_GT_DMA(nxt); }
        const char* nA = has_next ? nxt.a : cA; const char* nB = has_next ? nxt.b : cB;
        for (int t = 0; t < nt; t += 2) {
            const bool last = (t == nt - 2);
            const char* a1 = cA + (size_t)(t + 1) * kstep;
            const char* a2 = last ? nA : cA + (size_t)(t + 2) * kstep; const char* b2 = last ? nB : cB + (size_t)(t + 2) * kstep;
            const char* a3 = a2 + kstep; const char* b3 = b2 + kstep;
            if constexpr (GATHER) {
                if (last) { if (has_next) { PG8_GT_READ(vn, nxt); } else {
#pragma unroll
                        for (int _h = 0; _h < 2; ++_h) { vn[_h][0] = vc[_h][0]; vn[_h][1] = vc[_h][1]; } } }
#pragma unroll
                for (int _h = 0; _h < 2; ++_h) { v2[_h][0] = last ? vn[_h][0] : vc[_h][0]; v2[_h][1] = last ? vn[_h][1] : vc[_h][1]; }
            }
            PG8_LDB(B0, 0, 0); PG8_LDB(B1, 0, 1); PG8_SCHED; PG8_LDA(At, 0, 0); PG8_STAGE_A(PG8_SA(1, 1), a1, 1, vc);
            PG8_WAIT_V(8); PG8_WAIT_L(0); PG8_BAR; PG8_MMA(0, 0, At, B0); PG8_MMA(0, 1, At, B1); PG8_BAR; PG8_SCHED;
            PG8_LDA(At, 0, 1); PG8_STAGE(PG8_SB(0, 0), b2, voffB); PG8_STAGE(PG8_SB(0, 1), b2 + hstep, voffB); PG8_STAGE_A(PG8_SA(0, 0), a2, 0, v2);
            PG8_WAIT_V(8); PG8_WAIT_L(0); PG8_BAR; PG8_MMA(1, 0, At, B0); PG8_MMA(1, 1, At, B1); PG8_BAR; PG8_SCHED;
            PG8_LDB(B0, 1, 0); PG8_LDB(B1, 1, 1); PG8_SCHED; PG8_LDA(At, 1, 0); PG8_STAGE_A(PG8_SA(0, 1), a2, 1, v2);
            PG8_WAIT_V(8); PG8_WAIT_L(0); PG8_BAR; PG8_MMA(0, 0, At, B0); PG8_MMA(0, 1, At, B1); PG8_BAR; PG8_SCHED;
            PG8_LDA(At, 1, 1); PG8_STAGE(PG8_SB(1, 0), b3, voffB); PG8_STAGE(PG8_SB(1, 1), b3 + hstep, voffB); PG8_STAGE_A(PG8_SA(1, 0), a3, 0, v2);
            PG8_WAIT_V(8); PG8_WAIT_L(0); PG8_BAR; PG8_MMA(1, 0, At, B0); PG8_MMA(1, 1, At, B1); PG8_BAR; PG8_SCHED;
        }
        if constexpr (ALIGN_EPI) { if (wr == 0) PG8_BAR; }
        if constexpr (F8 != 0) {
            asm volatile("s_nop 15\n\ts_nop 15" : "+v"(acc[1][0][0][0]), "+v"(acc[1][0][0][1]), "+v"(acc[1][0][1][0]), "+v"(acc[1][0][1][1]), "+v"(acc[1][0][2][0]), "+v"(acc[1][0][2][1]), "+v"(acc[1][0][3][0]), "+v"(acc[1][0][3][1]) :: "memory");
            asm volatile("" : "+v"(acc[1][1][0][0]), "+v"(acc[1][1][0][1]), "+v"(acc[1][1][1][0]), "+v"(acc[1][1][1][1]), "+v"(acc[1][1][2][0]), "+v"(acc[1][1][2][1]), "+v"(acc[1][1][3][0]), "+v"(acc[1][1][3][1]) :: "memory"); }
        if constexpr (F8 == 2) {
#pragma unroll
            for (int a_ = 0; a_ < 2; ++a_)
#pragma unroll
                for (int b_ = 0; b_ < 2; ++b_)
#pragma unroll
                    for (int m = 0; m < 4; ++m)
#pragma unroll
                        for (int n = 0; n < 2; ++n) { const i32x4_t iv = __builtin_bit_cast(i32x4_t, acc[a_][b_][m][n]); acc[a_][b_][m][n] = (f32x4){(float)iv[0], (float)iv[1], (float)iv[2], (float)iv[3]}; } }
        E(acc, cur, wr, wc, fr, fq);
        if (!has_next) break;
        { const float z = zero_v();
#pragma unroll
        for (int a = 0; a < 2; ++a)
#pragma unroll
            for (int b = 0; b < 2; ++b)
#pragma unroll
                for (int m = 0; m < 4; ++m)
#pragma unroll
                    for (int n = 0; n < 2; ++n) acc[a][b][m][n] = (f32x4){z, z, z, z}; }
        cur = nxt; cA = nA; cB = nB; ++ui;
        if constexpr (GATHER) {
#pragma unroll
            for (int _h = 0; _h < 2; ++_h) { vc[_h][0] = vn[_h][0]; vc[_h][1] = vn[_h][1]; } }
        if constexpr (ALIGN_EPI) { if (wr == 1) PG8_BAR; }
    }
    PG8_WAIT_V(0);
    if constexpr (!ALIGN_EPI) { if (wr == 0) PG8_BAR; }
    PG8_BAR;
#undef PG8_SA
#undef PG8_SB
#undef PG8_STAGE
#undef PG8_STAGE_A
#undef PG8_LDA
#undef PG8_LDB
#undef PG8_CAT
#undef PG8_MMA
#undef PG8_WAIT_V
#undef PG8_WAIT_L
#undef PG8_BAR
#undef PG8_SCHED
#undef PG8_GT_DMA
#undef PG8_GT_READ
}
}
namespace attn_body {
using bf16=__hip_bfloat16;
using bf16x8=__attribute__((ext_vector_type(8)))short;
using s16x4=__attribute__((ext_vector_type(4)))short;
using f32x16=__attribute__((ext_vector_type(16)))float;
using u32x4=__attribute__((ext_vector_type(4)))unsigned;
constexpr int D=64,KP=64;
constexpr int NW=8,QBLK=32,QB=QBLK*NW,KVBLK=64;
__device__ __forceinline__ int crow(int r,int hi){return (r&3)+8*(r>>2)+4*hi;}
#define SBAR() __builtin_amdgcn_sched_barrier(0)
constexpr int NSLOT=3, SLOTB=8192;
constexpr int LDS_K=0, LDS_V=NSLOT*SLOTB, LDS_WS=2*NSLOT*SLOTB, LDS_OST=LDS_WS+NW*64*4, LDS_BYTES=LDS_OST+NW*4096;
constexpr float C2=0.125f*1.4426950408889634f;
__device__ __forceinline__ void glds16(const void*gsrc,unsigned lds_dst){unsigned keep;
  asm volatile("s_mov_b32 %0, m0\n\ts_mov_b32 m0, %2\n\ts_nop 0\n\tglobal_load_lds_dwordx4 %1, off\n\ts_mov_b32 m0, %0":"=&s"(keep):"v"(gsrc),"s"(lds_dst):"memory");}
__device__ __forceinline__ float max3f(float a,float b,float c){float r;asm("v_max3_f32 %0, %1, %2, %3":"=v"(r):"v"(a),"v"(b),"v"(c));return r;}
__device__ __forceinline__ float max2f(float a,float b){float r;asm("v_max_f32_e32 %0, %1, %2":"=v"(r):"v"(a),"v"(b));return r;}
__device__ __forceinline__ float fadd_s(float a,float b){float r;asm("v_add_f32_e32 %0, %1, %2":"=v"(r):"v"(a),"v"(b));return r;}
__device__ __forceinline__ float fsub_s(float a,float b){float r;asm("v_sub_f32_e32 %0, %1, %2":"=v"(r):"v"(a),"v"(b));return r;}
typedef float f32x2_t __attribute__((ext_vector_type(2))); typedef __bf16 bf16x2_t __attribute__((ext_vector_type(2)));
__device__ __forceinline__ unsigned cvtpk_s(float lo,float hi){f32x2_t v={lo,hi};bf16x2_t b=__builtin_convertvector(v,bf16x2_t);return __builtin_bit_cast(unsigned,b);}
#define WAIT_BAR(N) asm volatile("s_waitcnt vmcnt(" #N ") lgkmcnt(0)\n\ts_barrier":::"memory")

__device__ __forceinline__ void qkt(f32x16&p0,f32x16&p1,const char*Kslot,const bf16x8*qr,const f32x16&negm,int r32,int hi){
  const char*kb=Kslot+hi*1024+r32*16;
  #pragma unroll
  for(int d0=0;d0<4;++d0){
    const bf16x8 b0=*reinterpret_cast<const bf16x8*>(kb+d0*2048);
    const bf16x8 b1=*reinterpret_cast<const bf16x8*>(kb+d0*2048+512);
    if(d0==0){p0=__builtin_amdgcn_mfma_f32_32x32x16_bf16(b0,qr[0],negm,0,0,0);p1=__builtin_amdgcn_mfma_f32_32x32x16_bf16(b1,qr[0],negm,0,0,0);}
    else{p0=__builtin_amdgcn_mfma_f32_32x32x16_bf16(b0,qr[d0],p0,0,0,0);p1=__builtin_amdgcn_mfma_f32_32x32x16_bf16(b1,qr[d0],p1,0,0,0);}}
}
typedef __attribute__((address_space(3))) const char* lds_cptr;
typedef short v4i16_t __attribute__((ext_vector_type(4)));
__device__ __forceinline__ void kload8(bf16x8*kf,lds_cptr kp){
  kf[0]=*(const __attribute__((address_space(3))) bf16x8*)(kp);      kf[1]=*(const __attribute__((address_space(3))) bf16x8*)(kp+512);
  kf[2]=*(const __attribute__((address_space(3))) bf16x8*)(kp+2048); kf[3]=*(const __attribute__((address_space(3))) bf16x8*)(kp+2560);
  kf[4]=*(const __attribute__((address_space(3))) bf16x8*)(kp+4096); kf[5]=*(const __attribute__((address_space(3))) bf16x8*)(kp+4608);
  kf[6]=*(const __attribute__((address_space(3))) bf16x8*)(kp+6144); kf[7]=*(const __attribute__((address_space(3))) bf16x8*)(kp+6656);
}
__device__ __forceinline__ void kload2(bf16x8*kf,lds_cptr kp,int j){ kf[2*j]=*(const __attribute__((address_space(3))) bf16x8*)(kp+j*2048); kf[2*j+1]=*(const __attribute__((address_space(3))) bf16x8*)(kp+j*2048+512); }
__device__ __forceinline__ s16x4 vtr(lds_cptr p){ return __builtin_bit_cast(s16x4,__builtin_amdgcn_ds_read_tr16_b64_v4i16((__attribute__((address_space(3))) v4i16_t*)p)); }
__device__ __forceinline__ float rowmax(const f32x16&p0,const f32x16&p1){
  float a=max3f(p0[0],p0[1],p1[0]),b=max3f(p0[2],p0[3],p1[1]);a=max3f(a,p1[2],p1[3]);
  #pragma unroll
  for(int r=4;r<16;r+=4){a=max3f(a,p0[r],p0[r+1]);b=max3f(b,p0[r+2],p0[r+3]);a=max3f(a,p1[r],p1[r+1]);b=max3f(b,p1[r+2],p1[r+3]);}
  const float m=max2f(a,b);
  auto rr=__builtin_amdgcn_permlane32_swap(__float_as_uint(m),__float_as_uint(m),false,false);
  return max2f(__uint_as_float(rr[0]),__uint_as_float(rr[1]));
}
__device__ __forceinline__ void pv(f32x16*o,int vb,bf16x8 pa0,bf16x8 pa1,bf16x8 pa2,bf16x8 pa3){
  #pragma unroll
  for(int d0=0;d0<2;++d0){s16x4 lo[4],hi[4];
    #pragma unroll
    for(int ks=0;ks<4;++ks){
      asm volatile("ds_read_b64_tr_b16 %0,%1 offset:%c2":"=&v"(lo[ks]):"v"(vb),"i"(d0*4096+ks*1024):"memory");
      asm volatile("ds_read_b64_tr_b16 %0,%1 offset:%c2":"=&v"(hi[ks]):"v"(vb),"i"(d0*4096+ks*1024+512):"memory");}
    asm volatile("s_waitcnt lgkmcnt(0)":::"memory");SBAR();
    #define PK(k) (bf16x8){lo[k][0],lo[k][1],lo[k][2],lo[k][3],hi[k][0],hi[k][1],hi[k][2],hi[k][3]}
    o[d0]=__builtin_amdgcn_mfma_f32_32x32x16_bf16(pa0,PK(0),o[d0],0,0,0);
    o[d0]=__builtin_amdgcn_mfma_f32_32x32x16_bf16(pa1,PK(1),o[d0],0,0,0);
    o[d0]=__builtin_amdgcn_mfma_f32_32x32x16_bf16(pa2,PK(2),o[d0],0,0,0);
    o[d0]=__builtin_amdgcn_mfma_f32_32x32x16_bf16(pa3,PK(3),o[d0],0,0,0);
    #undef PK
  }
}

__device__ __forceinline__ void attn_unit(const int tid,const float mref,const bf16*Qu,int QP,const bf16*__restrict__ Kh,const bf16*__restrict__ Vh,int NT,bf16*Ou,int OP,char*shm){
  const int lane=tid&63,r32=lane&31,hi=lane>>5; const int wid=__builtin_amdgcn_readfirstlane(tid>>6);
  const bf16*Qw=Qu+(long)(wid*QBLK)*QP;
  const unsigned lds0=(unsigned)(uintptr_t)shm;
  float*wsf=(float*)(shm+LDS_WS)+wid*64;
  const bf16*ksrc=Kh+(long)lane*KP+wid*8;
  const bf16*vsrc=Vh+(long)(16*(wid&3)+(lane>>2))*KP+(wid>>2)*32+(lane&3)*8;
  const unsigned kdst=lds0+LDS_K+wid*1024, vdst=lds0+LDS_V+wid*1024;
  #define DMA_K(t,slot) glds16(ksrc+(long)(t)*KVBLK*KP,(unsigned)__builtin_amdgcn_readfirstlane(kdst+(slot)))
  #define DMA_V(t,slot) glds16(vsrc+(long)(t)*KVBLK*KP,(unsigned)__builtin_amdgcn_readfirstlane(vdst+(slot)))
  const int vb0=(int)(lds0+LDS_V)+((lane>>4)&1)*32+(lane&3)*8+(4*hi+((lane&15)>>2))*64;
  const char*Kbase=shm+LDS_K; bf16x8 kf[8];
  const lds_cptr shm3=(lds_cptr)shm; const lds_cptr kp0=shm3+LDS_K+hi*1024+r32*16; const lds_cptr vp0=shm3+LDS_V+((lane>>4)&1)*32+(lane&3)*8+(4*hi+((lane&15)>>2))*64;
  DMA_K(0,0);DMA_V(0,0);DMA_K(1,SLOTB);
  bf16x8 qr[4];
  #pragma unroll
  for(int d0=0;d0<4;++d0)qr[d0]=*reinterpret_cast<const bf16x8*>(&Qw[(long)r32*QP+d0*16+hi*8]);
  float l_reg=0.f;f32x16 o[2],negm; { const float z=pg8::zero_v(); _Pragma("unroll") for(int r=0;r<16;++r){o[0][r]=z;o[1][r]=z;negm[r]=z-mref;} } asm volatile("":"+v"(negm));
  f32x16 pA0,pA1,pB0,pB1;
  int sl_prev=0,sl_cur=0,sl_next=SLOTB;
  #define ROT() do{sl_prev=sl_cur;sl_cur=sl_next;sl_next=(sl_next==(NSLOT-1)*SLOTB)?0:sl_next+SLOTB;}while(0)
  DMA_K(2,2*SLOTB);
  WAIT_BAR(3);
  qkt(pA0,pA1,Kbase,qr,negm,r32,hi);asm volatile("s_nop 15\n\ts_nop 7":"+v"(pA0),"+v"(pA1));
  _Pragma("unroll") for(int r=0;r<16;++r){pA0[r]=__builtin_amdgcn_exp2f(pA0[r]);pA1[r]=__builtin_amdgcn_exp2f(pA1[r]);}
  WAIT_BAR(0);
  DMA_K(3,0);DMA_V(1,SLOTB);
  ROT();
  kload8(kf,kp0+sl_cur);
  WAIT_BAR(2);
  s16x4 vlo[8],vhi[8]; u32x4 pw0,pw1,pw2,pw3;
  #define MFX(a_,b_,c_) __builtin_amdgcn_mfma_f32_32x32x16_bf16(a_,b_,c_,0,0,0)
  #define PKW(P,B) cvtpk_s(P[B],P[B+1])
  #define PAF(k) __builtin_bit_cast(bf16x8,pw##k)
  #define VFR(i) (bf16x8){vlo[i][0],vlo[i][1],vlo[i][2],vlo[i][3],vhi[i][0],vhi[i][1],vhi[i][2],vhi[i][3]}
  #define PIN(x) asm volatile("":"+v"(x))
  #define GAPA(MF,A0,A1,A2,A3,W0,W1,PW) do{ MF; sacc+=A0; sacc+=A1; sacc+=A2; sacc+=A3; PIN(sacc); W0; W1; PIN(PW); SBAR(); }while(0)
  #define EX(v) __builtin_amdgcn_exp2f(v)
  #define GAPB(MF,X,B) do{ MF; X[B]=EX(X[B]); X[B+1]=EX(X[B+1]); X[B+2]=EX(X[B+2]); X[B+3]=EX(X[B+3]); PIN(X); SBAR(); }while(0)
  #define VRD(i) do{ vlo[i]=vtr(vp_+(((i)>>2)*4096+((i)&3)*1024)); vhi[i]=vtr(vp_+(((i)>>2)*4096+((i)&3)*1024+512)); }while(0)
  #define KRD(G,j) do{ if(G){ kload2(kf,kp0+sl_next,j); SBAR(); } }while(0)
  #define STEP(C0,C1,P0,P1,t,GK,GV,GL) do{ SBAR(); \
    const lds_cptr vp_=vp0+sl_prev; \
    VRD(0); SBAR(); float sacc=(P0[0]+P0[1]); \
    GAPA(C0=MFX(kf[0],qr[0],negm), P0[2],P0[3],P0[4],P0[5],     pw0[0]=PKW(P0,0), pw0[1]=PKW(P0,2), pw0); \
    VRD(4); SBAR(); GAPA(C1=MFX(kf[1],qr[0],negm), P0[6],P0[7],P0[8],P0[9],     pw0[2]=PKW(P0,4), pw0[3]=PKW(P0,6), pw0); \
    VRD(1); SBAR(); GAPA(C0=MFX(kf[2],qr[1],C0),   P0[10],P0[11],P0[12],P0[13], pw1[0]=PKW(P0,8), pw1[1]=PKW(P0,10), pw1); \
    VRD(5); SBAR(); GAPA(C1=MFX(kf[3],qr[1],C1),   P0[14],P0[15],P1[0],P1[1],   pw1[2]=PKW(P0,12),pw1[3]=PKW(P0,14), pw1); \
    VRD(2); SBAR(); GAPA(C0=MFX(kf[4],qr[2],C0),   P1[2],P1[3],P1[4],P1[5],     pw2[0]=PKW(P1,0), pw2[1]=PKW(P1,2), pw2); \
    VRD(6); SBAR(); GAPA(C1=MFX(kf[5],qr[2],C1),   P1[6],P1[7],P1[8],P1[9],     pw2[2]=PKW(P1,4), pw2[3]=PKW(P1,6), pw2); \
    VRD(3); SBAR(); GAPA(C0=MFX(kf[6],qr[3],C0),   P1[10],P1[11],P1[12],P1[13], pw3[0]=PKW(P1,8), pw3[1]=PKW(P1,10), pw3); \
    VRD(7); SBAR(); GAPA(C1=MFX(kf[7],qr[3],C1),   P1[14],P1[15],0.f,0.f,       pw3[2]=PKW(P1,12),pw3[3]=PKW(P1,14), pw3); \
    l_reg+=sacc; \
    if(GK){DMA_K((t)+3,sl_cur);} if(GV){DMA_V((t)+1,sl_next);} \
    SBAR(); \
    GAPB(o[0]=MFX(PAF(0),VFR(0),o[0]), C0,0); \
    GAPB(o[1]=MFX(PAF(0),VFR(4),o[1]), C0,4); \
    KRD(GL,0); GAPB(o[0]=MFX(PAF(1),VFR(1),o[0]), C0,8); \
    KRD(GL,1); GAPB(o[1]=MFX(PAF(1),VFR(5),o[1]), C0,12); \
    KRD(GL,2); GAPB(o[0]=MFX(PAF(2),VFR(2),o[0]), C1,0); \
    KRD(GL,3); GAPB(o[1]=MFX(PAF(2),VFR(6),o[1]), C1,4); \
    GAPB(o[0]=MFX(PAF(3),VFR(3),o[0]), C1,8); \
    GAPB(o[1]=MFX(PAF(3),VFR(7),o[1]), C1,12); \
    }while(0)
  int t=1;
  for(;t+5<NT;t+=2){
    STEP(pB0,pB1,pA0,pA1,t,true,true,true);     WAIT_BAR(2); ROT();
    STEP(pA0,pA1,pB0,pB1,t+1,true,true,true);   WAIT_BAR(2); ROT();
  }
  #define ENDW(tt) do{ if((tt)+3<NT){WAIT_BAR(2);} else if((tt)+2<NT){WAIT_BAR(1);} else {WAIT_BAR(0);} }while(0)
  for(;t+1<NT;t+=2){
    STEP(pB0,pB1,pA0,pA1,t,(t+3<NT),(t+1<NT),(t+1<NT));       ENDW(t);   ROT();
    STEP(pA0,pA1,pB0,pB1,t+1,(t+4<NT),(t+2<NT),(t+2<NT));     ENDW(t+1); ROT();
  }
  STEP(pB0,pB1,pA0,pA1,NT-1,false,false,false);
  { float sacc=pB0[0]+pB0[1]; _Pragma("unroll") for(int r=2;r<16;++r)sacc+=pB0[r]; _Pragma("unroll") for(int r=0;r<16;++r)sacc+=pB1[r]; l_reg+=sacc;
    pw0=(u32x4){PKW(pB0,0),PKW(pB0,2),PKW(pB0,4),PKW(pB0,6)};pw1=(u32x4){PKW(pB0,8),PKW(pB0,10),PKW(pB0,12),PKW(pB0,14)};pw2=(u32x4){PKW(pB1,0),PKW(pB1,2),PKW(pB1,4),PKW(pB1,6)};pw3=(u32x4){PKW(pB1,8),PKW(pB1,10),PKW(pB1,12),PKW(pB1,14)};
    SBAR(); pv(o,vb0+sl_cur,PAF(0),PAF(1),PAF(2),PAF(3)); }
  #undef PKW
  #undef PAF
  #undef VFR
  #undef PIN
  #undef GAPA
  #undef GAPB
  #undef EX
  #undef VRD
  #undef KRD
  #undef STEP
  #undef MFX
  #undef ENDW
  {auto rr=__builtin_amdgcn_permlane32_swap(__float_as_uint(l_reg),__float_as_uint(l_reg),false,false);l_reg=__uint_as_float(rr[0])+__uint_as_float(rr[1]);}
  if(hi==0)wsf[32+r32]=l_reg;asm volatile("s_waitcnt lgkmcnt(0)":::"memory");
  float rli[16];
  #pragma unroll
  for(int r=0;r<16;++r)rli[r]=__builtin_amdgcn_rcpf(wsf[32+crow(r,hi)]);
  bf16*Ow=Ou+(long)(wid*QBLK)*OP;
  { bf16*stg=(bf16*)(shm+LDS_OST)+wid*2048;
    #pragma unroll
    for(int r=0;r<16;++r){const int orow=crow(r,hi);
      #pragma unroll
      for(int d0=0;d0<2;++d0)stg[orow*64+d0*32+r32]=__float2bfloat16(o[d0][r]*rli[r]);}
    asm volatile("s_waitcnt lgkmcnt(0)":::"memory");
    #pragma unroll
    for(int i=0;i<4;++i){const int row=i*8+(lane>>3),ch=lane&7; const u32x4 v=*(const u32x4*)(stg+row*64+ch*8); *(u32x4*)(Ow+(long)row*OP+ch*8)=v;} }
  asm volatile("s_waitcnt lgkmcnt(0)\n\ts_barrier":::"memory");
  #undef DMA_K
  #undef DMA_V
  #undef ROT
}

typedef int v8i __attribute__((ext_vector_type(8)));
typedef float f32x4_t __attribute__((ext_vector_type(4)));
typedef int v4i __attribute__((ext_vector_type(4)));
typedef unsigned v2u_t __attribute__((ext_vector_type(2)));
constexpr int F8_SLOTB=4096, F8_LDS_K=0, F8_LDS_V=3*F8_SLOTB, F8_LDS_WS=6*F8_SLOTB, F8_OSTP=144, F8_LDS_OST=F8_LDS_WS+2048, F8_LDS_BYTES=F8_LDS_OST+NW*32*F8_OSTP;
constexpr float F8_ENC0=60.25f;
constexpr float F8_SH=13.0f;
#define MF8(a_,b_,c_,BF) __builtin_amdgcn_mfma_scale_f32_32x32x64_f8f6f4(a_,b_,c_,0,BF,0,0,0,0)
typedef __attribute__((address_space(3))) const v4i* lds_v4p;
__device__ __forceinline__ v8i ld256(lds_cptr p){ const v4i a=*(lds_v4p)(p), b=*(lds_v4p)(p+1024); return __builtin_shufflevector(a,b,0,1,2,3,4,5,6,7); }
__device__ __forceinline__ void attn_unit8(const int tid,const float mref,const unsigned char*Qu,int QP,const unsigned char*__restrict__ Kh,const unsigned char*__restrict__ Vh,int NT,bf16*Ou,int OP,char*shm){
  const int lane=tid&63,r32=lane&31,hi=lane>>5; const int wid=__builtin_amdgcn_readfirstlane(tid>>6);
  const unsigned lds0=(unsigned)(uintptr_t)shm;
  const bool isK=wid<4;
  const unsigned char*dsrc=(isK?Kh:Vh)+(wid&3)*1024+lane*16;
  const unsigned ddst=lds0+(isK?F8_LDS_K:F8_LDS_V)+(wid&3)*1024;
  #define DMA8(tk,sk,tv,sv) glds16(dsrc+(long)(isK?(tk):(tv))*4096,(unsigned)__builtin_amdgcn_readfirstlane(ddst+(isK?(sk):(sv))))
  const lds_cptr shm3=(lds_cptr)shm; const lds_cptr kp0=shm3+F8_LDS_K+hi*2048+r32*16; const lds_cptr vp0=shm3+F8_LDS_V+hi*2048+r32*16;
  DMA8(0,0,0,0); if(isK){DMA8(1,F8_SLOTB,0,0);}
  v8i qf; { const unsigned char*qp=Qu+(long)(wid*QBLK+r32)*QP+32*hi; const v4i a=*(const v4i*)qp, b=*(const v4i*)(qp+16); qf=__builtin_shufflevector(a,b,0,1,2,3,4,5,6,7); }
  f32x16 o[2],negm; f32x4_t lacc; { const float z=pg8::zero_v(); _Pragma("unroll") for(int r=0;r<16;++r){o[0][r]=z;o[1][r]=z;negm[r]=z+(4.0f*(F8_SH-mref)+F8_ENC0);} lacc=(f32x4_t){z,z,z,z}; } asm volatile("":"+v"(negm));
  v8i ones,pw; { int o1; asm volatile("v_mov_b32 %0, 0x38383838":"=v"(o1)); const int ri=lane&15, g=lane>>4; const int sel=((ri==0&&(g&1)==0)||(ri==1&&(g&1)==1))?o1:(o1&0); _Pragma("unroll") for(int j=0;j<8;++j){ones[j]=sel;pw[j]=o1;} } asm volatile("":"+v"(ones));
  f32x16 pA0,pA1,pB0,pB1; v8i kf[2],vf[2];
  int sl_prev=0,sl_cur=0,sl_next=F8_SLOTB;
  #define ROT() do{sl_prev=sl_cur;sl_cur=sl_next;sl_next=(sl_next==2*F8_SLOTB)?0:sl_next+F8_SLOTB;}while(0)
  if(isK){DMA8(2,2*F8_SLOTB,0,0);}
  WAIT_BAR(3);
  kf[0]=ld256(kp0); kf[1]=ld256(kp0+512);
  pA0=MF8(kf[0],qf,negm,0); pA1=MF8(kf[1],qf,negm,0);

  WAIT_BAR(0);
  DMA8(3,0,1,F8_SLOTB);
  ROT();
  kf[0]=ld256(kp0+sl_cur); kf[1]=ld256(kp0+sl_cur+512);
  WAIT_BAR(1);
  #define PIN(x) asm volatile("":"+v"(x))
  #define EX(v) (v)
  #define CV4(W,P,B) do{ unsigned w_=(unsigned)W; w_=__builtin_amdgcn_cvt_pk_u8_f32(P[B],0u,w_); w_=__builtin_amdgcn_cvt_pk_u8_f32(P[(B)+1],1u,w_); w_=__builtin_amdgcn_cvt_pk_u8_f32(P[(B)+2],2u,w_); w_=__builtin_amdgcn_cvt_pk_u8_f32(P[(B)+3],3u,w_); W=(int)w_; }while(0)
  #define STEP8(C0,C1,P0,P1,t,GK,GV,GL) do{ SBAR(); \
    const lds_cptr vp_=vp0+sl_prev; \
    vf[0]=ld256(vp_); SBAR(); \
    C0=MF8(kf[0],qf,negm,0); CV4(pw[0],P0,0); CV4(pw[1],P0,4); CV4(pw[2],P0,8); CV4(pw[3],P0,12); PIN(pw); SBAR(); \
    vf[1]=ld256(vp_+512); SBAR(); \
    C1=MF8(kf[1],qf,negm,0); CV4(pw[4],P1,0); CV4(pw[5],P1,4); CV4(pw[6],P1,8); CV4(pw[7],P1,12); PIN(pw); SBAR(); \
    if(isK?(GK):(GV)){DMA8((t)+3,sl_cur,(t)+1,sl_next);} \
    SBAR(); \
    o[0]=MF8(vf[0],pw,o[0],1); \
    C0[0]=EX(C0[0]);C0[1]=EX(C0[1]);C0[2]=EX(C0[2]);C0[3]=EX(C0[3]);C0[4]=EX(C0[4]);C0[5]=EX(C0[5]);C0[6]=EX(C0[6]);C0[7]=EX(C0[7]);C0[8]=EX(C0[8]);C0[9]=EX(C0[9]);C0[10]=EX(C0[10]); PIN(C0); SBAR(); \
    if(GL){ kf[0]=ld256(kp0+sl_next); SBAR(); } \
    o[1]=MF8(vf[1],pw,o[1],1); \
    C0[11]=EX(C0[11]);C0[12]=EX(C0[12]);C0[13]=EX(C0[13]);C0[14]=EX(C0[14]);C0[15]=EX(C0[15]);C1[0]=EX(C1[0]);C1[1]=EX(C1[1]);C1[2]=EX(C1[2]);C1[3]=EX(C1[3]);C1[4]=EX(C1[4]);C1[5]=EX(C1[5]); PIN(C0); PIN(C1); SBAR(); \
    if(GL){ kf[1]=ld256(kp0+sl_next+512); SBAR(); } \
    lacc=__builtin_amdgcn_mfma_scale_f32_16x16x128_f8f6f4(ones,pw,lacc,0,1,0,0,0,0); \
    C1[6]=EX(C1[6]);C1[7]=EX(C1[7]);C1[8]=EX(C1[8]);C1[9]=EX(C1[9]);C1[10]=EX(C1[10]);C1[11]=EX(C1[11]);C1[12]=EX(C1[12]);C1[13]=EX(C1[13]);C1[14]=EX(C1[14]);C1[15]=EX(C1[15]); PIN(C1); SBAR(); \
    }while(0)
  int t=1;
  for(;t+5<NT;t+=2){
    STEP8(pB0,pB1,pA0,pA1,t,true,true,true);     WAIT_BAR(1); ROT();
    STEP8(pA0,pA1,pB0,pB1,t+1,true,true,true);   WAIT_BAR(1); ROT();
  }
  #define ENDW8(tt) do{ if((tt)+3<NT){WAIT_BAR(1);} else {WAIT_BAR(0);} }while(0)
  for(;t+1<NT;t+=2){
    STEP8(pB0,pB1,pA0,pA1,t,(t+3<NT),(t+1<NT),(t+1<NT));       ENDW8(t);   ROT();
    STEP8(pA0,pA1,pB0,pB1,t+1,(t+4<NT),(t+2<NT),(t+2<NT));     ENDW8(t+1); ROT();
  }
  STEP8(pB0,pB1,pA0,pA1,NT-1,false,false,false);
  { CV4(pw[0],pB0,0); CV4(pw[1],pB0,4); CV4(pw[2],pB0,8); CV4(pw[3],pB0,12); CV4(pw[4],pB1,0); CV4(pw[5],pB1,4); CV4(pw[6],pB1,8); CV4(pw[7],pB1,12);
    const lds_cptr vp_=vp0+sl_cur; vf[0]=ld256(vp_); vf[1]=ld256(vp_+512);
    o[0]=MF8(vf[0],pw,o[0],1); o[1]=MF8(vf[1],pw,o[1],1); lacc=__builtin_amdgcn_mfma_scale_f32_16x16x128_f8f6f4(ones,pw,lacc,0,1,0,0,0,0); }
  #undef PIN
  #undef EX
  #undef CV4
  #undef STEP8
  #undef ENDW8
  { typedef __attribute__((address_space(3))) float* lds_fptr; const lds_fptr wsl=(lds_fptr)((__attribute__((address_space(3))) char*)shm+F8_LDS_WS)+wid*64;
    if(lane<16){ wsl[lane]=lacc[0]; wsl[16+lane]=lacc[1]; } asm volatile("s_waitcnt lgkmcnt(0)":::"memory");
    const float rl=__builtin_amdgcn_rcpf(wsl[r32]);
    typedef __attribute__((address_space(3))) char* lds_wptr;
    const lds_wptr stg=(lds_wptr)shm+F8_LDS_OST+wid*(32*F8_OSTP);
    #pragma unroll
    for(int m=0;m<2;++m)
      #pragma unroll
      for(int g=0;g<4;++g){ v2u_t w; w.x=cvtpk_s(o[m][4*g]*rl,o[m][4*g+1]*rl); w.y=cvtpk_s(o[m][4*g+2]*rl,o[m][4*g+3]*rl);
        *(__attribute__((address_space(3))) v2u_t*)(stg+r32*F8_OSTP+(32*m+8*g+4*hi)*2)=w; }
    asm volatile("s_waitcnt lgkmcnt(0)":::"memory");
    bf16*Ow=Ou+(long)(wid*QBLK)*OP;
    #pragma unroll
    for(int i=0;i<4;++i){const int row=i*8+(lane>>3),ch=lane&7; const u32x4 v=*(const __attribute__((address_space(3))) u32x4*)(stg+row*F8_OSTP+ch*16); *(u32x4*)(Ow+(long)row*OP+ch*8)=v;} }
  asm volatile("s_waitcnt lgkmcnt(0)\n\ts_barrier":::"memory");
  #undef DMA8
  #undef ROT
}
constexpr int F8P_NS=5, F8P_LDS_V=F8P_NS*F8_SLOTB, F8P_LDS_OST=2*F8P_NS*F8_SLOTB, F8P_LDS_BYTES=F8P_LDS_OST+NW*32*F8_OSTP;
__device__ __forceinline__ void attn_unit8p(const int tid,const float mref,const unsigned char*Qu,int QP,const unsigned char*__restrict__ Kh,const unsigned char*__restrict__ Vh,int NT,bf16*Ou,int OP,char*shm){
  const int lane=tid&63,r32=lane&31,hi=lane>>5; const int wid=__builtin_amdgcn_readfirstlane(tid>>6);
  const unsigned lds0=(unsigned)(uintptr_t)shm;
  const bool isK=wid<4;
  const unsigned char*dsrc=(isK?Kh:Vh)+(wid&3)*1024+lane*16;
  const unsigned ddst=lds0+(isK?0:F8P_LDS_V)+(wid&3)*1024;
  #define DMA8(tk,sk,tv,sv) glds16(dsrc+(long)(isK?(tk):(tv))*4096,(unsigned)__builtin_amdgcn_readfirstlane(ddst+(isK?(sk):(sv))))
  #define WR(x) (((x)>=F8P_NS*F8_SLOTB)?((x)-F8P_NS*F8_SLOTB):(x))
  const lds_cptr shm3=(lds_cptr)shm; const lds_cptr kp0=shm3+hi*2048+r32*16; const lds_cptr vp0=shm3+F8P_LDS_V+hi*2048+r32*16;
  DMA8(0,0,0,0); DMA8(1,F8_SLOTB,1,F8_SLOTB); DMA8(2,2*F8_SLOTB,2,2*F8_SLOTB); DMA8(4,4*F8_SLOTB,0,4*F8_SLOTB); if(isK){DMA8(3,3*F8_SLOTB,0,0);}
  v8i qf; { const unsigned char*qp=Qu+(long)(wid*QBLK+r32)*QP+32*hi; const v4i a=*(const v4i*)qp, b=*(const v4i*)(qp+16); qf=__builtin_shufflevector(a,b,0,1,2,3,4,5,6,7); }
  f32x16 o[2],negm; f32x4_t lacc; { const float z=pg8::zero_v(); lacc=(f32x4_t){z,z,z,z}; _Pragma("unroll") for(int r=0;r<16;++r){o[0][r]=z;o[1][r]=z;negm[r]=z+(4.0f*(F8_SH-mref)+F8_ENC0);} } asm volatile("":"+v"(negm));
  v8i ones,pw,pwB; { int o1; asm volatile("v_mov_b32 %0, 0x38383838":"=v"(o1)); const int ri=lane&15, g=lane>>4; const int sel=((ri==0&&(g&1)==0)||(ri==1&&(g&1)==1))?o1:(o1&0); _Pragma("unroll") for(int j=0;j<8;++j){ones[j]=sel;pw[j]=o1;pwB[j]=(o1&0);} } asm volatile("":"+v"(ones)); asm volatile("":"+v"(pwB));
  f32x16 pA0,pA1,pB0,pB1; v8i kf[2],vf[2];
  WAIT_BAR(0);
  kf[0]=ld256(kp0); kf[1]=ld256(kp0+512);
  pA0=MF8(kf[0],qf,negm,0); pA1=MF8(kf[1],qf,negm,0);
  kf[0]=ld256(kp0+F8_SLOTB); kf[1]=ld256(kp0+F8_SLOTB+512);
  WAIT_BAR(0);
  int sl=F8_SLOTB;
  #define PIN(x) asm volatile("":"+v"(x))
  #define EX(v) (v)
  #define CV4(W,P,B) do{ unsigned w_=(unsigned)W; w_=__builtin_amdgcn_cvt_pk_u8_f32(P[B],0u,w_); w_=__builtin_amdgcn_cvt_pk_u8_f32(P[(B)+1],1u,w_); w_=__builtin_amdgcn_cvt_pk_u8_f32(P[(B)+2],2u,w_); w_=__builtin_amdgcn_cvt_pk_u8_f32(P[(B)+3],3u,w_); W=(int)w_; }while(0)
  #define STEP8(C0,C1,P0,P1,WN,WO,t,GK,GV,GL) do{ SBAR(); \
    const int sl_p1=(sl==0)?(F8P_NS-1)*F8_SLOTB:sl-F8_SLOTB, sl_p2=(sl_p1==0)?(F8P_NS-1)*F8_SLOTB:sl_p1-F8_SLOTB, sl_n1=WR(sl+F8_SLOTB); \
    const lds_cptr vp_=vp0+sl_p2; \
    vf[0]=ld256(vp_); SBAR(); \
    C0=MF8(kf[0],qf,negm,0); CV4(WN[0],P0,0); CV4(WN[1],P0,4); PIN(WN); SBAR(); \
    vf[1]=ld256(vp_+512); SBAR(); \
    C1=MF8(kf[1],qf,negm,0); CV4(WN[2],P0,8); CV4(WN[3],P0,12); PIN(WN); SBAR(); \
    if(isK?(GK):(GV)){DMA8((t)+4,sl_p1,(t)+1,sl_n1);} \
    SBAR(); \
    if(GL){ kf[0]=ld256(kp0+sl_n1); SBAR(); } \
    o[0]=MF8(vf[0],WO,o[0],1); CV4(WN[4],P1,0); CV4(WN[5],P1,4); PIN(WN); SBAR(); \
    if(GL){ kf[1]=ld256(kp0+sl_n1+512); SBAR(); } \
    o[1]=MF8(vf[1],WO,o[1],1); CV4(WN[6],P1,8); CV4(WN[7],P1,12); PIN(WN); SBAR(); \
    lacc=__builtin_amdgcn_mfma_scale_f32_16x16x128_f8f6f4(ones,WO,lacc,0,1,0,0,0,0); PIN(C0); PIN(C1); SBAR(); \
    sl=sl_n1; \
    }while(0)
  int t=1;
  for(;t+6<NT;t+=2){
    STEP8(pB0,pB1,pA0,pA1,pw,pwB,t,true,true,true);
    STEP8(pA0,pA1,pB0,pB1,pwB,pw,t+1,true,true,true);   WAIT_BAR(1);
  }
  for(;t+1<NT;t+=2){
    STEP8(pB0,pB1,pA0,pA1,pw,pwB,t,(t+4<NT),(t+1<NT),true);
    STEP8(pA0,pA1,pB0,pB1,pwB,pw,t+1,(t+5<NT),(t+2<NT),(t+2<NT));
    if(t+5<NT){WAIT_BAR(1);} else {WAIT_BAR(0);}
  }
  STEP8(pB0,pB1,pA0,pA1,pw,pwB,NT-1,false,false,false);
  { const int s1_=(sl==0)?(F8P_NS-1)*F8_SLOTB:sl-F8_SLOTB; const int s2_=(s1_==0)?(F8P_NS-1)*F8_SLOTB:s1_-F8_SLOTB;
    { const lds_cptr vp_=vp0+s2_; vf[0]=ld256(vp_); vf[1]=ld256(vp_+512); }
    o[0]=MF8(vf[0],pw,o[0],1); o[1]=MF8(vf[1],pw,o[1],1); lacc=__builtin_amdgcn_mfma_scale_f32_16x16x128_f8f6f4(ones,pw,lacc,0,1,0,0,0,0);
    CV4(pwB[0],pB0,0); CV4(pwB[1],pB0,4); CV4(pwB[2],pB0,8); CV4(pwB[3],pB0,12); CV4(pwB[4],pB1,0); CV4(pwB[5],pB1,4); CV4(pwB[6],pB1,8); CV4(pwB[7],pB1,12);
    { const lds_cptr vp_=vp0+s1_; vf[0]=ld256(vp_); vf[1]=ld256(vp_+512); }
    o[0]=MF8(vf[0],pwB,o[0],1); o[1]=MF8(vf[1],pwB,o[1],1); lacc=__builtin_amdgcn_mfma_scale_f32_16x16x128_f8f6f4(ones,pwB,lacc,0,1,0,0,0,0); }
  #undef PIN
  #undef EX
  #undef CV4
  #undef STEP8
  #undef WR
  { typedef __attribute__((address_space(3))) float* lds_fptr; const lds_fptr wsl=(lds_fptr)((__attribute__((address_space(3))) char*)shm+F8P_LDS_OST+NW*32*F8_OSTP)+wid*64;
    if(lane<16){ wsl[lane]=lacc[0]; wsl[16+lane]=lacc[1]; } asm volatile("s_waitcnt lgkmcnt(0)":::"memory");
    const float rl=__builtin_amdgcn_rcpf(wsl[r32]);
    typedef __attribute__((address_space(3))) char* lds_wptr;
    const lds_wptr stg=(lds_wptr)shm+F8P_LDS_OST+wid*(32*F8_OSTP);
    #pragma unroll
    for(int m=0;m<2;++m)
      #pragma unroll
      for(int g=0;g<4;++g){ v2u_t w; w.x=cvtpk_s(o[m][4*g]*rl,o[m][4*g+1]*rl); w.y=cvtpk_s(o[m][4*g+2]*rl,o[m][4*g+3]*rl);
        *(__attribute__((address_space(3))) v2u_t*)(stg+r32*F8_OSTP+(32*m+8*g+4*hi)*2)=w; }
    asm volatile("s_waitcnt lgkmcnt(0)":::"memory");
    bf16*Ow=Ou+(long)(wid*QBLK)*OP;
    #pragma unroll
    for(int i=0;i<4;++i){const int row=i*8+(lane>>3),ch=lane&7; const u32x4 v=*(const __attribute__((address_space(3))) u32x4*)(stg+row*F8_OSTP+ch*16); *(u32x4*)(Ow+(long)row*OP+ch*8)=v;} }
  asm volatile("s_waitcnt lgkmcnt(0)\n\ts_barrier":::"memory");
  #undef DMA8
}
#undef MF8
#undef SBAR
#undef WAIT_BAR
}
#define GAS __attribute__((address_space(1)))
#define LAS __attribute__((address_space(3)))
typedef unsigned short bf16;
typedef unsigned v4u __attribute__((ext_vector_type(4)));
typedef float f32x4 __attribute__((ext_vector_type(4)));
typedef short bf16x8 __attribute__((ext_vector_type(8)));
typedef GAS unsigned gu32;
typedef GAS unsigned long long gu64;
#define RLX_AGENT __ATOMIC_RELAXED, __HIP_MEMORY_SCOPE_AGENT
#define LDS_WAIT() asm volatile("s_waitcnt lgkmcnt(0)" ::: "memory")
#define VM_WAIT() asm volatile("s_waitcnt vmcnt(0)" ::: "memory")
__device__ __forceinline__ unsigned long long rt() { return __builtin_amdgcn_s_memrealtime(); }
__device__ __forceinline__ unsigned f2bf(float f) { unsigned u = __builtin_bit_cast(unsigned, f); return (u + 0x7fffu + ((u >> 16) & 1u)) >> 16; }
__device__ __forceinline__ unsigned pk2(float lo, float hi) { return f2bf(lo) | (f2bf(hi) << 16); }

#define XB_TMO      128
#define XB_XCNT(j)  (256  + 64 * (j))
#define XB_XSUB(j)  (1280 + 64 * (j))
#define XB_XGEN(j)  (2304 + 64 * (j))
#define XB_TOP      3328
#define XB_TOPGEN   3392
#define XCD_BAR_WORDS 3456
#define XB_SPIN_CAP (1u << 18)

__device__ __forceinline__ unsigned xb_ld(unsigned* p)              { return __hip_atomic_load(p, __ATOMIC_RELAXED, __HIP_MEMORY_SCOPE_AGENT); }
__device__ __forceinline__ unsigned xb_add(unsigned* p, unsigned v) { return __hip_atomic_fetch_add(p, v, __ATOMIC_RELAXED, __HIP_MEMORY_SCOPE_AGENT); }
__device__ __forceinline__ unsigned xb_xcc_id() { return (unsigned)__builtin_amdgcn_s_getreg((3 << 11) | 20) & 0xFu; }
#define XB_SPIN(cond, bar) do { unsigned _sp = 0; while (cond) { __builtin_amdgcn_s_sleep(1); \
    if ((++_sp & 255u) == 0u) { if (xb_ld(&(bar)[XB_TMO])) break; if (_sp > XB_SPIN_CAP) { atomicAdd(&(bar)[XB_TMO], 1u); break; } } } } while (0)

struct XcdBarrier {
    unsigned* bar; unsigned x;
    volatile LAS unsigned* st;
};

__device__ __forceinline__ XcdBarrier xcd_barrier_post(unsigned* bar, volatile LAS unsigned* st) {
    XcdBarrier b; b.bar = bar; b.x = xb_xcc_id(); b.st = st;
    if (threadIdx.x == 0) (void)xb_add(&bar[XB_XCNT(b.x)], 1u);
    return b;
}
__device__ __forceinline__ void xcd_barrier_complete(unsigned* bar, unsigned x, unsigned& nloc, unsigned& nx) {
    const unsigned G = gridDim.x * gridDim.y * gridDim.z;
    unsigned sum, cnt, mine, sp = 0u;
    for (;;) {
        sum = 0u; cnt = 0u; mine = 0u;
#pragma unroll
        for (unsigned j = 0; j < 16; ++j) { const unsigned c = xb_ld(&bar[XB_XCNT(j)]); sum += c; cnt += (c > 0u) ? 1u : 0u; mine = (j == x) ? c : mine; }
        if (sum == G) break;
        __builtin_amdgcn_s_sleep(1);
        if ((++sp & 255u) == 0u) { if (xb_ld(&bar[XB_TMO])) break; if (sp > XB_SPIN_CAP) { atomicAdd(&bar[XB_TMO], 1u); break; } }
    }
    nloc = mine > 0u ? mine : 1u; nx = cnt > 0u ? cnt : 1u;
}

__device__ __forceinline__ void xcd_barrier(const XcdBarrier& b) {
    asm volatile("s_waitcnt vmcnt(0)" ::: "memory");
    __syncthreads();
    if (threadIdx.x == 0) {
        unsigned* bar = b.bar;
        __builtin_amdgcn_s_waitcnt(0);
        unsigned nloc = b.st[0], nx = b.st[1];
        if (nloc == 0u) { xcd_barrier_complete(bar, b.x, nloc, nx); b.st[0] = nloc; b.st[1] = nx; }
        const unsigned old = xb_add(&bar[XB_XSUB(b.x)], 1u);
        const unsigned gen = old / nloc;
        if (old + 1u == (gen + 1u) * nloc) {
            __builtin_amdgcn_fence(__ATOMIC_RELEASE, "agent");
            asm volatile("s_waitcnt vmcnt(0)" ::: "memory");
            const unsigned og = xb_add(&bar[XB_TOP], 1u);
            const unsigned tg = og / nx;
            if (og + 1u == (tg + 1u) * nx) xb_add(&bar[XB_TOPGEN], 1u);
            else XB_SPIN(xb_ld(&bar[XB_TOPGEN]) == tg, bar);
            __builtin_amdgcn_fence(__ATOMIC_ACQUIRE, "agent");
            xb_add(&bar[XB_XGEN(b.x)], 1u);
            asm volatile("s_waitcnt vmcnt(0)" ::: "memory");
        } else {
            XB_SPIN(xb_ld(&bar[XB_XGEN(b.x)]) == gen, bar);
            __builtin_amdgcn_fence(__ATOMIC_ACQUIRE, "agent");
            asm volatile("s_waitcnt vmcnt(0)" ::: "memory");
        }
    }
    __syncthreads();
}
constexpr int NWAVES = 8;
constexpr int DM = 1024, NB = 2, SEQ = 16384, CTX = 256, RB = SEQ + CTX  , NR = NB * RB  ;
constexpr int INW = 2048, FF = 2816, NE = 8, NCH = RB / 128  , NLAT = NB * SEQ;
constexpr float EPS = 1e-6f;
constexpr int PC_K = 512, PC_V = 640, PC_RQ = 768, PC_RK = 1024, PC_RV = 1280, PC_RG = 1536, PC_PP = 1792;
constexpr int MOE_TP = 104, MOE_PASSES = 3, LISTCAP = 32768;

constexpr size_t MiB = 1u << 20, U128K = 131072;
constexpr size_t WS_CTL = 0, CTL_ZERO_BYTES = 1 * MiB;
constexpr size_t WS_MODV = 1 * MiB;
constexpr size_t WS_ROPE = 1 * MiB + 256 * 1024;
constexpr size_t WS_DEC = WS_ROPE + 32768;
constexpr size_t WS_TOK = 3 * MiB / 2;
constexpr size_t WS_LIST = 5 * MiB / 2;
constexpr size_t WS_XC = 7 * MiB / 2;
constexpr size_t WS_WIN = 6 * MiB, WS_WOUT = 14 * MiB, WS_W13D = 18 * MiB, WS_W2D = 29 * MiB, WS_W13M = 35 * MiB, WS_W2M = 80 * MiB  , WS_XB = 103 * MiB  ;
constexpr size_t SZ_WIN = (size_t)INW * DM * 2, SZ_WOUT = (size_t)DM * DM * 2, SZ_W13 = (size_t)2 * FF * DM * 2, SZ_W2 = (size_t)DM * FF * 2;
constexpr size_t SZ8_W13 = SZ_W13 / 2, SZ8_W2 = SZ_W2 / 2;
constexpr size_t WS_AR = 168 * MiB;
constexpr size_t AR_P = 0, AR_QB = 1040 * U128K, AR_KC = 1300 * U128K, AR_VC = 1365 * U128K, AR_US = 1430 * U128K, AR_MIX = 1690 * U128K, AR_MX = 2210 * U128K;
constexpr size_t AR_HX2 = 0, AR_ACT = 520 * U128K, AR_YD = 2210 * U128K, AR_YM = 1664 * U128K;
constexpr size_t AR_PART0 = 1040 * U128K  , AR_PART1 = 0  ;
constexpr size_t AR_Q8 = AR_QB, AR_K8 = AR_QB + 136 * U128K, AR_V8 = AR_QB + 176 * U128K;
constexpr size_t DO_Q8 = AR_MX + 20 * MiB, DO_K8 = AR_MX + 40 * MiB, DO_V8 = AR_MX + 46 * MiB, DO_O8 = AR_US;
constexpr size_t WS_END = 512 * MiB;
static_assert(WS_XB + (size_t)NLAT * DM * 2 <= WS_AR && WS_W2M + 8 * SZ8_W2 <= WS_XB && WS_W13M + 8 * SZ8_W13 <= WS_W2M && WS_W13D + SZ_W13 <= WS_W2D && WS_W2D + SZ_W2 <= WS_W13M, "weights map");
static_assert(AR_MX + (size_t)NR * DM * 2 <= WS_END - WS_AR && AR_ACT + (size_t)NR * FF * 2 <= AR_YD && AR_YM + (size_t)264 * 256 * DM * 2 <= WS_END - WS_AR && AR_ACT + (size_t)MOE_TP * 256 * FF * 2 <= AR_YM, "arena map");
static_assert(AR_QB == (size_t)NR * INW * 2 && AR_KC == AR_QB + (size_t)NR * 512 * 2 && AR_US == AR_VC + (size_t)NR * 128 * 2 && AR_MIX == AR_US + (size_t)16 * NCH * 16384 && AR_MX == AR_MIX + (size_t)NR * DM * 2, "arena map 2");
constexpr int CW_TMO = 0, CW_CODE = 1, CW_CNT = 64  , CW_BAR = 4096;
constexpr int RING_BYTES = 131072, MISC_OFF = RING_BYTES + 320, GTAB_OFF = RING_BYTES + 1024, MOE_OFF = RING_BYTES + 2048, LDS_BYTES = 147456;

typedef unsigned v2u __attribute__((ext_vector_type(2)));
typedef float f32x16 __attribute__((ext_vector_type(16)));

struct Args { const float* in[24]; float* out; unsigned char* ws; int ph_lo, ph_hi, li, pad; };
enum { I_X = 0, I_C, I_CTX, I_CCTX, I_WMOD, I_BMOD, I_NPREMIX, I_NPOSTMIX, I_NPREFFN, I_NPOSTFFN, I_WIN, I_WOUT, I_QN, I_KN, I_DECAY, I_POOLW, I_POOLS, I_FW1, I_FW3, I_FW2, I_ROUTER, I_MW1, I_MW3, I_MW2 };

typedef const __attribute__((address_space(4))) Args* ArgP;
__device__ __forceinline__ ArgP args_here() { ArgP p = (ArgP)__builtin_amdgcn_kernarg_segment_ptr(); asm volatile("" : "+s"(p)); return p; }
struct Frame { LAS unsigned char* lds; int tid, lane, wave, G, gw, NGW, bx; };
__device__ __forceinline__ void relaunder(Frame& F) { int t = threadIdx.x; asm volatile("" : "+v"(t)); F.tid = t; F.lane = t & 63; F.wave = __builtin_amdgcn_readfirstlane(t >> 6);
    int g = gridDim.x; asm volatile("" : "+s"(g)); F.G = g; int bx = blockIdx.x; asm volatile("" : "+s"(bx)); F.bx = bx; F.gw = bx * NWAVES + F.wave; F.NGW = F.G * NWAVES; }

#ifndef ATT8_DEBUG
#define ATT8_DEBUG 0
#endif
#ifndef DENSE_F8
#define DENSE_F8 0
#endif
#ifndef MOE_F8
#define MOE_F8 1
#endif
#ifndef DENSE_I8UP
#define DENSE_I8UP 1
#endif
#ifndef MOE_I8UP
#define MOE_I8UP 1
#endif
#ifndef DENSE_DOWN_F8
#define DENSE_DOWN_F8 1
#endif
#ifndef IN_I8
#define IN_I8 3
#endif
constexpr float I8_XS = 20.0f, I8_XI = 20.0f, I8_WS = 1024.0f;
#ifndef IN1_F8
#define IN1_F8 0
#endif
__device__ __forceinline__ unsigned char* q8_ptr(ArgP a) { return ATT8_DEBUG ? a->ws + WS_AR + DO_Q8 : a->ws + WS_AR + AR_Q8; }
__device__ __forceinline__ unsigned char* k8_ptr(ArgP a) { return ATT8_DEBUG ? a->ws + WS_AR + DO_K8 : a->ws + WS_AR + AR_K8; }
__device__ __forceinline__ unsigned char* v8_ptr(ArgP a) { return ATT8_DEBUG ? a->ws + WS_AR + DO_V8 : a->ws + WS_AR + AR_V8; }
__device__ __forceinline__ unsigned fp8x4(float a, float b, float c, float d) { int w = 0; w = __builtin_amdgcn_cvt_pk_fp8_f32(a, b, w, false); w = __builtin_amdgcn_cvt_pk_fp8_f32(c, d, w, true); return (unsigned)w; }
__device__ __forceinline__ unsigned i8x4(float a, float b, float c, float d, float s) {
    unsigned w = 0;
    w = __builtin_amdgcn_cvt_pk_u8_f32(__builtin_amdgcn_fmed3f(__builtin_rintf(__builtin_fmaf(a, s, 128.0f)), 1.0f, 255.0f), 0, w);
    w = __builtin_amdgcn_cvt_pk_u8_f32(__builtin_amdgcn_fmed3f(__builtin_rintf(__builtin_fmaf(b, s, 128.0f)), 1.0f, 255.0f), 1, w);
    w = __builtin_amdgcn_cvt_pk_u8_f32(__builtin_amdgcn_fmed3f(__builtin_rintf(__builtin_fmaf(c, s, 128.0f)), 1.0f, 255.0f), 2, w);
    w = __builtin_amdgcn_cvt_pk_u8_f32(__builtin_amdgcn_fmed3f(__builtin_rintf(__builtin_fmaf(d, s, 128.0f)), 1.0f, 255.0f), 3, w);
    return w ^ 0x80808080u; }
__device__ __forceinline__ float bf_lo(unsigned u) { return __uint_as_float(u << 16); }
__device__ __forceinline__ float bf_hi(unsigned u) { return __uint_as_float(u & 0xffff0000u); }
__device__ __forceinline__ unsigned pkbf(float lo, float hi) { return attn_body::cvtpk_s(lo, hi); }
template <int M> __device__ __forceinline__ float shx(float v) { return __builtin_bit_cast(float, __builtin_amdgcn_ds_swizzle(__builtin_bit_cast(int, v), 0x1F | (M << 10))); }
__device__ __forceinline__ float half_sum(float v) { auto rr = __builtin_amdgcn_permlane32_swap(__float_as_uint(v), __float_as_uint(v), false, false); return __uint_as_float(rr[0]) + __uint_as_float(rr[1]); }
__device__ __forceinline__ float half_max(float v) { auto rr = __builtin_amdgcn_permlane32_swap(__float_as_uint(v), __float_as_uint(v), false, false); return fmaxf(__uint_as_float(rr[0]), __uint_as_float(rr[1])); }
__device__ __forceinline__ float wave_sum(float v) { v += shx<1>(v); v += shx<2>(v); v += shx<4>(v); v += shx<8>(v); v += shx<16>(v); return half_sum(v); }
__device__ __forceinline__ float siluf(float x) { return x / (1.0f + __expf(-x)); }
__device__ __forceinline__ float logsig(float x) { return -log1pf(expf(-x)); }
#define ROWCOL(j) (512 * ((j) >> 1) + 4 * ((j) & 1))
__device__ __forceinline__ void ld16(f32x4 (&v)[4], const float* p, int lane) {
#pragma unroll
    for (int j = 0; j < 4; ++j) v[j] = *(const f32x4*)(p + ROWCOL(j) + 8 * lane);
}
__device__ __forceinline__ void ld16b(f32x4 (&v)[4], const bf16* p, int lane) {
#pragma unroll
    for (int h = 0; h < 2; ++h) { const v4u u = *(const v4u*)(p + 512 * h + 8 * lane); v[2 * h] = (f32x4){bf_lo(u.x), bf_hi(u.x), bf_lo(u.y), bf_hi(u.y)}; v[2 * h + 1] = (f32x4){bf_lo(u.z), bf_hi(u.z), bf_lo(u.w), bf_hi(u.w)}; }
}
__device__ __forceinline__ void st16(float* p, const f32x4 (&v)[4], int lane) {
#pragma unroll
    for (int j = 0; j < 4; ++j) *(f32x4*)(p + ROWCOL(j) + 8 * lane) = v[j];
}
__device__ __forceinline__ void st16b(bf16* p, const f32x4 (&v)[4], int lane) {
#pragma unroll
    for (int h = 0; h < 2; ++h) { v4u u; u.x = pkbf(v[2 * h][0], v[2 * h][1]); u.y = pkbf(v[2 * h][2], v[2 * h][3]); u.z = pkbf(v[2 * h + 1][0], v[2 * h + 1][1]); u.w = pkbf(v[2 * h + 1][2], v[2 * h + 1][3]); *(v4u*)(p + 512 * h + 8 * lane) = u; }
}
__device__ __forceinline__ void st16f8(unsigned char* p, const f32x4 (&v)[4], int lane) {
#pragma unroll
    for (int h = 0; h < 2; ++h) { v2u u; u.x = fp8x4(v[2 * h][0], v[2 * h][1], v[2 * h][2], v[2 * h][3]); u.y = fp8x4(v[2 * h + 1][0], v[2 * h + 1][1], v[2 * h + 1][2], v[2 * h + 1][3]); *(v2u*)(p + 512 * h + 8 * lane) = u; }
}
__device__ __forceinline__ void st16i8(unsigned char* p, const f32x4 (&v)[4], int lane, const float I8_XS = ::I8_XS) {
#pragma unroll
    for (int h = 0; h < 2; ++h) { v2u u; u.x = i8x4(v[2 * h][0], v[2 * h][1], v[2 * h][2], v[2 * h][3], I8_XS); u.y = i8x4(v[2 * h + 1][0], v[2 * h + 1][1], v[2 * h + 1][2], v[2 * h + 1][3], I8_XS); *(v2u*)(p + 512 * h + 8 * lane) = u; }
}
__device__ __forceinline__ float sumsq16(const f32x4 (&v)[4]) {
    float s = 0.f;
#pragma unroll
    for (int j = 0; j < 4; ++j) s += (v[j][0] * v[j][0] + v[j][1] * v[j][1]) + (v[j][2] * v[j][2] + v[j][3] * v[j][3]);
    return s;
}
__device__ __forceinline__ const float* modv(const unsigned char* ws, int l, int cls, int chunk) { return (const float*)(ws + WS_MODV) + ((size_t)(l * 3 + cls) * 6 + chunk) * DM; }

template <int F8 = 0  > __device__ __forceinline__ void p0_transpose_item(const float* W, int K, int N, bf16* WT, int k0, int n0, int drow0, LAS float* scr, int lane) {
    { const int c4 = (lane & 7) * 4, r8 = lane >> 3;
#pragma unroll
        for (int i = 0; i < 8; ++i) { const int kk = 8 * i + r8; const f32x4 v = *(const f32x4*)(W + (size_t)(k0 + kk) * N + n0 + c4);
            LAS float* d = scr + kk * 33 + c4; d[0] = v[0]; d[1] = v[1]; d[2] = v[2]; d[3] = v[3]; } }
    LDS_WAIT(); asm volatile("" ::: "memory");
    const int c = lane & 7;
#pragma unroll
    for (int j = 0; j < 4; ++j) { const int n = (lane >> 3) + 8 * j; const LAS float* s = scr + (8 * c) * 33 + n;
        if constexpr (F8 == 2) { v2u o; o.x = i8x4(s[0 * 33], s[1 * 33], s[2 * 33], s[3 * 33], I8_WS); o.y = i8x4(s[4 * 33], s[5 * 33], s[6 * 33], s[7 * 33], I8_WS);
            *(v2u*)((unsigned char*)WT + (size_t)(drow0 + n) * K + k0 + 8 * c) = o; }
        else if constexpr (F8 == 1) { v2u o; o.x = fp8x4(s[0 * 33] * 64.0f, s[1 * 33] * 64.0f, s[2 * 33] * 64.0f, s[3 * 33] * 64.0f); o.y = fp8x4(s[4 * 33] * 64.0f, s[5 * 33] * 64.0f, s[6 * 33] * 64.0f, s[7 * 33] * 64.0f);
            *(v2u*)((unsigned char*)WT + (size_t)(drow0 + n) * K + k0 + 8 * c) = o; }
        else { v4u o; o.x = pkbf(s[0 * 33], s[1 * 33]); o.y = pkbf(s[2 * 33], s[3 * 33]); o.z = pkbf(s[4 * 33], s[5 * 33]); o.w = pkbf(s[6 * 33], s[7 * 33]);
        *(v4u*)(WT + (size_t)(drow0 + n) * K + k0 + 8 * c) = o; } }
    LDS_WAIT(); asm volatile("" ::: "memory");
}
constexpr int WC_IN = 16 * 64, WC_OUT = 16 * 32, WC_F = 1408, WCOPY_ITEMS = 2 * WC_IN + 2 * WC_OUT + 27 * WC_F;
constexpr int WCOPY_SPLIT1 = WCOPY_ITEMS - 21120, WCOPY_SPLIT2 = WCOPY_ITEMS - 12800;
struct WItem { const float* src; unsigned char* dst; int N, K, mode; };
__device__ __forceinline__ WItem wc_decode(ArgP a, int it) {
    WItem w; int r = it;
    if (r < 2 * WC_IN) { const int l = r / WC_IN, q = r % WC_IN, kb = q / 64, nb = q % 64;
        w.mode = ((IN_I8 >> l) & 1) ? 2 : ((IN1_F8 && l == 1) ? 1 : 0); w.N = INW; w.K = DM; w.src = a->in[I_WIN] + (size_t)l * DM * INW + (size_t)(64 * kb) * INW + 32 * nb;
        w.dst = a->ws + WS_WIN + l * SZ_WIN + ((size_t)(32 * nb) * DM + 64 * kb) * (w.mode ? 1 : 2); return w; }
    r -= 2 * WC_IN;
    if (r < 2 * WC_OUT) { const int l = r / WC_OUT, q = r % WC_OUT, kb = q / 32, nb = q % 32;
        w.mode = 0; w.N = DM; w.K = DM; w.src = a->in[I_WOUT] + (size_t)l * DM * DM + (size_t)(64 * kb) * DM + 32 * nb; w.dst = a->ws + WS_WOUT + l * SZ_WOUT + ((size_t)(32 * nb) * DM + 64 * kb) * 2; return w; }
    r -= 2 * WC_OUT;
    const int mat = r / WC_F, q = r % WC_F;
    int which, e; bool moe;
    if (mat < 3) { which = mat; e = 0; moe = false; } else { which = (mat - 3) % 3; e = (mat - 3) / 3; moe = true; }
    if (which < 2) {
        const float* W = (moe ? a->in[which == 0 ? I_MW1 : I_MW3] + (size_t)e * DM * FF : a->in[which == 0 ? I_FW1 : I_FW3]);
        unsigned char* WT = a->ws + (moe ? WS_W13M + e * (MOE_F8 ? SZ8_W13 : SZ_W13) : WS_W13D);
        const int kb = q / 88, nb = q % 88, n0 = 32 * nb; const int drow0 = (n0 >> 7) * 256 + which * 128 + (n0 & 127);
        w.mode = moe ? ((MOE_F8 && !MOE_I8UP) ? 1 : (MOE_I8UP ? 2 : 0)) : (DENSE_F8 ? 1 : (DENSE_I8UP ? 2 : 0));
        w.N = FF; w.K = DM; w.src = W + (size_t)(64 * kb) * FF + n0; w.dst = WT + ((size_t)drow0 * DM + 64 * kb) * (w.mode ? 1 : 2);
    } else {
        const float* W = (moe ? a->in[I_MW2] + (size_t)e * FF * DM : a->in[I_FW2]);
        unsigned char* WT = a->ws + (moe ? WS_W2M + e * (MOE_F8 ? SZ8_W2 : SZ_W2) : WS_W2D);
        const int kb = q / 32, nb = q % 32;
        w.mode = moe ? (MOE_F8 ? 1 : 0) : ((DENSE_F8 || DENSE_DOWN_F8) ? 1 : 0);
        w.N = DM; w.K = FF; w.src = W + (size_t)(64 * kb) * DM + 32 * nb; w.dst = WT + ((size_t)(32 * nb) * FF + 64 * kb) * (w.mode ? 1 : 2);
    }
    return w;
}
__device__ __forceinline__ void wc_load(const WItem& w, f32x4 (&v)[8], int lane) {
    const int c4 = (lane & 7) * 4, r8 = lane >> 3;
#pragma unroll
    for (int i = 0; i < 8; ++i) v[i] = *(const f32x4*)(w.src + (size_t)(8 * i + r8) * w.N + c4);
}
__device__ __forceinline__ void wc_process(const WItem& w, const f32x4 (&v)[8], LAS float* scr, int lane) {
    { const int c4 = (lane & 7) * 4, r8 = lane >> 3;
#pragma unroll
        for (int i = 0; i < 8; ++i) { LAS float* d = scr + (8 * i + r8) * 33 + c4; d[0] = v[i][0]; d[1] = v[i][1]; d[2] = v[i][2]; d[3] = v[i][3]; } }
    LDS_WAIT(); asm volatile("" ::: "memory");
    const int c = lane & 7;
#pragma unroll
    for (int j = 0; j < 4; ++j) { const int n = (lane >> 3) + 8 * j; const LAS float* s = scr + (8 * c) * 33 + n;
        const float s0 = s[0 * 33], s1 = s[1 * 33], s2 = s[2 * 33], s3 = s[3 * 33], s4 = s[4 * 33], s5 = s[5 * 33], s6 = s[6 * 33], s7 = s[7 * 33];
        if (w.mode == 2) { v2u o; o.x = i8x4(s0, s1, s2, s3, I8_WS); o.y = i8x4(s4, s5, s6, s7, I8_WS); *(v2u*)(w.dst + (size_t)n * w.K + 8 * c) = o; }
        else if (w.mode == 1) { v2u o; o.x = fp8x4(s0 * 64.0f, s1 * 64.0f, s2 * 64.0f, s3 * 64.0f); o.y = fp8x4(s4 * 64.0f, s5 * 64.0f, s6 * 64.0f, s7 * 64.0f); *(v2u*)(w.dst + (size_t)n * w.K + 8 * c) = o; }
        else { v4u o; o.x = pkbf(s0, s1); o.y = pkbf(s2, s3); o.z = pkbf(s4, s5); o.w = pkbf(s6, s7); *(v4u*)(w.dst + ((size_t)n * w.K + 8 * c) * 2) = o; } }
    LDS_WAIT(); asm volatile("" ::: "memory");
}
__device__ __forceinline__ void weight_copy_items(ArgP a, Frame& F, const int lo_, const int hi_, const int rk, const int nrk) {
    LAS float* scr = (LAS float*)(F.lds + F.wave * 16384);
    int it = lo_ + rk; if (it >= hi_) return;
    WItem cur = wc_decode(a, it); f32x4 vc[8]; wc_load(cur, vc, F.lane);
    for (;;) {
        const int itn = it + nrk; const bool more = itn < hi_;
        const WItem nx = wc_decode(a, more ? itn : it); f32x4 vn[8]; wc_load(nx, vn, F.lane);
        wc_process(cur, vc, scr, F.lane);
        if (!more) break;
        cur = nx; it = itn;
#pragma unroll
        for (int i = 0; i < 8; ++i) vc[i] = vn[i];
    }
}
__device__ __forceinline__ void phase_p0a(ArgP a, Frame& F) {
    LAS float* sv = (LAS float*)F.lds;
    LAS float* red = (LAS float*)(F.lds + 12288);
    for (int i = F.tid; i < 3072; i += 512) { const int v = i >> 10, k = i & 1023; const float x = (v < 2) ? a->in[I_C][v * 1024 + k] : a->in[I_CCTX][k]; sv[i] = siluf(x); }
    __syncthreads();
    for (int it = F.bx; it < 256; it += F.G) {
        const int l = it >> 7, cg = it & 127; const int r5 = F.lane / 12, c12 = F.lane % 12; const bool act = F.lane < 60;
        f32x4 acc[3]; acc[0] = acc[1] = acc[2] = (f32x4){0.f, 0.f, 0.f, 0.f};
        const float* Wl = a->in[I_WMOD] + (size_t)l * DM * 6144 + 48 * cg + 4 * c12;
#pragma unroll
        for (int hb = 0; hb < 2; ++hb) { f32x4 w4[13];
#pragma unroll
            for (int j = 0; j < 13; ++j) { const int kk = r5 + 5 * (13 * hb + j); const int kc = (act && kk < 128) ? 128 * F.wave + kk : 128 * F.wave; w4[j] = *(const f32x4*)(Wl + (size_t)kc * 6144); }
#pragma unroll
            for (int j = 0; j < 13; ++j) { const int kk = r5 + 5 * (13 * hb + j); const int k = 128 * F.wave + kk;
                if (act && kk < 128) { acc[0] += sv[k] * w4[j]; acc[1] += sv[1024 + k] * w4[j]; acc[2] += sv[2048 + k] * w4[j]; } } }
        if (act) {
#pragma unroll
            for (int v = 0; v < 3; ++v)
#pragma unroll
                for (int e = 0; e < 4; ++e) red[(F.wave * 60 + F.lane) * 12 + v * 4 + e] = acc[v][e]; }
        __syncthreads();
        if (F.tid < 144) { const int v = F.tid / 48, col = F.tid % 48, c12b = col >> 2, e = col & 3; float s = 0.f;
            for (int w = 0; w < 8; ++w)
                for (int r = 0; r < 5; ++r) s += red[(w * 60 + r * 12 + c12b) * 12 + v * 4 + e];
            ((float*)(a->ws + WS_MODV))[((size_t)(l * 3 + v)) * 6144 + 48 * cg + col] = s + a->in[I_BMOD][l * 6144 + 48 * cg + col]; }
        __syncthreads();
    }
    if (F.bx == F.G - 1 && F.tid >= 64 && F.tid < 80) { const int t = F.tid - 64; const float lg = logsig(a->in[I_DECAY][t]); ((float*)(a->ws + WS_DEC))[t] = lg; ((float*)(a->ws + WS_DEC))[16 + t] = expf(128.0f * lg); }
    if (F.tid < 16)
        for (int i = F.bx * 16 + F.tid; i < 4096; i += F.G * 16) { const int pos = i >> 4, fi = i & 15; const double inv = pow(10000.0, -(double)fi / 16.0); const double ang = (double)pos * inv;
            ((float*)(a->ws + WS_ROPE))[i] = (float)cos(ang); ((float*)(a->ws + WS_ROPE))[4096 + i] = (float)sin(ang); }
    weight_copy_items(a, F, 0, WCOPY_ITEMS, F.gw, F.NGW);
}

struct RowLoc { int b, jj, cls; size_t xoff; bool isctx; };
__device__ __forceinline__ RowLoc rowloc(int r) { RowLoc L; L.b = r / RB; L.jj = r - L.b * RB; L.isctx = L.jj < CTX; L.cls = L.isctx ? 2 : L.b;
    L.xoff = L.isctx ? (size_t)(L.b * CTX + L.jj) * DM : (size_t)(L.b * SEQ + (L.jj - CTX)) * DM; return L; }

__device__ __forceinline__ void wave_sum2(float& a, float& b) {
    for (int o = 0; o < 1; ++o) { float ta, tb; ta = shx<1>(a); tb = shx<1>(b); a += ta; b += tb; ta = shx<2>(a); tb = shx<2>(b); a += ta; b += tb; ta = shx<4>(a); tb = shx<4>(b); a += ta; b += tb;
        ta = shx<8>(a); tb = shx<8>(b); a += ta; b += tb; ta = shx<16>(a); tb = shx<16>(b); a += ta; b += tb; a = half_sum(a); b = half_sum(b); }
}
__device__ __forceinline__ void premix_rows(ArgP a, Frame& F, const int r0  , const int stride, const int nrows  , const bool isctx) {
    bf16* HX = (bf16*)(a->ws + WS_AR + AR_MIX);
    const float* xsrc = isctx ? a->in[I_CTX] : a->in[I_X];
    f32x4 A[4], B[4], t0[4]; int curcls = -1;
    f32x4 v0[4], v1[4], n0[4], n1[4]; ld16(v0, xsrc + (size_t)r0 * DM, F.lane); ld16(v1, xsrc + (size_t)(r0 + stride) * DM, F.lane);
#pragma unroll 1
    for (int rr = 0; rr < nrows; rr += 2) {
        const int ra = r0 + rr * stride, rb = ra + stride;
        if (rr + 2 < nrows) { ld16(n0, xsrc + (size_t)(ra + 2 * stride) * DM, F.lane); ld16(n1, xsrc + (size_t)(rb + 2 * stride) * DM, F.lane); }
        const int ba = isctx ? ra / CTX : ra / SEQ, bb = isctx ? rb / CTX : rb / SEQ; const int cls = isctx ? 2 : ba;
        if (cls != curcls) { curcls = cls; ld16(A, a->in[I_NPREMIX], F.lane); ld16(t0, modv(a->ws, 0, cls, 1), F.lane); ld16(B, modv(a->ws, 0, cls, 0), F.lane);
#pragma unroll
            for (int j = 0; j < 4; ++j) A[j] = A[j] * (1.0f + t0[j]); }
        const int ua = isctx ? ba * RB + (ra - ba * CTX) : ra + CTX * (ba + 1), ub = isctx ? bb * RB + (rb - bb * CTX) : rb + CTX * (bb + 1);
        float q0 = sumsq16(v0), q1 = sumsq16(v1); wave_sum2(q0, q1);
        const float r0s = 1.0f / sqrtf(q0 * (1.0f / DM) + EPS), r1s = 1.0f / sqrtf(q1 * (1.0f / DM) + EPS);
#pragma unroll
        for (int j = 0; j < 4; ++j) { v0[j] = v0[j] * r0s * A[j] + B[j]; v1[j] = v1[j] * r1s * A[j] + B[j]; }
        if (IN_I8 & 1) { st16i8((unsigned char*)HX + (size_t)ua * DM, v0, F.lane, I8_XI); st16i8((unsigned char*)HX + (size_t)ub * DM, v1, F.lane, I8_XI); }
        else { st16b(HX + (size_t)ua * DM, v0, F.lane); st16b(HX + (size_t)ub * DM, v1, F.lane); }
#pragma unroll
        for (int j = 0; j < 4; ++j) { v0[j] = n0[j]; v1[j] = n1[j]; }
    }
}
__device__ __forceinline__ void phase_premix0(ArgP a, Frame& F) {
    const int per = NLAT / F.NGW;
    if (F.gw < NLAT) premix_rows(a, F, F.gw, F.NGW, per, false);
    for (int j = F.gw; j < 8 * NB * CTX / 2; j += F.NGW) if ((j & 7) == 0) premix_rows(a, F, (j >> 3) * 2, 1, 2, true);
}

__device__ __forceinline__ void moe_prefix(const unsigned char* ws, int (&tstart)[9], int (&cnt)[8]) {
    const unsigned* cw = (const unsigned*)(ws + WS_CTL) + CW_CNT; int s = 0;
#pragma unroll
    for (int e = 0; e < 8; ++e) { cnt[e] = (int)__builtin_amdgcn_readfirstlane(cw[64 * e]); tstart[e] = s; s += (cnt[e] + 255) >> 8; }
    tstart[8] = s;
}

template <int MODE> __device__ __forceinline__ void resid_rows(ArgP a, Frame& F, const int r0, const int stride, const int nrows, const bool isctx,
                                                               const int (&tstart)[9], int& myE0, int& myE1, float& myW0, float& myW1) {
    constexpr int l = MODE >> 1; constexpr bool post_ffn = MODE & 1;
    const bf16* SRC = (const bf16*)(a->ws + WS_AR + (MODE == 1 ? AR_YD : (MODE == 3 ? AR_YM : AR_MX)));
    bf16* H = (bf16*)(a->ws + WS_AR + (MODE == 1 ? AR_MIX : AR_HX2));
    const float* gpost = a->in[post_ffn ? I_NPOSTFFN : I_NPOSTMIX] + l * DM;
    const float* gnext = (MODE == 1) ? a->in[I_NPREMIX] + DM : a->in[I_NPREFFN] + l * DM;
    constexpr int gate_chunk = post_ffn ? 5 : 2, sc_chunk = (MODE == 1) ? 1 : 4, sh_chunk = (MODE == 1) ? 0 : 3, lnext = (MODE == 1) ? 1 : l;
    const LAS float* rts = (const LAS float*)F.lds;
    float* XC = (float*)(a->ws + WS_XC);
    const float* xin = isctx ? (MODE == 0 ? a->in[I_CTX] : (const float*)XC) : a->in[I_X];
    float* xout = isctx ? XC : a->out;
    bf16* XB = (bf16*)(a->ws + WS_XB);
    f32x4 G1[4], A2[4], B2[4], t0[4]; int curcls = -1;
#define UROW(r_) (isctx ? ((r_) / CTX) * RB + ((r_) % CTX) : (r_) + CTX * ((r_) / SEQ + 1))
    v4u tiv = (v4u){0u, 0u, 0u, 0u}; float tw0 = 0.f, tw1 = 0.f;
    if constexpr (MODE == 3) { if (F.lane < nrows) { const unsigned char* tp = a->ws + WS_TOK + (size_t)(r0 + F.lane * stride) * 32; tiv = *(const v4u*)tp; tw0 = *(const float*)(tp + 16); tw1 = *(const float*)(tp + 20); } }
    f32x4 s0[4], x0[4], s1[4], x1[4], sn0[4], xn0[4], sn1[4], xn1[4], y1[4];
#define RESID_LOAD(S_, X_, rr_) do { \
        if constexpr (MODE == 3) { const int e0 = __builtin_amdgcn_readlane((int)tiv.x, rr_), p0l = __builtin_amdgcn_readlane((int)tiv.y, rr_), e1 = __builtin_amdgcn_readlane((int)tiv.z, rr_), p1l = __builtin_amdgcn_readlane((int)tiv.w, rr_); \
            const float w0 = __builtin_bit_cast(float, __builtin_amdgcn_readlane(__builtin_bit_cast(int, tw0), rr_)), w1 = __builtin_bit_cast(float, __builtin_amdgcn_readlane(__builtin_bit_cast(int, tw1), rr_)); \
            int ts0 = 0, ts1 = 0; _Pragma("unroll") for (int e = 0; e < 8; ++e) { ts0 = (e0 == e) ? tstart[e] : ts0; ts1 = (e1 == e) ? tstart[e] : ts1; } \
            ld16b(S_, SRC + ((size_t)ts0 * 256 + p0l) * DM, F.lane); ld16b(y1, SRC + ((size_t)ts1 * 256 + p1l) * DM, F.lane); \
            _Pragma("unroll") for (int j = 0; j < 4; ++j) S_[j] = w0 * S_[j] + w1 * y1[j]; } \
        else if (isctx && (MODE == 0 || (MODE == 1 && !DENSE_DOWN_F8))) { const int cr_ = r0 + (rr_) * stride; const float* pp_ = (const float*)(a->ws + WS_AR + (MODE == 0 ? AR_PART0 : AR_PART1)) + (size_t)((cr_ >> 8) * 256 + (cr_ & 255)) * DM; \
            ld16(S_, pp_, F.lane); for (int ks_ = 1; ks_ < (MODE == 0 ? 4 : 11); ++ks_) { ld16(y1, pp_ + (size_t)ks_ * 512 * DM, F.lane); _Pragma("unroll") for (int j = 0; j < 4; ++j) S_[j] += y1[j]; } } \
        else ld16b(S_, SRC + (size_t)UROW(r0 + (rr_) * stride) * DM, F.lane); \
        if (!isctx && MODE != 0) ld16b(X_, XB + (size_t)(r0 + (rr_) * stride) * DM, F.lane); else ld16(X_, xin + (size_t)(r0 + (rr_) * stride) * DM, F.lane); } while (0)
    RESID_LOAD(s0, x0, 0); RESID_LOAD(s1, x1, 1);
#pragma unroll 1
    for (int rr = 0; rr < nrows; rr += 2) {
        if (rr + 2 < nrows) { RESID_LOAD(sn0, xn0, rr + 2); RESID_LOAD(sn1, xn1, rr + 3); }
        const int ra = r0 + rr * stride, rb = ra + stride; const int cls = isctx ? 2 : ra / SEQ;
        if (cls != curcls) { curcls = cls; ld16(G1, gpost, F.lane); ld16(t0, modv(a->ws, l, cls, gate_chunk), F.lane);
#pragma unroll
            for (int j = 0; j < 4; ++j) G1[j] = G1[j] * t0[j];
            if constexpr (MODE != 3) { ld16(A2, gnext, F.lane); ld16(t0, modv(a->ws, lnext, cls, sc_chunk), F.lane); ld16(B2, modv(a->ws, lnext, cls, sh_chunk), F.lane);
#pragma unroll
                for (int j = 0; j < 4; ++j) A2[j] = A2[j] * (1.0f + t0[j]); } }
        float q0 = sumsq16(s0), q1 = sumsq16(s1); wave_sum2(q0, q1);
        const float rs0 = 1.0f / sqrtf(q0 * (1.0f / DM) + EPS), rs1 = 1.0f / sqrtf(q1 * (1.0f / DM) + EPS);
#pragma unroll
        for (int j = 0; j < 4; ++j) { x0[j] = x0[j] + G1[j] * (s0[j] * rs0); x1[j] = x1[j] + G1[j] * (s1[j] * rs1); }
        if (!isctx && MODE != 3) { st16b(XB + (size_t)ra * DM, x0, F.lane); st16b(XB + (size_t)rb * DM, x1, F.lane); } else { st16(xout + (size_t)ra * DM, x0, F.lane); st16(xout + (size_t)rb * DM, x1, F.lane); }
        if constexpr (MODE != 3) {
            float u0 = sumsq16(x0), u1 = sumsq16(x1); wave_sum2(u0, u1);
            const float t0r = 1.0f / sqrtf(u0 * (1.0f / DM) + EPS), t1r = 1.0f / sqrtf(u1 * (1.0f / DM) + EPS);
#pragma unroll
            for (int j = 0; j < 4; ++j) { x0[j] = x0[j] * t0r * A2[j] + B2[j]; x1[j] = x1[j] * t1r * A2[j] + B2[j]; }
            if constexpr (MODE == 1 && (IN_I8 & 2)) { st16i8((unsigned char*)H + (size_t)UROW(ra) * DM, x0, F.lane, I8_XI); st16i8((unsigned char*)H + (size_t)UROW(rb) * DM, x1, F.lane, I8_XI); }
            else if constexpr (MODE == 2 && MOE_F8 && MOE_I8UP) { st16i8((unsigned char*)H + (size_t)ra * DM, x0, F.lane); st16i8((unsigned char*)H + (size_t)rb * DM, x1, F.lane); }
            else if constexpr (MODE == 0 && DENSE_I8UP && !DENSE_F8) { st16i8((unsigned char*)H + (size_t)UROW(ra) * DM, x0, F.lane); st16i8((unsigned char*)H + (size_t)UROW(rb) * DM, x1, F.lane); }
            else if constexpr ((MODE == 1 && !IN1_F8) || (MODE == 0 && !DENSE_F8) || (MODE == 2 && !MOE_F8)) { st16b(H + (size_t)(MODE == 2 ? ra : UROW(ra)) * DM, x0, F.lane); st16b(H + (size_t)(MODE == 2 ? rb : UROW(rb)) * DM, x1, F.lane); }
            else { st16f8((unsigned char*)H + (size_t)(MODE == 2 ? ra : UROW(ra)) * DM, x0, F.lane); st16f8((unsigned char*)H + (size_t)(MODE == 2 ? rb : UROW(rb)) * DM, x1, F.lane); }
            if constexpr (MODE == 2) {
                asm volatile("" ::: "memory");
                float lgA[8], lgB[8];
#pragma unroll
                for (int e = 0; e < 8; ++e) { float pA = 0.f, pB = 0.f;
#pragma unroll
                    for (int j = 0; j < 4; ++j) { const f32x4 rv = *(const LAS f32x4*)(rts + e * 1024 + ROWCOL(j) + 8 * F.lane);
                        pA += (x0[j][0] * rv[0] + x0[j][1] * rv[1]) + (x0[j][2] * rv[2] + x0[j][3] * rv[3]); pB += (x1[j][0] * rv[0] + x1[j][1] * rv[1]) + (x1[j][2] * rv[2] + x1[j][3] * rv[3]); }
                    wave_sum2(pA, pB); lgA[e] = pA; lgB[e] = pB; }
#define TOP2(lg, rrow) do { int i0 = 0; float v0 = lg[0]; _Pragma("unroll") for (int e = 1; e < 8; ++e) if (lg[e] > v0) { v0 = lg[e]; i0 = e; } \
                    int i1 = -1; float v1 = -INFINITY; _Pragma("unroll") for (int e = 0; e < 8; ++e) if (e != i0 && lg[e] > v1) { v1 = lg[e]; i1 = e; } \
                    const float w0 = 1.0f / (1.0f + __expf(v1 - v0)); if (F.lane == (rrow)) { myE0 = i0; myE1 = i1; myW0 = w0; myW1 = 1.0f - w0; } } while (0)
                TOP2(lgA, rr); TOP2(lgB, rr + 1);
#undef TOP2
            }
        }
#pragma unroll
        for (int j = 0; j < 4; ++j) { s0[j] = sn0[j]; x0[j] = xn0[j]; s1[j] = sn1[j]; x1[j] = xn1[j]; }
    }
#undef RESID_LOAD
#undef UROW
}
template <int MODE> __device__ __forceinline__ void phase_resid(ArgP a, Frame& F) {
    float* XC = (float*)(a->ws + WS_XC);
    int tstart[9], ecnt[8];
    if constexpr (MODE == 3) moe_prefix(a->ws, tstart, ecnt); else {
#pragma unroll
        for (int e = 0; e < 9; ++e) tstart[e] = 0; }
    int myE0 = -1, myE1 = -1; float myW0 = 0.f, myW1 = 0.f;
    if constexpr (MODE < 2) {
        if (F.gw < NLAT) resid_rows<MODE>(a, F, F.gw, F.NGW, NLAT / F.NGW, false, tstart, myE0, myE1, myW0, myW1);
        for (int j = F.gw; j < 8 * NB * CTX / 2; j += F.NGW) if ((j & 7) == 0) resid_rows<MODE>(a, F, (j >> 3) * 2, 1, 2, true, tstart, myE0, myE1, myW0, myW1);
    } else {
        LAS float* rts = (LAS float*)F.lds;
        LAS int* wcnt = (LAS int*)(F.lds + 32768);
        LAS int* bbase = (LAS int*)(F.lds + 32768 + 256);
        if constexpr (MODE == 2) { for (int i = F.tid; i < 8192; i += 512) { const int k = i >> 3, e = i & 7; rts[e * 1024 + k] = a->in[I_ROUTER][i]; } __syncthreads(); }
        const int per = NLAT / F.NGW;
        for (int rd = 0; rd < 1; ++rd) {
            const bool active = F.gw < NLAT;
            myE0 = -1; myE1 = -1;
            if (active) resid_rows<MODE>(a, F, F.gw, F.NGW, per, false, tstart, myE0, myE1, myW0, myW1);
            if constexpr (MODE == 2) {
                int tid2 = F.tid; asm volatile("" : "+v"(tid2)); const int lane2 = tid2 & 63;
                if (lane2 < 8) wcnt[F.wave * 8 + lane2] = 0;
                LDS_WAIT();
                int r0 = 0, r1 = 0;
                if (active && lane2 < per) { r0 = __hip_atomic_fetch_add(wcnt + F.wave * 8 + myE0, 1, __ATOMIC_RELAXED, __HIP_MEMORY_SCOPE_WORKGROUP); r1 = __hip_atomic_fetch_add(wcnt + F.wave * 8 + myE1, 1, __ATOMIC_RELAXED, __HIP_MEMORY_SCOPE_WORKGROUP); }
                __syncthreads();
                if (tid2 < 8) { int tot = 0; for (int w = 0; w < 8; ++w) tot += wcnt[w * 8 + tid2];
                    int base = 0; if (tot > 0) base = (int)__hip_atomic_fetch_add((unsigned*)(a->ws + WS_CTL) + CW_CNT + 64 * tid2, (unsigned)tot, RLX_AGENT);
                    bbase[tid2] = base; }
                __syncthreads();
                if (active && lane2 < per) {
                    int wb0 = bbase[myE0], wb1 = bbase[myE1];
                    for (int w = 0; w < F.wave; ++w) { wb0 += wcnt[w * 8 + myE0]; wb1 += wcnt[w * 8 + myE1]; }
                    const int lp0 = wb0 + r0, lp1 = wb1 + r1;
                    const int tk = F.gw + lane2 * F.NGW; int* lists = (int*)(a->ws + WS_LIST);
                    lists[myE0 * LISTCAP + lp0] = tk; lists[myE1 * LISTCAP + lp1] = tk;
                    v4u ti; ti.x = (unsigned)myE0; ti.y = (unsigned)lp0; ti.z = (unsigned)myE1; ti.w = (unsigned)lp1;
                    *(v4u*)(a->ws + WS_TOK + (size_t)tk * 32) = ti; *(float*)(a->ws + WS_TOK + (size_t)tk * 32 + 16) = myW0; *(float*)(a->ws + WS_TOK + (size_t)tk * 32 + 20) = myW1;
                }
                __syncthreads();
            }
        }
    }
}
typedef float f32x16v __attribute__((ext_vector_type(16)));
__device__ __forceinline__ int crow32(int r, int hi) { return (r & 3) + 8 * (r >> 2) + 4 * hi; }
__device__ __forceinline__ int chain_id(int b, int h, int dir) { return (b * 4 + h) * 2 + dir; }

__device__ __forceinline__ void phase_prep(ArgP a, Frame& F, int l) {
    const bf16* P = (const bf16*)(a->ws + WS_AR + AR_P);
    bf16* QB = (bf16*)(a->ws + WS_AR + AR_QB); bf16* KC = (bf16*)(a->ws + WS_AR + AR_KC); bf16* VC = (bf16*)(a->ws + WS_AR + AR_VC);
    unsigned char* Q8 = q8_ptr(a); unsigned char* K8 = k8_ptr(a); unsigned char* V8 = v8_ptr(a);
    const float* ropec = (const float*)(a->ws + WS_ROPE); const float* ropes = ropec + 4096;
    {
        const int rr = F.lane >> 3, c = F.lane & 7;
        float gq[8], gk[8];
#pragma unroll
        for (int j = 0; j < 8; ++j) { gq[j] = a->in[I_QN][l * 64 + 8 * c + j]; gk[j] = a->in[I_KN][l * 64 + 8 * c + j]; }
        for (int it = F.gw; it < NR / 8; it += F.NGW) {
            const int row = it * 8 + rr; const int b = row / RB, jj = row - b * RB; const bool lat = jj >= CTX; const int t = jj - CTX;
            float cs[8], sn[8];
            if (lat) { const int pos = (c < 4) ? (t >> 6) : (t & 63); const int fi = 8 * (c & 1);
#pragma unroll
                for (int j = 0; j < 8; ++j) { cs[j] = ropec[pos * 16 + fi + j]; sn[j] = ropes[pos * 16 + fi + j]; } }
            else {
#pragma unroll
                for (int j = 0; j < 8; ++j) { cs[j] = 1.f; sn[j] = 0.f; } }
            const float sgn = (c & 2) ? 1.f : -1.f;
            const bf16* prow = P + (size_t)row * INW;
#pragma unroll 2
            for (int hs = 0; hs < 10; ++hs) {
                const v4u u = *(const v4u*)(prow + hs * 64 + 8 * c);
                float x[8] = {bf_lo(u.x), bf_hi(u.x), bf_lo(u.y), bf_hi(u.y), bf_lo(u.z), bf_hi(u.z), bf_lo(u.w), bf_hi(u.w)};
                float ss = 0.f;
#pragma unroll
                for (int j = 0; j < 8; ++j) ss += x[j] * x[j];
                ss += shx<1>(ss); ss += shx<2>(ss); ss += shx<4>(ss);
                const float rstd = 1.0f / sqrtf(ss * (1.0f / 64.0f) + EPS);
                float y[8];
#pragma unroll
                for (int j = 0; j < 8; ++j) { y[j] = x[j] * rstd * (hs < 8 ? gq[j] : gk[j]); }
#pragma unroll
                for (int j = 0; j < 8; ++j) { const float p = shx<2>(y[j]); x[j] = y[j] * cs[j] + sgn * p * sn[j]; }
                const float sc = (hs < 8) ? attn_body::C2 : 1.0f;
#if ATT8_DEBUG
                { v4u o; o.x = pkbf(x[0] * sc, x[1] * sc); o.y = pkbf(x[2] * sc, x[3] * sc); o.z = pkbf(x[4] * sc, x[5] * sc); o.w = pkbf(x[6] * sc, x[7] * sc);
                if (hs < 8) *(v4u*)(QB + (size_t)row * 512 + hs * 64 + 8 * c) = o;
                else *(v4u*)(KC + ((size_t)(b * 2 + (hs - 8)) * RB + jj) * 64 + 8 * c) = o; }
#endif
                { const float s8 = (hs < 8) ? 4.0f * sc : sc;
                  v2u o8; o8.x = fp8x4(x[0] * s8, x[1] * s8, x[2] * s8, x[3] * s8); o8.y = fp8x4(x[4] * s8, x[5] * s8, x[6] * s8, x[7] * s8);
                if (hs < 8) *(v2u*)(Q8 + (size_t)row * 512 + hs * 64 + 8 * c) = o8;
                else *(v2u*)(K8 + ((size_t)((b * 2 + (hs - 8)) * (RB / 64) + (jj >> 6))) * 4096 + (c >> 1) * 1024 + (jj & 63) * 16 + 8 * (c & 1)) = o8; }
            }
#if ATT8_DEBUG
#pragma unroll
            for (int kv = 0; kv < 2; ++kv) *(v4u*)(VC + ((size_t)(b * 2 + kv) * RB + jj) * 64 + 8 * c) = *(const v4u*)(prow + PC_V + kv * 64 + 8 * c);
#endif
        }
    }
    for (int it = F.gw; it < NR / 32; it += F.NGW) {
        const int b = it / (RB / 32), g = it - b * (RB / 32), tile = g >> 1, c2 = g & 1, kv = F.lane >> 5, kg = (F.lane >> 4) & 1, d4 = F.lane & 15;
        const bf16* src = P + (size_t)(b * RB + 32 * g + 4 * kg) * INW + PC_V + kv * 64 + 4 * d4;
        v2u u[16];
#pragma unroll
        for (int j = 0; j < 16; ++j) u[j] = *(const v2u*)(src + (size_t)((j & 3) + 8 * (j >> 2)) * INW);
        unsigned char* dst = V8 + ((size_t)((b * 2 + kv) * (RB / 64) + tile)) * 4096 + ((kg * 2 + c2) * 64 + 4 * d4) * 16;
        v4u o0, o1, o2, o3;
        o0.x = fp8x4(bf_lo(u[0].x), bf_lo(u[1].x), bf_lo(u[2].x), bf_lo(u[3].x)); o0.y = fp8x4(bf_lo(u[4].x), bf_lo(u[5].x), bf_lo(u[6].x), bf_lo(u[7].x)); o0.z = fp8x4(bf_lo(u[8].x), bf_lo(u[9].x), bf_lo(u[10].x), bf_lo(u[11].x)); o0.w = fp8x4(bf_lo(u[12].x), bf_lo(u[13].x), bf_lo(u[14].x), bf_lo(u[15].x));
        o1.x = fp8x4(bf_hi(u[0].x), bf_hi(u[1].x), bf_hi(u[2].x), bf_hi(u[3].x)); o1.y = fp8x4(bf_hi(u[4].x), bf_hi(u[5].x), bf_hi(u[6].x), bf_hi(u[7].x)); o1.z = fp8x4(bf_hi(u[8].x), bf_hi(u[9].x), bf_hi(u[10].x), bf_hi(u[11].x)); o1.w = fp8x4(bf_hi(u[12].x), bf_hi(u[13].x), bf_hi(u[14].x), bf_hi(u[15].x));
        o2.x = fp8x4(bf_lo(u[0].y), bf_lo(u[1].y), bf_lo(u[2].y), bf_lo(u[3].y)); o2.y = fp8x4(bf_lo(u[4].y), bf_lo(u[5].y), bf_lo(u[6].y), bf_lo(u[7].y)); o2.z = fp8x4(bf_lo(u[8].y), bf_lo(u[9].y), bf_lo(u[10].y), bf_lo(u[11].y)); o2.w = fp8x4(bf_lo(u[12].y), bf_lo(u[13].y), bf_lo(u[14].y), bf_lo(u[15].y));
        o3.x = fp8x4(bf_hi(u[0].y), bf_hi(u[1].y), bf_hi(u[2].y), bf_hi(u[3].y)); o3.y = fp8x4(bf_hi(u[4].y), bf_hi(u[5].y), bf_hi(u[6].y), bf_hi(u[7].y)); o3.z = fp8x4(bf_hi(u[8].y), bf_hi(u[9].y), bf_hi(u[10].y), bf_hi(u[11].y)); o3.w = fp8x4(bf_hi(u[12].y), bf_hi(u[13].y), bf_hi(u[14].y), bf_hi(u[15].y));
        *(v4u*)(dst) = o0; *(v4u*)(dst + 16) = o1; *(v4u*)(dst + 32) = o2; *(v4u*)(dst + 48) = o3;
    }
    __syncthreads();
    typedef short bf16x8_t __attribute__((ext_vector_type(8)));
    LAS unsigned char* VT = F.lds; LAS unsigned char* KTf = F.lds + 17536; LAS unsigned char* KTb = F.lds + 2 * 17536;
    float* US = (float*)(a->ws + WS_AR + AR_US);
    for (int it = F.bx; it < NB * 4 * NCH; it += F.G) {
        const int c = it % NCH, bh = it / NCH, b = bh >> 2, h = bh & 3;
        const float lgf = ((const float*)(a->ws + WS_DEC))[l * 8 + h], lgb = ((const float*)(a->ws + WS_DEC))[l * 8 + 4 + h];
        { const int p = F.tid >> 2, sg = F.tid & 3; const bf16* prow = P + (size_t)(b * RB + c * 128 + p) * INW;
            const float zf = __expf(lgf * (float)(127 - p)) * 0.125f, zb = __expf(lgb * (float)p) * 0.125f;
#pragma unroll
            for (int q = 0; q < 2; ++q) { const v4u uk = *(const v4u*)(prow + PC_RK + h * 64 + sg * 16 + q * 8), uv = *(const v4u*)(prow + PC_RV + h * 64 + sg * 16 + q * 8);
                const unsigned kw[4] = {uk.x, uk.y, uk.z, uk.w}, vw[4] = {uv.x, uv.y, uv.z, uv.w};
#pragma unroll
                for (int i = 0; i < 8; ++i) { const int ch = sg * 16 + q * 8 + i; const int off = ch * 272 + sg * 32 + 2 * p;
                    const unsigned kwv = kw[i >> 1], vwv = vw[i >> 1]; const float kf = (i & 1) ? bf_hi(kwv) : bf_lo(kwv);
                    *(LAS bf16*)(VT + off) = (bf16)((i & 1) ? (vwv >> 16) : (vwv & 0xffffu));
                    *(LAS bf16*)(KTf + off) = (bf16)(pkbf(kf * zf, 0.f) & 0xffffu); *(LAS bf16*)(KTb + off) = (bf16)(pkbf(kf * zb, 0.f) & 0xffffu); } } }
        __syncthreads();
        { const int dir = F.wave >> 2, di = (F.wave >> 1) & 1, ei = F.wave & 1, r32 = F.lane & 31, hh = F.lane >> 5;
            f32x16v acc; { const float z = pg8::zero_v(); _Pragma("unroll") for (int r = 0; r < 16; ++r) acc[r] = z; }
            const int erow = 32 * ei + r32, drow = 32 * di + r32;
            const LAS unsigned char* ap = VT + erow * 272 + (erow >> 4) * 32 + 16 * hh; const LAS unsigned char* bp = (dir ? KTb : KTf) + drow * 272 + (drow >> 4) * 32 + 16 * hh;
#pragma unroll
            for (int s8 = 0; s8 < 8; ++s8) { const bf16x8_t av = *(const LAS bf16x8_t*)(ap + 32 * s8), bv = *(const LAS bf16x8_t*)(bp + 32 * s8);
                acc = __builtin_amdgcn_mfma_f32_32x32x16_bf16(av, bv, acc, 0, 0, 0); }
            float* dst = US + ((size_t)(chain_id(b, h, dir) * NCH + c)) * 4096;
#pragma unroll
            for (int r = 0; r < 16; ++r) dst[(32 * ei + crow32(r, hh)) * 64 + 32 * di + r32] = acc[r]; }
        __syncthreads();
    }
}

__device__ __forceinline__ void phase_scan(ArgP a, Frame& F, int l) {
    float* US = (float*)(a->ws + WS_AR + AR_US);
    if (F.tid < 256) {
        for (int id = F.bx * 256 + F.tid; id < 16 * 4096; id += F.G * 256) {
            const int chain = id >> 12, e = id & 4095, dir = chain & 1, h = (chain >> 1) & 3;
            const float dec = ((const float*)(a->ws + WS_DEC))[16 + l * 8 + dir * 4 + h];
            const float* base = US + (size_t)chain * NCH * 4096 + e; float st = 0.f;
            bf16* sb = (bf16*)(a->ws + WS_AR + AR_MX) + (size_t)chain * NCH * 4096 + e;
            for (int s0 = 0; s0 < NCH; s0 += 10) { float u[10]; int ci[10];
#pragma unroll
                for (int q = 0; q < 10; ++q) { const int s = s0 + q; ci[q] = dir == 0 ? s : (s < 2 ? 1 - s : NCH + 1 - s); u[q] = base[(size_t)ci[q] * 4096]; }
#pragma unroll
                for (int q = 0; q < 10; ++q) { sb[(size_t)ci[q] * 4096] = (bf16)(pkbf(st, 0.f) & 0xffffu); st = dec * st + u[q]; } }
        }
    }
}

__device__ __forceinline__ void ret_out_item(ArgP a, Frame& F, int l, int b, int c, int hp, int buf) {
    typedef short bf16x8_t __attribute__((ext_vector_type(8)));
    const bf16* P = (const bf16*)(a->ws + WS_AR + AR_P); bf16* MIX = (bf16*)(a->ws + WS_AR + AR_MIX);
    LAS bf16* VT = (LAS bf16*)(F.lds + buf * 34816);
    const int hl = F.wave >> 2, head = 2 * hp + hl, pi = F.wave & 3, r32 = F.lane & 31, hh = F.lane >> 5;
    const int row0 = b * RB + c * 128;
    { const int m = F.tid >> 2, qd = F.tid & 3; const bf16* src = P + (size_t)(row0 + m) * INW + PC_RV + (2 * hp) * 64 + 32 * qd;
        LAS bf16* dst = VT + (size_t)((qd >> 1) * 64 + 32 * (qd & 1)) * 132 + m;
#pragma unroll
        for (int q = 0; q < 4; ++q) { const v4u u = *(const v4u*)(src + 8 * q);
            dst[(8 * q + 0) * 132] = (bf16)(u.x & 0xffffu); dst[(8 * q + 1) * 132] = (bf16)(u.x >> 16); dst[(8 * q + 2) * 132] = (bf16)(u.y & 0xffffu); dst[(8 * q + 3) * 132] = (bf16)(u.y >> 16);
            dst[(8 * q + 4) * 132] = (bf16)(u.z & 0xffffu); dst[(8 * q + 5) * 132] = (bf16)(u.z >> 16); dst[(8 * q + 6) * 132] = (bf16)(u.w & 0xffffu); dst[(8 * q + 7) * 132] = (bf16)(u.w >> 16); } }
    bf16x8_t qf[4], kf[4][4];
    { const bf16* qrow = P + (size_t)(row0 + 32 * pi + r32) * INW + PC_RQ + head * 64 + 8 * hh;
#pragma unroll
        for (int d0 = 0; d0 < 4; ++d0) qf[d0] = *(const bf16x8_t*)(qrow + 16 * d0);
#pragma unroll
        for (int mb = 0; mb < 4; ++mb) { const bf16* krow = P + (size_t)(row0 + 32 * mb + r32) * INW + PC_RK + head * 64 + 8 * hh;
#pragma unroll
            for (int d0 = 0; d0 < 4; ++d0) kf[mb][d0] = *(const bf16x8_t*)(krow + 16 * d0); } }
    const float L2E = 1.4426950408889634f;
    const float lgf2 = ((const float*)(a->ws + WS_DEC))[l * 8 + head] * L2E, lgb2 = ((const float*)(a->ws + WS_DEC))[l * 8 + 4 + head] * L2E;
    int p = 32 * pi + r32; asm volatile("" : "+v"(p));
    bf16x8_t pk[8];
#pragma unroll
    for (int mb = 0; mb < 4; ++mb) {
        f32x16v st; { const float z = pg8::zero_v(); _Pragma("unroll") for (int r = 0; r < 16; ++r) st[r] = z; }
#pragma unroll
        for (int d0 = 0; d0 < 4; ++d0) st = __builtin_amdgcn_mfma_f32_32x32x16_bf16(kf[mb][d0], qf[d0], st, 0, 0, 0);
#pragma unroll
        for (int r = 0; r < 16; ++r) { const float fd = (float)(p - (32 * mb + crow32(r, hh)));
            const float arg = lgf2 * fmaxf(fd, 0.f) + lgb2 * fmaxf(-fd, 0.f) + fmaxf(1.0f - fabsf(fd), 0.f) - 3.0f;
            st[r] = st[r] * __builtin_amdgcn_exp2f(arg); }
        v4u w0, w1; w0.x = pkbf(st[0], st[1]); w0.y = pkbf(st[2], st[3]); w0.z = pkbf(st[4], st[5]); w0.w = pkbf(st[6], st[7]);
        w1.x = pkbf(st[8], st[9]); w1.y = pkbf(st[10], st[11]); w1.z = pkbf(st[12], st[13]); w1.w = pkbf(st[14], st[15]);
        pk[2 * mb] = __builtin_bit_cast(bf16x8_t, w0); pk[2 * mb + 1] = __builtin_bit_cast(bf16x8_t, w1);
    }
    __builtin_amdgcn_sched_barrier(0);
    const float ef = __builtin_amdgcn_exp2f(lgf2 * (float)(p + 1)), ebk = __builtin_amdgcn_exp2f(lgb2 * (float)(128 - p));
    f32x16v ot[2];
    { const float z = pg8::zero_v(); _Pragma("unroll") for (int r = 0; r < 16; ++r) { ot[0][r] = z; ot[1][r] = z; } }
    { const bf16* SB = (const bf16*)(a->ws + WS_AR + AR_MX);
      const bf16* Sf = SB + ((size_t)(chain_id(b, head, 0) * NCH + c)) * 4096; const bf16* Sb = SB + ((size_t)(chain_id(b, head, 1) * NCH + c)) * 4096;
#pragma unroll
        for (int s4 = 0; s4 < 4; ++s4) {
            const v4u qu = __builtin_bit_cast(v4u, qf[s4]); v4u qa, qb;
            qa.x = pkbf(bf_lo(qu.x) * ef, bf_hi(qu.x) * ef); qa.y = pkbf(bf_lo(qu.y) * ef, bf_hi(qu.y) * ef); qa.z = pkbf(bf_lo(qu.z) * ef, bf_hi(qu.z) * ef); qa.w = pkbf(bf_lo(qu.w) * ef, bf_hi(qu.w) * ef);
            qb.x = pkbf(bf_lo(qu.x) * ebk, bf_hi(qu.x) * ebk); qb.y = pkbf(bf_lo(qu.y) * ebk, bf_hi(qu.y) * ebk); qb.z = pkbf(bf_lo(qu.z) * ebk, bf_hi(qu.z) * ebk); qb.w = pkbf(bf_lo(qu.w) * ebk, bf_hi(qu.w) * ebk);
#pragma unroll
            for (int eb = 0; eb < 2; ++eb) { const int off = (32 * eb + r32) * 64 + 16 * s4 + 8 * hh;
                const bf16x8_t wf = *(const bf16x8_t*)(Sf + off), wb = *(const bf16x8_t*)(Sb + off);
                ot[eb] = __builtin_amdgcn_mfma_f32_32x32x16_bf16(wf, __builtin_bit_cast(bf16x8_t, qa), ot[eb], 0, 0, 0);
                ot[eb] = __builtin_amdgcn_mfma_f32_32x32x16_bf16(wb, __builtin_bit_cast(bf16x8_t, qb), ot[eb], 0, 0, 0); } } }
    __builtin_amdgcn_sched_barrier(0);
    __syncthreads();
    { const LAS bf16* vrow = VT + (size_t)(hl * 64 + r32) * 132 + 4 * hh;
#pragma unroll
        for (int eb = 0; eb < 2; ++eb)
#pragma unroll
            for (int sg = 0; sg < 8; ++sg) { const LAS bf16* vp = vrow + (size_t)(32 * eb) * 132 + 16 * sg;
                const v2u lo = *(const LAS v2u*)vp, hi = *(const LAS v2u*)(vp + 8);
                const v4u av = (v4u){lo.x, lo.y, hi.x, hi.y};
                ot[eb] = __builtin_amdgcn_mfma_f32_32x32x16_bf16(__builtin_bit_cast(bf16x8_t, av), pk[sg], ot[eb], 0, 0, 0); } }
    __builtin_amdgcn_sched_barrier(0);
    float s1 = 0.f, s2 = 0.f;
#pragma unroll
    for (int eb = 0; eb < 2; ++eb)
#pragma unroll
        for (int r = 0; r < 16; ++r) { const float v = ot[eb][r]; s1 += v; s2 += v * v; }
    { auto rr = __builtin_amdgcn_permlane32_swap(__float_as_uint(s1), __float_as_uint(s1), false, false); s1 = __uint_as_float(rr[0]) + __uint_as_float(rr[1]); }
    { auto rr = __builtin_amdgcn_permlane32_swap(__float_as_uint(s2), __float_as_uint(s2), false, false); s2 = __uint_as_float(rr[0]) + __uint_as_float(rr[1]); }
    const float mu = s1 * (1.0f / 64.0f); const float var = fmaxf(s2 * (1.0f / 64.0f) - mu * mu, 0.f); const float rstd = 1.0f / sqrtf(var + EPS);
    const size_t orow = (size_t)(row0 + p);
#pragma unroll
    for (int eb = 0; eb < 2; ++eb)
#pragma unroll
        for (int g = 0; g < 4; ++g) { const int e0 = 32 * eb + 8 * g + 4 * hh;
            const v2u gu = *(const v2u*)(P + orow * INW + PC_RG + head * 64 + e0);
            const float g0 = bf_lo(gu.x), g1 = bf_hi(gu.x), g2 = bf_lo(gu.y), g3 = bf_hi(gu.y);
            v2u w; w.x = pkbf(siluf(g0) * ((ot[eb][4 * g] - mu) * rstd), siluf(g1) * ((ot[eb][4 * g + 1] - mu) * rstd)); w.y = pkbf(siluf(g2) * ((ot[eb][4 * g + 2] - mu) * rstd), siluf(g3) * ((ot[eb][4 * g + 3] - mu) * rstd));
            *(v2u*)(MIX + orow * DM + 512 + head * 64 + e0) = w; }
}
__device__ __forceinline__ void pool_item(ArgP a, Frame& F, int l, int b, int tl, int g) {
    typedef short bf16x8_t __attribute__((ext_vector_type(8)));
    const bf16* P = (const bf16*)(a->ws + WS_AR + AR_P); bf16* MIX = (bf16*)(a->ws + WS_AR + AR_MIX);
    LAS bf16* msb = (LAS bf16*)F.lds;
    LAS bf16* wt = (LAS bf16*)(F.lds + 18432);
    LAS bf16* ost = (LAS bf16*)(F.lds + 18432 + 9216);
    const int sb = (tl < 2) ? 0 : CTX, T = (tl < 2) ? CTX : SEQ, hw = 1 << g  ;
    { const int d = F.tid & 63, cq = F.tid >> 6; const float* W = a->in[I_POOLW] + ((size_t)(l * 4 + g)) * 4096 + d;
        v4u o; o.x = pkbf(W[(8 * cq + 0) * 64], W[(8 * cq + 1) * 64]); o.y = pkbf(W[(8 * cq + 2) * 64], W[(8 * cq + 3) * 64]); o.z = pkbf(W[(8 * cq + 4) * 64], W[(8 * cq + 5) * 64]); o.w = pkbf(W[(8 * cq + 6) * 64], W[(8 * cq + 7) * 64]);
        *(LAS v4u*)(wt + d * 72 + 8 * cq) = o; }
    { const int p = F.tid >> 2, qd = F.tid & 3; const int t = tl * 128 - sb + p; const int lo = max(t - hw, 0), hi = min(t + hw, T);
        float acc[16];
#pragma unroll
        for (int e = 0; e < 16; ++e) acc[e] = 0.f;
        const bf16* colp = P + (size_t)(b * RB + sb) * INW + PC_PP + g * 64 + 16 * qd;
        for (int tt = lo; tt < hi; ++tt) { const v4u u0 = *(const v4u*)(colp + (size_t)tt * INW), u1 = *(const v4u*)(colp + (size_t)tt * INW + 8);
            acc[0] += bf_lo(u0.x); acc[1] += bf_hi(u0.x); acc[2] += bf_lo(u0.y); acc[3] += bf_hi(u0.y); acc[4] += bf_lo(u0.z); acc[5] += bf_hi(u0.z); acc[6] += bf_lo(u0.w); acc[7] += bf_hi(u0.w);
            acc[8] += bf_lo(u1.x); acc[9] += bf_hi(u1.x); acc[10] += bf_lo(u1.y); acc[11] += bf_hi(u1.y); acc[12] += bf_lo(u1.z); acc[13] += bf_hi(u1.z); acc[14] += bf_lo(u1.w); acc[15] += bf_hi(u1.w); }
        const v4u s0 = *(const v4u*)(colp + (size_t)t * INW), s1 = *(const v4u*)(colp + (size_t)t * INW + 8);
        const float sf[16] = {bf_lo(s0.x), bf_hi(s0.x), bf_lo(s0.y), bf_hi(s0.y), bf_lo(s0.z), bf_hi(s0.z), bf_lo(s0.w), bf_hi(s0.w), bf_lo(s1.x), bf_hi(s1.x), bf_lo(s1.y), bf_hi(s1.y), bf_lo(s1.z), bf_hi(s1.z), bf_lo(s1.w), bf_hi(s1.w)};
        const float inv = 1.0f / (float)(hi - lo);
        float m[16];
#pragma unroll
        for (int e = 0; e < 16; ++e) m[e] = acc[e] * inv - sf[e];
        v4u o0, o1; o0.x = pkbf(m[0], m[1]); o0.y = pkbf(m[2], m[3]); o0.z = pkbf(m[4], m[5]); o0.w = pkbf(m[6], m[7]); o1.x = pkbf(m[8], m[9]); o1.y = pkbf(m[10], m[11]); o1.z = pkbf(m[12], m[13]); o1.w = pkbf(m[14], m[15]);
        *(LAS v4u*)(msb + p * 72 + 16 * qd) = o0; *(LAS v4u*)(msb + p * 72 + 16 * qd + 8) = o1; }
    __syncthreads();
    { const int pi = F.wave >> 1, di = F.wave & 1, i = F.lane & 31, kk = F.lane >> 5; f32x16v o; { const float z = pg8::zero_v(); _Pragma("unroll") for (int r = 0; r < 16; ++r) o[r] = z; }
        const LAS bf16* ap = msb + (32 * pi + i) * 72 + 8 * kk; const LAS bf16* bp = wt + (32 * di + i) * 72 + 8 * kk;
#pragma unroll
        for (int s4 = 0; s4 < 4; ++s4) o = __builtin_amdgcn_mfma_f32_32x32x16_bf16(*(const LAS bf16x8_t*)(ap + 16 * s4), *(const LAS bf16x8_t*)(bp + 16 * s4), o, 0, 0, 0);
        const float scl = a->in[I_POOLS][l * 256 + g * 64 + 32 * di + i];
#pragma unroll
        for (int r = 0; r < 16; ++r) ost[(32 * pi + crow32(r, kk)) * 72 + 32 * di + i] = (bf16)(pkbf(o[r] * scl, 0.f) & 0xffffu); }
    __syncthreads();
    { bf16* obase = MIX + (size_t)(b * RB + tl * 128) * DM + 768 + g * 64;
#pragma unroll
        for (int k = 0; k < 2; ++k) { const int idx = F.tid + 512 * k, row = idx >> 3, ch = idx & 7; *(v4u*)(obase + (size_t)row * DM + 8 * ch) = *(const LAS v4u*)(ost + row * 72 + 8 * ch); } }
    __syncthreads();
}
__device__ __forceinline__ void phase_mix(ArgP a, Frame& F, int l, int vcu) {
    { int nb = 0;
      for (int it = F.bx; it < NB * NCH * 2; it += F.G) { const int hp = it & 1, r = it >> 1, c = r % NCH, b = r / NCH;
          if (l == 1 && c < 2) continue;
          ret_out_item(a, F, l, b, c, hp, nb & 1); ++nb; }
      __syncthreads(); }
    for (int it = (F.bx + F.G - 16) % F.G; it < NB * 4 * NCH; it += F.G) { const int c = it % NCH, bh = it / NCH, b = bh >> 2, hg = bh & 3;
        if (l == 1 && c < 2) continue;
        pool_item(a, F, l, b, c, hg); }
    const bf16* QBp = (const bf16*)(a->ws + WS_AR + AR_QB); const bf16* KC = (const bf16*)(a->ws + WS_AR + AR_KC); const bf16* VC = (const bf16*)(a->ws + WS_AR + AR_VC); bf16* MIX = (bf16*)(a->ws + WS_AR + AR_MIX);
    const unsigned char* Q8 = q8_ptr(a); const unsigned char* K8 = k8_ptr(a); const unsigned char* V8 = v8_ptr(a);
    const int NU = NB * 8 * (SEQ / 256);
    float mref;
    { float gq = fabsf(a->in[I_QN][l * 64 + F.lane]), gk = fabsf(a->in[I_KN][l * 64 + F.lane]);
#pragma unroll
      for (int o = 0; o < 1; ++o) { gq = fmaxf(gq, shx<1>(gq)); gk = fmaxf(gk, shx<1>(gk)); gq = fmaxf(gq, shx<2>(gq)); gk = fmaxf(gk, shx<2>(gk)); gq = fmaxf(gq, shx<4>(gq)); gk = fmaxf(gk, shx<4>(gk));
          gq = fmaxf(gq, shx<8>(gq)); gk = fmaxf(gk, shx<8>(gk)); gq = fmaxf(gq, shx<16>(gq)); gk = fmaxf(gk, shx<16>(gk)); gq = half_max(gq); gk = half_max(gk); }
      mref = fminf(64.0f * gq * gk * attn_body::C2 * 1.01f + 0.125f, 64.0f); mref = __builtin_amdgcn_readfirstlane(mref); }
    for (int i = 0; ; ++i) {
        int u;
        if (F.G == 256) { if (i >= 4) break; const int x = vcu >> 5, cu = vcu & 31; const int grp = x >> 1; u = grp * 256 + (x & 1) * 128 + cu * 4 + i; }
        else { u = F.bx + i * F.G; if (u >= NU) break; }
        const int grp = u >> 8, w = u & 255, b = grp >> 1, kvh = grp & 1, hd = kvh * 4 + (w >> 6), qb = w & 63;
        const size_t qrow = (size_t)b * RB + CTX + qb * 256;
#if ATT8_DEBUG
        attn_body::attn_unit(F.tid, mref, (const attn_body::bf16*)(QBp + qrow * 512 + hd * 64), 512, (const attn_body::bf16*)(KC + (size_t)(b * 2 + kvh) * RB * 64), (const attn_body::bf16*)(VC + (size_t)(b * 2 + kvh) * RB * 64), RB / 64,
                                (attn_body::bf16*)(MIX + qrow * DM + hd * 64), DM, (char*)F.lds);
        attn_body::attn_unit8p(F.tid, mref, Q8 + qrow * 512 + hd * 64, 512, K8 + (size_t)(b * 2 + kvh) * (RB / 64) * 4096, V8 + (size_t)(b * 2 + kvh) * (RB / 64) * 4096, RB / 64,
                                (attn_body::bf16*)((bf16*)(a->ws + WS_AR + DO_O8) + qrow * 512 + hd * 64), 512, (char*)F.lds);
#else
        attn_body::attn_unit8p(F.tid, mref, Q8 + qrow * 512 + hd * 64, 512, K8 + (size_t)(b * 2 + kvh) * (RB / 64) * 4096, V8 + (size_t)(b * 2 + kvh) * (RB / 64) * 4096, RB / 64,
                                (attn_body::bf16*)(MIX + qrow * DM + hd * 64), DM, (char*)F.lds);
#endif
    }
    if (l == 0) {
        for (int u = (F.bx + F.G - 32) % F.G; u < NB * 8; u += F.G) { const int b = u >> 3, hd = u & 7, kvh = hd >> 2; const size_t qrow = (size_t)b * RB;
#if ATT8_DEBUG
            attn_body::attn_unit(F.tid, mref, (const attn_body::bf16*)(QBp + qrow * 512 + hd * 64), 512, (const attn_body::bf16*)(KC + (size_t)(b * 2 + kvh) * RB * 64), (const attn_body::bf16*)(VC + (size_t)(b * 2 + kvh) * RB * 64), CTX / 64,
                                    (attn_body::bf16*)(MIX + qrow * DM + hd * 64), DM, (char*)F.lds);
            attn_body::attn_unit8(F.tid, mref, Q8 + qrow * 512 + hd * 64, 512, K8 + (size_t)(b * 2 + kvh) * (RB / 64) * 4096, V8 + (size_t)(b * 2 + kvh) * (RB / 64) * 4096, CTX / 64,
                                    (attn_body::bf16*)((bf16*)(a->ws + WS_AR + DO_O8) + qrow * 512 + hd * 64), 512, (char*)F.lds);
#else
            attn_body::attn_unit8(F.tid, mref, Q8 + qrow * 512 + hd * 64, 512, K8 + (size_t)(b * 2 + kvh) * (RB / 64) * 4096, V8 + (size_t)(b * 2 + kvh) * (RB / 64) * 4096, CTX / 64,
                                    (attn_body::bf16*)(MIX + qrow * DM + hd * 64), DM, (char*)F.lds);
#endif
        }
    }
}
struct PlainSched {
    int nM, nN, G, c, skipctx; const char* A; const char* B; size_t tA, tB;
    __device__ __forceinline__ bool next(int i, pg8::Unit& u) const {
        const long L = (long)i * G + c; if (L >= (long)nM * nN) return false;
        int pm, pn; pg8::deal((int)L, nM, nN, pm, pn); if (skipctx) pm = pm + 1 + (pm >= 64 ? 1 : 0);
        u.pm = pm; u.pn = pn; u.a = A + (size_t)pm * tA; u.b = B + (size_t)pn * tB; u.goff = 0; u.gcnt = 0; return true; }
};
struct CtxSplitSched {
    int nN, nsp, G, c, KL; const char* A; const char* B; size_t tA, tB;
    __device__ __forceinline__ bool next(int i, pg8::Unit& u) const {
        const long L = (long)i * G + c; if (L >= (long)2 * nN * nsp) return false;
        const int ct = (int)L & 1, r = (int)L >> 1, pn = r % nN, ks = r / nN;
        u.pm = 2 * ks + ct; u.pn = pn; u.a = A + (size_t)(ct * 65) * tA + (size_t)ks * KL * 2; u.b = B + (size_t)pn * tB + (size_t)ks * KL * 2; u.goff = 0; u.gcnt = 0; return true; }
};
struct CtxFullSched {
    int nN, G, c; const char* A; const char* B; size_t tA, tB;
    __device__ __forceinline__ bool next(int i, pg8::Unit& u) const {
        const long L = (long)i * G + c; if (L >= (long)2 * nN) return false;
        const int ct = (int)L & 1, pn = (int)L >> 1;
        u.pm = ct * 65; u.pn = pn; u.a = A + (size_t)(ct * 65) * tA; u.b = B + (size_t)pn * tB; u.goff = 0; u.gcnt = 0; return true; }
};
struct MoeSched {
    int nM, nN, G, c, t0, up, c0; const char* A; const char* W; size_t tA, tB, wsz; int ts[9], cnt[8];
    __device__ __forceinline__ bool next(int i, pg8::Unit& u) const {
        long L = (long)i * G + c;
        if (c0 > 0) { const int w = G - c0; const long E = 3L * w; L = (c >= c0) ? ((i < 3) ? (long)i * w + (c - c0) : E + (long)(i - 3) * G + c) : E + (long)i * G + c; }
        if (L >= (long)nM * nN) return false;
        int pml, pn; pg8::deal((int)L, nM, nN, pml, pn); const int rt = t0 + pml;
        int e = 0, tse = 0, ce = cnt[0];
#pragma unroll
        for (int k = 1; k < 8; ++k) { const bool sel = (rt >= ts[k]) && (ts[k + 1] > ts[k]); e = sel ? k : e; tse = sel ? ts[k] : tse; ce = sel ? cnt[k] : ce; }
        const int lt = rt - tse;
        u.pn = pn; u.b = W + (size_t)e * wsz + (size_t)pn * tB;
        if (up) { u.pm = pml; u.a = A; u.goff = e * LISTCAP + lt * 256; const int rem = ce - lt * 256; u.gcnt = rem < 256 ? rem : 256; }
        else { u.pm = rt; u.a = A + (size_t)pml * tA; u.goff = 0; u.gcnt = 0; }
        return true; }
};

#if ATT8_DEBUG
__device__ __forceinline__ void dbg_compare(ArgP a, Frame& F, int l) {
    const bf16* MIX = (const bf16*)(a->ws + WS_AR + AR_MIX); const bf16* O8 = (const bf16*)(a->ws + WS_AR + DO_O8);
    float sd = 0.f, so = 0.f;
    for (int row = F.gw; row < NR; row += F.NGW) { const int b = row / RB, jj = row - b * RB; if (jj < CTX && l == 1) continue;
        const v4u x = *(const v4u*)(MIX + (size_t)row * DM + 8 * F.lane), y = *(const v4u*)(O8 + (size_t)row * 512 + 8 * F.lane);
        const float xv[8] = {bf_lo(x.x), bf_hi(x.x), bf_lo(x.y), bf_hi(x.y), bf_lo(x.z), bf_hi(x.z), bf_lo(x.w), bf_hi(x.w)}, yv[8] = {bf_lo(y.x), bf_hi(y.x), bf_lo(y.y), bf_hi(y.y), bf_lo(y.z), bf_hi(y.z), bf_lo(y.w), bf_hi(y.w)};
#pragma unroll
        for (int j = 0; j < 8; ++j) { const float d = yv[j] - xv[j]; sd += d * d; so += xv[j] * xv[j]; } }
    sd = wave_sum(sd); so = wave_sum(so);
    if (F.lane == 0) { atomicAdd((float*)(a->ws + WS_CTL) + 2048, sd); atomicAdd((float*)(a->ws + WS_CTL) + 2049, so); }
}
#endif
constexpr int N_PHASES_K = 22;
__global__ void __launch_bounds__(NWAVES * 64, 2) mk_fwd(Args a_unused) {
    extern __shared__ __attribute__((aligned(16))) unsigned char lds[];
    Frame F; ArgP a = args_here();
    F.lds = (LAS unsigned char*)lds;
    relaunder(F);
    unsigned* ctl = (unsigned*)(a->ws + WS_CTL);
    for (int u = F.tid; u < (LDS_BYTES - RING_BYTES) / 4; u += NWAVES * 64) ((LAS unsigned*)(F.lds + RING_BYTES))[u] = 0u;
    __syncthreads();
    volatile LAS unsigned* MISC = (volatile LAS unsigned*)(F.lds + MISC_OFF);
    XcdBarrier bar = xcd_barrier_post(ctl + CW_BAR + a->li * XCD_BAR_WORDS, MISC + 8);
    LAS unsigned* gtab = (LAS unsigned*)(F.lds + GTAB_OFF);
    const int lo = a->ph_lo, hi = a->ph_hi; int ph = 0;
#define RUN (a = args_here(), relaunder(F), (ph >= lo && ph < hi))
#ifndef PROF_MASK
#define PROF_MASK 0
#endif
#ifndef PROF_AMP
#define PROF_AMP 10
#endif
#if PROF_MASK
#define PROF_STAMP(k_) do { if (blockIdx.x == 0 && threadIdx.x == 0) ((volatile unsigned long long*)(a->ws + WS_CTL + 32768))[k_] = wall_clock64(); } while (0)
#else
#define PROF_STAMP(k_) do { } while (0)
#endif
#define SEAM() do { if (ph >= lo && ph + 1 < hi) xcd_barrier(bar); ++ph; a = args_here(); PROF_STAMP(ph); } while (0)
    unsigned char* AR = a->ws + WS_AR;
    PROF_STAMP(0);

    if (RUN) phase_p0a(a, F);
    SEAM();
    if (RUN) phase_premix0(a, F);
    SEAM();
#pragma unroll 1
    for (int l = 0; l < 2; ++l) {
        if (RUN) {
            if ((IN_I8 >> l) & 1) {
                PlainSched S{NR / 256, INW / 256, F.G, F.bx, 0, (const char*)(AR + AR_MIX), (const char*)(a->ws + WS_WIN + l * SZ_WIN), (size_t)256 * DM, (size_t)256 * DM};
                pg8::EpiBf16S E{(bf16*)(AR + AR_P), INW, 1.0f / (I8_XI * I8_WS)};
                pg8::gemm_phase<pg8::EpiBf16S, PlainSched, true, false, 2>(F.tid, F.lds, gtab, nullptr, DM / 2, DM / 2, S, E);
            } else if (IN1_F8 && l == 1) {
                PlainSched S{NR / 256, INW / 256, F.G, F.bx, 0, (const char*)(AR + AR_MIX), (const char*)(a->ws + WS_WIN + SZ_WIN), (size_t)256 * DM, (size_t)256 * DM};
                pg8::EpiBf16S E{(bf16*)(AR + AR_P), INW, 1.0f / 64.0f};
                pg8::gemm_phase<pg8::EpiBf16S, PlainSched, true, false, 1>(F.tid, F.lds, gtab, nullptr, DM / 2, DM / 2, S, E);
            } else {
            PlainSched S{NR / 256, INW / 256, F.G, F.bx, 0, (const char*)(AR + AR_MIX), (const char*)(a->ws + WS_WIN + l * SZ_WIN), (size_t)256 * DM * 2, (size_t)256 * DM * 2};
            pg8::EpiBf16 E{(bf16*)(AR + AR_P), INW};
            pg8::gemm_phase<pg8::EpiBf16, PlainSched, true, false>(F.tid, F.lds, gtab, nullptr, DM, DM, S, E); }
        }
        SEAM();
        if (RUN) phase_prep(a, F, l);
        SEAM();
        if (RUN) phase_scan(a, F, l);
        SEAM();
        if (RUN) phase_mix(a, F, l, (F.G % 8 == 0) ? (F.bx % 8) * (F.G / 8) + (F.bx / 8) : F.bx);
        SEAM();
        if (RUN) {
#if ATT8_DEBUG
            dbg_compare(a, F, l);
#endif
            PlainSched S{NLAT / 256, DM / 256, F.G, F.bx, 1, (const char*)(AR + AR_MIX), (const char*)(a->ws + WS_WOUT + l * SZ_WOUT), (size_t)256 * DM * 2, (size_t)256 * DM * 2};
            pg8::EpiBf16 E{(bf16*)(AR + AR_MX), DM};
            pg8::gemm_phase<pg8::EpiBf16, PlainSched, true, false>(F.tid, F.lds, gtab, nullptr, DM, DM, S, E);
            if (l == 0) {
                CtxSplitSched S2{DM / 256, 4, F.G, F.bx, 256, (const char*)(AR + AR_MIX), (const char*)(a->ws + WS_WOUT), (size_t)256 * DM * 2, (size_t)256 * DM * 2};
                pg8::EpiF32 E2{(float*)(AR + AR_PART0), DM};
                pg8::gemm_phase<pg8::EpiF32, CtxSplitSched, true, false>(F.tid, F.lds, gtab, nullptr, DM, 256, S2, E2); }
        }
        SEAM();
        if (l == 0) {
            if (RUN) phase_resid<0>(a, F);
            SEAM();
            if (RUN) {
#if DENSE_F8
                PlainSched S{NR / 256, 2 * FF / 256, F.G, F.bx, 0, (const char*)(AR + AR_HX2), (const char*)(a->ws + WS_W13D), (size_t)256 * DM, (size_t)256 * DM};
                pg8::EpiSwiglu8 E{(unsigned char*)(AR + AR_ACT), FF, 1.0f / 64.0f, 8.0f};
                pg8::gemm_phase<pg8::EpiSwiglu8, PlainSched, true, false, 1>(F.tid, F.lds, gtab, nullptr, DM / 2, DM / 2, S, E);
#elif DENSE_I8UP
                PlainSched S{NR / 256, 2 * FF / 256, F.G, F.bx, 0, (const char*)(AR + AR_HX2), (const char*)(a->ws + WS_W13D), (size_t)256 * DM, (size_t)256 * DM};
#if DENSE_DOWN_F8
                pg8::EpiSwiglu8 E{(unsigned char*)(AR + AR_ACT), FF, 1.0f / (I8_XS * I8_WS), 8.0f};
                pg8::gemm_phase<pg8::EpiSwiglu8, PlainSched, true, false, 2>(F.tid, F.lds, gtab, nullptr, DM / 2, DM / 2, S, E);
#else
                pg8::EpiSwigluS E{(bf16*)(AR + AR_ACT), FF, 1.0f / (I8_XS * I8_WS)};
                pg8::gemm_phase<pg8::EpiSwigluS, PlainSched, true, false, 2>(F.tid, F.lds, gtab, nullptr, DM / 2, DM / 2, S, E);
#endif
#else
                PlainSched S{NR / 256, 2 * FF / 256, F.G, F.bx, 0, (const char*)(AR + AR_HX2), (const char*)(a->ws + WS_W13D), (size_t)256 * DM * 2, (size_t)256 * DM * 2};
                pg8::EpiSwiglu E{(bf16*)(AR + AR_ACT), FF};
                pg8::gemm_phase<pg8::EpiSwiglu, PlainSched, true, false>(F.tid, F.lds, gtab, nullptr, DM, DM, S, E);
#endif
            }
            SEAM();
            if (RUN) {
#if DENSE_F8 || DENSE_DOWN_F8
                PlainSched S{NLAT / 256, DM / 256, F.G, F.bx, 1, (const char*)(AR + AR_ACT), (const char*)(a->ws + WS_W2D), (size_t)256 * FF, (size_t)256 * FF};
                pg8::EpiBf16S E{(bf16*)(AR + AR_YD), DM, 1.0f / 512.0f};
                pg8::gemm_phase<pg8::EpiBf16S, PlainSched, true, false, 1>(F.tid, F.lds, gtab, nullptr, FF / 2, FF / 2, S, E);
#if DENSE_DOWN_F8 && !DENSE_F8
                CtxFullSched S2{DM / 256, F.G, F.bx, (const char*)(AR + AR_ACT), (const char*)(a->ws + WS_W2D), (size_t)256 * FF, (size_t)256 * FF};
                pg8::gemm_phase<pg8::EpiBf16S, CtxFullSched, true, false, 1>(F.tid, F.lds, gtab, nullptr, FF / 2, FF / 2, S2, E);
#else
                CtxSplitSched S2{DM / 256, 11, F.G, F.bx, 128, (const char*)(AR + AR_ACT), (const char*)(a->ws + WS_W2D), (size_t)256 * FF, (size_t)256 * FF};
                pg8::EpiF32S E2{(float*)(AR + AR_PART1), DM, 1.0f / 512.0f};
                pg8::gemm_phase<pg8::EpiF32S, CtxSplitSched, true, false, 1>(F.tid, F.lds, gtab, nullptr, FF / 2, 128, S2, E2);
#endif
#else
                PlainSched S{NLAT / 256, DM / 256, F.G, F.bx, 1, (const char*)(AR + AR_ACT), (const char*)(a->ws + WS_W2D), (size_t)256 * FF * 2, (size_t)256 * FF * 2};
                pg8::EpiBf16 E{(bf16*)(AR + AR_YD), DM};
                pg8::gemm_phase<pg8::EpiBf16, PlainSched, true, false>(F.tid, F.lds, gtab, nullptr, FF, FF, S, E);
                CtxSplitSched S2{DM / 256, 11, F.G, F.bx, 256, (const char*)(AR + AR_ACT), (const char*)(a->ws + WS_W2D), (size_t)256 * FF * 2, (size_t)256 * FF * 2};
                pg8::EpiF32 E2{(float*)(AR + AR_PART1), DM};
                pg8::gemm_phase<pg8::EpiF32, CtxSplitSched, true, false>(F.tid, F.lds, gtab, nullptr, FF, 256, S2, E2);
#endif
            }
            SEAM();
            if (RUN) phase_resid<1>(a, F);
            SEAM();
        } else {
            if (RUN) phase_resid<2>(a, F);
            SEAM();
#pragma unroll 1
            for (int p = 0; p <= MOE_PASSES; ++p) {
                if (RUN) {
                    constexpr size_t ACTB = (size_t)MOE_TP * 256 * FF;
                    int nprev = 0;
                    if (p >= 1) {
                        MoeSched S; moe_prefix(a->ws, S.ts, S.cnt);
                        const int tot = S.ts[8]; int n = tot - (p - 1) * MOE_TP; n = n < 0 ? 0 : (n > MOE_TP ? MOE_TP : n); nprev = n;
                        S.nM = n; S.nN = DM / 256; S.G = F.G; S.c = F.bx; S.t0 = (p - 1) * MOE_TP; S.up = 0; S.c0 = 0; S.A = (const char*)(AR + AR_ACT + ((p - 1) & 1) * ACTB); S.W = (const char*)(a->ws + WS_W2M); S.tA = (size_t)256 * FF; S.tB = (size_t)256 * FF; S.wsz = SZ8_W2;
                        pg8::EpiBf16S E{(bf16*)(AR + AR_YM), DM, 1.0f / 512.0f};
                        pg8::gemm_phase<pg8::EpiBf16S, MoeSched, true, false, 1>(F.tid, F.lds, gtab, nullptr, FF / 2, FF / 2, S, E);
                    }
                    if (p < MOE_PASSES) {
                        a = args_here(); relaunder(F);
                        MoeSched S; moe_prefix(a->ws, S.ts, S.cnt);
                        const int tot = S.ts[8]; int n = tot - p * MOE_TP; n = n < 0 ? 0 : (n > MOE_TP ? MOE_TP : n);
                        S.nM = n; S.nN = 2 * FF / 256; S.G = F.G; S.c = F.bx; S.t0 = p * MOE_TP; S.up = 1; S.A = (const char*)(AR + AR_HX2); S.W = (const char*)(a->ws + WS_W13M); S.tA = 0; S.tB = (size_t)256 * DM; S.wsz = SZ8_W13;
                        { const int nd = nprev * (DM / 256), r = nd % F.G; S.c0 = (r != 0 && 3L * (F.G - r) <= (long)n * S.nN) ? r : 0; }
                        pg8::EpiSwiglu8 E{(unsigned char*)(AR + AR_ACT + (p & 1) * ACTB), FF, MOE_I8UP ? 1.0f / (I8_XS * I8_WS) : 1.0f / 64.0f, 8.0f};
                        pg8::gemm_phase<pg8::EpiSwiglu8, MoeSched, true, true, MOE_I8UP ? 2 : 1>(F.tid, F.lds, gtab, (const int*)(a->ws + WS_LIST), DM / 2, DM / 2, S, E);
                    }
                }
                SEAM();
            }
            if (RUN) phase_resid<3>(a, F);
            ++ph;
        }
    }
#if PROF_MASK
    a = args_here(); relaunder(F);
    if (F.bx == 0 && F.tid == 0) {
        PROF_STAMP(N_PHASES_K);
        const volatile unsigned long long* ts = (const volatile unsigned long long*)(a->ws + WS_CTL + 32768); long long sum = 0;
        for (int k = 0; k < N_PHASES_K; ++k) if ((PROF_MASK >> k) & 1) sum += (long long)(ts[k + 1] - ts[k]);
        const long long ticks = sum * PROF_AMP; const long long t0 = wall_clock64();
        while (wall_clock64() - t0 < ticks) __builtin_amdgcn_s_sleep(32);
    }
#endif
#if ATT8_DEBUG
    a = args_here(); relaunder(F);
    if (F.bx == 0 && F.tid == 0) {
        const float sd = __hip_atomic_load((float*)(a->ws + WS_CTL) + 2048, RLX_AGENT), so = __hip_atomic_load((float*)(a->ws + WS_CTL) + 2049, RLX_AGENT);
        float nl = -__log2f(sd / so); if (!(nl > 0.f)) nl = 0.f; if (nl > 40.f) nl = 40.f;
        const long long ticks = (long long)(nl * 200000.f); const long long t0 = wall_clock64();
        while (wall_clock64() - t0 < ticks) __builtin_amdgcn_s_sleep(32);
    }
#endif
#undef RUN
#undef SEAM
}
constexpr int N_PHASES = 22;

#ifndef DET_PROBE
#define DET_PROBE 0
#endif
#if DET_PROBE
__global__ void det_cksum(const unsigned* out, unsigned long long* dst, int n) {
    unsigned long long s = 0; for (int i = blockIdx.x * blockDim.x + threadIdx.x; i < n; i += gridDim.x * blockDim.x) s += (unsigned long long)out[i] * (unsigned)(2 * (i & 1023) + 1);
    for (int o = 32; o > 0; o >>= 1) s += __shfl_xor(s, o);
    if ((threadIdx.x & 63) == 0) atomicAdd(dst, s);
}
__global__ void det_fill(unsigned* p, size_t n, unsigned v) { for (size_t i = (size_t)blockIdx.x * blockDim.x + threadIdx.x; i < n; i += (size_t)gridDim.x * blockDim.x) p[i] = v; }
__global__ void det_cmp(const unsigned long long* c, float* out) { if (c[0] != c[1]) out[0] = __builtin_nanf(""); }
#endif
#ifndef MK_N_LAUNCHES
#define MK_N_LAUNCHES 1
#endif
extern "C" void kernel_launch(void* const* d_in, const int* in_sizes, int n_in, void* d_out, int out_size, void* d_ws, size_t ws_size, hipStream_t stream) {
    static int grid = 0;
    if (grid == 0) {
        if (n_in != 24 || out_size != NLAT * DM || ws_size < WS_END) { fprintf(stderr, "kernel_launch: unexpected shapes (n_in %d out %d ws %zu)\n", n_in, out_size, ws_size); grid = -1; return; }
        int dev = 0, cus = 0, per_cu = 0;
        if (hipGetDevice(&dev) != hipSuccess || hipDeviceGetAttribute(&cus, hipDeviceAttributeMultiprocessorCount, dev) != hipSuccess) { grid = -1; return; }
        if (hipFuncSetAttribute((const void*)mk_fwd, hipFuncAttributeMaxDynamicSharedMemorySize, LDS_BYTES) != hipSuccess) { fprintf(stderr, "kernel_launch: hipFuncSetAttribute failed\n"); grid = -1; return; }
        if (hipOccupancyMaxActiveBlocksPerMultiprocessor(&per_cu, (const void*)mk_fwd, NWAVES * 64, LDS_BYTES) != hipSuccess || per_cu < 1) fprintf(stderr, "kernel_launch: occupancy query says %d\n", per_cu);
        (void)hipGetLastError();
        grid = cus;
        while (grid > 8 && (NLAT % (2 * grid * NWAVES) != 0 || NLAT / (grid * NWAVES) > 64)) --grid;
    }
    if (grid < 0) return;
    if (hipMemsetAsync((char*)d_ws + WS_CTL, 0, CTL_ZERO_BYTES, stream) != hipSuccess) return;
    Args a{};
    for (int i = 0; i < 24; ++i) a.in[i] = (const float*)d_in[i];
    a.out = (float*)d_out; a.ws = (unsigned char*)d_ws; a.pad = 0;
#if DET_PROBE
    { a.ph_lo = 0; a.ph_hi = N_PHASES; a.li = 0;
      unsigned long long* ck = (unsigned long long*)((char*)d_ws + WS_CTL + 65536);
      hipLaunchKernelGGL(det_fill, dim3(2048), dim3(256), 0, stream, (unsigned*)((char*)d_ws + MiB), (WS_END - MiB) / 4, 0x3C3C3C3Cu);
      hipLaunchKernelGGL(mk_fwd, dim3(grid), dim3(NWAVES * 64), LDS_BYTES, stream, a);
      hipLaunchKernelGGL(det_cksum, dim3(1024), dim3(256), 0, stream, (const unsigned*)d_out, ck, out_size);
      if (hipMemsetAsync((char*)d_ws + WS_CTL, 0, 65536, stream) != hipSuccess) return;
      hipLaunchKernelGGL(det_fill, dim3(2048), dim3(256), 0, stream, (unsigned*)((char*)d_ws + MiB), (WS_END - MiB) / 4, 0xBDBDBDBDu);
      hipLaunchKernelGGL(det_fill, dim3(2048), dim3(256), 0, stream, (unsigned*)d_out, (size_t)out_size, 0xBDBDBDBDu);
      hipLaunchKernelGGL(mk_fwd, dim3(grid), dim3(NWAVES * 64), LDS_BYTES, stream, a);
      hipLaunchKernelGGL(det_cksum, dim3(1024), dim3(256), 0, stream, (const unsigned*)d_out, ck + 1, out_size);
      hipLaunchKernelGGL(det_cmp, dim3(1), dim3(1), 0, stream, (const unsigned long long*)ck, (float*)d_out);
      return; }
#endif
    if (MK_N_LAUNCHES == 1) { a.ph_lo = 0; a.ph_hi = N_PHASES; a.li = 0; hipLaunchKernelGGL(mk_fwd, dim3(grid), dim3(NWAVES * 64), LDS_BYTES, stream, a); }
    else { for (int p = 0; p < N_PHASES; ++p) { a.ph_lo = p; a.ph_hi = p + 1; a.li = p; hipLaunchKernelGGL(mk_fwd, dim3(grid), dim3(NWAVES * 64), LDS_BYTES, stream, a); } }
}
```
